# Optimizing an MI355X kernel written in HIP

```python
import jax, jax.numpy as jnp
from jax import lax
import numpy as np

D_MODEL = 1024
BATCH = 8
SEQ = 4096
DEPTH = 1

CHUNK = 64
Q_BLOCK = 128
RET_HEADS = 4
RET_DK = 128
RET_DV = 128
RET_W = RET_HEADS * RET_DK
RET_VW = RET_HEADS * RET_DV
SB_HEADS = 8
SB_DH = 64
SB_W = SB_HEADS * SB_DH
ROPE_BASE = 10000.0
PLE_DIM = 256
N_GROUPS = 4
EXPERTS_PER_GROUP = 4
N_EXPERTS = N_GROUPS * EXPERTS_PER_GROUP
TOP_K = 2
D_EXPERT = 512
EXPERT_BLOCK = 128
EPS = 1e-6
IN_WIDTHS = (RET_W, RET_W, RET_VW, RET_VW, SB_W, SB_W, SB_W, D_MODEL, D_MODEL)
IN_SPLITS = tuple(int(c) for c in np.cumsum(IN_WIDTHS)[:-1])
W_IN_COLS = sum(IN_WIDTHS)

kernel_name = "hybrid_retention_stickbreak_hmoe_block"


def rms_norm(x, g):
    xf = x.astype(jnp.float32)
    y = xf * lax.rsqrt(jnp.mean(xf * xf, axis=-1, keepdims=True) + EPS) * g.astype(jnp.float32)
    return y.astype(x.dtype)


def apply_rope(t, cos, sin):
    half = t.shape[-1] // 2
    t1, t2 = t[..., :half], t[..., half:]
    c = cos[None, :, None, :]
    s = sin[None, :, None, :]
    return jnp.concatenate([t1 * c - t2 * s, t1 * s + t2 * c], axis=-1)


def retention(q, k, v, gate, gn_gain):
    b, s, h, dk = q.shape
    dv = v.shape[-1]
    nc = s // CHUNK
    gamma = 1.0 - jnp.exp2(-5.0 - jnp.arange(h, dtype=jnp.float32))
    log_g = jnp.log(gamma)
    idx = jnp.arange(CHUNK, dtype=jnp.float32)
    d_intra = jnp.exp(log_g[:, None, None] * jnp.abs(idx[:, None] - idx[None, :]))
    q_dec = jnp.exp(log_g[:, None] * (idx + 1.0))
    k_dec = jnp.exp(log_g[:, None] * (CHUNK - 1.0 - idx))
    c_dec = jnp.exp(log_g * CHUNK)

    def to_chunks(t):
        return t.reshape(b, nc, CHUNK, h, t.shape[-1]).transpose(1, 0, 3, 2, 4)

    qc, kc, vc = to_chunks(q), to_chunks(k), to_chunks(v)

    def step(state, inp):
        qi, ki, vi = inp
        scores = jnp.einsum('bhid,bhjd->bhij', qi, ki) * d_intra
        o = (jnp.einsum('bhij,bhje->bhie', scores, vi)
             + jnp.einsum('bhid,bhde->bhie', qi * q_dec[..., None], state))
        state = c_dec[:, None, None] * state + jnp.einsum('bhjd,bhje->bhde', ki * k_dec[..., None], vi)
        return state, o

    state0 = jnp.zeros((b, h, dk, dv), jnp.float32)
    _, oc = lax.scan(step, state0, (qc, kc, vc))
    o = oc.transpose(1, 0, 3, 2, 4).reshape(b, s, h, dv)
    mu = jnp.mean(o, axis=-1, keepdims=True)
    var = jnp.mean((o - mu) ** 2, axis=-1, keepdims=True)
    o = ((o - mu) * lax.rsqrt(var + EPS)).reshape(b, s, h * dv) * gn_gain.astype(jnp.float32)
    return jax.nn.silu(gate) * o


def stick_breaking(q, k, v):
    b, s, h, d = q.shape
    q = q.transpose(0, 2, 1, 3) * (d ** -0.5)
    k = k.transpose(0, 2, 1, 3)
    v = v.transpose(0, 2, 1, 3)
    outs = []
    for i in range(s // Q_BLOCK):
        kl = (i + 1) * Q_BLOCK
        qb = q[:, :, i * Q_BLOCK:kl]
        z = jnp.einsum('bhtd,bhsd->bhts', qb, k[:, :, :kl])
        t_pos = i * Q_BLOCK + jnp.arange(Q_BLOCK)
        mask = jnp.arange(kl)[None, :] < t_pos[:, None]
        log_keep = jnp.where(mask, jax.nn.log_sigmoid(-z), 0.0)
        later = lax.cumsum(log_keep, axis=3, reverse=True) - log_keep
        a = jnp.where(mask, jnp.exp(jax.nn.log_sigmoid(z) + later), 0.0)
        outs.append(jnp.einsum('bhts,bhsd->bhtd', a, v[:, :, :kl]))
    o = jnp.concatenate(outs, axis=2)
    return o.transpose(0, 2, 1, 3).reshape(b, s, h * d)


def hier_moe(h, w_grp, b_grp, w_exp, b_exp, w_gate, w_up, w_down):
    b, s, dm = h.shape
    n = b * s
    hf = h.reshape(n, dm)
    grp_prob = jax.nn.softmax((hf @ w_grp).astype(jnp.float32) + b_grp.astype(jnp.float32), axis=-1)
    g_idx = jnp.argmax(grp_prob, axis=-1)
    p_grp = jnp.take_along_axis(grp_prob, g_idx[:, None], axis=1)[:, 0]
    exp_logits = ((hf @ w_exp).astype(jnp.float32) + b_exp.astype(jnp.float32)).reshape(n, N_GROUPS, EXPERTS_PER_GROUP)
    in_grp = jnp.take_along_axis(exp_logits, g_idx[:, None, None], axis=1)[:, 0]
    top_p, top_i = lax.top_k(jax.nn.softmax(in_grp, axis=-1), TOP_K)
    weights = top_p / jnp.sum(top_p, axis=-1, keepdims=True) * p_grp[:, None]
    expert_id = g_idx[:, None] * EXPERTS_PER_GROUP + top_i

    a = n * TOP_K
    flat_e = expert_id.reshape(a)
    flat_tok = jnp.repeat(jnp.arange(n, dtype=jnp.int32), TOP_K)
    flat_w = weights.reshape(a)
    order = jnp.argsort(flat_e)
    sorted_e = flat_e[order]
    counts = jax.ops.segment_sum(jnp.ones((a,), jnp.int32), flat_e, num_segments=N_EXPERTS)
    padded = (counts + EXPERT_BLOCK - 1) // EXPERT_BLOCK * EXPERT_BLOCK
    pad_end = jnp.cumsum(padded)
    pad_start = pad_end - padded
    start = jnp.cumsum(counts) - counts
    dest = pad_start[sorted_e] + (jnp.arange(a, dtype=jnp.int32) - start[sorted_e])
    m = a + N_EXPERTS * EXPERT_BLOCK
    nb = m // EXPERT_BLOCK
    buf_tok = jnp.zeros((m,), jnp.int32).at[dest].set(flat_tok[order])
    buf_w = jnp.zeros((m,), jnp.float32).at[dest].set(flat_w[order])
    block_e = jnp.minimum(
        jnp.searchsorted(pad_end, jnp.arange(nb, dtype=jnp.int32) * EXPERT_BLOCK, side='right'),
        N_EXPERTS - 1)
    xb = hf[buf_tok].reshape(nb, EXPERT_BLOCK, dm)

    def expert_block(args):
        xi, e = args
        hid = jax.nn.silu(xi @ w_gate[e]) * (xi @ w_up[e])
        return hid @ w_down[e]

    yb = lax.map(expert_block, (xb, block_e)).reshape(m, dm)
    y = jax.ops.segment_sum(yb.astype(jnp.float32) * buf_w[:, None], buf_tok, num_segments=n)
    return y.reshape(b, s, dm).astype(h.dtype)


def setup_inputs(seed: int = 0) -> dict:
    key = jax.random.key(seed)
    ks = jax.random.split(key, 24)
    f32 = jnp.float32

    def nrm(k, shape, fan_in):
        return jax.random.normal(k, shape, f32) * (fan_in ** -0.5)

    def gain(k, shape):
        return 1.0 + 0.02 * jax.random.normal(k, shape, f32)

    return {
        "x": jax.random.normal(ks[0], (BATCH, SEQ, D_MODEL), f32),
        "p": jax.random.normal(ks[1], (DEPTH, BATCH, SEQ, PLE_DIM), f32),
        "norm_mix": gain(ks[2], (DEPTH, D_MODEL)),
        "w_in": nrm(ks[3], (DEPTH, D_MODEL, W_IN_COLS), D_MODEL),
        "ret_gn": gain(ks[4], (DEPTH, RET_VW)),
        "w_br_ret": nrm(ks[5], (DEPTH, RET_VW, D_MODEL), RET_VW),
        "w_br_sb": nrm(ks[6], (DEPTH, SB_W, D_MODEL), SB_W),
        "w_out": nrm(ks[7], (DEPTH, D_MODEL, D_MODEL), D_MODEL),
        "norm_ffn": gain(ks[8], (DEPTH, D_MODEL)),
        "w_grp": nrm(ks[9], (DEPTH, D_MODEL, N_GROUPS), D_MODEL),
        "b_grp": 0.01 * jax.random.normal(ks[10], (DEPTH, N_GROUPS), f32),
        "w_exp": nrm(ks[11], (DEPTH, D_MODEL, N_EXPERTS), D_MODEL),
        "b_exp": 0.01 * jax.random.normal(ks[12], (DEPTH, N_EXPERTS), f32),
        "w_gate": nrm(ks[13], (DEPTH, N_EXPERTS, D_MODEL, D_EXPERT), D_MODEL),
        "w_up": nrm(ks[14], (DEPTH, N_EXPERTS, D_MODEL, D_EXPERT), D_MODEL),
        "w_down": nrm(ks[15], (DEPTH, N_EXPERTS, D_EXPERT, D_MODEL), D_EXPERT),
        "norm_ple": gain(ks[16], (DEPTH, D_MODEL)),
        "w_ple": nrm(ks[17], (DEPTH, PLE_DIM, D_MODEL), PLE_DIM),
        "w_ple_gate": nrm(ks[18], (DEPTH, D_MODEL, D_MODEL), D_MODEL),
        "norm_final": gain(ks[19], (D_MODEL,)),
    }


def reference(x, p, norm_mix, w_in, ret_gn, w_br_ret, w_br_sb, w_out, norm_ffn,
              w_grp, b_grp, w_exp, b_exp, w_gate, w_up, w_down,
              norm_ple, w_ple, w_ple_gate, norm_final):
    b, s, _ = x.shape
    f32 = jnp.float32
    pos = jnp.arange(s, dtype=f32)
    inv_freq = ROPE_BASE ** (-jnp.arange(0, RET_DK, 2, dtype=f32) / RET_DK)
    ang = pos[:, None] * inv_freq[None, :]
    cos, sin = jnp.cos(ang), jnp.sin(ang)
    for i in range(DEPTH):
        h = rms_norm(x, norm_mix[i])
        proj = h @ w_in[i]
        rq, rk, rv, rg, sq, sk, sv, g_ret, g_sb = jnp.split(proj, IN_SPLITS, axis=-1)
        rq = apply_rope(rq.reshape(b, s, RET_HEADS, RET_DK).astype(f32), cos, sin)
        rk = apply_rope(rk.reshape(b, s, RET_HEADS, RET_DK).astype(f32), cos, sin) * (RET_DK ** -0.5)
        rv = rv.reshape(b, s, RET_HEADS, RET_DV).astype(f32)
        ret = retention(rq, rk, rv, rg.astype(f32), ret_gn[i]).astype(x.dtype)
        sb = stick_breaking(sq.reshape(b, s, SB_HEADS, SB_DH).astype(f32),
                            sk.reshape(b, s, SB_HEADS, SB_DH).astype(f32),
                            sv.reshape(b, s, SB_HEADS, SB_DH).astype(f32)).astype(x.dtype)
        merged = (jax.nn.sigmoid(g_ret) * (ret @ w_br_ret[i])
                  + jax.nn.sigmoid(g_sb) * (sb @ w_br_sb[i]))
        x = x + merged @ w_out[i]
        x = x + hier_moe(rms_norm(x, norm_ffn[i]), w_grp[i], b_grp[i], w_exp[i], b_exp[i],
                         w_gate[i], w_up[i], w_down[i])
        hp = rms_norm(x, norm_ple[i])
        x = x + jax.nn.sigmoid(hp @ w_ple_gate[i]) * (p[i].astype(x.dtype) @ w_ple[i])
    return rms_norm(x, norm_final)
```

```cpp
#include <hip/hip_runtime.h>
#include <cstdio>
#include <cstdint>

#ifndef FAST_MASK
#define FAST_MASK 0
#endif
#ifndef SPLIT_PHASES
#define SPLIT_PHASES 0
#endif
#define F_PROJ 1
#define F_RET 2
#define F_ATT 4
#define F_BR 8
#define F_WOUT 16
#define F_MOE 32
#define F_PLE 64
#define FAST(x) ((FAST_MASK & (x)) != 0)

constexpr int NTOK = 32768, DM = 1024, SEQ = 4096, NBATCH = 8;
constexpr int NMAIN = 4608, NTR = 1536, NWIN = 5632;
constexpr int C_RQ = 0, C_RK = 512, C_RG = 1024, C_SQ = 1536, C_SK = 2048, C_GR = 2560, C_GS = 3584;
constexpr int T_KT = 0, T_VR = 512, T_VS = 1024;
constexpr int NEXP = 16, DEXP = 512, MPAD_MAX = 65536 + 16 * 256, NRT_MAX = MPAD_MAX / 256;
constexpr float EPS = 1e-6f;
constexpr float LOG2E = 1.4426950408889634f;
constexpr float SB_QSCALE = 0.125f * LOG2E;
constexpr float SB_EXIT = -160.0f;

constexpr size_t MiB = 1u << 20;
constexpr size_t WS_CTL = 0, CTL_ZERO_BYTES = 1 * MiB;
constexpr size_t WS_WIN = 2 * MiB;
constexpr size_t WS_WBR1 = 14 * MiB;
constexpr size_t WS_WBR2 = 15 * MiB;
constexpr size_t WS_WOUT = 16 * MiB;
constexpr size_t WS_WGU = 18 * MiB;
constexpr size_t WS_WD = 50 * MiB;
constexpr size_t WS_WPLE = 66 * MiB;
constexpr size_t WS_WPG = 67 * MiB;
constexpr size_t WS_TABA = 70 * MiB;
constexpr size_t WS_TABB = 72 * MiB;
constexpr size_t WS_ROUTE = 74 * MiB;
constexpr size_t WS_PB = 76 * MiB;
constexpr size_t WS_PROJ = 92 * MiB;
constexpr size_t WS_T = 380 * MiB;
constexpr size_t WS_END = 476 * MiB;
constexpr size_t WS_H2 = 92 * MiB;
constexpr size_t WS_XB = 156 * MiB;
constexpr size_t WS_HID = 292 * MiB;
constexpr size_t DO_HB = 0, DO_ST = 0, DO_NV = 64 * MiB;
constexpr size_t RT_EID = 0, RT_WGT = 256 * 1024, RT_RANK = 512 * 1024, RT_POS = 768 * 1024, RT_WROW = 1024 * 1024, RT_TILE = 1536 * 1024;
constexpr int CW_TMO = 0, CW_CODE = 1;
constexpr int CW_CNT = 64;
constexpr int CW_BAR = 4096, BAR_STRIDE = 4096;

#define GAS __attribute__((address_space(1)))
#define LAS __attribute__((address_space(3)))
typedef unsigned short bf16;
typedef unsigned v4u __attribute__((ext_vector_type(4)));
typedef unsigned v2u __attribute__((ext_vector_type(2)));
typedef float f32x4 __attribute__((ext_vector_type(4)));
typedef float f32x2 __attribute__((ext_vector_type(2)));
typedef float f32x16 __attribute__((ext_vector_type(16)));
typedef short bf16x8 __attribute__((ext_vector_type(8)));
typedef short s16x4 __attribute__((ext_vector_type(4)));
typedef GAS unsigned gu32;
#define RLX_AGENT __ATOMIC_RELAXED, __HIP_MEMORY_SCOPE_AGENT
#define LDS_WAIT() asm volatile("s_waitcnt lgkmcnt(0)" ::: "memory")
#define VM_WAIT() asm volatile("s_waitcnt vmcnt(0)" ::: "memory")
#define DI __device__ __forceinline__
DI unsigned f2bf(float f) { unsigned u = __builtin_bit_cast(unsigned, f); return (u + 0x7fffu + ((u >> 16) & 1u)) >> 16; }
DI unsigned pk2(float lo, float hi) { return f2bf(lo) | (f2bf(hi) << 16); }
DI float bf2f(unsigned b) { return __builtin_bit_cast(float, b << 16); }
DI float bflo(unsigned w) { return __builtin_bit_cast(float, w << 16); }
DI float bfhi(unsigned w) { return __builtin_bit_cast(float, w & 0xffff0000u); }
DI float fsigmoid(float x) { return 1.0f / (1.0f + __expf(-x)); }
DI float fsilu(float x) { return x / (1.0f + __expf(-x)); }
DI float wave_sum(float v) {
#pragma unroll
    for (int o = 1; o < 64; o <<= 1) v += __shfl_xor(v, o);
    return v;
}
DI float ret_log2g(int h) { return log2f(1.0f - exp2f(-5.0f - (float)h)); }

__host__ __device__ __forceinline__ int in_src(int r) {
    if (r < 1024) { const int base = (r < 512) ? 0 : 512; const int i = r & 511, h = i >> 7, j = i & 127; return base + h * 128 + (j & 1) * 64 + (j >> 1); }
    if (r < 1536) return 1536 + (r - 1024);
    if (r < 2048) return 2048 + (r - 1536);
    if (r < 2560) return 2560 + (r - 2048);
    if (r < 3584) return 3584 + (r - 2560);
    if (r < 4608) return 4608 + (r - 3584);
    if (r < 5120) { const int i = r - 4608, h = i >> 7, j = i & 127; return 512 + h * 128 + (j & 1) * 64 + (j >> 1); }
    if (r < 5632) return 1024 + (r - 5120);
    return 3072 + (r - 5632);
}

DI void proj_pair(int row, int col, float v0, float v1, const f32x2* __restrict__ tabA, float& o0, float& o1) {
    if (col < C_RG) {
        const int pos = row & (SEQ - 1), p = (col & 127) >> 1;
        const f32x2 cs = tabA[pos * 64 + p];
        float a = v0 * cs.x - v1 * cs.y, b = v0 * cs.y + v1 * cs.x;
        if (col >= C_RK) { a *= 0.08838834764831845f; b *= 0.08838834764831845f; }
        o0 = a; o1 = b;
    } else if (col < C_SQ) { o0 = fsilu(v0); o1 = fsilu(v1); }
    else if (col < C_SK) { o0 = v0 * SB_QSCALE; o1 = v1 * SB_QSCALE; }
    else if (col < C_GR) { o0 = v0; o1 = v1; }
    else { o0 = fsigmoid(v0); o1 = fsigmoid(v1); }
}

DI void projT_pair(int f, int tok, float v0, float v1, const f32x2* __restrict__ tabB, float& o0, float& o1) {
    if (f < T_VR) {
        const int pos = tok & (SEQ - 1), h = f >> 7, p = (f & 127) >> 1;
        const f32x2 cs = tabB[p * SEQ + pos];
        const float sc = 0.08838834764831845f * exp2f(ret_log2g(h) * (float)(63 - (pos & 63)));
        o0 = (v0 * cs.x - v1 * cs.y) * sc; o1 = (v0 * cs.y + v1 * cs.x) * sc;
    } else { o0 = v0; o1 = v1; }
}

template <class E> __global__ void __launch_bounds__(256) naive_gemm(E e, int N, int K) {
    __shared__ float As[16][132];
    __shared__ float Bs[16][68];
    __shared__ float Bs2[E::DUAL ? 16 : 1][68];
    const int tid = threadIdx.x, tx = tid & 15, ty = tid >> 4;
    const int m0 = blockIdx.y * 128, n0 = blockIdx.x * 64;
    if (!e.active(m0)) return;
    float acc[8][4], acc2[8][4];
#pragma unroll
    for (int i = 0; i < 8; ++i)
#pragma unroll
        for (int j = 0; j < 4; ++j) { acc[i][j] = 0.f; acc2[i][j] = 0.f; }
    const bf16* arow = e.arow(m0 + (tid >> 1)) + (tid & 1) * 8;
    const float* bc0 = e.bcol(m0, n0 + tx * 4 + 0); const float* bc1 = e.bcol(m0, n0 + tx * 4 + 1);
    const float* bc2 = e.bcol(m0, n0 + tx * 4 + 2); const float* bc3 = e.bcol(m0, n0 + tx * 4 + 3);
    const float* bd0 = E::DUAL ? e.bcol2(m0, n0 + tx * 4 + 0) : bc0; const float* bd1 = E::DUAL ? e.bcol2(m0, n0 + tx * 4 + 1) : bc0;
    const float* bd2 = E::DUAL ? e.bcol2(m0, n0 + tx * 4 + 2) : bc0; const float* bd3 = E::DUAL ? e.bcol2(m0, n0 + tx * 4 + 3) : bc0;
    const size_t ldb = (size_t)e.ldb();
    for (int k0 = 0; k0 < K; k0 += 16) {
        const v4u av = *(const v4u*)(arow + k0);
        const int kk = (tid & 1) * 8, ar = tid >> 1;
        As[kk + 0][ar] = bflo(av.x); As[kk + 1][ar] = bfhi(av.x); As[kk + 2][ar] = bflo(av.y); As[kk + 3][ar] = bfhi(av.y);
        As[kk + 4][ar] = bflo(av.z); As[kk + 5][ar] = bfhi(av.z); As[kk + 6][ar] = bflo(av.w); As[kk + 7][ar] = bfhi(av.w);
        const size_t ko = (size_t)(k0 + ty) * ldb;
        Bs[ty][tx * 4 + 0] = bc0[ko]; Bs[ty][tx * 4 + 1] = bc1[ko]; Bs[ty][tx * 4 + 2] = bc2[ko]; Bs[ty][tx * 4 + 3] = bc3[ko];
        if (E::DUAL) { Bs2[ty][tx * 4 + 0] = bd0[ko]; Bs2[ty][tx * 4 + 1] = bd1[ko]; Bs2[ty][tx * 4 + 2] = bd2[ko]; Bs2[ty][tx * 4 + 3] = bd3[ko]; }
        __syncthreads();
#pragma unroll
        for (int k = 0; k < 16; ++k) {
            float a[8], b[4], b2[4];
#pragma unroll
            for (int i = 0; i < 8; ++i) a[i] = As[k][ty * 8 + i];
#pragma unroll
            for (int j = 0; j < 4; ++j) { b[j] = Bs[k][tx * 4 + j]; b2[j] = E::DUAL ? Bs2[k][tx * 4 + j] : 0.f; }
#pragma unroll
            for (int i = 0; i < 8; ++i)
#pragma unroll
                for (int j = 0; j < 4; ++j) { acc[i][j] += a[i] * b[j]; if (E::DUAL) acc2[i][j] += a[i] * b2[j]; }
        }
        __syncthreads();
    }
#pragma unroll
    for (int i = 0; i < 8; ++i)
#pragma unroll
        for (int j = 0; j < 4; j += 2) e.store(m0 + ty * 8 + i, n0 + tx * 4 + j, acc[i][j], acc[i][j + 1], acc2[i][j], acc2[i][j + 1]);
}

struct NProjMain {
    static constexpr bool DUAL = false;
    const bf16* HB; const float* w_in; bf16* PROJ; const f32x2* tabA;
    DI bool active(int) const { return true; }
    DI const bf16* arow(int m) const { return HB + (size_t)m * DM; }
    DI const float* bcol(int, int n) const { return w_in + in_src(n); }
    DI const float* bcol2(int, int) const { return nullptr; }
    DI int ldb() const { return NWIN; }
    DI void store(int row, int col, float v0, float v1, float, float) const { float o0, o1; proj_pair(row, col, v0, v1, tabA, o0, o1); *(unsigned*)(PROJ + (size_t)row * NMAIN + col) = pk2(o0, o1); }
};
struct NProjT {
    static constexpr bool DUAL = false;
    const bf16* HB; const float* w_in; bf16* T; const f32x2* tabB;
    DI bool active(int) const { return true; }
    DI const bf16* arow(int m) const { return HB + (size_t)m * DM; }
    DI const float* bcol(int, int n) const { return w_in + in_src(NMAIN + n); }
    DI const float* bcol2(int, int) const { return nullptr; }
    DI int ldb() const { return NWIN; }
    DI void store(int row, int col, float v0, float v1, float, float) const { float o0, o1; projT_pair(col, row, v0, v1, tabB, o0, o1); T[(size_t)col * NTOK + row] = (bf16)f2bf(o0); T[(size_t)(col + 1) * NTOK + row] = (bf16)f2bf(o1); }
};
struct NProjV {
    static constexpr bool DUAL = false;
    const bf16* HB; const float* w_in; bf16* NV;
    DI bool active(int) const { return true; }
    DI const bf16* arow(int m) const { return HB + (size_t)m * DM; }
    DI const float* bcol(int, int n) const { return w_in + (n < 512 ? 1024 + n : 3072 + (n - 512)); }
    DI const float* bcol2(int, int) const { return nullptr; }
    DI int ldb() const { return NWIN; }
    DI void store(int row, int col, float v0, float v1, float, float) const { *(unsigned*)(NV + (size_t)row * 1024 + col) = pk2(v0, v1); }
};
struct NBr {
    static constexpr bool DUAL = false;
    bf16* PROJ; const float* W; int step; int pad;
    DI bool active(int) const { return true; }
    DI const bf16* arow(int m) const { return PROJ + (size_t)m * NMAIN + (step ? C_SQ : C_RG); }
    DI const float* bcol(int, int n) const { return W + n; }
    DI const float* bcol2(int, int) const { return nullptr; }
    DI int ldb() const { return DM; }
    DI void store(int row, int col, float v0, float v1, float, float) const {
        bf16* pr = PROJ + (size_t)row * NMAIN;
        const unsigned g = *(const unsigned*)(pr + (step ? C_GS : C_GR) + col);
        float o0 = bflo(g) * v0, o1 = bfhi(g) * v1;
        if (step) { const unsigned t1 = *(const unsigned*)(pr + C_GR + col); o0 += bflo(t1); o1 += bfhi(t1); }
        *(unsigned*)(pr + C_GR + col) = pk2(o0, o1);
    }
};
struct NWout {
    static constexpr bool DUAL = false;
    const bf16* PROJ; const float* W; const float* x; float* out;
    DI bool active(int) const { return true; }
    DI const bf16* arow(int m) const { return PROJ + (size_t)m * NMAIN + C_GR; }
    DI const float* bcol(int, int n) const { return W + n; }
    DI const float* bcol2(int, int) const { return nullptr; }
    DI int ldb() const { return DM; }
    DI void store(int row, int col, float v0, float v1, float, float) const { const size_t o = (size_t)row * DM + col; out[o] = x[o] + v0; out[o + 1] = x[o + 1] + v1; }
};
struct NGateUp {
    static constexpr bool DUAL = true;
    const bf16* XB; const float* wg; const float* wu; bf16* HID; const int* tile;
    DI bool active(int m0) const { return (m0 >> 8) < tile[0]; }
    DI const bf16* arow(int m) const { return XB + (size_t)m * DM; }
    DI const float* bcol(int m0, int n) const { return wg + (size_t)tile[1 + (m0 >> 8)] * DM * DEXP + n; }
    DI const float* bcol2(int m0, int n) const { return wu + (size_t)tile[1 + (m0 >> 8)] * DM * DEXP + n; }
    DI int ldb() const { return DEXP; }
    DI void store(int row, int col, float g0, float g1, float u0, float u1) const { *(unsigned*)(HID + (size_t)row * DEXP + col) = pk2(fsilu(g0) * u0, fsilu(g1) * u1); }
};
struct NDown {
    static constexpr bool DUAL = false;
    const bf16* HID; const float* wd; bf16* YB; const int* tile; const float* wrow;
    DI bool active(int m0) const { return (m0 >> 8) < tile[0]; }
    DI const bf16* arow(int m) const { return HID + (size_t)m * DEXP; }
    DI const float* bcol(int m0, int n) const { return wd + (size_t)tile[1 + (m0 >> 8)] * DEXP * DM + n; }
    DI const float* bcol2(int, int) const { return nullptr; }
    DI int ldb() const { return DM; }
    DI void store(int row, int col, float v0, float v1, float, float) const { const float w = wrow[row]; *(unsigned*)(YB + (size_t)row * DM + col) = pk2(v0 * w, v1 * w); }
};
struct NPe {
    static constexpr bool DUAL = false;
    const bf16* PB; const float* W; bf16* PE;
    DI bool active(int) const { return true; }
    DI const bf16* arow(int m) const { return PB + (size_t)m * 256; }
    DI const float* bcol(int, int n) const { return W + n; }
    DI const float* bcol2(int, int) const { return nullptr; }
    DI int ldb() const { return DM; }
    DI void store(int row, int col, float v0, float v1, float, float) const { *(unsigned*)(PE + (size_t)row * DM + col) = pk2(v0, v1); }
};
struct NPg {
    static constexpr bool DUAL = false;
    const bf16* HP; const float* W; const bf16* PE; float* out;
    DI bool active(int) const { return true; }
    DI const bf16* arow(int m) const { return HP + (size_t)m * DM; }
    DI const float* bcol(int, int n) const { return W + n; }
    DI const float* bcol2(int, int) const { return nullptr; }
    DI int ldb() const { return DM; }
    DI void store(int row, int col, float v0, float v1, float, float) const {
        const size_t o = (size_t)row * DM + col; const unsigned pe = *(const unsigned*)(PE + o);
        out[o] = out[o] + fsigmoid(v0) * bflo(pe); out[o + 1] = out[o + 1] + fsigmoid(v1) * bfhi(pe);
    }
};

__global__ void __launch_bounds__(256) naive_ret(bf16* PROJ, const bf16* NV, const float* gn) {
    __shared__ float Ks[64][129];
    __shared__ float Vs[64][128];
    __shared__ float Ps[64][65];
    __shared__ float Qs[64][129];
    const int tid = threadIdx.x, i = tid >> 2, part = tid & 3;
    const int c = blockIdx.x & 63, h = (blockIdx.x >> 6) & 3, b = blockIdx.x >> 8;
    const int t0 = b * SEQ + c * 64;
    const float l2g = ret_log2g(h);
    {
        const bf16* qp = PROJ + (size_t)(t0 + i) * NMAIN + C_RQ + h * 128 + part * 32;
        for (int d = 0; d < 32; d += 2) { const unsigned w = *(const unsigned*)(qp + d); Qs[i][part * 32 + d] = bflo(w); Qs[i][part * 32 + d + 1] = bfhi(w); }
    }
    float o[32];
#pragma unroll
    for (int e = 0; e < 32; ++e) o[e] = 0.f;
    for (int kt = 0; kt <= c; ++kt) {
        const int s0 = b * SEQ + kt * 64;
        for (int idx = tid; idx < 64 * 64; idx += 256) {
            const int r = idx >> 6, d2 = (idx & 63) * 2;
            const unsigned kw = *(const unsigned*)(PROJ + (size_t)(s0 + r) * NMAIN + C_RK + h * 128 + d2);
            const unsigned vw = *(const unsigned*)(NV + (size_t)(s0 + r) * 1024 + h * 128 + d2);
            Ks[r][d2] = bflo(kw); Ks[r][d2 + 1] = bfhi(kw); Vs[r][d2] = bflo(vw); Vs[r][d2 + 1] = bfhi(vw);
        }
        __syncthreads();
#pragma unroll 1
        for (int jj = 0; jj < 16; ++jj) {
            const int j = part * 16 + jj; float s = 0.f;
#pragma unroll 8
            for (int d = 0; d < 128; ++d) s += Qs[i][d] * Ks[j][d];
            const int dist = (c * 64 + i) - (kt * 64 + j);
            Ps[i][j] = s * exp2f(l2g * (float)(dist < 0 ? -dist : dist));
        }
        __syncthreads();
#pragma unroll 2
        for (int j = 0; j < 64; ++j) { const float p = Ps[i][j];
#pragma unroll
            for (int e = 0; e < 32; ++e) o[e] += p * Vs[j][part * 32 + e]; }
        __syncthreads();
    }
    float s = 0.f;
#pragma unroll
    for (int e = 0; e < 32; ++e) s += o[e];
    s += __shfl_xor(s, 1); s += __shfl_xor(s, 2);
    const float mu = s * (1.0f / 128.0f); float v = 0.f;
#pragma unroll
    for (int e = 0; e < 32; ++e) { const float d = o[e] - mu; v += d * d; }
    v += __shfl_xor(v, 1); v += __shfl_xor(v, 2);
    const float rstd = rsqrtf(v * (1.0f / 128.0f) + EPS);
    bf16* gp = PROJ + (size_t)(t0 + i) * NMAIN + C_RG + h * 128 + part * 32;
#pragma unroll
    for (int e = 0; e < 32; e += 2) {
        const unsigned g = *(const unsigned*)(gp + e);
        const float r0 = (o[e] - mu) * rstd * gn[h * 128 + part * 32 + e] * bflo(g), r1 = (o[e + 1] - mu) * rstd * gn[h * 128 + part * 32 + e + 1] * bfhi(g);
        *(unsigned*)(gp + e) = pk2(r0, r1);
    }
}

__global__ void __launch_bounds__(256) naive_att(bf16* PROJ, const bf16* NV) {
    __shared__ float Ks[64][65];
    __shared__ float Vs[64][64];
    __shared__ float Zs[64][65];
    const int tid = threadIdx.x, i = tid >> 2, part = tid & 3;
    const int qb = blockIdx.x & 63, h = (blockIdx.x >> 6) & 7, b = blockIdx.x >> 9;
    const int t0 = b * SEQ + qb * 64;
    float q[64];
    {
        const bf16* qp = PROJ + (size_t)(t0 + i) * NMAIN + C_SQ + h * 64;
#pragma unroll
        for (int d = 0; d < 64; d += 2) { const unsigned w = *(const unsigned*)(qp + d); q[d] = bflo(w); q[d + 1] = bfhi(w); }
    }
    float o[16];
#pragma unroll
    for (int e = 0; e < 16; ++e) o[e] = 0.f;
    float carry = 0.f;
    for (int kt = qb; kt >= 0; --kt) {
        const int s0 = b * SEQ + kt * 64;
        for (int idx = tid; idx < 64 * 32; idx += 256) {
            const int r = idx >> 5, d2 = (idx & 31) * 2;
            const unsigned kw = *(const unsigned*)(PROJ + (size_t)(s0 + r) * NMAIN + C_SK + h * 64 + d2);
            const unsigned vw = *(const unsigned*)(NV + (size_t)(s0 + r) * 1024 + 512 + h * 64 + d2);
            Ks[r][d2] = bflo(kw); Ks[r][d2 + 1] = bfhi(kw); Vs[r][d2] = bflo(vw); Vs[r][d2 + 1] = bfhi(vw);
        }
        __syncthreads();
        for (int jj = 0; jj < 16; ++jj) {
            const int j = part * 16 + jj; float s = 0.f;
#pragma unroll
            for (int d = 0; d < 64; ++d) s += q[d] * Ks[j][d];
            Zs[i][j] = s;
        }
        __syncthreads();
        if (part == 0) {
            for (int j = 63; j >= 0; --j) {
                const float z = Zs[i][j]; float a = 0.f;
                if (kt * 64 + j < qb * 64 + i) {
                    const float lk = -log2f(1.0f + exp2f(z));
                    a = exp2f(z + lk + carry);
                    carry += lk;
                }
                Zs[i][j] = a;
            }
        }
        __syncthreads();
        for (int j = 0; j < 64; ++j) { const float p = Zs[i][j];
#pragma unroll
            for (int e = 0; e < 16; ++e) o[e] += p * Vs[j][part * 16 + e]; }
        __syncthreads();
    }
    bf16* op = PROJ + (size_t)(t0 + i) * NMAIN + C_SQ + h * 64 + part * 16;
#pragma unroll
    for (int e = 0; e < 16; e += 2) *(unsigned*)(op + e) = pk2(o[e], o[e + 1]);
}

namespace pg8 {
#define PG8_LAS __attribute__((address_space(3)))
typedef unsigned short bf16_t;
typedef short bf16x8 __attribute__((ext_vector_type(8)));
typedef float f32x4 __attribute__((ext_vector_type(4)));
typedef unsigned u32x4 __attribute__((ext_vector_type(4)));
constexpr int BM = 256, BK = 64, HALF = 128, HTB = HALF * BK * 2  , STAGE_BYTES = 8 * HTB, NXCD = 8, WGM = 8;

__host__ __device__ __forceinline__ int lds_byte(int r, int c) { const int st = (r >> 4) * 2 + (c >> 5), rr = r & 15, cc = c & 31, ob = rr * 64 + cc * 2; return st * 1024 + (ob ^ (((ob >> 9) & 1) << 5)); }
__host__ __device__ __forceinline__ void stage_rc(int b, int& R, int& C) { const int st = b / 1024, sb = b % 1024, swz = sb ^ (((sb >> 9) & 1) << 5); R = (st >> 1) * 16 + swz / 64; C = (st & 1) * 32 + (swz % 64) / 2; }
__host__ __device__ __forceinline__ int perm32(int rho) { const int n = rho >> 4, i = rho & 15; return 8 * (i >> 2) + 4 * n + (i & 3); }

struct Unit { int pm, pn; size_t bofs; int ex; };
struct Gemm { const bf16_t* A; const bf16_t* Bt; int lda, K; };

struct StaticOrder {
    int nM, nN, nwg, G, c; size_t tstepB;
    __device__ void init(int M, int N, int K, int G_, int c_) { nM = M / BM; nN = N / BM; nwg = nM * nN; G = G_; c = c_; tstepB = (size_t)BM * K * 2; }
    __device__ bool next(int i, Unit& u) const {
        const long L = (long)i * G + c; if (L >= nwg) return false;
        int wgid = (int)L; { const int q = nwg / NXCD, r = nwg % NXCD, xcd = wgid % NXCD, off = wgid / NXCD; wgid = (xcd < r ? xcd * (q + 1) : r * (q + 1) + (xcd - r) * q) + off; }
        const int nig = WGM * nN, gid = wgid / nig, fm = gid * WGM, gsz = (nM - fm) < WGM ? (nM - fm) : WGM;
        u.pm = fm + ((wgid % nig) % gsz); u.pn = (wgid % nig) / gsz; u.bofs = (size_t)u.pn * tstepB; u.ex = 0; return true;
    }
    __device__ __forceinline__ void a_ready(const Unit&) const {}
    __device__ __forceinline__ void done(const Unit&) const {}
};
__device__ __forceinline__ unsigned cvt_pk_bf16(float lo, float hi) { unsigned r; asm volatile("v_cvt_pk_bf16_f32 %0, %1, %2" : "=v"(r) : "v"(lo), "v"(hi)); return r; }
template <class Epi, class Sched, bool ALIGN_EPI = false, bool SP2 = false>
__device__ __forceinline__ void gemm_phase(PG8_LAS unsigned char* lds, const Gemm g, const Sched& S, const Epi& E) {
    const int tid = threadIdx.x, wid = __builtin_amdgcn_readfirstlane(tid >> 6), lane = tid & 63, wr = wid >> 2, wc = wid & 3, fr = lane & 15, fq = lane >> 4;
    const int K = g.K, nt = K / BK;
    unsigned voffA[2], voffB[2];
#pragma unroll
    for (int i = 0; i < 2; ++i) { int R, C; stage_rc(tid * 16 + i * 8192, R, C); const int Rb = Epi::PERM ? ((R & ~31) + perm32(R & 31)) : R;
        voffA[i] = (unsigned)(R * g.lda + C) * 2u; voffB[i] = (unsigned)(Rb * K + C) * 2u; }
    const size_t kstep = (size_t)(BK * 2);
    const size_t hstepA = (size_t)HALF * g.lda * 2, hstepB = (size_t)HALF * K * 2;
    const size_t tstepA = 2 * hstepA;
    const unsigned ldsw = (unsigned)wid * 1024u;
    const int aoff = lds_byte(wr * 64 + fr, fq * 8), boff = lds_byte(wc * 32 + fr, fq * 8);
#define PG8_SA(b, h) (((b) * 2 + (h)) * HTB)
#define PG8_SB(b, h) ((4 + (b) * 2 + (h)) * HTB)
#define PG8_STAGE(bufoff, gbase, voff) do { _Pragma("unroll") for (int _i = 0; _i < 2; ++_i) \
        __builtin_amdgcn_global_load_lds((const unsigned*)((const char*)(gbase) + (voff)[_i]), (PG8_LAS unsigned*)(lds + (bufoff) + ldsw + _i * 8192), 16, 0, 0); } while (0)
#define PG8_LDA(dst, b, h) do { _Pragma("unroll") for (int m = 0; m < 4; ++m) _Pragma("unroll") for (int k = 0; k < 2; ++k) dst[m][k] = *(const PG8_LAS bf16x8*)(lds + PG8_SA(b, h) + aoff + m * 2048 + k * 1024); } while (0)
#define PG8_LDB(dst, b, h) do { _Pragma("unroll") for (int n = 0; n < 2; ++n) _Pragma("unroll") for (int k = 0; k < 2; ++k) dst[n][k] = *(const PG8_LAS bf16x8*)(lds + PG8_SB(b, h) + boff + n * 2048 + k * 1024); } while (0)
#define PG8_MMA(ai, bj, At, Bt) do { __builtin_amdgcn_s_setprio(1); _Pragma("unroll") for (int m = 0; m < 4; ++m) _Pragma("unroll") for (int n = 0; n < 2; ++n) _Pragma("unroll") for (int k = 0; k < 2; ++k) \
        acc[ai][bj][m][n] = __builtin_amdgcn_mfma_f32_16x16x32_bf16(Bt[n][k], At[m][k], acc[ai][bj][m][n], 0, 0, 0); __builtin_amdgcn_s_setprio(0); } while (0)
#define PG8_WAIT_V(n) asm volatile("s_waitcnt vmcnt(" #n ")" ::: "memory")
#define PG8_WAIT_L(n) asm volatile("s_waitcnt lgkmcnt(" #n ")" ::: "memory")
#define PG8_BAR __builtin_amdgcn_s_barrier()
#define PG8_SCHED __builtin_amdgcn_sched_barrier(0)
    Unit cur, nxt; int ui = 0;
    if (!S.next(0, cur)) return;
    f32x4 acc[2][2][4][2];
#pragma unroll
    for (int a = 0; a < 2; ++a)
#pragma unroll
        for (int b = 0; b < 2; ++b)
#pragma unroll
            for (int m = 0; m < 4; ++m)
#pragma unroll
                for (int n = 0; n < 2; ++n) acc[a][b][m][n] = (f32x4){0.f, 0.f, 0.f, 0.f};
    bf16x8 At[4][2], B0[2][2], B1[2][2];
    const char* cA = (const char*)g.A + (size_t)cur.pm * tstepA; const char* cB = (const char*)g.Bt + cur.bofs;
    S.a_ready(cur);
    if constexpr (SP2) {
        PG8_STAGE(PG8_SB(0, 0), cB, voffB); PG8_STAGE(PG8_SB(0, 1), cB + hstepB, voffB); PG8_STAGE(PG8_SA(0, 0), cA, voffA); PG8_STAGE(PG8_SA(0, 1), cA + hstepA, voffA);
        if (wr == 1) PG8_BAR;
        PG8_WAIT_V(2); PG8_BAR;
        PG8_STAGE(PG8_SB(1, 0), cB + kstep, voffB); PG8_STAGE(PG8_SA(1, 0), cA + kstep, voffA); PG8_STAGE(PG8_SB(1, 1), cB + hstepB + kstep, voffB);
        PG8_WAIT_V(6); PG8_BAR;
    } else {
        PG8_STAGE(PG8_SB(0, 0), cB, voffB); PG8_STAGE(PG8_SA(0, 0), cA, voffA); PG8_STAGE(PG8_SB(0, 1), cB + hstepB, voffB); PG8_STAGE(PG8_SA(0, 1), cA + hstepA, voffA);
        if (wr == 1) PG8_BAR;
        PG8_WAIT_V(4); PG8_BAR;
        PG8_STAGE(PG8_SB(1, 0), cB + kstep, voffB); PG8_STAGE(PG8_SA(1, 0), cA + kstep, voffA); PG8_STAGE(PG8_SB(1, 1), cB + hstepB + kstep, voffB);
        PG8_WAIT_V(6); PG8_BAR;
    }
    for (;;) {
        const bool has_next = S.next(ui + 1, nxt);
        const char* nA = has_next ? (const char*)g.A + (size_t)nxt.pm * tstepA : cA; const char* nB = has_next ? (const char*)g.Bt + nxt.bofs : cB;
        for (int t = 0; t < nt; t += 2) {
            const bool last = (t == nt - 2);
            const char* a1 = cA + (size_t)(t + 1) * kstep;
            const char* a2 = last ? nA : cA + (size_t)(t + 2) * kstep; const char* b2 = last ? nB : cB + (size_t)(t + 2) * kstep;
            const char* a3 = a2 + kstep; const char* b3 = b2 + kstep;
            if (last && has_next) S.a_ready(nxt);
            if constexpr (SP2) {
            PG8_LDB(B0, 0, 0); PG8_LDB(B1, 0, 1); PG8_SCHED; PG8_LDA(At, 0, 0); PG8_STAGE(PG8_SA(1, 1), a1 + hstepA, voffA);
            PG8_WAIT_V(8); PG8_WAIT_L(0); PG8_BAR; PG8_MMA(0, 0, At, B0); PG8_MMA(0, 1, At, B1); PG8_BAR; PG8_SCHED;
            PG8_LDA(At, 0, 1); PG8_STAGE(PG8_SB(0, 0), b2, voffB); PG8_STAGE(PG8_SB(0, 1), b2 + hstepB, voffB); PG8_STAGE(PG8_SA(0, 0), a2, voffA);
            PG8_WAIT_V(8); PG8_WAIT_L(0); PG8_BAR; PG8_MMA(1, 0, At, B0); PG8_MMA(1, 1, At, B1); PG8_BAR; PG8_SCHED;
            PG8_LDB(B0, 1, 0); PG8_LDB(B1, 1, 1); PG8_SCHED; PG8_LDA(At, 1, 0); PG8_STAGE(PG8_SA(0, 1), a2 + hstepA, voffA);
            PG8_WAIT_V(8); PG8_WAIT_L(0); PG8_BAR; PG8_MMA(0, 0, At, B0); PG8_MMA(0, 1, At, B1); PG8_BAR; PG8_SCHED;
            PG8_LDA(At, 1, 1); PG8_STAGE(PG8_SB(1, 0), b3, voffB); PG8_STAGE(PG8_SB(1, 1), b3 + hstepB, voffB); PG8_STAGE(PG8_SA(1, 0), a3, voffA);
            PG8_WAIT_V(8); PG8_WAIT_L(0); PG8_BAR; PG8_MMA(1, 0, At, B0); PG8_MMA(1, 1, At, B1); PG8_BAR; PG8_SCHED;
            } else {
            PG8_LDB(B0, 0, 0); PG8_SCHED; PG8_LDA(At, 0, 0); PG8_STAGE(PG8_SA(1, 1), a1 + hstepA, voffA);
            PG8_WAIT_L(8); PG8_BAR; PG8_WAIT_L(0); PG8_MMA(0, 0, At, B0); PG8_BAR; PG8_SCHED;
            PG8_LDB(B1, 0, 1); PG8_STAGE(PG8_SB(0, 0), b2, voffB);
            PG8_BAR; PG8_WAIT_L(0); PG8_MMA(0, 1, At, B1); PG8_BAR;
            PG8_LDA(At, 0, 1); PG8_STAGE(PG8_SA(0, 0), a2, voffA);
            PG8_BAR; PG8_WAIT_L(0); PG8_MMA(1, 0, At, B0); PG8_BAR; PG8_SCHED;
            PG8_STAGE(PG8_SB(0, 1), b2 + hstepB, voffB);
            PG8_WAIT_V(6); PG8_BAR; PG8_MMA(1, 1, At, B1); PG8_BAR;
            PG8_LDB(B0, 1, 0); PG8_SCHED; PG8_LDA(At, 1, 0); PG8_STAGE(PG8_SA(0, 1), a2 + hstepA, voffA);
            PG8_WAIT_L(8); PG8_BAR; PG8_WAIT_L(0); PG8_MMA(0, 0, At, B0); PG8_BAR; PG8_SCHED;
            PG8_LDB(B1, 1, 1); PG8_STAGE(PG8_SB(1, 0), b3, voffB);
            PG8_BAR; PG8_WAIT_L(0); PG8_MMA(0, 1, At, B1); PG8_BAR;
            PG8_LDA(At, 1, 1); PG8_STAGE(PG8_SA(1, 0), a3, voffA);
            PG8_BAR; PG8_WAIT_L(0); PG8_MMA(1, 0, At, B0); PG8_BAR; PG8_SCHED;
            PG8_STAGE(PG8_SB(1, 1), b3 + hstepB, voffB);
            PG8_WAIT_V(6); PG8_BAR; PG8_MMA(1, 1, At, B1); PG8_BAR;
            }
        }
        if constexpr (ALIGN_EPI) { if (wr == 0) PG8_BAR; }
        if constexpr (!Epi::AFTER_DRAIN) { E(acc, cur, wr, wc, fr, fq); S.done(cur); }
        if (!has_next) break;
#pragma unroll
        for (int a = 0; a < 2; ++a)
#pragma unroll
            for (int b = 0; b < 2; ++b)
#pragma unroll
                for (int m = 0; m < 4; ++m)
#pragma unroll
                    for (int n = 0; n < 2; ++n) acc[a][b][m][n] = (f32x4){0.f, 0.f, 0.f, 0.f};
        cur = nxt; cA = nA; cB = nB; ++ui;
        if constexpr (ALIGN_EPI) { if (wr == 1) PG8_BAR; }
    }
    PG8_WAIT_V(0);
    if constexpr (!ALIGN_EPI) { if (wr == 0) PG8_BAR; }
    PG8_BAR;
    if constexpr (Epi::AFTER_DRAIN) { E.fused(acc, cur, wr, wc, fr, fq, lds, wid, lane); S.done(cur); }
#undef PG8_SA
#undef PG8_SB
#undef PG8_STAGE
#undef PG8_LDA
#undef PG8_LDB
#undef PG8_MMA
#undef PG8_WAIT_V
#undef PG8_WAIT_L
#undef PG8_BAR
#undef PG8_SCHED
}
}
#define XB_TMO      128
#define XB_XCNT(j)  (256  + 64 * (j))
#define XB_XSUB(j)  (1280 + 64 * (j))
#define XB_XGEN(j)  (2304 + 64 * (j))
#define XB_TOP      3328
#define XB_TOPGEN   3392
#define XCD_BAR_WORDS 3456
#define XB_SPIN_CAP (1u << 18)

__device__ __forceinline__ unsigned xb_ld(unsigned* p)              { return __hip_atomic_load(p, __ATOMIC_RELAXED, __HIP_MEMORY_SCOPE_AGENT); }
__device__ __forceinline__ unsigned xb_add(unsigned* p, unsigned v) { return __hip_atomic_fetch_add(p, v, __ATOMIC_RELAXED, __HIP_MEMORY_SCOPE_AGENT); }
__device__ __forceinline__ unsigned xb_xcc_id() { return (unsigned)__builtin_amdgcn_s_getreg((3 << 11) | 20) & 0xFu; }
#define XB_SPIN(cond, bar) do { unsigned _sp = 0; while (cond) { __builtin_amdgcn_s_sleep(1); \
    if ((++_sp & 255u) == 0u) { if (xb_ld(&(bar)[XB_TMO])) break; if (_sp > XB_SPIN_CAP) { atomicAdd(&(bar)[XB_TMO], 1u); break; } } } } while (0)

struct XcdBarrier {
    unsigned* bar; unsigned x;
    volatile LAS unsigned* st;
};

__device__ __forceinline__ XcdBarrier xcd_barrier_post(unsigned* bar, volatile LAS unsigned* st) {
    XcdBarrier b; b.bar = bar; b.x = xb_xcc_id(); b.st = st;
    if (threadIdx.x == 0) (void)xb_add(&bar[XB_XCNT(b.x)], 1u);
    return b;
}
__device__ __forceinline__ void xcd_barrier_complete(unsigned* bar, unsigned x, unsigned& nloc, unsigned& nx) {
    const unsigned G = gridDim.x * gridDim.y * gridDim.z;
    unsigned sum, cnt, mine, sp = 0u;
    for (;;) {
        sum = 0u; cnt = 0u; mine = 0u;
#pragma unroll
        for (unsigned j = 0; j < 16; ++j) { const unsigned c = xb_ld(&bar[XB_XCNT(j)]); sum += c; cnt += (c > 0u) ? 1u : 0u; mine = (j == x) ? c : mine; }
        if (sum == G) break;
        __builtin_amdgcn_s_sleep(1);
        if ((++sp & 255u) == 0u) { if (xb_ld(&bar[XB_TMO])) break; if (sp > XB_SPIN_CAP) { atomicAdd(&bar[XB_TMO], 1u); break; } }
    }
    nloc = mine > 0u ? mine : 1u; nx = cnt > 0u ? cnt : 1u;
}

__device__ __forceinline__ void xcd_barrier(const XcdBarrier& b) {
    asm volatile("s_waitcnt vmcnt(0)" ::: "memory");
    __syncthreads();
    if (threadIdx.x == 0) {
        unsigned* bar = b.bar;
        __builtin_amdgcn_s_waitcnt(0);
        unsigned nloc = b.st[0], nx = b.st[1];
        if (nloc == 0u) { xcd_barrier_complete(bar, b.x, nloc, nx); b.st[0] = nloc; b.st[1] = nx; }
        const unsigned old = xb_add(&bar[XB_XSUB(b.x)], 1u);
        const unsigned gen = old / nloc;
        if (old + 1u == (gen + 1u) * nloc) {
            __builtin_amdgcn_fence(__ATOMIC_RELEASE, "agent");
            asm volatile("s_waitcnt vmcnt(0)" ::: "memory");
            const unsigned og = xb_add(&bar[XB_TOP], 1u);
            const unsigned tg = og / nx;
            if (og + 1u == (tg + 1u) * nx) xb_add(&bar[XB_TOPGEN], 1u);
            else XB_SPIN(xb_ld(&bar[XB_TOPGEN]) == tg, bar);
            __builtin_amdgcn_fence(__ATOMIC_ACQUIRE, "agent");
            xb_add(&bar[XB_XGEN(b.x)], 1u);
            asm volatile("s_waitcnt vmcnt(0)" ::: "memory");
        } else {
            XB_SPIN(xb_ld(&bar[XB_XGEN(b.x)]) == gen, bar);
            __builtin_amdgcn_fence(__ATOMIC_ACQUIRE, "agent");
            asm volatile("s_waitcnt vmcnt(0)" ::: "memory");
        }
    }
    __syncthreads();
}

constexpr int NWAVES = 8;
constexpr int RING_OFF = 0, RING_BYTES = 131072;
constexpr int LDSCTL_OFF = RING_BYTES, MISC_OFF = LDSCTL_OFF + 320;
constexpr int LDS_BYTES = 147456;

struct Args { const float* in[20]; float* out; unsigned char* ws; int ph_lo, ph_hi, li, pad; };

struct Frame {
    LAS unsigned char* lds;
    volatile LAS unsigned* MISC;
    gu32* ctl;
    int tid, lane, wave, vcu, G;
    unsigned char* ws; float* out;
    const float* x; const float* p;
};

enum Phase { PH_PRO = 0, PH_PROJ, PH_MIX1, PH_SCAN, PH_RETO, PH_BR, PH_WOUT, PH_ROUTE, PH_GATHER, PH_GU, PH_DOWN, PH_COMB, PH_PLE, PH_FINAL, NPH };

DI void tr_item(const float* __restrict__ W, int ldw, int mycol, bf16* WT, int K, int r0, int k0, LAS float* scr, int lane) {
#pragma unroll 8
    for (int i = 0; i < 32; ++i) { const int kk = 2 * i + (lane >> 5); scr[kk * 33 + (lane & 31)] = W[(size_t)(k0 + kk) * ldw + mycol]; }
    LDS_WAIT(); asm volatile("" ::: "memory");
    const int c = lane & 7;
#pragma unroll
    for (int j = 0; j < 4; ++j) { const int n = (lane >> 3) + 8 * j; const LAS float* s = scr + (8 * c) * 33 + n;
        v4u o; o.x = pk2(s[0 * 33], s[1 * 33]); o.y = pk2(s[2 * 33], s[3 * 33]); o.z = pk2(s[4 * 33], s[5 * 33]); o.w = pk2(s[6 * 33], s[7 * 33]);
        *(GAS v4u*)(WT + (size_t)(r0 + n) * K + k0 + 8 * c) = o; }
    LDS_WAIT(); asm volatile("" ::: "memory");
}
DI void rms_row_to_bf16(const float* xrow, const float* gain, bf16* orow, int lane) {
    const GAS f32x4* xr = (const GAS f32x4*)xrow + lane; const GAS f32x4* gr = (const GAS f32x4*)gain + lane;
    f32x4 v[4]; float s = 0.f;
#pragma unroll
    for (int j = 0; j < 4; ++j) { v[j] = xr[64 * j]; s += (v[j].x * v[j].x + v[j].y * v[j].y) + (v[j].z * v[j].z + v[j].w * v[j].w); }
    const float rstd = rsqrtf(wave_sum(s) * (1.f / DM) + EPS);
    GAS v2u* o8 = (GAS v2u*)orow + lane;
#pragma unroll
    for (int j = 0; j < 4; ++j) { const f32x4 g = gr[64 * j]; v2u o; o.x = pk2(v[j].x * rstd * g.x, v[j].y * rstd * g.y); o.y = pk2(v[j].z * rstd * g.z, v[j].w * rstd * g.w); o8[64 * j] = o; }
}
DI void ph_prologue(Frame& F, const Args& a) {
    LAS float* scr = (LAS float*)(F.lds + RING_OFF + F.wave * 16384);
    const int gw = F.vcu * NWAVES + F.wave, NGW = F.G * NWAVES, lane = F.lane;
    unsigned char* ws = F.ws;
    constexpr int I_IN = (6144 / 32) * 16, I_BR = 32 * 8, I_OUT = 32 * 16, I_GU = 16 * 32 * 16, I_D = 16 * 32 * 8, I_PLE = 32 * 4, I_PG = 32 * 16;
    constexpr int NITEMS = I_IN + 2 * I_BR + I_OUT + I_GU + I_D + I_PLE + I_PG;
    for (int it = gw; it < NITEMS; it += NGW) {
        int r = it;
        if (r < I_IN) { const int rb = r >> 4, kb = r & 15; tr_item(a.in[3], NWIN, in_src(rb * 32 + (lane & 31)), (bf16*)(ws + WS_WIN), 1024, rb * 32, kb * 64, scr, lane); continue; } r -= I_IN;
        if (r < I_BR) { const int rb = r >> 3, kb = r & 7; tr_item(a.in[5], DM, rb * 32 + (lane & 31), (bf16*)(ws + WS_WBR1), 512, rb * 32, kb * 64, scr, lane); continue; } r -= I_BR;
        if (r < I_BR) { const int rb = r >> 3, kb = r & 7; tr_item(a.in[6], DM, rb * 32 + (lane & 31), (bf16*)(ws + WS_WBR2), 512, rb * 32, kb * 64, scr, lane); continue; } r -= I_BR;
        if (r < I_OUT) { const int rb = r >> 4, kb = r & 15; tr_item(a.in[7], DM, rb * 32 + (lane & 31), (bf16*)(ws + WS_WOUT), 1024, rb * 32, kb * 64, scr, lane); continue; } r -= I_OUT;
        if (r < I_GU) { const int e = r >> 9, q = r & 511, rb = q >> 4, kb = q & 15;
            const int row = rb * 32, j = row >> 8, w = row & 255; const bool up = w >= 128; const int col = 128 * j + (w & 127) + (lane & 31);
            tr_item((up ? a.in[14] : a.in[13]) + (size_t)e * DM * DEXP, DEXP, col, (bf16*)(ws + WS_WGU) + (size_t)e * 1024 * 1024, 1024, row, kb * 64, scr, lane); continue; } r -= I_GU;
        if (r < I_D) { const int e = r >> 8, q = r & 255, rb = q >> 3, kb = q & 7;
            tr_item(a.in[15] + (size_t)e * DEXP * DM, DM, rb * 32 + (lane & 31), (bf16*)(ws + WS_WD) + (size_t)e * 1024 * 512, 512, rb * 32, kb * 64, scr, lane); continue; } r -= I_D;
        if (r < I_PLE) { const int rb = r >> 2, kb = r & 3; tr_item(a.in[17], DM, rb * 32 + (lane & 31), (bf16*)(ws + WS_WPLE), 256, rb * 32, kb * 64, scr, lane); continue; } r -= I_PLE;
        { const int rb = r >> 4, kb = r & 15; tr_item(a.in[18], DM, rb * 32 + (lane & 31), (bf16*)(ws + WS_WPG), 1024, rb * 32, kb * 64, scr, lane); }
    }
    bf16* HB = (bf16*)((unsigned char*)F.out + DO_HB);
    for (int m = gw; m < NTOK; m += NGW) {
        rms_row_to_bf16(F.x + (size_t)m * DM, a.in[2], HB + (size_t)m * DM, lane);
        const f32x4 pv = ((const GAS f32x4*)(F.p + (size_t)m * 256))[lane];
        v2u o; o.x = pk2(pv.x, pv.y); o.y = pk2(pv.z, pv.w); ((GAS v2u*)((bf16*)(ws + WS_PB) + (size_t)m * 256))[lane] = o;
    }
    f32x2* tabA = (f32x2*)(ws + WS_TABA); f32x2* tabB = (f32x2*)(ws + WS_TABB);
    for (int i = F.vcu * 512 + F.tid; i < SEQ * 64; i += F.G * 512) {
        const int pos = i >> 6, p = i & 63;
        const float invf = powf(10000.0f, -(float)(2 * p) * (1.0f / 128.0f)); const float ang = (float)pos * invf;
        const f32x2 cs = {cosf(ang), sinf(ang)};
        tabA[i] = cs; tabB[p * SEQ + pos] = cs;
    }
}

DI void ph_route(Frame& F, const Args& a) {
    LAS float* WL = (LAS float*)(F.lds);
    for (int i = F.tid; i < 1024 * 20; i += 512) { const int k = i / 20, o = i - k * 20; WL[i] = o < 4 ? a.in[9][k * 4 + o] : a.in[11][k * 16 + (o - 4)]; }
    LAS int* s_e = (LAS int*)(F.lds + 81920); LAS int* s_lr = s_e + 256; LAS int* lcnt = s_lr + 256; LAS int* lbase = lcnt + 16;
    unsigned char* ws = F.ws; const int lane = F.lane;
    int* eid = (int*)(ws + WS_ROUTE + RT_EID); float* wgt = (float*)(ws + WS_ROUTE + RT_WGT); int* rank = (int*)(ws + WS_ROUTE + RT_RANK);
    bf16* H2 = (bf16*)(ws + WS_H2);
    const float* bg = a.in[10]; const float* be = a.in[12];
    __syncthreads();
    for (int blk = F.vcu; blk < NTOK / 128; blk += F.G) {
        if (F.tid < 16) lcnt[F.tid] = 0;
        __syncthreads();
        for (int tl = F.wave; tl < 128; tl += NWAVES) {
            const int tok = blk * 128 + tl;
            const GAS f32x4* xr = (const GAS f32x4*)(F.out + (size_t)tok * DM) + lane; const GAS f32x4* gr = (const GAS f32x4*)a.in[8] + lane;
            f32x4 v[4]; float ss = 0.f;
#pragma unroll
            for (int j = 0; j < 4; ++j) { v[j] = xr[64 * j]; ss += (v[j].x * v[j].x + v[j].y * v[j].y) + (v[j].z * v[j].z + v[j].w * v[j].w); }
            const float rstd = rsqrtf(wave_sum(ss) * (1.f / DM) + EPS);
            GAS v2u* o8 = (GAS v2u*)(H2 + (size_t)tok * DM) + lane;
            float acc[20];
#pragma unroll
            for (int o = 0; o < 20; ++o) acc[o] = 0.f;
#pragma unroll
            for (int j = 0; j < 4; ++j) {
                const f32x4 g = gr[64 * j]; v[j] = v[j] * rstd * g;
                v2u o; o.x = pk2(v[j].x, v[j].y); o.y = pk2(v[j].z, v[j].w); o8[64 * j] = o;
#pragma unroll
                for (int i = 0; i < 4; ++i) {
                    const float hv = v[j][i]; const LAS f32x4* w = (const LAS f32x4*)(WL + (4 * (lane + 64 * j) + i) * 20);
#pragma unroll
                    for (int q = 0; q < 5; ++q) { const f32x4 wv = w[q]; acc[4 * q] += hv * wv.x; acc[4 * q + 1] += hv * wv.y; acc[4 * q + 2] += hv * wv.z; acc[4 * q + 3] += hv * wv.w; }
                }
            }
#pragma unroll
            for (int o = 0; o < 20; ++o) acc[o] = wave_sum(acc[o]);
            float gl[4];
#pragma unroll
            for (int i = 0; i < 4; ++i) gl[i] = acc[i] + bg[i];
            int g = 0; float gm = gl[0];
#pragma unroll
            for (int i = 1; i < 4; ++i) if (gl[i] > gm) { gm = gl[i]; g = i; }
            float se = 0.f;
#pragma unroll
            for (int i = 0; i < 4; ++i) se += __expf(gl[i] - gm);
            const float pg = 1.0f / se;
            float el[4];
#pragma unroll
            for (int i = 0; i < 4; ++i) { const float l0 = acc[4 + i], l1 = acc[8 + i], l2 = acc[12 + i], l3 = acc[16 + i]; el[i] = (g == 0 ? l0 : g == 1 ? l1 : g == 2 ? l2 : l3) + be[4 * g + i]; }
            int i1 = 0; float m1 = el[0];
#pragma unroll
            for (int i = 1; i < 4; ++i) if (el[i] > m1) { m1 = el[i]; i1 = i; }
            int i2 = -1; float m2 = -3.0e38f;
#pragma unroll
            for (int i = 0; i < 4; ++i) if (i != i1 && el[i] > m2) { m2 = el[i]; i2 = i; }
            const float e2 = __expf(m2 - m1), w1 = pg / (1.0f + e2), w2 = pg * e2 / (1.0f + e2);
            if (lane == 0) {
                eid[2 * tok] = 4 * g + i1; eid[2 * tok + 1] = 4 * g + i2; wgt[2 * tok] = w1; wgt[2 * tok + 1] = w2;
                s_e[2 * tl] = 4 * g + i1; s_e[2 * tl + 1] = 4 * g + i2;
            }
        }
        __syncthreads();
        if (F.tid < 256) s_lr[F.tid] = atomicAdd((int*)&lcnt[s_e[F.tid]], 1);
        __syncthreads();
        if (F.tid < 16) lbase[F.tid] = (int)__hip_atomic_fetch_add(F.ctl + CW_CNT + F.tid, (unsigned)lcnt[F.tid], RLX_AGENT);
        __syncthreads();
        if (F.tid < 256) rank[blk * 256 + F.tid] = lbase[s_e[F.tid]] + s_lr[F.tid];
        __syncthreads();
    }
}

DI void expert_table(Frame& F, LAS int* pst) {
    if (F.tid == 0) { int acc = 0; for (int e = 0; e < NEXP; ++e) { pst[e] = acc; const int c = (int)__hip_atomic_load(F.ctl + CW_CNT + e, RLX_AGENT); acc += (c + 255) & ~255; } pst[NEXP] = acc; }
    __syncthreads();
}

DI void ph_gather(Frame& F, const Args& a) {
    LAS int* pst = (LAS int*)(F.lds);
    expert_table(F, pst);
    unsigned char* ws = F.ws; const int lane = F.lane;
    const int* eid = (const int*)(ws + WS_ROUTE + RT_EID); const float* wgt = (const float*)(ws + WS_ROUTE + RT_WGT); const int* rank = (const int*)(ws + WS_ROUTE + RT_RANK);
    int* pos = (int*)(ws + WS_ROUTE + RT_POS); float* wrow = (float*)(ws + WS_ROUTE + RT_WROW); int* tile = (int*)(ws + WS_ROUTE + RT_TILE);
    const bf16* H2 = (const bf16*)(ws + WS_H2); bf16* XB = (bf16*)(ws + WS_XB);
    if (blockIdx.x == 0 && F.tid < NEXP) { const int e = F.tid; for (int rt = pst[e] >> 8; rt < (pst[e + 1] >> 8); ++rt) tile[1 + rt] = e; if (e == 0) tile[0] = pst[NEXP] >> 8; }
    const int gw = F.vcu * NWAVES + F.wave, NGW = F.G * NWAVES;
    for (int tok = gw; tok < NTOK; tok += NGW) {
        const int p0 = pst[eid[2 * tok]] + rank[2 * tok], p1 = pst[eid[2 * tok + 1]] + rank[2 * tok + 1];
        const GAS v4u* src = (const GAS v4u*)(H2 + (size_t)tok * DM) + lane;
        const v4u r0 = src[0], r1 = src[64];
        GAS v4u* d0 = (GAS v4u*)(XB + (size_t)p0 * DM) + lane; GAS v4u* d1 = (GAS v4u*)(XB + (size_t)p1 * DM) + lane;
        d0[0] = r0; d0[64] = r1; d1[0] = r0; d1[64] = r1;
        if (lane == 0) { pos[2 * tok] = p0; pos[2 * tok + 1] = p1; wrow[p0] = wgt[2 * tok]; wrow[p1] = wgt[2 * tok + 1]; }
    }
}

DI void ph_combine(Frame& F, const Args& a) {
    unsigned char* ws = F.ws; const int lane = F.lane;
    const int* pos = (const int*)(ws + WS_ROUTE + RT_POS); const bf16* YB = (const bf16*)(ws + WS_XB); bf16* HP = (bf16*)(ws + WS_H2);
    const int gw = F.vcu * NWAVES + F.wave, NGW = F.G * NWAVES;
    for (int tok = gw; tok < NTOK; tok += NGW) {
        GAS f32x4* xr = (GAS f32x4*)(F.out + (size_t)tok * DM) + lane; const GAS f32x4* gr = (const GAS f32x4*)a.in[16] + lane;
        const GAS v2u* y0 = (const GAS v2u*)(YB + (size_t)pos[2 * tok] * DM) + lane; const GAS v2u* y1 = (const GAS v2u*)(YB + (size_t)pos[2 * tok + 1] * DM) + lane;
        f32x4 v[4]; float ss = 0.f;
#pragma unroll
        for (int j = 0; j < 4; ++j) {
            v[j] = xr[64 * j]; const v2u a0 = y0[64 * j], a1 = y1[64 * j];
            v[j].x += bflo(a0.x) + bflo(a1.x); v[j].y += bfhi(a0.x) + bfhi(a1.x); v[j].z += bflo(a0.y) + bflo(a1.y); v[j].w += bfhi(a0.y) + bfhi(a1.y);
            xr[64 * j] = v[j]; ss += (v[j].x * v[j].x + v[j].y * v[j].y) + (v[j].z * v[j].z + v[j].w * v[j].w);
        }
        const float rstd = rsqrtf(wave_sum(ss) * (1.f / DM) + EPS);
        GAS v2u* o8 = (GAS v2u*)(HP + (size_t)tok * DM) + lane;
#pragma unroll
        for (int j = 0; j < 4; ++j) { const f32x4 g = gr[64 * j]; v2u o; o.x = pk2(v[j].x * rstd * g.x, v[j].y * rstd * g.y); o.y = pk2(v[j].z * rstd * g.z, v[j].w * rstd * g.w); o8[64 * j] = o; }
    }
}

DI void ph_final(Frame& F, const Args& a) {
    const int lane = F.lane, gw = F.vcu * NWAVES + F.wave, NGW = F.G * NWAVES;
    for (int tok = gw; tok < NTOK; tok += NGW) {
        GAS f32x4* xr = (GAS f32x4*)(F.out + (size_t)tok * DM) + lane; const GAS f32x4* gr = (const GAS f32x4*)a.in[19] + lane;
        f32x4 v[4]; float ss = 0.f;
#pragma unroll
        for (int j = 0; j < 4; ++j) { v[j] = xr[64 * j]; ss += (v[j].x * v[j].x + v[j].y * v[j].y) + (v[j].z * v[j].z + v[j].w * v[j].w); }
        const float rstd = rsqrtf(wave_sum(ss) * (1.f / DM) + EPS);
#pragma unroll
        for (int j = 0; j < 4; ++j) { const f32x4 g = gr[64 * j]; xr[64 * j] = v[j] * rstd * g; }
    }
}

DI void fast_proj(Frame&, const Args&) {}
DI void fast_ret_kv(Frame&, const Args&) {}
DI void fast_att(Frame&, const Args&) {}
DI void fast_ret_scan(Frame&, const Args&) {}
DI void fast_ret_out(Frame&, const Args&) {}
DI void fast_br(Frame&, const Args&) {}
DI void fast_wout(Frame&, const Args&) {}
DI void fast_gu(Frame&, const Args&) {}
DI void fast_down(Frame&, const Args&) {}
DI void fast_ple(Frame&, const Args&) {}

__global__ void __launch_bounds__(NWAVES * 64, 2) mega(Args args) {
    extern __shared__ __attribute__((aligned(16))) unsigned char lds[];
    Frame F;
    F.lds = (LAS unsigned char*)lds;
    F.MISC = (volatile LAS unsigned*)(F.lds + MISC_OFF);
    F.tid = threadIdx.x; F.lane = F.tid & 63; F.wave = __builtin_amdgcn_readfirstlane(F.tid >> 6);
    F.G = gridDim.x; { const int bx = blockIdx.x; F.vcu = (F.G % 8 == 0) ? (bx % 8) * (F.G / 8) + bx / 8 : bx; }
    F.ws = args.ws; F.out = args.out; F.x = args.in[0]; F.p = args.in[1];
    F.ctl = (gu32*)(args.ws + WS_CTL);
    for (int u = F.tid; u < (LDS_BYTES - LDSCTL_OFF) / 4; u += NWAVES * 64) ((LAS unsigned*)(F.lds + LDSCTL_OFF))[u] = 0u;
    __syncthreads();
    const int lo = args.ph_lo, hi = args.ph_hi;
    XcdBarrier bar; bar.bar = (unsigned*)(F.ctl + CW_BAR) + args.li * BAR_STRIDE; bar.x = 0; bar.st = nullptr;
    if (hi - lo > 1) bar = xcd_barrier_post((unsigned*)(F.ctl + CW_BAR) + args.li * BAR_STRIDE, F.MISC + 8);
#define IN(k) (lo <= (k) && (k) < hi)
#define SEAM(k) do { if (IN(k) && IN((k) + 1)) xcd_barrier(bar); } while (0)

    if (IN(PH_PRO)) { ph_prologue(F, args); } SEAM(PH_PRO);
    if (IN(PH_PROJ)) { if (FAST(F_PROJ)) fast_proj(F, args); } SEAM(PH_PROJ);
    if (IN(PH_MIX1)) { if (FAST(F_RET)) fast_ret_kv(F, args); if (FAST(F_ATT)) fast_att(F, args); } SEAM(PH_MIX1);
    if (IN(PH_SCAN)) { if (FAST(F_RET)) fast_ret_scan(F, args); } SEAM(PH_SCAN);
    if (IN(PH_RETO)) { if (FAST(F_RET)) fast_ret_out(F, args); } SEAM(PH_RETO);
    if (IN(PH_BR)) { if (FAST(F_BR)) fast_br(F, args); } SEAM(PH_BR);
    if (IN(PH_WOUT)) { if (FAST(F_WOUT)) fast_wout(F, args); } SEAM(PH_WOUT);
    if (IN(PH_ROUTE)) { ph_route(F, args); } SEAM(PH_ROUTE);
    if (IN(PH_GATHER)) { ph_gather(F, args); } SEAM(PH_GATHER);
    if (IN(PH_GU)) { if (FAST(F_MOE)) fast_gu(F, args); } SEAM(PH_GU);
    if (IN(PH_DOWN)) { if (FAST(F_MOE)) fast_down(F, args); } SEAM(PH_DOWN);
    if (IN(PH_COMB)) { ph_combine(F, args); } SEAM(PH_COMB);
    if (IN(PH_PLE)) { if (FAST(F_PLE)) fast_ple(F, args); } SEAM(PH_PLE);
    if (IN(PH_FINAL)) { ph_final(F, args); }
#undef IN
#undef SEAM
}

struct Launcher {
    Args a; int grid; hipStream_t stream; int pend_lo, pend_hi, li;
    void flush() {
        if (pend_lo < 0) return;
#if SPLIT_PHASES
        for (int p = pend_lo; p < pend_hi; ++p) { a.ph_lo = p; a.ph_hi = p + 1; a.li = 0; hipLaunchKernelGGL(mega, dim3(grid), dim3(NWAVES * 64), LDS_BYTES, stream, a); }
#else
        a.ph_lo = pend_lo; a.ph_hi = pend_hi; a.li = li++;
        hipLaunchKernelGGL(mega, dim3(grid), dim3(NWAVES * 64), LDS_BYTES, stream, a);
#endif
        pend_lo = pend_hi = -1;
    }
    void phases(int lo, int hi) { if (pend_lo >= 0 && pend_hi == lo) { pend_hi = hi; return; } flush(); pend_lo = lo; pend_hi = hi; }
};
template <class E> static void launch_naive(hipStream_t s, const E& e, int M, int N, int K) { hipLaunchKernelGGL(naive_gemm<E>, dim3(N / 64, M / 128), dim3(256), 0, s, e, N, K); }

extern "C" void kernel_launch(void* const* d_in, const int* in_sizes, int n_in, void* d_out, int out_size, void* d_ws, size_t ws_size, hipStream_t stream) {
    static int grid = 0;
    if (grid == 0) {
        if (n_in != 20 || in_sizes[0] != NTOK * DM || out_size != NTOK * DM || ws_size < WS_END) { fprintf(stderr, "kernel_launch: unexpected shapes (n_in %d, in0 %d, out %d, ws %zu)\n", n_in, n_in > 0 ? in_sizes[0] : -1, out_size, ws_size); grid = -1; return; }
        int dev = 0, cus = 0, per_cu = 0;
        if (hipGetDevice(&dev) != hipSuccess || hipDeviceGetAttribute(&cus, hipDeviceAttributeMultiprocessorCount, dev) != hipSuccess) { grid = -1; return; }
        if (hipFuncSetAttribute((const void*)mega, hipFuncAttributeMaxDynamicSharedMemorySize, LDS_BYTES) != hipSuccess) { fprintf(stderr, "kernel_launch: hipFuncSetAttribute failed\n"); grid = -1; return; }
        if (hipOccupancyMaxActiveBlocksPerMultiprocessor(&per_cu, (const void*)mega, NWAVES * 64, LDS_BYTES) != hipSuccess || per_cu < 1) fprintf(stderr, "kernel_launch: occupancy query reports %d\n", per_cu);
        (void)hipGetLastError();
        grid = cus;
    }
    if (grid < 0) return;
    unsigned char* ws = (unsigned char*)d_ws;
    if (hipMemsetAsync(ws + WS_CTL, 0, CTL_ZERO_BYTES, stream) != hipSuccess) return;
    Launcher L{}; L.grid = grid; L.stream = stream; L.pend_lo = L.pend_hi = -1; L.li = 0;
    for (int i = 0; i < 20; ++i) L.a.in[i] = (const float*)d_in[i];
    L.a.out = (float*)d_out; L.a.ws = ws;
    const float* const* in = (const float* const*)d_in; (void)in;
    bf16* HB = (bf16*)((unsigned char*)d_out + DO_HB); bf16* NV = (bf16*)((unsigned char*)d_out + DO_NV);
    bf16* PROJ = (bf16*)(ws + WS_PROJ); bf16* T = (bf16*)(ws + WS_T);
    const f32x2* tabA = (const f32x2*)(ws + WS_TABA); const f32x2* tabB = (const f32x2*)(ws + WS_TABB);
    const int* tile = (const int*)(ws + WS_ROUTE + RT_TILE); const float* wrow = (const float*)(ws + WS_ROUTE + RT_WROW);

    L.phases(PH_PRO, PH_PRO + 1);
    if (FAST(F_PROJ)) L.phases(PH_PROJ, PH_PROJ + 1);
    else { L.flush(); launch_naive(stream, NProjMain{HB, in[3], PROJ, tabA}, NTOK, NMAIN, DM); if (FAST(F_RET) || FAST(F_ATT)) launch_naive(stream, NProjT{HB, in[3], T, tabB}, NTOK, NTR, DM); }
    if (!FAST(F_RET) || !FAST(F_ATT)) { L.flush(); launch_naive(stream, NProjV{HB, in[3], NV}, NTOK, 1024, DM); }
    if (FAST(F_RET) || FAST(F_ATT)) L.phases(PH_MIX1, PH_MIX1 + 1);
    if (FAST(F_RET)) L.phases(PH_SCAN, PH_RETO + 1);
    if (!FAST(F_RET)) { L.flush(); hipLaunchKernelGGL(naive_ret, dim3(NBATCH * 4 * 64), dim3(256), 0, stream, PROJ, (const bf16*)NV, in[4]); }
    if (!FAST(F_ATT)) { L.flush(); hipLaunchKernelGGL(naive_att, dim3(NBATCH * 8 * 64), dim3(256), 0, stream, PROJ, (const bf16*)NV); }
    if (FAST(F_BR)) L.phases(PH_BR, PH_BR + 1);
    else { L.flush(); launch_naive(stream, NBr{PROJ, in[5], 0, 0}, NTOK, DM, 512); launch_naive(stream, NBr{PROJ, in[6], 1, 0}, NTOK, DM, 512); }
    if (FAST(F_WOUT)) L.phases(PH_WOUT, PH_WOUT + 1);
    else { L.flush(); launch_naive(stream, NWout{PROJ, in[7], in[0], (float*)d_out}, NTOK, DM, DM); }
    L.phases(PH_ROUTE, PH_GATHER + 1);
    if (FAST(F_MOE)) L.phases(PH_GU, PH_DOWN + 1);
    else { L.flush(); launch_naive(stream, NGateUp{(const bf16*)(ws + WS_XB), in[13], in[14], (bf16*)(ws + WS_HID), tile}, MPAD_MAX, DEXP, DM);
           launch_naive(stream, NDown{(const bf16*)(ws + WS_HID), in[15], (bf16*)(ws + WS_XB), tile, wrow}, MPAD_MAX, DM, DEXP); }
    L.phases(PH_COMB, PH_COMB + 1);
    if (FAST(F_PLE)) L.phases(PH_PLE, PH_PLE + 1);
    else { L.flush(); launch_naive(stream, NPe{(const bf16*)(ws + WS_PB), in[17], (bf16*)(ws + WS_HID)}, NTOK, DM, 256);
           launch_naive(stream, NPg{(const bf16*)(ws + WS_H2), in[18], (const bf16*)(ws + WS_HID), (float*)d_out}, NTOK, DM, DM); }
    L.phases(PH_FINAL, PH_FINAL + 1);
    L.flush();
}
```

```cpp
#define FAST_MASK 127
#include <hip/hip_runtime.h>
#include <cstdio>
#include <cstdint>

#ifndef FAST_MASK
#define FAST_MASK 0
#endif
#ifndef SPLIT_PHASES
#define SPLIT_PHASES 0
#endif
#define F_PROJ 1
#define F_RET 2
#define F_ATT 4
#define F_BR 8
#define F_WOUT 16
#define F_MOE 32
#define F_PLE 64
#define FAST(x) ((FAST_MASK & (x)) != 0)

constexpr int NTOK = 32768, DM = 1024, SEQ = 4096, NBATCH = 8;
constexpr int NMAIN = 4608, NTR = 1536, NWIN = 5632;
constexpr int C_RQ = 0, C_RK = 512, C_RG = 1024, C_SQ = 1536, C_SK = 2048, C_GR = 2560, C_GS = 3584;
constexpr int T_KT = 0, T_VR = 512, T_VS = 1024;
constexpr int NEXP = 16, DEXP = 512, MPAD_MAX = 65536 + 16 * 256, NRT_MAX = MPAD_MAX / 256;
constexpr float EPS = 1e-6f;
constexpr float LOG2E = 1.4426950408889634f;
constexpr float SB_QSCALE = 0.125f * LOG2E;
constexpr float SB_EXIT = -160.0f;

constexpr size_t MiB = 1u << 20;
constexpr size_t WS_CTL = 0, CTL_ZERO_BYTES = 1 * MiB;
constexpr size_t WS_WIN = 2 * MiB;
constexpr size_t WS_WBR1 = 14 * MiB;
constexpr size_t WS_WBR2 = 15 * MiB;
constexpr size_t WS_WOUT = 16 * MiB;
constexpr size_t WS_WGU = 18 * MiB;
constexpr size_t WS_WD = 50 * MiB;
constexpr size_t WS_WPLE = 66 * MiB;
constexpr size_t WS_WPG = 67 * MiB;
constexpr size_t WS_TABA = 70 * MiB;
constexpr size_t WS_TABB = 72 * MiB;
constexpr size_t WS_ROUTE = 74 * MiB;
constexpr size_t WS_PB = 76 * MiB;
constexpr size_t WS_PROJ = 92 * MiB;
constexpr size_t WS_T = 380 * MiB;
constexpr size_t WS_END = 476 * MiB;
constexpr size_t WS_H2 = 92 * MiB;
constexpr size_t WS_XB = 156 * MiB;
constexpr size_t WS_HID = 292 * MiB;
constexpr size_t DO_HB = 0, DO_ST = 0, DO_NV = 64 * MiB;
constexpr size_t RT_EID = 0, RT_WGT = 256 * 1024, RT_RANK = 512 * 1024, RT_POS = 768 * 1024, RT_WROW = 1024 * 1024, RT_TILE = 1536 * 1024;
constexpr int CW_TMO = 0, CW_CODE = 1;
constexpr int CW_CNT = 64;
constexpr int CW_BAR = 4096, BAR_STRIDE = 4096;

#define GAS __attribute__((address_space(1)))
#define LAS __attribute__((address_space(3)))
typedef unsigned short bf16;
typedef unsigned v4u __attribute__((ext_vector_type(4)));
typedef unsigned v2u __attribute__((ext_vector_type(2)));
typedef float f32x4 __attribute__((ext_vector_type(4)));
typedef float f32x2 __attribute__((ext_vector_type(2)));
typedef float f32x16 __attribute__((ext_vector_type(16)));
typedef short bf16x8 __attribute__((ext_vector_type(8)));
typedef short s16x4 __attribute__((ext_vector_type(4)));
typedef GAS unsigned gu32;
#define RLX_AGENT __ATOMIC_RELAXED, __HIP_MEMORY_SCOPE_AGENT
#define LDS_WAIT() asm volatile("s_waitcnt lgkmcnt(0)" ::: "memory")
#define VM_WAIT() asm volatile("s_waitcnt vmcnt(0)" ::: "memory")
#define DI __device__ __forceinline__
DI unsigned f2bf(float f) { unsigned u = __builtin_bit_cast(unsigned, f); return (u + 0x7fffu + ((u >> 16) & 1u)) >> 16; }
DI unsigned pk2(float lo, float hi) { return f2bf(lo) | (f2bf(hi) << 16); }
DI float bf2f(unsigned b) { return __builtin_bit_cast(float, b << 16); }
DI float bflo(unsigned w) { return __builtin_bit_cast(float, w << 16); }
DI float bfhi(unsigned w) { return __builtin_bit_cast(float, w & 0xffff0000u); }
DI float fsigmoid(float x) { return 1.0f / (1.0f + __expf(-x)); }
DI float fsilu(float x) { return x / (1.0f + __expf(-x)); }
DI float wave_sum(float v) {
#pragma unroll
    for (int o = 1; o < 64; o <<= 1) v += __shfl_xor(v, o);
    return v;
}
DI float ret_log2g(int h) { return log2f(1.0f - exp2f(-5.0f - (float)h)); }

__host__ __device__ __forceinline__ int in_src(int r) {
    if (r < 1024) { const int base = (r < 512) ? 0 : 512; const int i = r & 511, h = i >> 7, j = i & 127; return base + h * 128 + (j & 1) * 64 + (j >> 1); }
    if (r < 1536) return 1536 + (r - 1024);
    if (r < 2048) return 2048 + (r - 1536);
    if (r < 2560) return 2560 + (r - 2048);
    if (r < 3584) return 3584 + (r - 2560);
    if (r < 4608) return 4608 + (r - 3584);
    if (r < 5120) { const int i = r - 4608, h = i >> 7, j = i & 127; return 512 + h * 128 + (j & 1) * 64 + (j >> 1); }
    if (r < 5632) return 1024 + (r - 5120);
    return 3072 + (r - 5632);
}

DI void proj_pair(int row, int col, float v0, float v1, const f32x2* __restrict__ tabA, float& o0, float& o1) {
    if (col < C_RG) {
        const int pos = row & (SEQ - 1), p = (col & 127) >> 1;
        const f32x2 cs = tabA[pos * 64 + p];
        float a = v0 * cs.x - v1 * cs.y, b = v0 * cs.y + v1 * cs.x;
        if (col >= C_RK) { a *= 0.08838834764831845f; b *= 0.08838834764831845f; }
        o0 = a; o1 = b;
    } else if (col < C_SQ) { o0 = fsilu(v0); o1 = fsilu(v1); }
    else if (col < C_SK) { o0 = v0 * SB_QSCALE; o1 = v1 * SB_QSCALE; }
    else if (col < C_GR) { o0 = v0; o1 = v1; }
    else { o0 = fsigmoid(v0); o1 = fsigmoid(v1); }
}

DI void projT_pair(int f, int tok, float v0, float v1, const f32x2* __restrict__ tabB, float& o0, float& o1) {
    if (f < T_VR) {
        const int pos = tok & (SEQ - 1), h = f >> 7, p = (f & 127) >> 1;
        const f32x2 cs = tabB[p * SEQ + pos];
        const float sc = 0.08838834764831845f * exp2f(ret_log2g(h) * (float)(63 - (pos & 63)));
        o0 = (v0 * cs.x - v1 * cs.y) * sc; o1 = (v0 * cs.y + v1 * cs.x) * sc;
    } else { o0 = v0; o1 = v1; }
}

template <class E> __global__ void __launch_bounds__(256) naive_gemm(E e, int N, int K) {
    __shared__ float As[16][132];
    __shared__ float Bs[16][68];
    __shared__ float Bs2[E::DUAL ? 16 : 1][68];
    const int tid = threadIdx.x, tx = tid & 15, ty = tid >> 4;
    const int m0 = blockIdx.y * 128, n0 = blockIdx.x * 64;
    if (!e.active(m0)) return;
    float acc[8][4], acc2[8][4];
#pragma unroll
    for (int i = 0; i < 8; ++i)
#pragma unroll
        for (int j = 0; j < 4; ++j) { acc[i][j] = 0.f; acc2[i][j] = 0.f; }
    const bf16* arow = e.arow(m0 + (tid >> 1)) + (tid & 1) * 8;
    const float* bc0 = e.bcol(m0, n0 + tx * 4 + 0); const float* bc1 = e.bcol(m0, n0 + tx * 4 + 1);
    const float* bc2 = e.bcol(m0, n0 + tx * 4 + 2); const float* bc3 = e.bcol(m0, n0 + tx * 4 + 3);
    const float* bd0 = E::DUAL ? e.bcol2(m0, n0 + tx * 4 + 0) : bc0; const float* bd1 = E::DUAL ? e.bcol2(m0, n0 + tx * 4 + 1) : bc0;
    const float* bd2 = E::DUAL ? e.bcol2(m0, n0 + tx * 4 + 2) : bc0; const float* bd3 = E::DUAL ? e.bcol2(m0, n0 + tx * 4 + 3) : bc0;
    const size_t ldb = (size_t)e.ldb();
    for (int k0 = 0; k0 < K; k0 += 16) {
        const v4u av = *(const v4u*)(arow + k0);
        const int kk = (tid & 1) * 8, ar = tid >> 1;
        As[kk + 0][ar] = bflo(av.x); As[kk + 1][ar] = bfhi(av.x); As[kk + 2][ar] = bflo(av.y); As[kk + 3][ar] = bfhi(av.y);
        As[kk + 4][ar] = bflo(av.z); As[kk + 5][ar] = bfhi(av.z); As[kk + 6][ar] = bflo(av.w); As[kk + 7][ar] = bfhi(av.w);
        const size_t ko = (size_t)(k0 + ty) * ldb;
        Bs[ty][tx * 4 + 0] = bc0[ko]; Bs[ty][tx * 4 + 1] = bc1[ko]; Bs[ty][tx * 4 + 2] = bc2[ko]; Bs[ty][tx * 4 + 3] = bc3[ko];
        if (E::DUAL) { Bs2[ty][tx * 4 + 0] = bd0[ko]; Bs2[ty][tx * 4 + 1] = bd1[ko]; Bs2[ty][tx * 4 + 2] = bd2[ko]; Bs2[ty][tx * 4 + 3] = bd3[ko]; }
        __syncthreads();
#pragma unroll
        for (int k = 0; k < 16; ++k) {
            float a[8], b[4], b2[4];
#pragma unroll
            for (int i = 0; i < 8; ++i) a[i] = As[k][ty * 8 + i];
#pragma unroll
            for (int j = 0; j < 4; ++j) { b[j] = Bs[k][tx * 4 + j]; b2[j] = E::DUAL ? Bs2[k][tx * 4 + j] : 0.f; }
#pragma unroll
            for (int i = 0; i < 8; ++i)
#pragma unroll
                for (int j = 0; j < 4; ++j) { acc[i][j] += a[i] * b[j]; if (E::DUAL) acc2[i][j] += a[i] * b2[j]; }
        }
        __syncthreads();
    }
#pragma unroll
    for (int i = 0; i < 8; ++i)
#pragma unroll
        for (int j = 0; j < 4; j += 2) e.store(m0 + ty * 8 + i, n0 + tx * 4 + j, acc[i][j], acc[i][j + 1], acc2[i][j], acc2[i][j + 1]);
}

struct NProjMain {
    static constexpr bool DUAL = false;
    const bf16* HB; const float* w_in; bf16* PROJ; const f32x2* tabA;
    DI bool active(int) const { return true; }
    DI const bf16* arow(int m) const { return HB + (size_t)m * DM; }
    DI const float* bcol(int, int n) const { return w_in + in_src(n); }
    DI const float* bcol2(int, int) const { return nullptr; }
    DI int ldb() const { return NWIN; }
    DI void store(int row, int col, float v0, float v1, float, float) const { float o0, o1; proj_pair(row, col, v0, v1, tabA, o0, o1); *(unsigned*)(PROJ + (size_t)row * NMAIN + col) = pk2(o0, o1); }
};
struct NProjT {
    static constexpr bool DUAL = false;
    const bf16* HB; const float* w_in; bf16* T; const f32x2* tabB;
    DI bool active(int) const { return true; }
    DI const bf16* arow(int m) const { return HB + (size_t)m * DM; }
    DI const float* bcol(int, int n) const { return w_in + in_src(NMAIN + n); }
    DI const float* bcol2(int, int) const { return nullptr; }
    DI int ldb() const { return NWIN; }
    DI void store(int row, int col, float v0, float v1, float, float) const { float o0, o1; projT_pair(col, row, v0, v1, tabB, o0, o1); T[(size_t)col * NTOK + row] = (bf16)f2bf(o0); T[(size_t)(col + 1) * NTOK + row] = (bf16)f2bf(o1); }
};
struct NProjV {
    static constexpr bool DUAL = false;
    const bf16* HB; const float* w_in; bf16* NV;
    DI bool active(int) const { return true; }
    DI const bf16* arow(int m) const { return HB + (size_t)m * DM; }
    DI const float* bcol(int, int n) const { return w_in + (n < 512 ? 1024 + n : 3072 + (n - 512)); }
    DI const float* bcol2(int, int) const { return nullptr; }
    DI int ldb() const { return NWIN; }
    DI void store(int row, int col, float v0, float v1, float, float) const { *(unsigned*)(NV + (size_t)row * 1024 + col) = pk2(v0, v1); }
};
struct NBr {
    static constexpr bool DUAL = false;
    bf16* PROJ; const float* W; int step; int pad;
    DI bool active(int) const { return true; }
    DI const bf16* arow(int m) const { return PROJ + (size_t)m * NMAIN + (step ? C_SQ : C_RG); }
    DI const float* bcol(int, int n) const { return W + n; }
    DI const float* bcol2(int, int) const { return nullptr; }
    DI int ldb() const { return DM; }
    DI void store(int row, int col, float v0, float v1, float, float) const {
        bf16* pr = PROJ + (size_t)row * NMAIN;
        const unsigned g = *(const unsigned*)(pr + (step ? C_GS : C_GR) + col);
        float o0 = bflo(g) * v0, o1 = bfhi(g) * v1;
        if (step) { const unsigned t1 = *(const unsigned*)(pr + C_GR + col); o0 += bflo(t1); o1 += bfhi(t1); }
        *(unsigned*)(pr + C_GR + col) = pk2(o0, o1);
    }
};
struct NWout {
    static constexpr bool DUAL = false;
    const bf16* PROJ; const float* W; const float* x; float* out;
    DI bool active(int) const { return true; }
    DI const bf16* arow(int m) const { return PROJ + (size_t)m * NMAIN + C_GR; }
    DI const float* bcol(int, int n) const { return W + n; }
    DI const float* bcol2(int, int) const { return nullptr; }
    DI int ldb() const { return DM; }
    DI void store(int row, int col, float v0, float v1, float, float) const { const size_t o = (size_t)row * DM + col; out[o] = x[o] + v0; out[o + 1] = x[o + 1] + v1; }
};
struct NGateUp {
    static constexpr bool DUAL = true;
    const bf16* XB; const float* wg; const float* wu; bf16* HID; const int* tile;
    DI bool active(int m0) const { return (m0 >> 8) < tile[0]; }
    DI const bf16* arow(int m) const { return XB + (size_t)m * DM; }
    DI const float* bcol(int m0, int n) const { return wg + (size_t)tile[1 + (m0 >> 8)] * DM * DEXP + n; }
    DI const float* bcol2(int m0, int n) const { return wu + (size_t)tile[1 + (m0 >> 8)] * DM * DEXP + n; }
    DI int ldb() const { return DEXP; }
    DI void store(int row, int col, float g0, float g1, float u0, float u1) const { *(unsigned*)(HID + (size_t)row * DEXP + col) = pk2(fsilu(g0) * u0, fsilu(g1) * u1); }
};
struct NDown {
    static constexpr bool DUAL = false;
    const bf16* HID; const float* wd; bf16* YB; const int* tile; const float* wrow;
    DI bool active(int m0) const { return (m0 >> 8) < tile[0]; }
    DI const bf16* arow(int m) const { return HID + (size_t)m * DEXP; }
    DI const float* bcol(int m0, int n) const { return wd + (size_t)tile[1 + (m0 >> 8)] * DEXP * DM + n; }
    DI const float* bcol2(int, int) const { return nullptr; }
    DI int ldb() const { return DM; }
    DI void store(int row, int col, float v0, float v1, float, float) const { const float w = wrow[row]; *(unsigned*)(YB + (size_t)row * DM + col) = pk2(v0 * w, v1 * w); }
};
struct NPe {
    static constexpr bool DUAL = false;
    const bf16* PB; const float* W; bf16* PE;
    DI bool active(int) const { return true; }
    DI const bf16* arow(int m) const { return PB + (size_t)m * 256; }
    DI const float* bcol(int, int n) const { return W + n; }
    DI const float* bcol2(int, int) const { return nullptr; }
    DI int ldb() const { return DM; }
    DI void store(int row, int col, float v0, float v1, float, float) const { *(unsigned*)(PE + (size_t)row * DM + col) = pk2(v0, v1); }
};
struct NPg {
    static constexpr bool DUAL = false;
    const bf16* HP; const float* W; const bf16* PE; float* out;
    DI bool active(int) const { return true; }
    DI const bf16* arow(int m) const { return HP + (size_t)m * DM; }
    DI const float* bcol(int, int n) const { return W + n; }
    DI const float* bcol2(int, int) const { return nullptr; }
    DI int ldb() const { return DM; }
    DI void store(int row, int col, float v0, float v1, float, float) const {
        const size_t o = (size_t)row * DM + col; const unsigned pe = *(const unsigned*)(PE + o);
        out[o] = out[o] + fsigmoid(v0) * bflo(pe); out[o + 1] = out[o + 1] + fsigmoid(v1) * bfhi(pe);
    }
};

__global__ void __launch_bounds__(256) naive_ret(bf16* PROJ, const bf16* NV, const float* gn) {
    __shared__ float Ks[64][129];
    __shared__ float Vs[64][128];
    __shared__ float Ps[64][65];
    __shared__ float Qs[64][129];
    const int tid = threadIdx.x, i = tid >> 2, part = tid & 3;
    const int c = blockIdx.x & 63, h = (blockIdx.x >> 6) & 3, b = blockIdx.x >> 8;
    const int t0 = b * SEQ + c * 64;
    const float l2g = ret_log2g(h);
    {
        const bf16* qp = PROJ + (size_t)(t0 + i) * NMAIN + C_RQ + h * 128 + part * 32;
        for (int d = 0; d < 32; d += 2) { const unsigned w = *(const unsigned*)(qp + d); Qs[i][part * 32 + d] = bflo(w); Qs[i][part * 32 + d + 1] = bfhi(w); }
    }
    float o[32];
#pragma unroll
    for (int e = 0; e < 32; ++e) o[e] = 0.f;
    for (int kt = 0; kt <= c; ++kt) {
        const int s0 = b * SEQ + kt * 64;
        for (int idx = tid; idx < 64 * 64; idx += 256) {
            const int r = idx >> 6, d2 = (idx & 63) * 2;
            const unsigned kw = *(const unsigned*)(PROJ + (size_t)(s0 + r) * NMAIN + C_RK + h * 128 + d2);
            const unsigned vw = *(const unsigned*)(NV + (size_t)(s0 + r) * 1024 + h * 128 + d2);
            Ks[r][d2] = bflo(kw); Ks[r][d2 + 1] = bfhi(kw); Vs[r][d2] = bflo(vw); Vs[r][d2 + 1] = bfhi(vw);
        }
        __syncthreads();
#pragma unroll 1
        for (int jj = 0; jj < 16; ++jj) {
            const int j = part * 16 + jj; float s = 0.f;
#pragma unroll 8
            for (int d = 0; d < 128; ++d) s += Qs[i][d] * Ks[j][d];
            const int dist = (c * 64 + i) - (kt * 64 + j);
            Ps[i][j] = s * exp2f(l2g * (float)(dist < 0 ? -dist : dist));
        }
        __syncthreads();
#pragma unroll 2
        for (int j = 0; j < 64; ++j) { const float p = Ps[i][j];
#pragma unroll
            for (int e = 0; e < 32; ++e) o[e] += p * Vs[j][part * 32 + e]; }
        __syncthreads();
    }
    float s = 0.f;
#pragma unroll
    for (int e = 0; e < 32; ++e) s += o[e];
    s += __shfl_xor(s, 1); s += __shfl_xor(s, 2);
    const float mu = s * (1.0f / 128.0f); float v = 0.f;
#pragma unroll
    for (int e = 0; e < 32; ++e) { const float d = o[e] - mu; v += d * d; }
    v += __shfl_xor(v, 1); v += __shfl_xor(v, 2);
    const float rstd = rsqrtf(v * (1.0f / 128.0f) + EPS);
    bf16* gp = PROJ + (size_t)(t0 + i) * NMAIN + C_RG + h * 128 + part * 32;
#pragma unroll
    for (int e = 0; e < 32; e += 2) {
        const unsigned g = *(const unsigned*)(gp + e);
        const float r0 = (o[e] - mu) * rstd * gn[h * 128 + part * 32 + e] * bflo(g), r1 = (o[e + 1] - mu) * rstd * gn[h * 128 + part * 32 + e + 1] * bfhi(g);
        *(unsigned*)(gp + e) = pk2(r0, r1);
    }
}

__global__ void __launch_bounds__(256) naive_att(bf16* PROJ, const bf16* NV) {
    __shared__ float Ks[64][65];
    __shared__ float Vs[64][64];
    __shared__ float Zs[64][65];
    const int tid = threadIdx.x, i = tid >> 2, part = tid & 3;
    const int qb = blockIdx.x & 63, h = (blockIdx.x >> 6) & 7, b = blockIdx.x >> 9;
    const int t0 = b * SEQ + qb * 64;
    float q[64];
    {
        const bf16* qp = PROJ + (size_t)(t0 + i) * NMAIN + C_SQ + h * 64;
#pragma unroll
        for (int d = 0; d < 64; d += 2) { const unsigned w = *(const unsigned*)(qp + d); q[d] = bflo(w); q[d + 1] = bfhi(w); }
    }
    float o[16];
#pragma unroll
    for (int e = 0; e < 16; ++e) o[e] = 0.f;
    float carry = 0.f;
    for (int kt = qb; kt >= 0; --kt) {
        const int s0 = b * SEQ + kt * 64;
        for (int idx = tid; idx < 64 * 32; idx += 256) {
            const int r = idx >> 5, d2 = (idx & 31) * 2;
            const unsigned kw = *(const unsigned*)(PROJ + (size_t)(s0 + r) * NMAIN + C_SK + h * 64 + d2);
            const unsigned vw = *(const unsigned*)(NV + (size_t)(s0 + r) * 1024 + 512 + h * 64 + d2);
            Ks[r][d2] = bflo(kw); Ks[r][d2 + 1] = bfhi(kw); Vs[r][d2] = bflo(vw); Vs[r][d2 + 1] = bfhi(vw);
        }
        __syncthreads();
        for (int jj = 0; jj < 16; ++jj) {
            const int j = part * 16 + jj; float s = 0.f;
#pragma unroll
            for (int d = 0; d < 64; ++d) s += q[d] * Ks[j][d];
            Zs[i][j] = s;
        }
        __syncthreads();
        if (part == 0) {
            for (int j = 63; j >= 0; --j) {
                const float z = Zs[i][j]; float a = 0.f;
                if (kt * 64 + j < qb * 64 + i) {
                    const float lk = -log2f(1.0f + exp2f(z));
                    a = exp2f(z + lk + carry);
                    carry += lk;
                }
                Zs[i][j] = a;
            }
        }
        __syncthreads();
        for (int j = 0; j < 64; ++j) { const float p = Zs[i][j];
#pragma unroll
            for (int e = 0; e < 16; ++e) o[e] += p * Vs[j][part * 16 + e]; }
        __syncthreads();
    }
    bf16* op = PROJ + (size_t)(t0 + i) * NMAIN + C_SQ + h * 64 + part * 16;
#pragma unroll
    for (int e = 0; e < 16; e += 2) *(unsigned*)(op + e) = pk2(o[e], o[e + 1]);
}

namespace pg8 {
#define PG8_LAS __attribute__((address_space(3)))
typedef unsigned short bf16_t;
typedef short bf16x8 __attribute__((ext_vector_type(8)));
typedef float f32x4 __attribute__((ext_vector_type(4)));
typedef unsigned u32x4 __attribute__((ext_vector_type(4)));
constexpr int BM = 256, BK = 64, HALF = 128, HTB = HALF * BK * 2  , STAGE_BYTES = 8 * HTB, NXCD = 8, WGM = 8;

__host__ __device__ __forceinline__ int lds_byte(int r, int c) { const int st = (r >> 4) * 2 + (c >> 5), rr = r & 15, cc = c & 31, ob = rr * 64 + cc * 2; return st * 1024 + (ob ^ (((ob >> 9) & 1) << 5)); }
__host__ __device__ __forceinline__ void stage_rc(int b, int& R, int& C) { const int st = b / 1024, sb = b % 1024, swz = sb ^ (((sb >> 9) & 1) << 5); R = (st >> 1) * 16 + swz / 64; C = (st & 1) * 32 + (swz % 64) / 2; }
__host__ __device__ __forceinline__ int perm32(int rho) { const int n = rho >> 4, i = rho & 15; return 8 * (i >> 2) + 4 * n + (i & 3); }

struct Unit { int pm, pn; size_t bofs; int ex; };
struct Gemm { const bf16_t* A; const bf16_t* Bt; int lda, K; };

struct StaticOrder {
    int nM, nN, nwg, G, c; size_t tstepB;
    __device__ void init(int M, int N, int K, int G_, int c_) { nM = M / BM; nN = N / BM; nwg = nM * nN; G = G_; c = c_; tstepB = (size_t)BM * K * 2; }
    __device__ bool next(int i, Unit& u) const {
        const long L = (long)i * G + c; if (L >= nwg) return false;
        int wgid = (int)L; { const int q = nwg / NXCD, r = nwg % NXCD, xcd = wgid % NXCD, off = wgid / NXCD; wgid = (xcd < r ? xcd * (q + 1) : r * (q + 1) + (xcd - r) * q) + off; }
        const int nig = WGM * nN, gid = wgid / nig, fm = gid * WGM, gsz = (nM - fm) < WGM ? (nM - fm) : WGM;
        u.pm = fm + ((wgid % nig) % gsz); u.pn = (wgid % nig) / gsz; u.bofs = (size_t)u.pn * tstepB; u.ex = 0; return true;
    }
    __device__ __forceinline__ void a_ready(const Unit&) const {}
    __device__ __forceinline__ void done(const Unit&) const {}
};
__device__ __forceinline__ unsigned cvt_pk_bf16(float lo, float hi) { unsigned r; asm volatile("v_cvt_pk_bf16_f32 %0, %1, %2" : "=v"(r) : "v"(lo), "v"(hi)); return r; }
template <class Epi, class Sched, bool ALIGN_EPI = false, bool SP2 = false>
__device__ __forceinline__ void gemm_phase(PG8_LAS unsigned char* lds, const Gemm g, const Sched& S, const Epi& E) {
    int tid_ = threadIdx.x; asm volatile("" : "+v"(tid_));
    const int tid = tid_, wid = __builtin_amdgcn_readfirstlane(tid >> 6), lane = tid & 63, wr = wid >> 2, wc = wid & 3, fr = lane & 15, fq = lane >> 4;
    const int K = g.K, nt = K / BK;
    unsigned voffA[2], voffB[2];
#pragma unroll
    for (int i = 0; i < 2; ++i) { int R, C; stage_rc(tid * 16 + i * 8192, R, C); const int Rb = Epi::PERM ? ((R & ~31) + perm32(R & 31)) : R;
        voffA[i] = (unsigned)(R * g.lda + C) * 2u; voffB[i] = (unsigned)(Rb * K + C) * 2u; }
    const size_t kstep = (size_t)(BK * 2);
    const size_t hstepA = (size_t)HALF * g.lda * 2, hstepB = (size_t)HALF * K * 2;
    const size_t tstepA = 2 * hstepA;
    const unsigned ldsw = (unsigned)wid * 1024u;
    const int aoff = lds_byte(wr * 64 + fr, fq * 8), boff = lds_byte(wc * 32 + fr, fq * 8);
#define PG8_SA(b, h) (((b) * 2 + (h)) * HTB)
#define PG8_SB(b, h) ((4 + (b) * 2 + (h)) * HTB)
#define PG8_STAGE(bufoff, gbase, voff) do { _Pragma("unroll") for (int _i = 0; _i < 2; ++_i) \
        __builtin_amdgcn_global_load_lds((const unsigned*)((const char*)(gbase) + (voff)[_i]), (PG8_LAS unsigned*)(lds + (bufoff) + ldsw + _i * 8192), 16, 0, 0); } while (0)
#define PG8_LDA(dst, b, h) do { _Pragma("unroll") for (int m = 0; m < 4; ++m) _Pragma("unroll") for (int k = 0; k < 2; ++k) dst[m][k] = *(const PG8_LAS bf16x8*)(lds + PG8_SA(b, h) + aoff + m * 2048 + k * 1024); } while (0)
#define PG8_LDB(dst, b, h) do { _Pragma("unroll") for (int n = 0; n < 2; ++n) _Pragma("unroll") for (int k = 0; k < 2; ++k) dst[n][k] = *(const PG8_LAS bf16x8*)(lds + PG8_SB(b, h) + boff + n * 2048 + k * 1024); } while (0)
#define PG8_MMA(ai, bj, At, Bt) do { __builtin_amdgcn_s_setprio(1); _Pragma("unroll") for (int m = 0; m < 4; ++m) _Pragma("unroll") for (int n = 0; n < 2; ++n) _Pragma("unroll") for (int k = 0; k < 2; ++k) \
        acc[ai][bj][m][n] = __builtin_amdgcn_mfma_f32_16x16x32_bf16(Bt[n][k], At[m][k], acc[ai][bj][m][n], 0, 0, 0); __builtin_amdgcn_s_setprio(0); } while (0)
#define PG8_WAIT_V(n) asm volatile("s_waitcnt vmcnt(" #n ")" ::: "memory")
#define PG8_WAIT_L(n) asm volatile("s_waitcnt lgkmcnt(" #n ")" ::: "memory")
#define PG8_BAR __builtin_amdgcn_s_barrier()
#define PG8_SCHED __builtin_amdgcn_sched_barrier(0)
    Unit cur, nxt; int ui = 0;
    if (!S.next(0, cur)) return;
    f32x4 acc[2][2][4][2];
#pragma unroll
    for (int a = 0; a < 2; ++a)
#pragma unroll
        for (int b = 0; b < 2; ++b)
#pragma unroll
            for (int m = 0; m < 4; ++m)
#pragma unroll
                for (int n = 0; n < 2; ++n) acc[a][b][m][n] = (f32x4){0.f, 0.f, 0.f, 0.f};
    bf16x8 At[4][2], B0[2][2], B1[2][2];
    const char* cA = (const char*)g.A + (size_t)cur.pm * tstepA; const char* cB = (const char*)g.Bt + cur.bofs;
    S.a_ready(cur);
    if constexpr (SP2) {
        PG8_STAGE(PG8_SB(0, 0), cB, voffB); PG8_STAGE(PG8_SB(0, 1), cB + hstepB, voffB); PG8_STAGE(PG8_SA(0, 0), cA, voffA); PG8_STAGE(PG8_SA(0, 1), cA + hstepA, voffA);
        if (wr == 1) PG8_BAR;
        PG8_WAIT_V(2); PG8_BAR;
        PG8_STAGE(PG8_SB(1, 0), cB + kstep, voffB); PG8_STAGE(PG8_SA(1, 0), cA + kstep, voffA); PG8_STAGE(PG8_SB(1, 1), cB + hstepB + kstep, voffB);
        PG8_WAIT_V(6); PG8_BAR;
    } else {
        PG8_STAGE(PG8_SB(0, 0), cB, voffB); PG8_STAGE(PG8_SA(0, 0), cA, voffA); PG8_STAGE(PG8_SB(0, 1), cB + hstepB, voffB); PG8_STAGE(PG8_SA(0, 1), cA + hstepA, voffA);
        if (wr == 1) PG8_BAR;
        PG8_WAIT_V(4); PG8_BAR;
        PG8_STAGE(PG8_SB(1, 0), cB + kstep, voffB); PG8_STAGE(PG8_SA(1, 0), cA + kstep, voffA); PG8_STAGE(PG8_SB(1, 1), cB + hstepB + kstep, voffB);
        PG8_WAIT_V(6); PG8_BAR;
    }
    for (;;) {
        const bool has_next = S.next(ui + 1, nxt);
        const char* nA = has_next ? (const char*)g.A + (size_t)nxt.pm * tstepA : cA; const char* nB = has_next ? (const char*)g.Bt + nxt.bofs : cB;
        for (int t = 0; t < nt; t += 2) {
            const bool last = (t == nt - 2);
            const char* a1 = cA + (size_t)(t + 1) * kstep;
            const char* a2 = last ? nA : cA + (size_t)(t + 2) * kstep; const char* b2 = last ? nB : cB + (size_t)(t + 2) * kstep;
            const char* a3 = a2 + kstep; const char* b3 = b2 + kstep;
            if (last && has_next) S.a_ready(nxt);
            if constexpr (SP2) {
            PG8_LDB(B0, 0, 0); PG8_LDB(B1, 0, 1); PG8_SCHED; PG8_LDA(At, 0, 0); PG8_STAGE(PG8_SA(1, 1), a1 + hstepA, voffA);
            PG8_WAIT_V(8); PG8_WAIT_L(0); PG8_BAR; PG8_MMA(0, 0, At, B0); PG8_MMA(0, 1, At, B1); PG8_BAR; PG8_SCHED;
            PG8_LDA(At, 0, 1); PG8_STAGE(PG8_SB(0, 0), b2, voffB); PG8_STAGE(PG8_SB(0, 1), b2 + hstepB, voffB); PG8_STAGE(PG8_SA(0, 0), a2, voffA);
            PG8_WAIT_V(8); PG8_WAIT_L(0); PG8_BAR; PG8_MMA(1, 0, At, B0); PG8_MMA(1, 1, At, B1); PG8_BAR; PG8_SCHED;
            PG8_LDB(B0, 1, 0); PG8_LDB(B1, 1, 1); PG8_SCHED; PG8_LDA(At, 1, 0); PG8_STAGE(PG8_SA(0, 1), a2 + hstepA, voffA);
            PG8_WAIT_V(8); PG8_WAIT_L(0); PG8_BAR; PG8_MMA(0, 0, At, B0); PG8_MMA(0, 1, At, B1); PG8_BAR; PG8_SCHED;
            PG8_LDA(At, 1, 1); PG8_STAGE(PG8_SB(1, 0), b3, voffB); PG8_STAGE(PG8_SB(1, 1), b3 + hstepB, voffB); PG8_STAGE(PG8_SA(1, 0), a3, voffA);
            PG8_WAIT_V(8); PG8_WAIT_L(0); PG8_BAR; PG8_MMA(1, 0, At, B0); PG8_MMA(1, 1, At, B1); PG8_BAR; PG8_SCHED;
            } else {
            PG8_LDB(B0, 0, 0); PG8_SCHED; PG8_LDA(At, 0, 0); PG8_STAGE(PG8_SA(1, 1), a1 + hstepA, voffA);
            PG8_WAIT_L(8); PG8_BAR; PG8_WAIT_L(0); PG8_MMA(0, 0, At, B0); PG8_BAR; PG8_SCHED;
            PG8_LDB(B1, 0, 1); PG8_STAGE(PG8_SB(0, 0), b2, voffB);
            PG8_BAR; PG8_WAIT_L(0); PG8_MMA(0, 1, At, B1); PG8_BAR;
            PG8_LDA(At, 0, 1); PG8_STAGE(PG8_SA(0, 0), a2, voffA);
            PG8_BAR; PG8_WAIT_L(0); PG8_MMA(1, 0, At, B0); PG8_BAR; PG8_SCHED;
            PG8_STAGE(PG8_SB(0, 1), b2 + hstepB, voffB);
            PG8_WAIT_V(6); PG8_BAR; PG8_MMA(1, 1, At, B1); PG8_BAR;
            PG8_LDB(B0, 1, 0); PG8_SCHED; PG8_LDA(At, 1, 0); PG8_STAGE(PG8_SA(0, 1), a2 + hstepA, voffA);
            PG8_WAIT_L(8); PG8_BAR; PG8_WAIT_L(0); PG8_MMA(0, 0, At, B0); PG8_BAR; PG8_SCHED;
            PG8_LDB(B1, 1, 1); PG8_STAGE(PG8_SB(1, 0), b3, voffB);
            PG8_BAR; PG8_WAIT_L(0); PG8_MMA(0, 1, At, B1); PG8_BAR;
            PG8_LDA(At, 1, 1); PG8_STAGE(PG8_SA(1, 0), a3, voffA);
            PG8_BAR; PG8_WAIT_L(0); PG8_MMA(1, 0, At, B0); PG8_BAR; PG8_SCHED;
            PG8_STAGE(PG8_SB(1, 1), b3 + hstepB, voffB);
            PG8_WAIT_V(6); PG8_BAR; PG8_MMA(1, 1, At, B1); PG8_BAR;
            }
        }
        if constexpr (ALIGN_EPI) { if (wr == 0) PG8_BAR; }
        if constexpr (!Epi::AFTER_DRAIN) { E(acc, cur, wr, wc, fr, fq); S.done(cur); }
        if (!has_next) break;
#pragma unroll
        for (int a = 0; a < 2; ++a)
#pragma unroll
            for (int b = 0; b < 2; ++b)
#pragma unroll
                for (int m = 0; m < 4; ++m)
#pragma unroll
                    for (int n = 0; n < 2; ++n) acc[a][b][m][n] = (f32x4){0.f, 0.f, 0.f, 0.f};
        cur = nxt; cA = nA; cB = nB; ++ui;
        if constexpr (ALIGN_EPI) { if (wr == 1) PG8_BAR; }
    }
    PG8_WAIT_V(0);
    if constexpr (!ALIGN_EPI) { if (wr == 0) PG8_BAR; }
    PG8_BAR;
    if constexpr (Epi::AFTER_DRAIN) { E.fused(acc, cur, wr, wc, fr, fq, lds, wid, lane); S.done(cur); }
#undef PG8_SA
#undef PG8_SB
#undef PG8_STAGE
#undef PG8_LDA
#undef PG8_LDB
#undef PG8_MMA
#undef PG8_WAIT_V
#undef PG8_WAIT_L
#undef PG8_BAR
#undef PG8_SCHED
}
}
#define XB_TMO      128
#define XB_XCNT(j)  (256  + 64 * (j))
#define XB_XSUB(j)  (1280 + 64 * (j))
#define XB_XGEN(j)  (2304 + 64 * (j))
#define XB_TOP      3328
#define XB_TOPGEN   3392
#define XCD_BAR_WORDS 3456
#define XB_SPIN_CAP (1u << 18)

__device__ __forceinline__ unsigned xb_ld(unsigned* p)              { return __hip_atomic_load(p, __ATOMIC_RELAXED, __HIP_MEMORY_SCOPE_AGENT); }
__device__ __forceinline__ unsigned xb_add(unsigned* p, unsigned v) { return __hip_atomic_fetch_add(p, v, __ATOMIC_RELAXED, __HIP_MEMORY_SCOPE_AGENT); }
__device__ __forceinline__ unsigned xb_xcc_id() { return (unsigned)__builtin_amdgcn_s_getreg((3 << 11) | 20) & 0xFu; }
#define XB_SPIN(cond, bar) do { unsigned _sp = 0; while (cond) { __builtin_amdgcn_s_sleep(1); \
    if ((++_sp & 255u) == 0u) { if (xb_ld(&(bar)[XB_TMO])) break; if (_sp > XB_SPIN_CAP) { atomicAdd(&(bar)[XB_TMO], 1u); break; } } } } while (0)

struct XcdBarrier {
    unsigned* bar; unsigned x;
    volatile LAS unsigned* st;
};

__device__ __forceinline__ XcdBarrier xcd_barrier_post(unsigned* bar, volatile LAS unsigned* st) {
    XcdBarrier b; b.bar = bar; b.x = xb_xcc_id(); b.st = st;
    if (threadIdx.x == 0) (void)xb_add(&bar[XB_XCNT(b.x)], 1u);
    return b;
}
__device__ __forceinline__ void xcd_barrier_complete(unsigned* bar, unsigned x, unsigned& nloc, unsigned& nx) {
    const unsigned G = gridDim.x * gridDim.y * gridDim.z;
    unsigned sum, cnt, mine, sp = 0u;
    for (;;) {
        sum = 0u; cnt = 0u; mine = 0u;
#pragma unroll
        for (unsigned j = 0; j < 16; ++j) { const unsigned c = xb_ld(&bar[XB_XCNT(j)]); sum += c; cnt += (c > 0u) ? 1u : 0u; mine = (j == x) ? c : mine; }
        if (sum == G) break;
        __builtin_amdgcn_s_sleep(1);
        if ((++sp & 255u) == 0u) { if (xb_ld(&bar[XB_TMO])) break; if (sp > XB_SPIN_CAP) { atomicAdd(&bar[XB_TMO], 1u); break; } }
    }
    nloc = mine > 0u ? mine : 1u; nx = cnt > 0u ? cnt : 1u;
}

__device__ __forceinline__ void xcd_barrier(const XcdBarrier& b) {
    asm volatile("s_waitcnt vmcnt(0)" ::: "memory");
    __syncthreads();
    if (threadIdx.x == 0) {
        unsigned* bar = b.bar;
        __builtin_amdgcn_s_waitcnt(0);
        unsigned nloc = b.st[0], nx = b.st[1];
        if (nloc == 0u) { xcd_barrier_complete(bar, b.x, nloc, nx); b.st[0] = nloc; b.st[1] = nx; }
        const unsigned old = xb_add(&bar[XB_XSUB(b.x)], 1u);
        const unsigned gen = old / nloc;
        if (old + 1u == (gen + 1u) * nloc) {
            __builtin_amdgcn_fence(__ATOMIC_RELEASE, "agent");
            asm volatile("s_waitcnt vmcnt(0)" ::: "memory");
            const unsigned og = xb_add(&bar[XB_TOP], 1u);
            const unsigned tg = og / nx;
            if (og + 1u == (tg + 1u) * nx) xb_add(&bar[XB_TOPGEN], 1u);
            else XB_SPIN(xb_ld(&bar[XB_TOPGEN]) == tg, bar);
            __builtin_amdgcn_fence(__ATOMIC_ACQUIRE, "agent");
            xb_add(&bar[XB_XGEN(b.x)], 1u);
            asm volatile("s_waitcnt vmcnt(0)" ::: "memory");
        } else {
            XB_SPIN(xb_ld(&bar[XB_XGEN(b.x)]) == gen, bar);
            __builtin_amdgcn_fence(__ATOMIC_ACQUIRE, "agent");
            asm volatile("s_waitcnt vmcnt(0)" ::: "memory");
        }
    }
    __syncthreads();
}

constexpr int NWAVES = 8;
constexpr int RING_OFF = 0, RING_BYTES = 131072;
constexpr int LDSCTL_OFF = RING_BYTES, MISC_OFF = LDSCTL_OFF + 320;
constexpr int LDS_BYTES = 147456;

struct Args { const float* in[20]; float* out; unsigned char* ws; int ph_lo, ph_hi, li, pad; };

struct Frame {
    LAS unsigned char* lds;
    volatile LAS unsigned* MISC;
    gu32* ctl;
    int tid, lane, wave, vcu, G;
    __device__ __forceinline__ void refresh() { int t = threadIdx.x; asm volatile("" : "+v"(t)); tid = t; lane = t & 63; wave = __builtin_amdgcn_readfirstlane(t >> 6); }
    unsigned char* ws; float* out;
    const float* x; const float* p;
};

enum Phase { PH_PRO = 0, PH_PROJ, PH_MIX1, PH_SCAN, PH_RETO, PH_BR, PH_WOUT, PH_ROUTE, PH_GATHER, PH_GU, PH_DOWN, PH_COMB, PH_PLE, PH_FINAL, NPH };

DI void tr_item(const float* __restrict__ W, int ldw, int mycol, bf16* WT, int K, int r0, int k0, LAS float* scr, int lane) {
#pragma unroll 8
    for (int i = 0; i < 32; ++i) { const int kk = 2 * i + (lane >> 5); scr[kk * 33 + (lane & 31)] = W[(size_t)(k0 + kk) * ldw + mycol]; }
    LDS_WAIT(); asm volatile("" ::: "memory");
    const int c = lane & 7;
#pragma unroll
    for (int j = 0; j < 4; ++j) { const int n = (lane >> 3) + 8 * j; const LAS float* s = scr + (8 * c) * 33 + n;
        v4u o; o.x = pk2(s[0 * 33], s[1 * 33]); o.y = pk2(s[2 * 33], s[3 * 33]); o.z = pk2(s[4 * 33], s[5 * 33]); o.w = pk2(s[6 * 33], s[7 * 33]);
        *(GAS v4u*)(WT + (size_t)(r0 + n) * K + k0 + 8 * c) = o; }
    LDS_WAIT(); asm volatile("" ::: "memory");
}
DI void rms_row_to_bf16(const float* xrow, const float* gain, bf16* orow, int lane) {
    const GAS f32x4* xr = (const GAS f32x4*)xrow + lane; const GAS f32x4* gr = (const GAS f32x4*)gain + lane;
    f32x4 v[4]; float s = 0.f;
#pragma unroll
    for (int j = 0; j < 4; ++j) { v[j] = xr[64 * j]; s += (v[j].x * v[j].x + v[j].y * v[j].y) + (v[j].z * v[j].z + v[j].w * v[j].w); }
    const float rstd = rsqrtf(wave_sum(s) * (1.f / DM) + EPS);
    GAS v2u* o8 = (GAS v2u*)orow + lane;
#pragma unroll
    for (int j = 0; j < 4; ++j) { const f32x4 g = gr[64 * j]; v2u o; o.x = pk2(v[j].x * rstd * g.x, v[j].y * rstd * g.y); o.y = pk2(v[j].z * rstd * g.z, v[j].w * rstd * g.w); o8[64 * j] = o; }
}
DI void ph_prologue(Frame& F, const Args& a) {
    LAS float* scr = (LAS float*)(F.lds + RING_OFF + F.wave * 16384);
    const int gw = F.vcu * NWAVES + F.wave, NGW = F.G * NWAVES, lane = F.lane;
    unsigned char* ws = F.ws;
    constexpr int I_IN = (6144 / 32) * 16, I_BR = 32 * 8, I_OUT = 32 * 16, I_GU = 16 * 32 * 16, I_D = 16 * 32 * 8, I_PLE = 32 * 4, I_PG = 32 * 16;
    constexpr int NITEMS = I_IN + 2 * I_BR + I_OUT + I_GU + I_D + I_PLE + I_PG;
    for (int it = gw; it < NITEMS; it += NGW) {
        int r = it;
        if (r < I_IN) { const int rb = r >> 4, kb = r & 15; tr_item(a.in[3], NWIN, in_src(rb * 32 + (lane & 31)), (bf16*)(ws + WS_WIN), 1024, rb * 32, kb * 64, scr, lane); continue; } r -= I_IN;
        if (r < I_BR) { const int rb = r >> 3, kb = r & 7; tr_item(a.in[5], DM, rb * 32 + (lane & 31), (bf16*)(ws + WS_WBR1), 512, rb * 32, kb * 64, scr, lane); continue; } r -= I_BR;
        if (r < I_BR) { const int rb = r >> 3, kb = r & 7; tr_item(a.in[6], DM, rb * 32 + (lane & 31), (bf16*)(ws + WS_WBR2), 512, rb * 32, kb * 64, scr, lane); continue; } r -= I_BR;
        if (r < I_OUT) { const int rb = r >> 4, kb = r & 15; tr_item(a.in[7], DM, rb * 32 + (lane & 31), (bf16*)(ws + WS_WOUT), 1024, rb * 32, kb * 64, scr, lane); continue; } r -= I_OUT;
        if (r < I_GU) { const int e = r >> 9, q = r & 511, rb = q >> 4, kb = q & 15;
            const int row = rb * 32, j = row >> 8, w = row & 255; const bool up = w >= 128; const int col = 128 * j + (w & 127) + (lane & 31);
            tr_item((up ? a.in[14] : a.in[13]) + (size_t)e * DM * DEXP, DEXP, col, (bf16*)(ws + WS_WGU) + (size_t)e * 1024 * 1024, 1024, row, kb * 64, scr, lane); continue; } r -= I_GU;
        if (r < I_D) { const int e = r >> 8, q = r & 255, rb = q >> 3, kb = q & 7;
            tr_item(a.in[15] + (size_t)e * DEXP * DM, DM, rb * 32 + (lane & 31), (bf16*)(ws + WS_WD) + (size_t)e * 1024 * 512, 512, rb * 32, kb * 64, scr, lane); continue; } r -= I_D;
        if (r < I_PLE) { const int rb = r >> 2, kb = r & 3; tr_item(a.in[17], DM, rb * 32 + (lane & 31), (bf16*)(ws + WS_WPLE), 256, rb * 32, kb * 64, scr, lane); continue; } r -= I_PLE;
        { const int rb = r >> 4, kb = r & 15; tr_item(a.in[18], DM, rb * 32 + (lane & 31), (bf16*)(ws + WS_WPG), 1024, rb * 32, kb * 64, scr, lane); }
    }
    bf16* HB = (bf16*)((unsigned char*)F.out + DO_HB);
    for (int m = gw; m < NTOK; m += NGW) {
        rms_row_to_bf16(F.x + (size_t)m * DM, a.in[2], HB + (size_t)m * DM, lane);
        const f32x4 pv = ((const GAS f32x4*)(F.p + (size_t)m * 256))[lane];
        v2u o; o.x = pk2(pv.x, pv.y); o.y = pk2(pv.z, pv.w); ((GAS v2u*)((bf16*)(ws + WS_PB) + (size_t)m * 256))[lane] = o;
    }
    f32x2* tabA = (f32x2*)(ws + WS_TABA); f32x2* tabB = (f32x2*)(ws + WS_TABB);
    for (int i = F.vcu * 512 + F.tid; i < SEQ * 64; i += F.G * 512) {
        const int pos = i >> 6, p = i & 63;
        const float invf = powf(10000.0f, -(float)(2 * p) * (1.0f / 128.0f)); const float ang = (float)pos * invf;
        const f32x2 cs = {cosf(ang), sinf(ang)};
        tabA[i] = cs; tabB[p * SEQ + pos] = cs;
    }
}

DI void ph_route(Frame& F, const Args& a) {
    LAS float* WL = (LAS float*)(F.lds);
    for (int i = F.tid; i < 1024 * 20; i += 512) { const int k = i / 20, o = i - k * 20; WL[i] = o < 4 ? a.in[9][k * 4 + o] : a.in[11][k * 16 + (o - 4)]; }
    LAS int* s_e = (LAS int*)(F.lds + 81920); LAS int* s_lr = s_e + 256; LAS int* lcnt = s_lr + 256; LAS int* lbase = lcnt + 16;
    unsigned char* ws = F.ws; const int lane = F.lane;
    int* eid = (int*)(ws + WS_ROUTE + RT_EID); float* wgt = (float*)(ws + WS_ROUTE + RT_WGT); int* rank = (int*)(ws + WS_ROUTE + RT_RANK);
    bf16* H2 = (bf16*)(ws + WS_H2);
    const float* bg = a.in[10]; const float* be = a.in[12];
    __syncthreads();
    for (int blk = F.vcu; blk < NTOK / 128; blk += F.G) {
        if (F.tid < 16) lcnt[F.tid] = 0;
        __syncthreads();
        for (int tl = F.wave; tl < 128; tl += NWAVES) {
            const int tok = blk * 128 + tl;
            const GAS f32x4* xr = (const GAS f32x4*)(F.out + (size_t)tok * DM) + lane; const GAS f32x4* gr = (const GAS f32x4*)a.in[8] + lane;
            f32x4 v[4]; float ss = 0.f;
#pragma unroll
            for (int j = 0; j < 4; ++j) { v[j] = xr[64 * j]; ss += (v[j].x * v[j].x + v[j].y * v[j].y) + (v[j].z * v[j].z + v[j].w * v[j].w); }
            const float rstd = rsqrtf(wave_sum(ss) * (1.f / DM) + EPS);
            GAS v2u* o8 = (GAS v2u*)(H2 + (size_t)tok * DM) + lane;
            float acc[20];
#pragma unroll
            for (int o = 0; o < 20; ++o) acc[o] = 0.f;
#pragma unroll
            for (int j = 0; j < 4; ++j) {
                const f32x4 g = gr[64 * j]; v[j] = v[j] * rstd * g;
                v2u o; o.x = pk2(v[j].x, v[j].y); o.y = pk2(v[j].z, v[j].w); o8[64 * j] = o;
#pragma unroll
                for (int i = 0; i < 4; ++i) {
                    const float hv = v[j][i]; const LAS f32x4* w = (const LAS f32x4*)(WL + (4 * (lane + 64 * j) + i) * 20);
#pragma unroll
                    for (int q = 0; q < 5; ++q) { const f32x4 wv = w[q]; acc[4 * q] += hv * wv.x; acc[4 * q + 1] += hv * wv.y; acc[4 * q + 2] += hv * wv.z; acc[4 * q + 3] += hv * wv.w; }
                }
            }
#pragma unroll
            for (int o = 0; o < 20; ++o) acc[o] = wave_sum(acc[o]);
            float gl[4];
#pragma unroll
            for (int i = 0; i < 4; ++i) gl[i] = acc[i] + bg[i];
            int g = 0; float gm = gl[0];
#pragma unroll
            for (int i = 1; i < 4; ++i) if (gl[i] > gm) { gm = gl[i]; g = i; }
            float se = 0.f;
#pragma unroll
            for (int i = 0; i < 4; ++i) se += __expf(gl[i] - gm);
            const float pg = 1.0f / se;
            float el[4];
#pragma unroll
            for (int i = 0; i < 4; ++i) { const float l0 = acc[4 + i], l1 = acc[8 + i], l2 = acc[12 + i], l3 = acc[16 + i]; el[i] = (g == 0 ? l0 : g == 1 ? l1 : g == 2 ? l2 : l3) + be[4 * g + i]; }
            int i1 = 0; float m1 = el[0];
#pragma unroll
            for (int i = 1; i < 4; ++i) if (el[i] > m1) { m1 = el[i]; i1 = i; }
            int i2 = -1; float m2 = -3.0e38f;
#pragma unroll
            for (int i = 0; i < 4; ++i) if (i != i1 && el[i] > m2) { m2 = el[i]; i2 = i; }
            const float e2 = __expf(m2 - m1), w1 = pg / (1.0f + e2), w2 = pg * e2 / (1.0f + e2);
            if (lane == 0) {
                eid[2 * tok] = 4 * g + i1; eid[2 * tok + 1] = 4 * g + i2; wgt[2 * tok] = w1; wgt[2 * tok + 1] = w2;
                s_e[2 * tl] = 4 * g + i1; s_e[2 * tl + 1] = 4 * g + i2;
            }
        }
        __syncthreads();
        if (F.tid < 256) s_lr[F.tid] = atomicAdd((int*)&lcnt[s_e[F.tid]], 1);
        __syncthreads();
        if (F.tid < 16) lbase[F.tid] = (int)__hip_atomic_fetch_add(F.ctl + CW_CNT + F.tid, (unsigned)lcnt[F.tid], RLX_AGENT);
        __syncthreads();
        if (F.tid < 256) rank[blk * 256 + F.tid] = lbase[s_e[F.tid]] + s_lr[F.tid];
        __syncthreads();
    }
}

DI void expert_table(Frame& F, LAS int* pst) {
    if (F.tid == 0) { int acc = 0; for (int e = 0; e < NEXP; ++e) { pst[e] = acc; const int c = (int)__hip_atomic_load(F.ctl + CW_CNT + e, RLX_AGENT); acc += (c + 255) & ~255; } pst[NEXP] = acc; }
    __syncthreads();
}

DI void ph_gather(Frame& F, const Args& a) {
    LAS int* pst = (LAS int*)(F.lds);
    expert_table(F, pst);
    unsigned char* ws = F.ws; const int lane = F.lane;
    const int* eid = (const int*)(ws + WS_ROUTE + RT_EID); const float* wgt = (const float*)(ws + WS_ROUTE + RT_WGT); const int* rank = (const int*)(ws + WS_ROUTE + RT_RANK);
    int* pos = (int*)(ws + WS_ROUTE + RT_POS); float* wrow = (float*)(ws + WS_ROUTE + RT_WROW); int* tile = (int*)(ws + WS_ROUTE + RT_TILE);
    const bf16* H2 = (const bf16*)(ws + WS_H2); bf16* XB = (bf16*)(ws + WS_XB);
    if (blockIdx.x == 0 && F.tid < NEXP) { const int e = F.tid; for (int rt = pst[e] >> 8; rt < (pst[e + 1] >> 8); ++rt) tile[1 + rt] = e; if (e == 0) tile[0] = pst[NEXP] >> 8; }
    const int gw = F.vcu * NWAVES + F.wave, NGW = F.G * NWAVES;
    for (int tok = gw; tok < NTOK; tok += NGW) {
        const int p0 = pst[eid[2 * tok]] + rank[2 * tok], p1 = pst[eid[2 * tok + 1]] + rank[2 * tok + 1];
        const GAS v4u* src = (const GAS v4u*)(H2 + (size_t)tok * DM) + lane;
        const v4u r0 = src[0], r1 = src[64];
        GAS v4u* d0 = (GAS v4u*)(XB + (size_t)p0 * DM) + lane; GAS v4u* d1 = (GAS v4u*)(XB + (size_t)p1 * DM) + lane;
        d0[0] = r0; d0[64] = r1; d1[0] = r0; d1[64] = r1;
        if (lane == 0) { pos[2 * tok] = p0; pos[2 * tok + 1] = p1; wrow[p0] = wgt[2 * tok]; wrow[p1] = wgt[2 * tok + 1]; }
    }
}

DI void ph_combine(Frame& F, const Args& a) {
    unsigned char* ws = F.ws; const int lane = F.lane;
    const int* pos = (const int*)(ws + WS_ROUTE + RT_POS); const bf16* YB = (const bf16*)(ws + WS_XB); bf16* HP = (bf16*)(ws + WS_H2);
    const int gw = F.vcu * NWAVES + F.wave, NGW = F.G * NWAVES;
    for (int tok = gw; tok < NTOK; tok += NGW) {
        GAS f32x4* xr = (GAS f32x4*)(F.out + (size_t)tok * DM) + lane; const GAS f32x4* gr = (const GAS f32x4*)a.in[16] + lane;
        const GAS v2u* y0 = (const GAS v2u*)(YB + (size_t)pos[2 * tok] * DM) + lane; const GAS v2u* y1 = (const GAS v2u*)(YB + (size_t)pos[2 * tok + 1] * DM) + lane;
        f32x4 v[4]; float ss = 0.f;
#pragma unroll
        for (int j = 0; j < 4; ++j) {
            v[j] = xr[64 * j]; const v2u a0 = y0[64 * j], a1 = y1[64 * j];
            v[j].x += bflo(a0.x) + bflo(a1.x); v[j].y += bfhi(a0.x) + bfhi(a1.x); v[j].z += bflo(a0.y) + bflo(a1.y); v[j].w += bfhi(a0.y) + bfhi(a1.y);
            xr[64 * j] = v[j]; ss += (v[j].x * v[j].x + v[j].y * v[j].y) + (v[j].z * v[j].z + v[j].w * v[j].w);
        }
        const float rstd = rsqrtf(wave_sum(ss) * (1.f / DM) + EPS);
        GAS v2u* o8 = (GAS v2u*)(HP + (size_t)tok * DM) + lane;
#pragma unroll
        for (int j = 0; j < 4; ++j) { const f32x4 g = gr[64 * j]; v2u o; o.x = pk2(v[j].x * rstd * g.x, v[j].y * rstd * g.y); o.y = pk2(v[j].z * rstd * g.z, v[j].w * rstd * g.w); o8[64 * j] = o; }
    }
}

DI void ph_final(Frame& F, const Args& a) {
    const int lane = F.lane, gw = F.vcu * NWAVES + F.wave, NGW = F.G * NWAVES;
    for (int tok = gw; tok < NTOK; tok += NGW) {
        GAS f32x4* xr = (GAS f32x4*)(F.out + (size_t)tok * DM) + lane; const GAS f32x4* gr = (const GAS f32x4*)a.in[19] + lane;
        f32x4 v[4]; float ss = 0.f;
#pragma unroll
        for (int j = 0; j < 4; ++j) { v[j] = xr[64 * j]; ss += (v[j].x * v[j].x + v[j].y * v[j].y) + (v[j].z * v[j].z + v[j].w * v[j].w); }
        const float rstd = rsqrtf(wave_sum(ss) * (1.f / DM) + EPS);
#pragma unroll
        for (int j = 0; j < 4; ++j) { const f32x4 g = gr[64 * j]; xr[64 * j] = v[j] * rstd * g; }
    }
}

typedef pg8::f32x4 af4;
DI unsigned cvtpk(float lo, float hi) { typedef float f2 __attribute__((ext_vector_type(2))); typedef __bf16 b2 __attribute__((ext_vector_type(2))); f2 v = {lo, hi}; b2 b = __builtin_convertvector(v, b2); return __builtin_bit_cast(unsigned, b); }
DI v4u pack8(const float (&x)[8]) { v4u w; w.x = cvtpk(x[0], x[1]); w.y = cvtpk(x[2], x[3]); w.z = cvtpk(x[4], x[5]); w.w = cvtpk(x[6], x[7]); return w; }
DI void unpack8(const v4u w, float (&x)[8]) { x[0] = bflo(w.x); x[1] = bfhi(w.x); x[2] = bflo(w.y); x[3] = bfhi(w.y); x[4] = bflo(w.z); x[5] = bfhi(w.z); x[6] = bflo(w.w); x[7] = bfhi(w.w); }

struct EpiProj {
    static constexpr bool PERM = true, AFTER_DRAIN = false;
    bf16* PROJ; const f32x2* tabA;
    DI void operator()(const af4 (&acc)[2][2][4][2], const pg8::Unit& u, int wr, int wc, int fr, int fq) const {
        const int row0 = u.pm * 256 + wr * 64 + fr, colb = u.pn * 256 + wc * 32 + 8 * fq;
        const int kind = u.pn < 2 ? 0 : u.pn < 4 ? 1 : u.pn < 6 ? 2 : u.pn < 8 ? 3 : u.pn < 10 ? 4 : 5;
#pragma unroll
        for (int ai = 0; ai < 2; ++ai)
#pragma unroll
            for (int m = 0; m < 4; ++m) {
                const int row = row0 + ai * 128 + m * 16;
#pragma unroll
                for (int bj = 0; bj < 2; ++bj) {
                    const int col = colb + bj * 128;
                    const af4 a0 = acc[ai][bj][m][0], a1 = acc[ai][bj][m][1];
                    float x[8] = {a0[0], a0[1], a0[2], a0[3], a1[0], a1[1], a1[2], a1[3]};
                    if (kind <= 1) {
                        const int pos = row & (SEQ - 1), p = (col & 127) >> 1;
                        const f32x4* tp = (const f32x4*)(tabA + pos * 64 + p);
                        const f32x4 t0 = tp[0], t1 = tp[1];
                        const float sc = kind == 1 ? 0.08838834764831845f : 1.0f;
                        float y[8];
                        y[0] = (x[0] * t0.x - x[1] * t0.y) * sc; y[1] = (x[0] * t0.y + x[1] * t0.x) * sc;
                        y[2] = (x[2] * t0.z - x[3] * t0.w) * sc; y[3] = (x[2] * t0.w + x[3] * t0.z) * sc;
                        y[4] = (x[4] * t1.x - x[5] * t1.y) * sc; y[5] = (x[4] * t1.y + x[5] * t1.x) * sc;
                        y[6] = (x[6] * t1.z - x[7] * t1.w) * sc; y[7] = (x[6] * t1.w + x[7] * t1.z) * sc;
#pragma unroll
                        for (int i = 0; i < 8; ++i) x[i] = y[i];
                    } else if (kind == 2) {
#pragma unroll
                        for (int i = 0; i < 8; ++i) x[i] = fsilu(x[i]);
                    } else if (kind == 3) {
#pragma unroll
                        for (int i = 0; i < 8; ++i) x[i] *= SB_QSCALE;
                    } else if (kind == 5) {
#pragma unroll
                        for (int i = 0; i < 8; ++i) x[i] = fsigmoid(x[i]);
                    }
                    *(v4u*)(PROJ + (size_t)row * NMAIN + col) = pack8(x);
                }
            }
    }
};
struct EpiProjT {
    static constexpr bool PERM = true, AFTER_DRAIN = false;
    bf16* T; const f32x2* tabB;
    DI void operator()(const af4 (&acc)[2][2][4][2], const pg8::Unit& u, int wr, int wc, int fr, int fq) const {
        const int f0 = u.pm * 256 + wr * 64 + fr, tokb = u.pn * 256 + wc * 32 + 8 * fq;
        const bool isk = u.pm < 2;
#pragma unroll
        for (int ai = 0; ai < 2; ++ai)
#pragma unroll
            for (int m = 0; m < 4; ++m) {
                const int f = f0 + ai * 128 + m * 16;
#pragma unroll
                for (int bj = 0; bj < 2; ++bj) {
                    const int tok = tokb + bj * 128;
                    const af4 a0 = acc[ai][bj][m][0], a1 = acc[ai][bj][m][1];
                    float x[8] = {a0[0], a0[1], a0[2], a0[3], a1[0], a1[1], a1[2], a1[3]};
                    if (isk) {
                        const int pos = tok & (SEQ - 1), h = f >> 7, p = (f & 127) >> 1;
                        const f32x4* tp = (const f32x4*)(tabB + p * SEQ + pos);
                        const f32x4 t0 = tp[0], t1 = tp[1], t2 = tp[2], t3 = tp[3];
                        const float cs[8] = {t0.x, t0.z, t1.x, t1.z, t2.x, t2.z, t3.x, t3.z}, sn[8] = {t0.y, t0.w, t1.y, t1.w, t2.y, t2.w, t3.y, t3.w};
                        const float l2g = ret_log2g(h); const float ginv = exp2f(-l2g);
                        float sc = 0.08838834764831845f * exp2f(l2g * (float)(63 - (pos & 63)));
                        const bool odd = (f & 1) != 0;
                        float y[8];
#pragma unroll
                        for (int i = 0; i < 8; ++i) {
                            const float other = __shfl_xor(x[i], 1);
                            const float r = odd ? (other * sn[i] + x[i] * cs[i]) : (x[i] * cs[i] - other * sn[i]);
                            y[i] = r * sc; sc *= ginv;
                        }
#pragma unroll
                        for (int i = 0; i < 8; ++i) x[i] = y[i];
                    }
                    *(v4u*)(T + (size_t)f * NTOK + tok) = pack8(x);
                }
            }
    }
};

struct EpiBr {
    static constexpr bool PERM = true, AFTER_DRAIN = false;
    bf16* PROJ; int step;
    DI void operator()(const af4 (&acc)[2][2][4][2], const pg8::Unit& u, int wr, int wc, int fr, int fq) const {
        const int row0 = u.pm * 256 + wr * 64 + fr, colb = u.pn * 256 + wc * 32 + 8 * fq;
#pragma unroll
        for (int ai = 0; ai < 2; ++ai)
#pragma unroll
            for (int m = 0; m < 4; ++m) {
                bf16* pr = PROJ + (size_t)(row0 + ai * 128 + m * 16) * NMAIN;
#pragma unroll
                for (int bj = 0; bj < 2; ++bj) {
                    const int col = colb + bj * 128;
                    const af4 a0 = acc[ai][bj][m][0], a1 = acc[ai][bj][m][1];
                    float g[8], x[8] = {a0[0], a0[1], a0[2], a0[3], a1[0], a1[1], a1[2], a1[3]};
                    unpack8(*(const v4u*)(pr + (step ? C_GS : C_GR) + col), g);
#pragma unroll
                    for (int i = 0; i < 8; ++i) x[i] *= g[i];
                    if (step) { float t1[8]; unpack8(*(const v4u*)(pr + C_GR + col), t1);
#pragma unroll
                        for (int i = 0; i < 8; ++i) x[i] += t1[i]; }
                    *(v4u*)(pr + C_GR + col) = pack8(x);
                }
            }
    }
};
struct EpiWout {
    static constexpr bool PERM = true, AFTER_DRAIN = false;
    const float* x; float* out;
    DI void operator()(const af4 (&acc)[2][2][4][2], const pg8::Unit& u, int wr, int wc, int fr, int fq) const {
        const int row0 = u.pm * 256 + wr * 64 + fr, colb = u.pn * 256 + wc * 32 + 8 * fq;
#pragma unroll
        for (int ai = 0; ai < 2; ++ai)
#pragma unroll
            for (int m = 0; m < 4; ++m) {
                const size_t ro = (size_t)(row0 + ai * 128 + m * 16) * DM;
#pragma unroll
                for (int bj = 0; bj < 2; ++bj) {
                    const size_t o = ro + colb + bj * 128;
                    const af4 x0 = *(const af4*)(x + o), x1 = *(const af4*)(x + o + 4);
                    *(af4*)(out + o) = x0 + acc[ai][bj][m][0]; *(af4*)(out + o + 4) = x1 + acc[ai][bj][m][1];
                }
            }
    }
};
struct EpiGu {
    static constexpr bool PERM = true, AFTER_DRAIN = false;
    bf16* HID;
    DI void operator()(const af4 (&acc)[2][2][4][2], const pg8::Unit& u, int wr, int wc, int fr, int fq) const {
        const int row0 = u.pm * 256 + wr * 64 + fr, col = u.pn * 128 + wc * 32 + 8 * fq;
#pragma unroll
        for (int ai = 0; ai < 2; ++ai)
#pragma unroll
            for (int m = 0; m < 4; ++m) {
                const af4 g0 = acc[ai][0][m][0], g1 = acc[ai][0][m][1], u0 = acc[ai][1][m][0], u1 = acc[ai][1][m][1];
                float x[8];
#pragma unroll
                for (int i = 0; i < 4; ++i) { x[i] = fsilu(g0[i]) * u0[i]; x[4 + i] = fsilu(g1[i]) * u1[i]; }
                *(v4u*)(HID + (size_t)(row0 + ai * 128 + m * 16) * DEXP + col) = pack8(x);
            }
    }
};
struct EpiDown {
    static constexpr bool PERM = true, AFTER_DRAIN = false;
    bf16* YB; const float* wrow;
    DI void operator()(const af4 (&acc)[2][2][4][2], const pg8::Unit& u, int wr, int wc, int fr, int fq) const {
        const int row0 = u.pm * 256 + wr * 64 + fr, colb = u.pn * 256 + wc * 32 + 8 * fq;
#pragma unroll
        for (int ai = 0; ai < 2; ++ai)
#pragma unroll
            for (int m = 0; m < 4; ++m) {
                const int row = row0 + ai * 128 + m * 16; const float w = wrow[row];
#pragma unroll
                for (int bj = 0; bj < 2; ++bj) {
                    const af4 a0 = acc[ai][bj][m][0] * w, a1 = acc[ai][bj][m][1] * w;
                    const float x[8] = {a0[0], a0[1], a0[2], a0[3], a1[0], a1[1], a1[2], a1[3]};
                    *(v4u*)(YB + (size_t)row * DM + colb + bj * 128) = pack8(x);
                }
            }
    }
};
struct EpiPe {
    static constexpr bool PERM = true, AFTER_DRAIN = false;
    bf16* PE;
    DI void operator()(const af4 (&acc)[2][2][4][2], const pg8::Unit& u, int wr, int wc, int fr, int fq) const {
        const int row0 = u.pm * 256 + wr * 64 + fr, colb = u.pn * 256 + wc * 32 + 8 * fq;
#pragma unroll
        for (int ai = 0; ai < 2; ++ai)
#pragma unroll
            for (int m = 0; m < 4; ++m)
#pragma unroll
                for (int bj = 0; bj < 2; ++bj) {
                    const af4 a0 = acc[ai][bj][m][0], a1 = acc[ai][bj][m][1];
                    const float x[8] = {a0[0], a0[1], a0[2], a0[3], a1[0], a1[1], a1[2], a1[3]};
                    *(v4u*)(PE + (size_t)(row0 + ai * 128 + m * 16) * DM + colb + bj * 128) = pack8(x);
                }
    }
};
struct EpiPg {
    static constexpr bool PERM = true, AFTER_DRAIN = false;
    const bf16* PE; float* out;
    DI void operator()(const af4 (&acc)[2][2][4][2], const pg8::Unit& u, int wr, int wc, int fr, int fq) const {
        const int row0 = u.pm * 256 + wr * 64 + fr, colb = u.pn * 256 + wc * 32 + 8 * fq;
#pragma unroll
        for (int ai = 0; ai < 2; ++ai)
#pragma unroll
            for (int m = 0; m < 4; ++m) {
                const size_t ro = (size_t)(row0 + ai * 128 + m * 16) * DM;
#pragma unroll
                for (int bj = 0; bj < 2; ++bj) {
                    const size_t o = ro + colb + bj * 128;
                    float pe[8]; unpack8(*(const v4u*)(PE + o), pe);
                    const af4 a0 = acc[ai][bj][m][0], a1 = acc[ai][bj][m][1];
                    af4 x0 = *(const af4*)(out + o), x1 = *(const af4*)(out + o + 4);
#pragma unroll
                    for (int i = 0; i < 4; ++i) { x0[i] += fsigmoid(a0[i]) * pe[i]; x1[i] += fsigmoid(a1[i]) * pe[4 + i]; }
                    *(af4*)(out + o) = x0; *(af4*)(out + o + 4) = x1;
                }
                asm volatile("" ::: "memory");
            }
    }
};

struct MoeOrder {
    const LAS int* pst; int G, c; size_t estride, tstepB;
    DI bool next(int i, pg8::Unit& u) const {
        const int L = i * G + c, rt = L >> 2; if (rt * 256 >= pst[NEXP]) return false;
        int ex = 0;
#pragma unroll
        for (int e = 1; e < NEXP; ++e) ex += (rt * 256 >= pst[e]) ? 1 : 0;
        u.pm = rt; u.pn = L & 3; u.ex = ex; u.bofs = (size_t)ex * estride + (size_t)u.pn * tstepB; return true;
    }
    DI void a_ready(const pg8::Unit&) const {}
    DI void done(const pg8::Unit&) const {}
};

#define GEMM_PHASE(EPI, ORD, g, S, E) pg8::gemm_phase<EPI, ORD, true, true>(F.lds + RING_OFF, g, S, E)

DI void fast_proj(Frame& F, const Args& a) {
    unsigned char* ws = F.ws; const bf16* HB = (const bf16*)((unsigned char*)F.out + DO_HB); const bf16* WIN = (const bf16*)(ws + WS_WIN);
    { pg8::Gemm g{HB, WIN, DM, DM}; pg8::StaticOrder S; S.init(NTOK, NMAIN, DM, F.G, (int)blockIdx.x);
      EpiProj E{(bf16*)(ws + WS_PROJ), (const f32x2*)(ws + WS_TABA)}; GEMM_PHASE(EpiProj, pg8::StaticOrder, g, S, E); }
    { pg8::Gemm g{WIN + (size_t)NMAIN * DM, HB, DM, DM}; pg8::StaticOrder S; S.init(NTR, NTOK, DM, F.G, (int)blockIdx.x);
      EpiProjT E{(bf16*)(ws + WS_T), (const f32x2*)(ws + WS_TABB)}; GEMM_PHASE(EpiProjT, pg8::StaticOrder, g, S, E); }
}
DI void fast_br(Frame& F, const Args& a) {
    unsigned char* ws = F.ws; bf16* PROJ = (bf16*)(ws + WS_PROJ);
    pg8::StaticOrder S; S.init(NTOK, DM, 512, F.G, (int)blockIdx.x);
    { pg8::Gemm g{PROJ + C_RG, (const bf16*)(ws + WS_WBR1), NMAIN, 512}; EpiBr E{PROJ, 0}; GEMM_PHASE(EpiBr, pg8::StaticOrder, g, S, E); }
    { pg8::Gemm g{PROJ + C_SQ, (const bf16*)(ws + WS_WBR2), NMAIN, 512}; EpiBr E{PROJ, 1}; GEMM_PHASE(EpiBr, pg8::StaticOrder, g, S, E); }
}
DI void fast_wout(Frame& F, const Args& a) {
    unsigned char* ws = F.ws;
    pg8::Gemm g{(const bf16*)(ws + WS_PROJ) + C_GR, (const bf16*)(ws + WS_WOUT), NMAIN, DM}; pg8::StaticOrder S; S.init(NTOK, DM, DM, F.G, (int)blockIdx.x);
    EpiWout E{F.x, F.out}; GEMM_PHASE(EpiWout, pg8::StaticOrder, g, S, E);
}
DI void fast_gu(Frame& F, const Args& a) {
    LAS int* pst = (LAS int*)(F.lds + LDSCTL_OFF);
    expert_table(F, pst);
    unsigned char* ws = F.ws;
    pg8::Gemm g{(const bf16*)(ws + WS_XB), (const bf16*)(ws + WS_WGU), DM, DM};
    MoeOrder S{pst, F.G, F.vcu, (size_t)1024 * 1024 * 2, (size_t)256 * DM * 2};
    EpiGu E{(bf16*)(ws + WS_HID)}; GEMM_PHASE(EpiGu, MoeOrder, g, S, E);
}
DI void fast_down(Frame& F, const Args& a) {
    LAS int* pst = (LAS int*)(F.lds + LDSCTL_OFF);
    expert_table(F, pst);
    unsigned char* ws = F.ws;
    pg8::Gemm g{(const bf16*)(ws + WS_HID), (const bf16*)(ws + WS_WD), DEXP, DEXP};
    MoeOrder S{pst, F.G, F.vcu, (size_t)1024 * 512 * 2, (size_t)256 * DEXP * 2};
    EpiDown E{(bf16*)(ws + WS_XB), (const float*)(ws + WS_ROUTE + RT_WROW)}; GEMM_PHASE(EpiDown, MoeOrder, g, S, E);
}
DI void fast_ple(Frame& F, const Args& a) {
    unsigned char* ws = F.ws;
    { int k256 = 256; asm volatile("" : "+s"(k256));
      pg8::Gemm g{(const bf16*)(ws + WS_PB), (const bf16*)(ws + WS_WPLE), 256, k256}; pg8::StaticOrder S; S.init(NTOK, DM, k256, F.G, (int)blockIdx.x);
      EpiPe E{(bf16*)(ws + WS_HID)}; GEMM_PHASE(EpiPe, pg8::StaticOrder, g, S, E); }
    { pg8::Gemm g{(const bf16*)(ws + WS_H2), (const bf16*)(ws + WS_WPG), DM, DM}; pg8::StaticOrder S; S.init(NTOK, DM, DM, F.G, (int)blockIdx.x);
      EpiPg E{(const bf16*)(ws + WS_HID), F.out}; GEMM_PHASE(EpiPg, pg8::StaticOrder, g, S, E); }
}

#define MFMA32(a, b, c) __builtin_amdgcn_mfma_f32_32x32x16_bf16((a), (b), (c), 0, 0, 0)
DI int crow(int reg, int h) { return (reg & 3) + 8 * (reg >> 2) + 4 * h; }
DI bf16x8 ld16(const bf16* p) { return *(const bf16x8*)p; }
DI bf16x8 ld8x2(const bf16* p0, const bf16* p1) { const s16x4 lo = *(const s16x4*)p0, hi = *(const s16x4*)p1; return __builtin_shufflevector(lo, hi, 0, 1, 2, 3, 4, 5, 6, 7); }
template <int S> DI bf16x8 pack_step(const f32x16& x) { v4u p; p.x = cvtpk(x[8 * S], x[8 * S + 1]); p.y = cvtpk(x[8 * S + 2], x[8 * S + 3]); p.z = cvtpk(x[8 * S + 4], x[8 * S + 5]); p.w = cvtpk(x[8 * S + 6], x[8 * S + 7]); return __builtin_bit_cast(bf16x8, p); }
DI f32x16 splat16(float v) { f32x16 x;
#pragma unroll
    for (int i = 0; i < 16; ++i) x[i] = v; return x; }

DI void fast_ret_kv(Frame& F, const Args& a) {
    const bf16* T = (const bf16*)(F.ws + WS_T); bf16* ST = (bf16*)((unsigned char*)F.out + DO_ST);
    const int lane = F.lane, r = lane & 31, h2 = lane >> 5, gw = F.vcu * NWAVES + F.wave, NGW = F.G * NWAVES;
    for (int it = gw; it < NBATCH * 4 * 64 * 4; it += NGW) {
        const int eb = it & 3, c = (it >> 2) & 63, hh = (it >> 8) & 3, b = it >> 10;
        const int tok0 = b * SEQ + c * 64;
        const bf16* vrow = T + (size_t)(T_VR + hh * 128 + eb * 32 + r) * NTOK + tok0 + 8 * h2;
        bf16x8 vb[4];
#pragma unroll
        for (int ks = 0; ks < 4; ++ks) vb[ks] = ld16(vrow + 16 * ks);
        bf16* st = ST + ((size_t)((b * 4 + hh) * 64 + c)) * 16384 + (size_t)(eb * 32 + r) * 128 + 4 * h2;
#pragma unroll
        for (int db = 0; db < 4; ++db) {
            const bf16* krow = T + (size_t)(T_KT + hh * 128 + db * 32 + r) * NTOK + tok0 + 8 * h2;
            f32x16 acc = splat16(0.f);
#pragma unroll
            for (int ks = 0; ks < 4; ++ks) acc = MFMA32(ld16(krow + 16 * ks), vb[ks], acc);
#pragma unroll
            for (int g = 0; g < 4; ++g) { v2u w; w.x = cvtpk(acc[4 * g], acc[4 * g + 1]); w.y = cvtpk(acc[4 * g + 2], acc[4 * g + 3]); *(v2u*)(st + db * 32 + 8 * g) = w; }
        }
    }
}
DI void fast_ret_scan(Frame& F, const Args& a) {
    bf16* ST = (bf16*)((unsigned char*)F.out + DO_ST);
    for (int g = F.vcu * 512 + F.tid; g < NBATCH * 4 * 4096; g += F.G * 512) {
        const int bh = g >> 12, idx = (g & 4095) * 4;
        const float cdec = exp2f(ret_log2g(bh & 3) * 64.0f);
        bf16* p = ST + (size_t)bh * 64 * 16384 + idx;
        float s0 = 0.f, s1 = 0.f, s2 = 0.f, s3 = 0.f;
#pragma unroll 8
        for (int c = 0; c < 64; ++c) {
            const v2u w = *(const v2u*)(p + (size_t)c * 16384);
            v2u o; o.x = cvtpk(s0, s1); o.y = cvtpk(s2, s3); *(v2u*)(p + (size_t)c * 16384) = o;
            s0 = cdec * s0 + bflo(w.x); s1 = cdec * s1 + bfhi(w.x); s2 = cdec * s2 + bflo(w.y); s3 = cdec * s3 + bfhi(w.y);
        }
    }
}
DI void fast_ret_out(Frame& F, const Args& a) {
    bf16* PROJ = (bf16*)(F.ws + WS_PROJ); const bf16* T = (const bf16*)(F.ws + WS_T); const bf16* ST = (const bf16*)((unsigned char*)F.out + DO_ST);
    const float* gn = a.in[4];
    const int lane = F.lane, r = lane & 31, h2 = lane >> 5, gw = F.vcu * NWAVES + F.wave, NGW = F.G * NWAVES;
    for (int it = gw; it < NBATCH * 4 * 64 * 2; it += NGW) {
        const int ib = it & 1, c = (it >> 1) & 63, hh = (it >> 7) & 3, b = it >> 9;
        const int tok0 = b * SEQ + c * 64;
        const float l2g = ret_log2g(hh);
        const bf16* qrow = PROJ + (size_t)(tok0 + ib * 32 + r) * NMAIN + C_RQ + hh * 128 + 8 * h2;
        bf16x8 qf[8];
#pragma unroll
        for (int ks = 0; ks < 8; ++ks) qf[ks] = ld16(qrow + 16 * ks);
        bf16x8 pb[2][2];
#pragma unroll
        for (int jb = 0; jb < 2; ++jb) {
            const bf16* krow = PROJ + (size_t)(tok0 + jb * 32 + r) * NMAIN + C_RK + hh * 128 + 8 * h2;
            f32x16 pt = splat16(0.f);
#pragma unroll
            for (int ks = 0; ks < 8; ++ks) pt = MFMA32(ld16(krow + 16 * ks), qf[ks], pt);
#pragma unroll
            for (int reg = 0; reg < 16; ++reg) { const int dist = (ib * 32 + r) - (jb * 32 + crow(reg, h2)); pt[reg] *= __builtin_amdgcn_exp2f(l2g * (float)(dist < 0 ? -dist : dist)); }
            pb[jb][0] = pack_step<0>(pt); pb[jb][1] = pack_step<1>(pt);
        }
        const float qd = __builtin_amdgcn_exp2f(l2g * (float)(ib * 32 + r + 1));
        const bf16* stb = ST + ((size_t)((b * 4 + hh) * 64 + c)) * 16384 + (size_t)r * 128 + 8 * h2;
        f32x16 o[4];
#pragma unroll
        for (int eb = 0; eb < 4; ++eb) {
            f32x16 acc = splat16(0.f);
            const bf16* srow = stb + (size_t)eb * 32 * 128;
#pragma unroll
            for (int ks = 0; ks < 8; ++ks) acc = MFMA32(ld16(srow + 16 * ks), qf[ks], acc);
#pragma unroll
            for (int reg = 0; reg < 16; ++reg) acc[reg] *= qd;
            const bf16* vrow = T + (size_t)(T_VR + hh * 128 + eb * 32 + r) * NTOK + tok0 + 4 * h2;
#pragma unroll
            for (int jb = 0; jb < 2; ++jb) {
                acc = MFMA32(ld8x2(vrow + jb * 32, vrow + jb * 32 + 8), pb[jb][0], acc);
                acc = MFMA32(ld8x2(vrow + jb * 32 + 16, vrow + jb * 32 + 24), pb[jb][1], acc);
            }
            o[eb] = acc;
        }
        float s = 0.f;
#pragma unroll
        for (int eb = 0; eb < 4; ++eb)
#pragma unroll
            for (int reg = 0; reg < 16; ++reg) s += o[eb][reg];
        s += __shfl_xor(s, 32);
        const float mu = s * (1.0f / 128.0f); float v = 0.f;
#pragma unroll
        for (int eb = 0; eb < 4; ++eb)
#pragma unroll
            for (int reg = 0; reg < 16; ++reg) { const float d = o[eb][reg] - mu; v += d * d; }
        v += __shfl_xor(v, 32);
        const float rstd = rsqrtf(v * (1.0f / 128.0f) + EPS);
        bf16* gp = PROJ + (size_t)(tok0 + ib * 32 + r) * NMAIN + C_RG + hh * 128 + 4 * h2;
        const float* gnp = gn + hh * 128 + 4 * h2;
#pragma unroll
        for (int eb = 0; eb < 4; ++eb)
#pragma unroll
            for (int g = 0; g < 4; ++g) {
                const int e = eb * 32 + 8 * g;
                const v2u gate = *(const v2u*)(gp + e); const f32x4 gain = *(const f32x4*)(gnp + e);
                v2u w;
                w.x = cvtpk((o[eb][4 * g] - mu) * rstd * gain.x * bflo(gate.x), (o[eb][4 * g + 1] - mu) * rstd * gain.y * bfhi(gate.x));
                w.y = cvtpk((o[eb][4 * g + 2] - mu) * rstd * gain.z * bflo(gate.y), (o[eb][4 * g + 3] - mu) * rstd * gain.w * bfhi(gate.y));
                *(v2u*)(gp + e) = w;
            }
    }
}

DI void fast_att(Frame& F, const Args& a) {
    bf16* PROJ = (bf16*)(F.ws + WS_PROJ); const bf16* T = (const bf16*)(F.ws + WS_T);
    const int lane = F.lane, r = lane & 31, h2 = lane >> 5, gw = F.vcu * NWAVES + F.wave, NGW = F.G * NWAVES;
    bf16x8 tri0, tri1, ones;
#pragma unroll
    for (int j = 0; j < 8; ++j) { const int k0 = 8 * (j >> 2) + 4 * h2 + (j & 3); tri0[j] = (k0 > r) ? (short)0x3F80 : (short)0; tri1[j] = (16 + k0 > r) ? (short)0x3F80 : (short)0; ones[j] = (short)0x3F80; }
    for (int it = gw; it < NBATCH * 8 * 128; it += NGW) {
        const int qb = it & 127, hh = (it >> 7) & 7, b = it >> 10;
        const int q0 = qb * 32, tokq = b * SEQ + q0 + r;
        const bf16* qrow = PROJ + (size_t)tokq * NMAIN + C_SQ + hh * 64 + 8 * h2;
        bf16x8 qf[4];
#pragma unroll
        for (int ks = 0; ks < 4; ++ks) qf[ks] = ld16(qrow + 16 * ks);
        f32x16 o0 = splat16(0.f), o1 = splat16(0.f);
        float carry = 0.f;
        const int ktd = q0 >> 6;
        for (int kt = ktd; kt >= 0; --kt) {
            const int key0 = kt * 64, tokk = b * SEQ + key0;
            const bool diag = (kt == ktd);
            f32x16 p0 = splat16(0.f), p1 = splat16(0.f);
            {
                const bf16* k0row = PROJ + (size_t)(tokk + r) * NMAIN + C_SK + hh * 64 + 8 * h2;
                const bf16* k1row = k0row + (size_t)32 * NMAIN;
#pragma unroll
                for (int ks = 0; ks < 4; ++ks) { p0 = MFMA32(ld16(k0row + 16 * ks), qf[ks], p0); p1 = MFMA32(ld16(k1row + 16 * ks), qf[ks], p1); }
            }
            f32x16 l0, l1;
#pragma unroll
            for (int reg = 0; reg < 16; ++reg) {
                const float z0 = fminf(p0[reg], 100.0f), z1 = fminf(p1[reg], 100.0f);
                float a0 = -__builtin_amdgcn_logf(1.0f + __builtin_amdgcn_exp2f(z0)), a1 = -__builtin_amdgcn_logf(1.0f + __builtin_amdgcn_exp2f(z1));
                float b0 = z0 + a0, b1 = z1 + a1;
                if (diag) {
                    const bool v0 = (key0 + crow(reg, h2)) < (q0 + r), v1 = (key0 + 32 + crow(reg, h2)) < (q0 + r);
                    a0 = v0 ? a0 : 0.f; b0 = v0 ? b0 : -1.0e30f; a1 = v1 ? a1 : 0.f; b1 = v1 ? b1 : -1.0e30f;
                }
                l0[reg] = a0; l1[reg] = a1; p0[reg] = b0; p1[reg] = b1;
            }
            f32x16 y0 = splat16(carry), y1 = y0;
            {
                const bf16x8 x00 = pack_step<0>(l0), x01 = pack_step<1>(l0), x10 = pack_step<0>(l1), x11 = pack_step<1>(l1);
                y0 = MFMA32(tri0, x00, y0); y0 = MFMA32(tri1, x01, y0); y0 = MFMA32(ones, x10, y0); y0 = MFMA32(ones, x11, y0);
                y1 = MFMA32(tri0, x10, y1); y1 = MFMA32(tri1, x11, y1);
            }
            const float tot = y0[0] + l0[0];
            carry = __shfl(tot, r);
#pragma unroll
            for (int reg = 0; reg < 16; ++reg) { p0[reg] = __builtin_amdgcn_exp2f(p0[reg] + y0[reg]); p1[reg] = __builtin_amdgcn_exp2f(p1[reg] + y1[reg]); }
            {
                const bf16x8 a00 = pack_step<0>(p0), a01 = pack_step<1>(p0), a10 = pack_step<0>(p1), a11 = pack_step<1>(p1);
                const bf16* v0row = T + (size_t)(T_VS + hh * 64 + r) * NTOK + tokk + 4 * h2;
                const bf16* v1row = v0row + (size_t)32 * NTOK;
                o0 = MFMA32(ld8x2(v0row, v0row + 8), a00, o0); o0 = MFMA32(ld8x2(v0row + 16, v0row + 24), a01, o0);
                o0 = MFMA32(ld8x2(v0row + 32, v0row + 40), a10, o0); o0 = MFMA32(ld8x2(v0row + 48, v0row + 56), a11, o0);
                o1 = MFMA32(ld8x2(v1row, v1row + 8), a00, o1); o1 = MFMA32(ld8x2(v1row + 16, v1row + 24), a01, o1);
                o1 = MFMA32(ld8x2(v1row + 32, v1row + 40), a10, o1); o1 = MFMA32(ld8x2(v1row + 48, v1row + 56), a11, o1);
            }
            if (__all(carry < SB_EXIT)) break;
        }
        bf16* op = PROJ + (size_t)tokq * NMAIN + C_SQ + hh * 64 + 4 * h2;
#pragma unroll
        for (int g = 0; g < 4; ++g) {
            v2u w; w.x = cvtpk(o0[4 * g], o0[4 * g + 1]); w.y = cvtpk(o0[4 * g + 2], o0[4 * g + 3]); *(v2u*)(op + 8 * g) = w;
            v2u u; u.x = cvtpk(o1[4 * g], o1[4 * g + 1]); u.y = cvtpk(o1[4 * g + 2], o1[4 * g + 3]); *(v2u*)(op + 32 + 8 * g) = u;
        }
    }
}

__global__ void __launch_bounds__(NWAVES * 64, 2) mega(Args args) {
    extern __shared__ __attribute__((aligned(16))) unsigned char lds[];
    Frame F;
    F.lds = (LAS unsigned char*)lds;
    F.MISC = (volatile LAS unsigned*)(F.lds + MISC_OFF);
    F.tid = threadIdx.x; F.lane = F.tid & 63; F.wave = __builtin_amdgcn_readfirstlane(F.tid >> 6);
    F.G = gridDim.x; { const int bx = blockIdx.x; F.vcu = (F.G % 8 == 0) ? (bx % 8) * (F.G / 8) + bx / 8 : bx; }
    F.ws = args.ws; F.out = args.out; F.x = args.in[0]; F.p = args.in[1];
    F.ctl = (gu32*)(args.ws + WS_CTL);
    for (int u = F.tid; u < (LDS_BYTES - LDSCTL_OFF) / 4; u += NWAVES * 64) ((LAS unsigned*)(F.lds + LDSCTL_OFF))[u] = 0u;
    __syncthreads();
    const int lo = args.ph_lo, hi = args.ph_hi;
    XcdBarrier bar; bar.bar = (unsigned*)(F.ctl + CW_BAR) + args.li * BAR_STRIDE; bar.x = 0; bar.st = nullptr;
    if (hi - lo > 1) bar = xcd_barrier_post((unsigned*)(F.ctl + CW_BAR) + args.li * BAR_STRIDE, F.MISC + 8);
#define IN(k) (F.refresh(), lo <= (k) && (k) < hi)
#define SEAM(k) do { if (IN(k) && IN((k) + 1)) xcd_barrier(bar); } while (0)

    if (IN(PH_PRO)) { ph_prologue(F, args); } SEAM(PH_PRO);
    if (IN(PH_PROJ)) { if (FAST(F_PROJ)) fast_proj(F, args); } SEAM(PH_PROJ);
    if (IN(PH_MIX1)) { if (FAST(F_RET)) fast_ret_kv(F, args); if (FAST(F_ATT)) fast_att(F, args); } SEAM(PH_MIX1);
    if (IN(PH_SCAN)) { if (FAST(F_RET)) fast_ret_scan(F, args); } SEAM(PH_SCAN);
    if (IN(PH_RETO)) { if (FAST(F_RET)) fast_ret_out(F, args); } SEAM(PH_RETO);
    if (IN(PH_BR)) { if (FAST(F_BR)) fast_br(F, args); } SEAM(PH_BR);
    if (IN(PH_WOUT)) { if (FAST(F_WOUT)) fast_wout(F, args); } SEAM(PH_WOUT);
    if (IN(PH_ROUTE)) { ph_route(F, args); } SEAM(PH_ROUTE);
    if (IN(PH_GATHER)) { ph_gather(F, args); } SEAM(PH_GATHER);
    if (IN(PH_GU)) { if (FAST(F_MOE)) fast_gu(F, args); } SEAM(PH_GU);
    if (IN(PH_DOWN)) { if (FAST(F_MOE)) fast_down(F, args); } SEAM(PH_DOWN);
    if (IN(PH_COMB)) { ph_combine(F, args); } SEAM(PH_COMB);
    if (IN(PH_PLE)) { if (FAST(F_PLE)) fast_ple(F, args); } SEAM(PH_PLE);
    if (IN(PH_FINAL)) { ph_final(F, args); }
#undef IN
#undef SEAM
}

struct Launcher {
    Args a; int grid; hipStream_t stream; int pend_lo, pend_hi, li;
    void flush() {
        if (pend_lo < 0) return;
#if SPLIT_PHASES
        for (int p = pend_lo; p < pend_hi; ++p) { a.ph_lo = p; a.ph_hi = p + 1; a.li = 0; hipLaunchKernelGGL(mega, dim3(grid), dim3(NWAVES * 64), LDS_BYTES, stream, a); }
#else
        a.ph_lo = pend_lo; a.ph_hi = pend_hi; a.li = li++;
        hipLaunchKernelGGL(mega, dim3(grid), dim3(NWAVES * 64), LDS_BYTES, stream, a);
#endif
        pend_lo = pend_hi = -1;
    }
    void phases(int lo, int hi) { if (pend_lo >= 0 && pend_hi == lo) { pend_hi = hi; return; } flush(); pend_lo = lo; pend_hi = hi; }
};
template <class E> static void launch_naive(hipStream_t s, const E& e, int M, int N, int K) { hipLaunchKernelGGL(naive_gemm<E>, dim3(N / 64, M / 128), dim3(256), 0, s, e, N, K); }

extern "C" void kernel_launch(void* const* d_in, const int* in_sizes, int n_in, void* d_out, int out_size, void* d_ws, size_t ws_size, hipStream_t stream) {
    static int grid = 0;
    if (grid == 0) {
        if (n_in != 20 || in_sizes[0] != NTOK * DM || out_size != NTOK * DM || ws_size < WS_END) { fprintf(stderr, "kernel_launch: unexpected shapes (n_in %d, in0 %d, out %d, ws %zu)\n", n_in, n_in > 0 ? in_sizes[0] : -1, out_size, ws_size); grid = -1; return; }
        int dev = 0, cus = 0, per_cu = 0;
        if (hipGetDevice(&dev) != hipSuccess || hipDeviceGetAttribute(&cus, hipDeviceAttributeMultiprocessorCount, dev) != hipSuccess) { grid = -1; return; }
        if (hipFuncSetAttribute((const void*)mega, hipFuncAttributeMaxDynamicSharedMemorySize, LDS_BYTES) != hipSuccess) { fprintf(stderr, "kernel_launch: hipFuncSetAttribute failed\n"); grid = -1; return; }
        if (hipOccupancyMaxActiveBlocksPerMultiprocessor(&per_cu, (const void*)mega, NWAVES * 64, LDS_BYTES) != hipSuccess || per_cu < 1) fprintf(stderr, "kernel_launch: occupancy query reports %d\n", per_cu);
        (void)hipGetLastError();
        grid = cus;
    }
    if (grid < 0) return;
    unsigned char* ws = (unsigned char*)d_ws;
    if (hipMemsetAsync(ws + WS_CTL, 0, CTL_ZERO_BYTES, stream) != hipSuccess) return;
    Launcher L{}; L.grid = grid; L.stream = stream; L.pend_lo = L.pend_hi = -1; L.li = 0;
    for (int i = 0; i < 20; ++i) L.a.in[i] = (const float*)d_in[i];
    L.a.out = (float*)d_out; L.a.ws = ws;
    const float* const* in = (const float* const*)d_in; (void)in;
    bf16* HB = (bf16*)((unsigned char*)d_out + DO_HB); bf16* NV = (bf16*)((unsigned char*)d_out + DO_NV);
    bf16* PROJ = (bf16*)(ws + WS_PROJ); bf16* T = (bf16*)(ws + WS_T);
    const f32x2* tabA = (const f32x2*)(ws + WS_TABA); const f32x2* tabB = (const f32x2*)(ws + WS_TABB);
    const int* tile = (const int*)(ws + WS_ROUTE + RT_TILE); const float* wrow = (const float*)(ws + WS_ROUTE + RT_WROW);

    L.phases(PH_PRO, PH_PRO + 1);
    if (FAST(F_PROJ)) L.phases(PH_PROJ, PH_PROJ + 1);
    else { L.flush(); launch_naive(stream, NProjMain{HB, in[3], PROJ, tabA}, NTOK, NMAIN, DM); if (FAST(F_RET) || FAST(F_ATT)) launch_naive(stream, NProjT{HB, in[3], T, tabB}, NTOK, NTR, DM); }
    if (!FAST(F_RET) || !FAST(F_ATT)) { L.flush(); launch_naive(stream, NProjV{HB, in[3], NV}, NTOK, 1024, DM); }
    if (FAST(F_RET) || FAST(F_ATT)) L.phases(PH_MIX1, PH_MIX1 + 1);
    if (FAST(F_RET)) L.phases(PH_SCAN, PH_RETO + 1);
    if (!FAST(F_RET)) { L.flush(); hipLaunchKernelGGL(naive_ret, dim3(NBATCH * 4 * 64), dim3(256), 0, stream, PROJ, (const bf16*)NV, in[4]); }
    if (!FAST(F_ATT)) { L.flush(); hipLaunchKernelGGL(naive_att, dim3(NBATCH * 8 * 64), dim3(256), 0, stream, PROJ, (const bf16*)NV); }
    if (FAST(F_BR)) L.phases(PH_BR, PH_BR + 1);
    else { L.flush(); launch_naive(stream, NBr{PROJ, in[5], 0, 0}, NTOK, DM, 512); launch_naive(stream, NBr{PROJ, in[6], 1, 0}, NTOK, DM, 512); }
    if (FAST(F_WOUT)) L.phases(PH_WOUT, PH_WOUT + 1);
    else { L.flush(); launch_naive(stream, NWout{PROJ, in[7], in[0], (float*)d_out}, NTOK, DM, DM); }
    L.phases(PH_ROUTE, PH_GATHER + 1);
    if (FAST(F_MOE)) L.phases(PH_GU, PH_DOWN + 1);
    else { L.flush(); launch_naive(stream, NGateUp{(const bf16*)(ws + WS_XB), in[13], in[14], (bf16*)(ws + WS_HID), tile}, MPAD_MAX, DEXP, DM);
           launch_naive(stream, NDown{(const bf16*)(ws + WS_HID), in[15], (bf16*)(ws + WS_XB), tile, wrow}, MPAD_MAX, DM, DEXP); }
    L.phases(PH_COMB, PH_COMB + 1);
    if (FAST(F_PLE)) L.phases(PH_PLE, PH_PLE + 1);
    else { L.flush(); launch_naive(stream, NPe{(const bf16*)(ws + WS_PB), in[17], (bf16*)(ws + WS_HID)}, NTOK, DM, 256);
           launch_naive(stream, NPg{(const bf16*)(ws + WS_H2), in[18], (const bf16*)(ws + WS_HID), (float*)d_out}, NTOK, DM, DM); }
    L.phases(PH_FINAL, PH_FINAL + 1);
    L.flush();
}
```

```cpp
#define DUP_MASK 0
#include <hip/hip_runtime.h>
#include <cstdio>
#include <cstdint>

#ifndef SPLIT_PHASES
#define SPLIT_PHASES 0
#endif
#ifndef DUP_MASK
#define DUP_MASK 0
#endif

constexpr int NTOK = 32768, DM = 1024, SEQ = 4096, NBATCH = 8;
constexpr int NMAIN = 4608, NTR = 1536, NWIN = 5632;
constexpr int C_RQ = 0, C_RK = 512, C_RG = 1024, C_SQ = 1536, C_SK = 2048, C_GR = 2560, C_GS = 3584;
constexpr int C_MG = 0;
constexpr int T_KT = 0, T_VR = 512, T_VS = 1024;
constexpr int NEXP = 16, DEXP = 512, MPAD_MAX = 65536 + 16 * 256, NRT_MAX = MPAD_MAX / 256;
constexpr float EPS = 1e-6f;
constexpr float LOG2E = 1.4426950408889634f;
constexpr float SB_QSCALE = 0.125f * LOG2E;
constexpr float SB_EXIT = -160.0f;

constexpr size_t MiB = 1u << 20;
constexpr size_t WS_CTL = 0, CTL_ZERO_BYTES = 1 * MiB;
constexpr size_t WS_WIN = 2 * MiB;
constexpr size_t WS_WBR1 = 14 * MiB;
constexpr size_t WS_WBR2 = 15 * MiB;
constexpr size_t WS_WOUT = 16 * MiB;
constexpr size_t WS_WGU = 18 * MiB;
constexpr size_t WS_WD = 50 * MiB;
constexpr size_t WS_WPLE = 66 * MiB;
constexpr size_t WS_WPG = 67 * MiB;
constexpr size_t WS_TABA = 70 * MiB;
constexpr size_t WS_TABB = 72 * MiB;
constexpr size_t WS_ROUTE = 74 * MiB;
constexpr size_t WS_PB = 76 * MiB;
constexpr size_t WS_PROJ = 92 * MiB;
constexpr size_t WS_T = 380 * MiB;
constexpr size_t WS_X2 = 360 * MiB;
constexpr size_t WS_END = 488 * MiB;
constexpr size_t WS_H2 = 92 * MiB;
constexpr size_t WS_XB = 156 * MiB;
constexpr size_t WS_HID = 292 * MiB;
constexpr size_t DO_HB = 0, DO_ST = 0, DO_RS = 64 * MiB;
constexpr size_t RT_EID = 0, RT_WGT = 256 * 1024, RT_RANK = 512 * 1024, RT_POS = 768 * 1024, RT_WROW = 1024 * 1024, RT_TILE = 1536 * 1024;
constexpr int CW_TMO = 0, CW_CODE = 1;
constexpr int CW_CNT = 64;
constexpr int CW_BAR = 4096, BAR_STRIDE = 4096;

#define GAS __attribute__((address_space(1)))
#define LAS __attribute__((address_space(3)))
typedef unsigned short bf16;
typedef unsigned v4u __attribute__((ext_vector_type(4)));
typedef unsigned v2u __attribute__((ext_vector_type(2)));
typedef float f32x4 __attribute__((ext_vector_type(4)));
typedef float f32x2 __attribute__((ext_vector_type(2)));
typedef float f32x16 __attribute__((ext_vector_type(16)));
typedef short bf16x8 __attribute__((ext_vector_type(8)));
typedef short s16x4 __attribute__((ext_vector_type(4)));
typedef GAS unsigned gu32;
#define RLX_AGENT __ATOMIC_RELAXED, __HIP_MEMORY_SCOPE_AGENT
#define LDS_WAIT() asm volatile("s_waitcnt lgkmcnt(0)" ::: "memory")
#define VM_WAIT() asm volatile("s_waitcnt vmcnt(0)" ::: "memory")
#define DI __device__ __forceinline__
DI unsigned f2bf(float f) { unsigned u = __builtin_bit_cast(unsigned, f); return (u + 0x7fffu + ((u >> 16) & 1u)) >> 16; }
DI unsigned pk2(float lo, float hi) { return f2bf(lo) | (f2bf(hi) << 16); }
DI float bf2f(unsigned b) { return __builtin_bit_cast(float, b << 16); }
DI float bflo(unsigned w) { return __builtin_bit_cast(float, w << 16); }
DI float bfhi(unsigned w) { return __builtin_bit_cast(float, w & 0xffff0000u); }
DI float fsigmoid(float x) { return 1.0f / (1.0f + __expf(-x)); }
DI float fsilu(float x) { return x / (1.0f + __expf(-x)); }
DI float wave_sum(float v) {
#pragma unroll
    for (int o = 1; o < 64; o <<= 1) v += __shfl_xor(v, o);
    return v;
}
DI float ret_log2g(int h) { return log2f(1.0f - exp2f(-5.0f - (float)h)); }

__host__ __device__ __forceinline__ int in_src(int r) {
    if (r < 1024) { const int base = (r < 512) ? 0 : 512; const int i = r & 511, h = i >> 7, j = i & 127; return base + h * 128 + (j & 1) * 64 + (j >> 1); }
    if (r < 1536) return 1536 + (r - 1024);
    if (r < 2048) return 2048 + (r - 1536);
    if (r < 2560) return 2560 + (r - 2048);
    if (r < 3584) return 3584 + (r - 2560);
    if (r < 4608) return 4608 + (r - 3584);
    if (r < 5120) { const int i = r - 4608, h = i >> 7, j = i & 127; return 512 + h * 128 + (j & 1) * 64 + (j >> 1); }
    if (r < 5632) return 1024 + (r - 5120);
    return 3072 + (r - 5632);
}


namespace pg8 {
#define PG8_LAS __attribute__((address_space(3)))
typedef unsigned short bf16_t;
typedef short bf16x8 __attribute__((ext_vector_type(8)));
typedef float f32x4 __attribute__((ext_vector_type(4)));
typedef unsigned u32x4 __attribute__((ext_vector_type(4)));
constexpr int BM = 256, BK = 64, HALF = 128, HTB = HALF * BK * 2  , STAGE_BYTES = 8 * HTB, NXCD = 8, WGM = 8;

__host__ __device__ __forceinline__ int lds_byte(int r, int c) { const int st = (r >> 4) * 2 + (c >> 5), rr = r & 15, cc = c & 31, ob = rr * 64 + cc * 2; return st * 1024 + (ob ^ (((ob >> 9) & 1) << 5)); }
__host__ __device__ __forceinline__ void stage_rc(int b, int& R, int& C) { const int st = b / 1024, sb = b % 1024, swz = sb ^ (((sb >> 9) & 1) << 5); R = (st >> 1) * 16 + swz / 64; C = (st & 1) * 32 + (swz % 64) / 2; }
__host__ __device__ __forceinline__ int perm32(int rho) { const int n = rho >> 4, i = rho & 15; return 8 * (i >> 2) + 4 * n + (i & 3); }

struct Unit { int pm, pn; size_t bofs; int ex; };
struct Gemm { const bf16_t* A; const bf16_t* Bt; int lda, K; };

struct StaticOrder {
    int nM, nN, nwg, G, c; size_t tstepB;
    __device__ void init(int M, int N, int K, int G_, int c_) { nM = M / BM; nN = N / BM; nwg = nM * nN; G = G_; c = c_; tstepB = (size_t)BM * K * 2; }
    __device__ bool next(int i, Unit& u) const {
        const long L = (long)i * G + c; if (L >= nwg) return false;
        int wgid = (int)L; { const int q = nwg / NXCD, r = nwg % NXCD, xcd = wgid % NXCD, off = wgid / NXCD; wgid = (xcd < r ? xcd * (q + 1) : r * (q + 1) + (xcd - r) * q) + off; }
        const int nig = WGM * nN, gid = wgid / nig, fm = gid * WGM, gsz = (nM - fm) < WGM ? (nM - fm) : WGM;
        u.pm = fm + ((wgid % nig) % gsz); u.pn = (wgid % nig) / gsz; u.bofs = (size_t)u.pn * tstepB; u.ex = 0; return true;
    }
    __device__ __forceinline__ void a_ready(const Unit&) const {}
    __device__ __forceinline__ void done(const Unit&) const {}
};
__device__ __forceinline__ unsigned cvt_pk_bf16(float lo, float hi) { unsigned r; asm volatile("v_cvt_pk_bf16_f32 %0, %1, %2" : "=v"(r) : "v"(lo), "v"(hi)); return r; }
template <class Epi, class Sched, bool ALIGN_EPI = false, bool SP2 = false>
__device__ __forceinline__ void gemm_phase(PG8_LAS unsigned char* lds, const Gemm g, const Sched& S, const Epi& E) {
    int tid_ = threadIdx.x; asm volatile("" : "+v"(tid_));
    const int tid = tid_, wid = __builtin_amdgcn_readfirstlane(tid >> 6), lane = tid & 63, wr = wid >> 2, wc = wid & 3, fr = lane & 15, fq = lane >> 4;
    const int K = g.K, nt = K / BK;
    unsigned voffA[2], voffB[2];
#pragma unroll
    for (int i = 0; i < 2; ++i) { int R, C; stage_rc(tid * 16 + i * 8192, R, C); const int Rb = Epi::PERM ? ((R & ~31) + perm32(R & 31)) : R;
        voffA[i] = (unsigned)(R * g.lda + C) * 2u; voffB[i] = (unsigned)(Rb * K + C) * 2u; }
    const size_t kstep = (size_t)(BK * 2);
    const size_t hstepA = (size_t)HALF * g.lda * 2, hstepB = (size_t)HALF * K * 2;
    const size_t tstepA = 2 * hstepA;
    const unsigned ldsw = (unsigned)wid * 1024u;
    const int aoff = lds_byte(wr * 64 + fr, fq * 8), boff = lds_byte(wc * 32 + fr, fq * 8);
#define PG8_SA(b, h) (((b) * 2 + (h)) * HTB)
#define PG8_SB(b, h) ((4 + (b) * 2 + (h)) * HTB)
#define PG8_STAGE(bufoff, gbase, voff) do { _Pragma("unroll") for (int _i = 0; _i < 2; ++_i) \
        __builtin_amdgcn_global_load_lds((const unsigned*)((const char*)(gbase) + (voff)[_i]), (PG8_LAS unsigned*)(lds + (bufoff) + ldsw + _i * 8192), 16, 0, 0); } while (0)
#define PG8_LDA(dst, b, h) do { _Pragma("unroll") for (int m = 0; m < 4; ++m) _Pragma("unroll") for (int k = 0; k < 2; ++k) dst[m][k] = *(const PG8_LAS bf16x8*)(lds + PG8_SA(b, h) + aoff + m * 2048 + k * 1024); } while (0)
#define PG8_LDB(dst, b, h) do { _Pragma("unroll") for (int n = 0; n < 2; ++n) _Pragma("unroll") for (int k = 0; k < 2; ++k) dst[n][k] = *(const PG8_LAS bf16x8*)(lds + PG8_SB(b, h) + boff + n * 2048 + k * 1024); } while (0)
#define PG8_MMA(ai, bj, At, Bt) do { __builtin_amdgcn_s_setprio(1); _Pragma("unroll") for (int m = 0; m < 4; ++m) _Pragma("unroll") for (int n = 0; n < 2; ++n) _Pragma("unroll") for (int k = 0; k < 2; ++k) \
        acc[ai][bj][m][n] = __builtin_amdgcn_mfma_f32_16x16x32_bf16(Bt[n][k], At[m][k], acc[ai][bj][m][n], 0, 0, 0); __builtin_amdgcn_s_setprio(0); } while (0)
#define PG8_WAIT_V(n) asm volatile("s_waitcnt vmcnt(" #n ")" ::: "memory")
#define PG8_WAIT_L(n) asm volatile("s_waitcnt lgkmcnt(" #n ")" ::: "memory")
#define PG8_BAR __builtin_amdgcn_s_barrier()
#define PG8_SCHED __builtin_amdgcn_sched_barrier(0)
    Unit cur, nxt; int ui = 0;
    if (!S.next(0, cur)) return;
    f32x4 acc[2][2][4][2];
#pragma unroll
    for (int a = 0; a < 2; ++a)
#pragma unroll
        for (int b = 0; b < 2; ++b)
#pragma unroll
            for (int m = 0; m < 4; ++m)
#pragma unroll
                for (int n = 0; n < 2; ++n) acc[a][b][m][n] = (f32x4){0.f, 0.f, 0.f, 0.f};
    bf16x8 At[4][2], B0[2][2], B1[2][2];
    const char* cA = (const char*)g.A + (size_t)cur.pm * tstepA; const char* cB = (const char*)g.Bt + cur.bofs;
    S.a_ready(cur);
    if constexpr (SP2) {
        PG8_STAGE(PG8_SB(0, 0), cB, voffB); PG8_STAGE(PG8_SB(0, 1), cB + hstepB, voffB); PG8_STAGE(PG8_SA(0, 0), cA, voffA); PG8_STAGE(PG8_SA(0, 1), cA + hstepA, voffA);
        if (wr == 1) PG8_BAR;
        PG8_WAIT_V(2); PG8_BAR;
        PG8_STAGE(PG8_SB(1, 0), cB + kstep, voffB); PG8_STAGE(PG8_SA(1, 0), cA + kstep, voffA); PG8_STAGE(PG8_SB(1, 1), cB + hstepB + kstep, voffB);
        PG8_WAIT_V(6); PG8_BAR;
    } else {
        PG8_STAGE(PG8_SB(0, 0), cB, voffB); PG8_STAGE(PG8_SA(0, 0), cA, voffA); PG8_STAGE(PG8_SB(0, 1), cB + hstepB, voffB); PG8_STAGE(PG8_SA(0, 1), cA + hstepA, voffA);
        if (wr == 1) PG8_BAR;
        PG8_WAIT_V(4); PG8_BAR;
        PG8_STAGE(PG8_SB(1, 0), cB + kstep, voffB); PG8_STAGE(PG8_SA(1, 0), cA + kstep, voffA); PG8_STAGE(PG8_SB(1, 1), cB + hstepB + kstep, voffB);
        PG8_WAIT_V(6); PG8_BAR;
    }
    for (;;) {
        const bool has_next = S.next(ui + 1, nxt);
        const char* nA = has_next ? (const char*)g.A + (size_t)nxt.pm * tstepA : cA; const char* nB = has_next ? (const char*)g.Bt + nxt.bofs : cB;
        for (int t = 0; t < nt; t += 2) {
            const bool last = (t == nt - 2);
            const char* a1 = cA + (size_t)(t + 1) * kstep;
            const char* a2 = last ? nA : cA + (size_t)(t + 2) * kstep; const char* b2 = last ? nB : cB + (size_t)(t + 2) * kstep;
            const char* a3 = a2 + kstep; const char* b3 = b2 + kstep;
            if (last && has_next) S.a_ready(nxt);
            if constexpr (SP2) {
            PG8_LDB(B0, 0, 0); PG8_LDB(B1, 0, 1); PG8_SCHED; PG8_LDA(At, 0, 0); PG8_STAGE(PG8_SA(1, 1), a1 + hstepA, voffA);
            PG8_WAIT_V(8); PG8_WAIT_L(0); PG8_BAR; PG8_MMA(0, 0, At, B0); PG8_MMA(0, 1, At, B1); PG8_BAR; PG8_SCHED;
            PG8_LDA(At, 0, 1); PG8_STAGE(PG8_SB(0, 0), b2, voffB); PG8_STAGE(PG8_SB(0, 1), b2 + hstepB, voffB); PG8_STAGE(PG8_SA(0, 0), a2, voffA);
            PG8_WAIT_V(8); PG8_WAIT_L(0); PG8_BAR; PG8_MMA(1, 0, At, B0); PG8_MMA(1, 1, At, B1); PG8_BAR; PG8_SCHED;
            PG8_LDB(B0, 1, 0); PG8_LDB(B1, 1, 1); PG8_SCHED; PG8_LDA(At, 1, 0); PG8_STAGE(PG8_SA(0, 1), a2 + hstepA, voffA);
            PG8_WAIT_V(8); PG8_WAIT_L(0); PG8_BAR; PG8_MMA(0, 0, At, B0); PG8_MMA(0, 1, At, B1); PG8_BAR; PG8_SCHED;
            PG8_LDA(At, 1, 1); PG8_STAGE(PG8_SB(1, 0), b3, voffB); PG8_STAGE(PG8_SB(1, 1), b3 + hstepB, voffB); PG8_STAGE(PG8_SA(1, 0), a3, voffA);
            PG8_WAIT_V(8); PG8_WAIT_L(0); PG8_BAR; PG8_MMA(1, 0, At, B0); PG8_MMA(1, 1, At, B1); PG8_BAR; PG8_SCHED;
            } else {
            PG8_LDB(B0, 0, 0); PG8_SCHED; PG8_LDA(At, 0, 0); PG8_STAGE(PG8_SA(1, 1), a1 + hstepA, voffA);
            PG8_WAIT_L(8); PG8_BAR; PG8_WAIT_L(0); PG8_MMA(0, 0, At, B0); PG8_BAR; PG8_SCHED;
            PG8_LDB(B1, 0, 1); PG8_STAGE(PG8_SB(0, 0), b2, voffB);
            PG8_BAR; PG8_WAIT_L(0); PG8_MMA(0, 1, At, B1); PG8_BAR;
            PG8_LDA(At, 0, 1); PG8_STAGE(PG8_SA(0, 0), a2, voffA);
            PG8_BAR; PG8_WAIT_L(0); PG8_MMA(1, 0, At, B0); PG8_BAR; PG8_SCHED;
            PG8_STAGE(PG8_SB(0, 1), b2 + hstepB, voffB);
            PG8_WAIT_V(6); PG8_BAR; PG8_MMA(1, 1, At, B1); PG8_BAR;
            PG8_LDB(B0, 1, 0); PG8_SCHED; PG8_LDA(At, 1, 0); PG8_STAGE(PG8_SA(0, 1), a2 + hstepA, voffA);
            PG8_WAIT_L(8); PG8_BAR; PG8_WAIT_L(0); PG8_MMA(0, 0, At, B0); PG8_BAR; PG8_SCHED;
            PG8_LDB(B1, 1, 1); PG8_STAGE(PG8_SB(1, 0), b3, voffB);
            PG8_BAR; PG8_WAIT_L(0); PG8_MMA(0, 1, At, B1); PG8_BAR;
            PG8_LDA(At, 1, 1); PG8_STAGE(PG8_SA(1, 0), a3, voffA);
            PG8_BAR; PG8_WAIT_L(0); PG8_MMA(1, 0, At, B0); PG8_BAR; PG8_SCHED;
            PG8_STAGE(PG8_SB(1, 1), b3 + hstepB, voffB);
            PG8_WAIT_V(6); PG8_BAR; PG8_MMA(1, 1, At, B1); PG8_BAR;
            }
        }
        if constexpr (ALIGN_EPI) { if (wr == 0) PG8_BAR; }
        if constexpr (!Epi::AFTER_DRAIN) { E(acc, cur, wr, wc, fr, fq); S.done(cur); }
        if (!has_next) break;
#pragma unroll
        for (int a = 0; a < 2; ++a)
#pragma unroll
            for (int b = 0; b < 2; ++b)
#pragma unroll
                for (int m = 0; m < 4; ++m)
#pragma unroll
                    for (int n = 0; n < 2; ++n) acc[a][b][m][n] = (f32x4){0.f, 0.f, 0.f, 0.f};
        cur = nxt; cA = nA; cB = nB; ++ui;
        if constexpr (ALIGN_EPI) { if (wr == 1) PG8_BAR; }
    }
    PG8_WAIT_V(0);
    if constexpr (!ALIGN_EPI) { if (wr == 0) PG8_BAR; }
    PG8_BAR;
    if constexpr (Epi::AFTER_DRAIN) { E.fused(acc, cur, wr, wc, fr, fq, lds, wid, lane); S.done(cur); }
#undef PG8_SA
#undef PG8_SB
#undef PG8_STAGE
#undef PG8_LDA
#undef PG8_LDB
#undef PG8_MMA
#undef PG8_WAIT_V
#undef PG8_WAIT_L
#undef PG8_BAR
#undef PG8_SCHED
}
}
#define XB_TMO      128
#define XB_XCNT(j)  (256  + 64 * (j))
#define XB_XSUB(j)  (1280 + 64 * (j))
#define XB_XGEN(j)  (2304 + 64 * (j))
#define XB_TOP      3328
#define XB_TOPGEN   3392
#define XCD_BAR_WORDS 3456
#define XB_SPIN_CAP (1u << 18)

__device__ __forceinline__ unsigned xb_ld(unsigned* p)              { return __hip_atomic_load(p, __ATOMIC_RELAXED, __HIP_MEMORY_SCOPE_AGENT); }
__device__ __forceinline__ unsigned xb_add(unsigned* p, unsigned v) { return __hip_atomic_fetch_add(p, v, __ATOMIC_RELAXED, __HIP_MEMORY_SCOPE_AGENT); }
__device__ __forceinline__ unsigned xb_xcc_id() { return (unsigned)__builtin_amdgcn_s_getreg((3 << 11) | 20) & 0xFu; }
#define XB_SPIN(cond, bar) do { unsigned _sp = 0; while (cond) { __builtin_amdgcn_s_sleep(1); \
    if ((++_sp & 255u) == 0u) { if (xb_ld(&(bar)[XB_TMO])) break; if (_sp > XB_SPIN_CAP) { atomicAdd(&(bar)[XB_TMO], 1u); break; } } } } while (0)

struct XcdBarrier {
    unsigned* bar; unsigned x;
    volatile LAS unsigned* st;
};

__device__ __forceinline__ XcdBarrier xcd_barrier_post(unsigned* bar, volatile LAS unsigned* st) {
    XcdBarrier b; b.bar = bar; b.x = xb_xcc_id(); b.st = st;
    if (threadIdx.x == 0) (void)xb_add(&bar[XB_XCNT(b.x)], 1u);
    return b;
}
__device__ __forceinline__ void xcd_barrier_complete(unsigned* bar, unsigned x, unsigned& nloc, unsigned& nx) {
    const unsigned G = gridDim.x * gridDim.y * gridDim.z;
    unsigned sum, cnt, mine, sp = 0u;
    for (;;) {
        sum = 0u; cnt = 0u; mine = 0u;
#pragma unroll
        for (unsigned j = 0; j < 16; ++j) { const unsigned c = xb_ld(&bar[XB_XCNT(j)]); sum += c; cnt += (c > 0u) ? 1u : 0u; mine = (j == x) ? c : mine; }
        if (sum == G) break;
        __builtin_amdgcn_s_sleep(1);
        if ((++sp & 255u) == 0u) { if (xb_ld(&bar[XB_TMO])) break; if (sp > XB_SPIN_CAP) { atomicAdd(&bar[XB_TMO], 1u); break; } }
    }
    nloc = mine > 0u ? mine : 1u; nx = cnt > 0u ? cnt : 1u;
}

__device__ __forceinline__ void xcd_barrier(const XcdBarrier& b) {
    asm volatile("s_waitcnt vmcnt(0)" ::: "memory");
    __syncthreads();
    if (threadIdx.x == 0) {
        unsigned* bar = b.bar;
        __builtin_amdgcn_s_waitcnt(0);
        unsigned nloc = b.st[0], nx = b.st[1];
        if (nloc == 0u) { xcd_barrier_complete(bar, b.x, nloc, nx); b.st[0] = nloc; b.st[1] = nx; }
        const unsigned old = xb_add(&bar[XB_XSUB(b.x)], 1u);
        const unsigned gen = old / nloc;
        if (old + 1u == (gen + 1u) * nloc) {
            __builtin_amdgcn_fence(__ATOMIC_RELEASE, "agent");
            asm volatile("s_waitcnt vmcnt(0)" ::: "memory");
            const unsigned og = xb_add(&bar[XB_TOP], 1u);
            const unsigned tg = og / nx;
            if (og + 1u == (tg + 1u) * nx) xb_add(&bar[XB_TOPGEN], 1u);
            else XB_SPIN(xb_ld(&bar[XB_TOPGEN]) == tg, bar);
            __builtin_amdgcn_fence(__ATOMIC_ACQUIRE, "agent");
            xb_add(&bar[XB_XGEN(b.x)], 1u);
            asm volatile("s_waitcnt vmcnt(0)" ::: "memory");
        } else {
            XB_SPIN(xb_ld(&bar[XB_XGEN(b.x)]) == gen, bar);
            __builtin_amdgcn_fence(__ATOMIC_ACQUIRE, "agent");
            asm volatile("s_waitcnt vmcnt(0)" ::: "memory");
        }
    }
    __syncthreads();
}

constexpr int NWAVES = 8;
constexpr int RING_OFF = 0, RING_BYTES = 131072;
constexpr int LDSCTL_OFF = RING_BYTES, MISC_OFF = LDSCTL_OFF + 320;
constexpr int LDS_BYTES = 147456;

struct Args { const float* in[20]; float* out; unsigned char* ws; int ph_lo, ph_hi, li, pad; };

struct Frame {
    LAS unsigned char* lds;
    volatile LAS unsigned* MISC;
    gu32* ctl;
    int tid, lane, wave, vcu, G;
    __device__ __forceinline__ void refresh() { int t = threadIdx.x; asm volatile("" : "+v"(t)); tid = t; lane = t & 63; wave = __builtin_amdgcn_readfirstlane(t >> 6); }
    unsigned char* ws; float* out;
    const float* x; const float* p;
};

enum Phase { PH_PRO = 0, PH_PROJ, PH_MIX1, PH_SCAN, PH_RETO, PH_BR, PH_WOUT, PH_ROUTE, PH_GATHER, PH_GU, PH_DOWN, PH_COMB, PH_PLE, PH_FINAL, NPH };

DI void tr_item(const float* __restrict__ W, int ldw, int mycol, bf16* WT, int K, int r0, int k0, LAS float* scr, int lane) {
#pragma unroll 8
    for (int i = 0; i < 32; ++i) { const int kk = 2 * i + (lane >> 5); scr[kk * 33 + (lane & 31)] = W[(size_t)(k0 + kk) * ldw + mycol]; }
    LDS_WAIT(); asm volatile("" ::: "memory");
    const int c = lane & 7;
#pragma unroll
    for (int j = 0; j < 4; ++j) { const int n = (lane >> 3) + 8 * j; const LAS float* s = scr + (8 * c) * 33 + n;
        v4u o; o.x = pk2(s[0 * 33], s[1 * 33]); o.y = pk2(s[2 * 33], s[3 * 33]); o.z = pk2(s[4 * 33], s[5 * 33]); o.w = pk2(s[6 * 33], s[7 * 33]);
        *(GAS v4u*)(WT + (size_t)(r0 + n) * K + k0 + 8 * c) = o; }
    LDS_WAIT(); asm volatile("" ::: "memory");
}
DI void rms_row_to_bf16(const float* xrow, const float* gain, bf16* orow, int lane) {
    const GAS f32x4* xr = (const GAS f32x4*)xrow + lane; const GAS f32x4* gr = (const GAS f32x4*)gain + lane;
    f32x4 v[4]; float s = 0.f;
#pragma unroll
    for (int j = 0; j < 4; ++j) { v[j] = xr[64 * j]; s += (v[j].x * v[j].x + v[j].y * v[j].y) + (v[j].z * v[j].z + v[j].w * v[j].w); }
    const float rstd = rsqrtf(wave_sum(s) * (1.f / DM) + EPS);
    GAS v2u* o8 = (GAS v2u*)orow + lane;
#pragma unroll
    for (int j = 0; j < 4; ++j) { const f32x4 g = gr[64 * j]; v2u o; o.x = pk2(v[j].x * rstd * g.x, v[j].y * rstd * g.y); o.y = pk2(v[j].z * rstd * g.z, v[j].w * rstd * g.w); o8[64 * j] = o; }
}
DI void ph_prologue(Frame& F, const Args& a) {
    LAS float* scr = (LAS float*)(F.lds + RING_OFF + F.wave * 16384);
    const int gw = F.vcu * NWAVES + F.wave, NGW = F.G * NWAVES, lane = F.lane;
    unsigned char* ws = F.ws;
    constexpr int I_IN = (6144 / 32) * 16, I_BR = 32 * 8, I_OUT = 32 * 16, I_GU = 16 * 32 * 16, I_D = 16 * 32 * 8, I_PLE = 32 * 4, I_PG = 32 * 16;
    constexpr int NITEMS = I_IN + 2 * I_BR + I_OUT + I_GU + I_D + I_PLE + I_PG;
    for (int it = gw; it < NITEMS; it += NGW) {
        int r = it;
        if (r < I_IN) { const int rb = r >> 4, kb = r & 15; tr_item(a.in[3], NWIN, in_src(rb * 32 + (lane & 31)), (bf16*)(ws + WS_WIN), 1024, rb * 32, kb * 64, scr, lane); continue; } r -= I_IN;
        if (r < I_BR) { const int rb = r >> 3, kb = r & 7; tr_item(a.in[5], DM, rb * 32 + (lane & 31), (bf16*)(ws + WS_WBR1), 512, rb * 32, kb * 64, scr, lane); continue; } r -= I_BR;
        if (r < I_BR) { const int rb = r >> 3, kb = r & 7; tr_item(a.in[6], DM, rb * 32 + (lane & 31), (bf16*)(ws + WS_WBR2), 512, rb * 32, kb * 64, scr, lane); continue; } r -= I_BR;
        if (r < I_OUT) { const int rb = r >> 4, kb = r & 15; tr_item(a.in[7], DM, rb * 32 + (lane & 31), (bf16*)(ws + WS_WOUT), 1024, rb * 32, kb * 64, scr, lane); continue; } r -= I_OUT;
        if (r < I_GU) { const int e = r >> 9, q = r & 511, rb = q >> 4, kb = q & 15;
            const int row = rb * 32, j = row >> 8, w = row & 255; const bool up = w >= 128; const int col = 128 * j + (w & 127) + (lane & 31);
            tr_item((up ? a.in[14] : a.in[13]) + (size_t)e * DM * DEXP, DEXP, col, (bf16*)(ws + WS_WGU) + (size_t)e * 1024 * 1024, 1024, row, kb * 64, scr, lane); continue; } r -= I_GU;
        if (r < I_D) { const int e = r >> 8, q = r & 255, rb = q >> 3, kb = q & 7;
            tr_item(a.in[15] + (size_t)e * DEXP * DM, DM, rb * 32 + (lane & 31), (bf16*)(ws + WS_WD) + (size_t)e * 1024 * 512, 512, rb * 32, kb * 64, scr, lane); continue; } r -= I_D;
        if (r < I_PLE) { const int rb = r >> 2, kb = r & 3; tr_item(a.in[17], DM, rb * 32 + (lane & 31), (bf16*)(ws + WS_WPLE), 256, rb * 32, kb * 64, scr, lane); continue; } r -= I_PLE;
        { const int rb = r >> 4, kb = r & 15; tr_item(a.in[18], DM, rb * 32 + (lane & 31), (bf16*)(ws + WS_WPG), 1024, rb * 32, kb * 64, scr, lane); }
    }
    bf16* HB = (bf16*)((unsigned char*)F.out + DO_HB);
    for (int m = gw; m < NTOK; m += NGW) {
        rms_row_to_bf16(F.x + (size_t)m * DM, a.in[2], HB + (size_t)m * DM, lane);
        const f32x4 pv = ((const GAS f32x4*)(F.p + (size_t)m * 256))[lane];
        v2u o; o.x = pk2(pv.x, pv.y); o.y = pk2(pv.z, pv.w); ((GAS v2u*)((bf16*)(ws + WS_PB) + (size_t)m * 256))[lane] = o;
    }
    f32x2* tabA = (f32x2*)(ws + WS_TABA); f32x2* tabB = (f32x2*)(ws + WS_TABB);
    for (int i = F.vcu * 512 + F.tid; i < SEQ * 64; i += F.G * 512) {
        const int pos = i >> 6, p = i & 63;
        const float invf = powf(10000.0f, -(float)(2 * p) * (1.0f / 128.0f)); const float ang = (float)pos * invf;
        const f32x2 cs = {cosf(ang), sinf(ang)};
        tabA[i] = cs; tabB[p * SEQ + pos] = cs;
    }
}

DI void ph_route(Frame& F, const Args& a) {
    LAS float* WL = (LAS float*)(F.lds);
    for (int i = F.tid; i < 1024 * 20; i += 512) { const int k = i / 20, o = i - k * 20; WL[i] = o < 4 ? a.in[9][k * 4 + o] : a.in[11][k * 16 + (o - 4)]; }
    LAS int* s_e = (LAS int*)(F.lds + 81920); LAS int* s_lr = s_e + 256; LAS int* lcnt = s_lr + 256; LAS int* lbase = lcnt + 16;
    unsigned char* ws = F.ws; const int lane = F.lane;
    int* eid = (int*)(ws + WS_ROUTE + RT_EID); float* wgt = (float*)(ws + WS_ROUTE + RT_WGT); int* rank = (int*)(ws + WS_ROUTE + RT_RANK);
    bf16* H2 = (bf16*)(ws + WS_H2);
    const float* bg = a.in[10]; const float* be = a.in[12];
    __syncthreads();
    for (int blk = F.vcu; blk < NTOK / 128; blk += F.G) {
        if (F.tid < 16) lcnt[F.tid] = 0;
        __syncthreads();
        for (int tl = F.wave; tl < 128; tl += NWAVES) {
            const int tok = blk * 128 + tl;
            const GAS f32x4* xr = (const GAS f32x4*)(F.out + (size_t)tok * DM) + lane; const GAS f32x4* gr = (const GAS f32x4*)a.in[8] + lane;
            f32x4 v[4]; float ss = 0.f;
#pragma unroll
            for (int j = 0; j < 4; ++j) { v[j] = xr[64 * j]; ss += (v[j].x * v[j].x + v[j].y * v[j].y) + (v[j].z * v[j].z + v[j].w * v[j].w); }
            const float rstd = rsqrtf(wave_sum(ss) * (1.f / DM) + EPS);
            GAS v2u* o8 = (GAS v2u*)(H2 + (size_t)tok * DM) + lane;
            float acc[20];
#pragma unroll
            for (int o = 0; o < 20; ++o) acc[o] = 0.f;
#pragma unroll
            for (int j = 0; j < 4; ++j) {
                const f32x4 g = gr[64 * j]; v[j] = v[j] * rstd * g;
                v2u o; o.x = pk2(v[j].x, v[j].y); o.y = pk2(v[j].z, v[j].w); o8[64 * j] = o;
#pragma unroll
                for (int i = 0; i < 4; ++i) {
                    const float hv = v[j][i]; const LAS f32x4* w = (const LAS f32x4*)(WL + (4 * (lane + 64 * j) + i) * 20);
#pragma unroll
                    for (int q = 0; q < 5; ++q) { const f32x4 wv = w[q]; acc[4 * q] += hv * wv.x; acc[4 * q + 1] += hv * wv.y; acc[4 * q + 2] += hv * wv.z; acc[4 * q + 3] += hv * wv.w; }
                }
            }
#pragma unroll
            for (int o = 0; o < 20; ++o) acc[o] = wave_sum(acc[o]);
            float gl[4];
#pragma unroll
            for (int i = 0; i < 4; ++i) gl[i] = acc[i] + bg[i];
            int g = 0; float gm = gl[0];
#pragma unroll
            for (int i = 1; i < 4; ++i) if (gl[i] > gm) { gm = gl[i]; g = i; }
            float se = 0.f;
#pragma unroll
            for (int i = 0; i < 4; ++i) se += __expf(gl[i] - gm);
            const float pg = 1.0f / se;
            float el[4];
#pragma unroll
            for (int i = 0; i < 4; ++i) { const float l0 = acc[4 + i], l1 = acc[8 + i], l2 = acc[12 + i], l3 = acc[16 + i]; el[i] = (g == 0 ? l0 : g == 1 ? l1 : g == 2 ? l2 : l3) + be[4 * g + i]; }
            int i1 = 0; float m1 = el[0];
#pragma unroll
            for (int i = 1; i < 4; ++i) if (el[i] > m1) { m1 = el[i]; i1 = i; }
            int i2 = -1; float m2 = -3.0e38f;
#pragma unroll
            for (int i = 0; i < 4; ++i) if (i != i1 && el[i] > m2) { m2 = el[i]; i2 = i; }
            const float e2 = __expf(m2 - m1), w1 = pg / (1.0f + e2), w2 = pg * e2 / (1.0f + e2);
            if (lane == 0) {
                eid[2 * tok] = 4 * g + i1; eid[2 * tok + 1] = 4 * g + i2; wgt[2 * tok] = w1; wgt[2 * tok + 1] = w2;
                s_e[2 * tl] = 4 * g + i1; s_e[2 * tl + 1] = 4 * g + i2;
            }
        }
        __syncthreads();
        if (F.tid < 256) s_lr[F.tid] = atomicAdd((int*)&lcnt[s_e[F.tid]], 1);
        __syncthreads();
        if (F.tid < 16) lbase[F.tid] = (int)__hip_atomic_fetch_add(F.ctl + CW_CNT + F.tid, (unsigned)lcnt[F.tid], RLX_AGENT);
        __syncthreads();
        if (F.tid < 256) rank[blk * 256 + F.tid] = lbase[s_e[F.tid]] + s_lr[F.tid];
        __syncthreads();
    }
}

DI void expert_table(Frame& F, LAS int* pst) {
    if (F.tid == 0) { int acc = 0; for (int e = 0; e < NEXP; ++e) { pst[e] = acc; const int c = (int)__hip_atomic_load(F.ctl + CW_CNT + e, RLX_AGENT); acc += (c + 255) & ~255; } pst[NEXP] = acc; }
    __syncthreads();
}

DI void ph_gather(Frame& F, const Args& a) {
    LAS int* pst = (LAS int*)(F.lds);
    expert_table(F, pst);
    unsigned char* ws = F.ws; const int lane = F.lane;
    const int* eid = (const int*)(ws + WS_ROUTE + RT_EID); const float* wgt = (const float*)(ws + WS_ROUTE + RT_WGT); const int* rank = (const int*)(ws + WS_ROUTE + RT_RANK);
    int* pos = (int*)(ws + WS_ROUTE + RT_POS); float* wrow = (float*)(ws + WS_ROUTE + RT_WROW); int* tile = (int*)(ws + WS_ROUTE + RT_TILE);
    const bf16* H2 = (const bf16*)(ws + WS_H2); bf16* XB = (bf16*)(ws + WS_XB);
    if (blockIdx.x == 0 && F.tid < NEXP) { const int e = F.tid; for (int rt = pst[e] >> 8; rt < (pst[e + 1] >> 8); ++rt) tile[1 + rt] = e; if (e == 0) tile[0] = pst[NEXP] >> 8; }
    const int gw = F.vcu * NWAVES + F.wave, NGW = F.G * NWAVES;
    for (int tok = gw; tok < NTOK; tok += NGW) {
        const int p0 = pst[eid[2 * tok]] + rank[2 * tok], p1 = pst[eid[2 * tok + 1]] + rank[2 * tok + 1];
        const GAS v4u* src = (const GAS v4u*)(H2 + (size_t)tok * DM) + lane;
        const v4u r0 = src[0], r1 = src[64];
        GAS v4u* d0 = (GAS v4u*)(XB + (size_t)p0 * DM) + lane; GAS v4u* d1 = (GAS v4u*)(XB + (size_t)p1 * DM) + lane;
        d0[0] = r0; d0[64] = r1; d1[0] = r0; d1[64] = r1;
        if (lane == 0) { pos[2 * tok] = p0; pos[2 * tok + 1] = p1; wrow[p0] = wgt[2 * tok]; wrow[p1] = wgt[2 * tok + 1]; }
    }
}

DI void ph_combine(Frame& F, const Args& a) {
    unsigned char* ws = F.ws; const int lane = F.lane;
    const int* pos = (const int*)(ws + WS_ROUTE + RT_POS); const bf16* YB = (const bf16*)(ws + WS_XB); bf16* HP = (bf16*)(ws + WS_H2);
    const int gw = F.vcu * NWAVES + F.wave, NGW = F.G * NWAVES;
    for (int tok = gw; tok < NTOK; tok += NGW) {
        const GAS f32x4* xr = (const GAS f32x4*)(F.out + (size_t)tok * DM) + lane; GAS f32x4* xw = (GAS f32x4*)((float*)(ws + WS_X2) + (size_t)tok * DM) + lane; const GAS f32x4* gr = (const GAS f32x4*)a.in[16] + lane;
        const GAS v2u* y0 = (const GAS v2u*)(YB + (size_t)pos[2 * tok] * DM) + lane; const GAS v2u* y1 = (const GAS v2u*)(YB + (size_t)pos[2 * tok + 1] * DM) + lane;
        f32x4 v[4]; float ss = 0.f;
#pragma unroll
        for (int j = 0; j < 4; ++j) {
            v[j] = xr[64 * j]; const v2u a0 = y0[64 * j], a1 = y1[64 * j];
            v[j].x += bflo(a0.x) + bflo(a1.x); v[j].y += bfhi(a0.x) + bfhi(a1.x); v[j].z += bflo(a0.y) + bflo(a1.y); v[j].w += bfhi(a0.y) + bfhi(a1.y);
            xw[64 * j] = v[j]; ss += (v[j].x * v[j].x + v[j].y * v[j].y) + (v[j].z * v[j].z + v[j].w * v[j].w);
        }
        const float rstd = rsqrtf(wave_sum(ss) * (1.f / DM) + EPS);
        GAS v2u* o8 = (GAS v2u*)(HP + (size_t)tok * DM) + lane;
#pragma unroll
        for (int j = 0; j < 4; ++j) { const f32x4 g = gr[64 * j]; v2u o; o.x = pk2(v[j].x * rstd * g.x, v[j].y * rstd * g.y); o.y = pk2(v[j].z * rstd * g.z, v[j].w * rstd * g.w); o8[64 * j] = o; }
    }
}

DI void ph_final(Frame& F, const Args& a) {
    const int lane = F.lane, gw = F.vcu * NWAVES + F.wave, NGW = F.G * NWAVES;
    for (int tok = gw; tok < NTOK; tok += NGW) {
        GAS f32x4* xr = (GAS f32x4*)(F.out + (size_t)tok * DM) + lane; const GAS f32x4* gr = (const GAS f32x4*)a.in[19] + lane;
        f32x4 v[4]; float ss = 0.f;
#pragma unroll
        for (int j = 0; j < 4; ++j) { v[j] = xr[64 * j]; ss += (v[j].x * v[j].x + v[j].y * v[j].y) + (v[j].z * v[j].z + v[j].w * v[j].w); }
        const float rstd = rsqrtf(wave_sum(ss) * (1.f / DM) + EPS);
#pragma unroll
        for (int j = 0; j < 4; ++j) { const f32x4 g = gr[64 * j]; xr[64 * j] = v[j] * rstd * g; }
    }
}

typedef pg8::f32x4 af4;
DI unsigned cvtpk(float lo, float hi) { typedef float f2 __attribute__((ext_vector_type(2))); typedef __bf16 b2 __attribute__((ext_vector_type(2))); f2 v = {lo, hi}; b2 b = __builtin_convertvector(v, b2); return __builtin_bit_cast(unsigned, b); }
DI v4u pack8(const float (&x)[8]) { v4u w; w.x = cvtpk(x[0], x[1]); w.y = cvtpk(x[2], x[3]); w.z = cvtpk(x[4], x[5]); w.w = cvtpk(x[6], x[7]); return w; }
DI void unpack8(const v4u w, float (&x)[8]) { x[0] = bflo(w.x); x[1] = bfhi(w.x); x[2] = bflo(w.y); x[3] = bfhi(w.y); x[4] = bflo(w.z); x[5] = bfhi(w.z); x[6] = bflo(w.w); x[7] = bfhi(w.w); }

struct EpiProj {
    static constexpr bool PERM = true, AFTER_DRAIN = false;
    bf16* PROJ; const f32x2* tabA;
    DI void operator()(const af4 (&acc)[2][2][4][2], const pg8::Unit& u, int wr, int wc, int fr, int fq) const {
        const int row0 = u.pm * 256 + wr * 64 + fr, colb = u.pn * 256 + wc * 32 + 8 * fq;
        const int kind = u.pn < 2 ? 0 : u.pn < 4 ? 1 : u.pn < 6 ? 2 : u.pn < 8 ? 3 : u.pn < 10 ? 4 : 5;
#pragma unroll
        for (int ai = 0; ai < 2; ++ai)
#pragma unroll
            for (int m = 0; m < 4; ++m) {
                const int row = row0 + ai * 128 + m * 16;
#pragma unroll
                for (int bj = 0; bj < 2; ++bj) {
                    const int col = colb + bj * 128;
                    const af4 a0 = acc[ai][bj][m][0], a1 = acc[ai][bj][m][1];
                    float x[8] = {a0[0], a0[1], a0[2], a0[3], a1[0], a1[1], a1[2], a1[3]};
                    if (kind <= 1) {
                        const int pos = row & (SEQ - 1), p = (col & 127) >> 1;
                        const f32x4* tp = (const f32x4*)(tabA + pos * 64 + p);
                        const f32x4 t0 = tp[0], t1 = tp[1];
                        const float sc = kind == 1 ? 0.08838834764831845f : 1.0f;
                        float y[8];
                        y[0] = (x[0] * t0.x - x[1] * t0.y) * sc; y[1] = (x[0] * t0.y + x[1] * t0.x) * sc;
                        y[2] = (x[2] * t0.z - x[3] * t0.w) * sc; y[3] = (x[2] * t0.w + x[3] * t0.z) * sc;
                        y[4] = (x[4] * t1.x - x[5] * t1.y) * sc; y[5] = (x[4] * t1.y + x[5] * t1.x) * sc;
                        y[6] = (x[6] * t1.z - x[7] * t1.w) * sc; y[7] = (x[6] * t1.w + x[7] * t1.z) * sc;
#pragma unroll
                        for (int i = 0; i < 8; ++i) x[i] = y[i];
                    } else if (kind == 2) {
#pragma unroll
                        for (int i = 0; i < 8; ++i) x[i] = fsilu(x[i]);
                    } else if (kind == 3) {
#pragma unroll
                        for (int i = 0; i < 8; ++i) x[i] *= SB_QSCALE;
                    } else if (kind == 5) {
#pragma unroll
                        for (int i = 0; i < 8; ++i) x[i] = fsigmoid(x[i]);
                    }
                    *(v4u*)(PROJ + (size_t)row * NMAIN + col) = pack8(x);
                }
            }
    }
};
struct EpiProjT {
    static constexpr bool PERM = true, AFTER_DRAIN = false;
    bf16* T; const f32x2* tabB;
    DI void operator()(const af4 (&acc)[2][2][4][2], const pg8::Unit& u, int wr, int wc, int fr, int fq) const {
        const int f0 = u.pm * 256 + wr * 64 + fr, tokb = u.pn * 256 + wc * 32 + 8 * fq;
        const bool isk = u.pm < 2;
#pragma unroll
        for (int ai = 0; ai < 2; ++ai)
#pragma unroll
            for (int m = 0; m < 4; ++m) {
                const int f = f0 + ai * 128 + m * 16;
#pragma unroll
                for (int bj = 0; bj < 2; ++bj) {
                    const int tok = tokb + bj * 128;
                    const af4 a0 = acc[ai][bj][m][0], a1 = acc[ai][bj][m][1];
                    float x[8] = {a0[0], a0[1], a0[2], a0[3], a1[0], a1[1], a1[2], a1[3]};
                    if (isk) {
                        const int pos = tok & (SEQ - 1), h = f >> 7, p = (f & 127) >> 1;
                        const f32x4* tp = (const f32x4*)(tabB + p * SEQ + pos);
                        const f32x4 t0 = tp[0], t1 = tp[1], t2 = tp[2], t3 = tp[3];
                        const float cs[8] = {t0.x, t0.z, t1.x, t1.z, t2.x, t2.z, t3.x, t3.z}, sn[8] = {t0.y, t0.w, t1.y, t1.w, t2.y, t2.w, t3.y, t3.w};
                        const float l2g = ret_log2g(h); const float ginv = exp2f(-l2g);
                        float sc = 0.08838834764831845f * exp2f(l2g * (float)(63 - (pos & 63)));
                        const bool odd = (f & 1) != 0;
                        float y[8];
#pragma unroll
                        for (int i = 0; i < 8; ++i) {
                            const float other = __shfl_xor(x[i], 1);
                            const float r = odd ? (other * sn[i] + x[i] * cs[i]) : (x[i] * cs[i] - other * sn[i]);
                            y[i] = r * sc; sc *= ginv;
                        }
#pragma unroll
                        for (int i = 0; i < 8; ++i) x[i] = y[i];
                    }
                    *(v4u*)(T + (size_t)f * NTOK + tok) = pack8(x);
                }
            }
    }
};

struct EpiBr {
    static constexpr bool PERM = true, AFTER_DRAIN = false;
    bf16* PROJ; int step;
    DI void operator()(const af4 (&acc)[2][2][4][2], const pg8::Unit& u, int wr, int wc, int fr, int fq) const {
        const int row0 = u.pm * 256 + wr * 64 + fr, colb = u.pn * 256 + wc * 32 + 8 * fq;
#pragma unroll
        for (int ai = 0; ai < 2; ++ai)
#pragma unroll
            for (int m = 0; m < 4; ++m) {
                bf16* pr = PROJ + (size_t)(row0 + ai * 128 + m * 16) * NMAIN;
#pragma unroll
                for (int bj = 0; bj < 2; ++bj) {
                    const int col = colb + bj * 128;
                    const af4 a0 = acc[ai][bj][m][0], a1 = acc[ai][bj][m][1];
                    float g[8], x[8] = {a0[0], a0[1], a0[2], a0[3], a1[0], a1[1], a1[2], a1[3]};
                    unpack8(*(const v4u*)(pr + (step ? C_GS : C_GR) + col), g);
#pragma unroll
                    for (int i = 0; i < 8; ++i) x[i] *= g[i];
                    if (step) { float t1[8]; unpack8(*(const v4u*)(pr + C_MG + col), t1);
#pragma unroll
                        for (int i = 0; i < 8; ++i) x[i] += t1[i]; }
                    *(v4u*)(pr + C_MG + col) = pack8(x);
                }
            }
    }
};
struct EpiWout {
    static constexpr bool PERM = true, AFTER_DRAIN = false;
    const float* x; float* out;
    DI void operator()(const af4 (&acc)[2][2][4][2], const pg8::Unit& u, int wr, int wc, int fr, int fq) const {
        const int row0 = u.pm * 256 + wr * 64 + fr, colb = u.pn * 256 + wc * 32 + 8 * fq;
#pragma unroll
        for (int ai = 0; ai < 2; ++ai)
#pragma unroll
            for (int m = 0; m < 4; ++m) {
                const size_t ro = (size_t)(row0 + ai * 128 + m * 16) * DM;
#pragma unroll
                for (int bj = 0; bj < 2; ++bj) {
                    const size_t o = ro + colb + bj * 128;
                    const af4 x0 = *(const af4*)(x + o), x1 = *(const af4*)(x + o + 4);
                    *(af4*)(out + o) = x0 + acc[ai][bj][m][0]; *(af4*)(out + o + 4) = x1 + acc[ai][bj][m][1];
                }
            }
    }
};
struct EpiGu {
    static constexpr bool PERM = true, AFTER_DRAIN = false;
    bf16* HID;
    DI void operator()(const af4 (&acc)[2][2][4][2], const pg8::Unit& u, int wr, int wc, int fr, int fq) const {
        const int row0 = u.pm * 256 + wr * 64 + fr, col = u.pn * 128 + wc * 32 + 8 * fq;
#pragma unroll
        for (int ai = 0; ai < 2; ++ai)
#pragma unroll
            for (int m = 0; m < 4; ++m) {
                const af4 g0 = acc[ai][0][m][0], g1 = acc[ai][0][m][1], u0 = acc[ai][1][m][0], u1 = acc[ai][1][m][1];
                float x[8];
#pragma unroll
                for (int i = 0; i < 4; ++i) { x[i] = fsilu(g0[i]) * u0[i]; x[4 + i] = fsilu(g1[i]) * u1[i]; }
                *(v4u*)(HID + (size_t)(row0 + ai * 128 + m * 16) * DEXP + col) = pack8(x);
            }
    }
};
struct EpiDown {
    static constexpr bool PERM = true, AFTER_DRAIN = false;
    bf16* YB; const float* wrow;
    DI void operator()(const af4 (&acc)[2][2][4][2], const pg8::Unit& u, int wr, int wc, int fr, int fq) const {
        const int row0 = u.pm * 256 + wr * 64 + fr, colb = u.pn * 256 + wc * 32 + 8 * fq;
#pragma unroll
        for (int ai = 0; ai < 2; ++ai)
#pragma unroll
            for (int m = 0; m < 4; ++m) {
                const int row = row0 + ai * 128 + m * 16; const float w = wrow[row];
#pragma unroll
                for (int bj = 0; bj < 2; ++bj) {
                    const af4 a0 = acc[ai][bj][m][0] * w, a1 = acc[ai][bj][m][1] * w;
                    const float x[8] = {a0[0], a0[1], a0[2], a0[3], a1[0], a1[1], a1[2], a1[3]};
                    *(v4u*)(YB + (size_t)row * DM + colb + bj * 128) = pack8(x);
                }
            }
    }
};
struct EpiPe {
    static constexpr bool PERM = true, AFTER_DRAIN = false;
    bf16* PE;
    DI void operator()(const af4 (&acc)[2][2][4][2], const pg8::Unit& u, int wr, int wc, int fr, int fq) const {
        const int row0 = u.pm * 256 + wr * 64 + fr, colb = u.pn * 256 + wc * 32 + 8 * fq;
#pragma unroll
        for (int ai = 0; ai < 2; ++ai)
#pragma unroll
            for (int m = 0; m < 4; ++m)
#pragma unroll
                for (int bj = 0; bj < 2; ++bj) {
                    const af4 a0 = acc[ai][bj][m][0], a1 = acc[ai][bj][m][1];
                    const float x[8] = {a0[0], a0[1], a0[2], a0[3], a1[0], a1[1], a1[2], a1[3]};
                    *(v4u*)(PE + (size_t)(row0 + ai * 128 + m * 16) * DM + colb + bj * 128) = pack8(x);
                }
    }
};
struct EpiPg {
    static constexpr bool PERM = true, AFTER_DRAIN = false;
    const bf16* PE; const float* x2; float* out;
    DI void operator()(const af4 (&acc)[2][2][4][2], const pg8::Unit& u, int wr, int wc, int fr, int fq) const {
        const int row0 = u.pm * 256 + wr * 64 + fr, colb = u.pn * 256 + wc * 32 + 8 * fq;
#pragma unroll
        for (int ai = 0; ai < 2; ++ai)
#pragma unroll
            for (int m = 0; m < 4; ++m) {
                const size_t ro = (size_t)(row0 + ai * 128 + m * 16) * DM;
#pragma unroll
                for (int bj = 0; bj < 2; ++bj) {
                    const size_t o = ro + colb + bj * 128;
                    float pe[8]; unpack8(*(const v4u*)(PE + o), pe);
                    const af4 a0 = acc[ai][bj][m][0], a1 = acc[ai][bj][m][1];
                    af4 x0 = *(const af4*)(x2 + o), x1 = *(const af4*)(x2 + o + 4);
#pragma unroll
                    for (int i = 0; i < 4; ++i) { x0[i] += fsigmoid(a0[i]) * pe[i]; x1[i] += fsigmoid(a1[i]) * pe[4 + i]; }
                    *(af4*)(out + o) = x0; *(af4*)(out + o + 4) = x1;
                }
                asm volatile("" ::: "memory");
            }
    }
};

struct MoeOrder {
    const LAS int* pst; int G, c; size_t estride, tstepB;
    DI bool next(int i, pg8::Unit& u) const {
        const int L = i * G + c, rt = L >> 2; if (rt * 256 >= pst[NEXP]) return false;
        int ex = 0;
#pragma unroll
        for (int e = 1; e < NEXP; ++e) ex += (rt * 256 >= pst[e]) ? 1 : 0;
        u.pm = rt; u.pn = L & 3; u.ex = ex; u.bofs = (size_t)ex * estride + (size_t)u.pn * tstepB; return true;
    }
    DI void a_ready(const pg8::Unit&) const {}
    DI void done(const pg8::Unit&) const {}
};

#define GEMM_PHASE(EPI, ORD, g, S, E) pg8::gemm_phase<EPI, ORD, true, true>(F.lds + RING_OFF, g, S, E)

DI void fast_proj(Frame& F, const Args& a) {
    unsigned char* ws = F.ws; const bf16* HB = (const bf16*)((unsigned char*)F.out + DO_HB); const bf16* WIN = (const bf16*)(ws + WS_WIN);
    { pg8::Gemm g{HB, WIN, DM, DM}; pg8::StaticOrder S; S.init(NTOK, NMAIN, DM, F.G, (int)blockIdx.x);
      EpiProj E{(bf16*)(ws + WS_PROJ), (const f32x2*)(ws + WS_TABA)}; GEMM_PHASE(EpiProj, pg8::StaticOrder, g, S, E); }
    { pg8::Gemm g{WIN + (size_t)NMAIN * DM, HB, DM, DM}; pg8::StaticOrder S; S.init(NTR, NTOK, DM, F.G, (int)blockIdx.x);
      EpiProjT E{(bf16*)(ws + WS_T), (const f32x2*)(ws + WS_TABB)}; GEMM_PHASE(EpiProjT, pg8::StaticOrder, g, S, E); }
}
DI void fast_br(Frame& F, const Args& a) {
    unsigned char* ws = F.ws; bf16* PROJ = (bf16*)(ws + WS_PROJ); const bf16* RS = (const bf16*)((unsigned char*)F.out + DO_RS);
    pg8::StaticOrder S; S.init(NTOK, DM, 512, F.G, (int)blockIdx.x);
    { pg8::Gemm g{RS, (const bf16*)(ws + WS_WBR1), DM, 512}; EpiBr E{PROJ, 0}; GEMM_PHASE(EpiBr, pg8::StaticOrder, g, S, E); }
    { pg8::Gemm g{RS + 512, (const bf16*)(ws + WS_WBR2), DM, 512}; EpiBr E{PROJ, 1}; GEMM_PHASE(EpiBr, pg8::StaticOrder, g, S, E); }
}
DI void fast_wout(Frame& F, const Args& a) {
    unsigned char* ws = F.ws;
    pg8::Gemm g{(const bf16*)(ws + WS_PROJ) + C_MG, (const bf16*)(ws + WS_WOUT), NMAIN, DM}; pg8::StaticOrder S; S.init(NTOK, DM, DM, F.G, (int)blockIdx.x);
    EpiWout E{F.x, F.out}; GEMM_PHASE(EpiWout, pg8::StaticOrder, g, S, E);
}
DI void fast_gu(Frame& F, const Args& a) {
    LAS int* pst = (LAS int*)(F.lds + LDSCTL_OFF);
    expert_table(F, pst);
    unsigned char* ws = F.ws;
    pg8::Gemm g{(const bf16*)(ws + WS_XB), (const bf16*)(ws + WS_WGU), DM, DM};
    MoeOrder S{pst, F.G, F.vcu, (size_t)1024 * 1024 * 2, (size_t)256 * DM * 2};
    EpiGu E{(bf16*)(ws + WS_HID)}; GEMM_PHASE(EpiGu, MoeOrder, g, S, E);
}
DI void fast_down(Frame& F, const Args& a) {
    LAS int* pst = (LAS int*)(F.lds + LDSCTL_OFF);
    expert_table(F, pst);
    unsigned char* ws = F.ws;
    pg8::Gemm g{(const bf16*)(ws + WS_HID), (const bf16*)(ws + WS_WD), DEXP, DEXP};
    MoeOrder S{pst, F.G, F.vcu, (size_t)1024 * 512 * 2, (size_t)256 * DEXP * 2};
    EpiDown E{(bf16*)(ws + WS_XB), (const float*)(ws + WS_ROUTE + RT_WROW)}; GEMM_PHASE(EpiDown, MoeOrder, g, S, E);
}
DI void fast_ple(Frame& F, const Args& a) {
    unsigned char* ws = F.ws;
    { int k256 = 256; asm volatile("" : "+s"(k256));
      pg8::Gemm g{(const bf16*)(ws + WS_PB), (const bf16*)(ws + WS_WPLE), 256, k256}; pg8::StaticOrder S; S.init(NTOK, DM, k256, F.G, (int)blockIdx.x);
      EpiPe E{(bf16*)(ws + WS_HID)}; GEMM_PHASE(EpiPe, pg8::StaticOrder, g, S, E); }
    { pg8::Gemm g{(const bf16*)(ws + WS_H2), (const bf16*)(ws + WS_WPG), DM, DM}; pg8::StaticOrder S; S.init(NTOK, DM, DM, F.G, (int)blockIdx.x);
      EpiPg E{(const bf16*)(ws + WS_HID), (const float*)(ws + WS_X2), F.out}; GEMM_PHASE(EpiPg, pg8::StaticOrder, g, S, E); }
}

#define MFMA32(a, b, c) __builtin_amdgcn_mfma_f32_32x32x16_bf16((a), (b), (c), 0, 0, 0)
DI int crow(int reg, int h) { return (reg & 3) + 8 * (reg >> 2) + 4 * h; }
DI bf16x8 ld16(const bf16* p) { return *(const bf16x8*)p; }
DI bf16x8 ld8x2(const bf16* p0, const bf16* p1) { const s16x4 lo = *(const s16x4*)p0, hi = *(const s16x4*)p1; return __builtin_shufflevector(lo, hi, 0, 1, 2, 3, 4, 5, 6, 7); }
template <int S> DI bf16x8 pack_step(const f32x16& x) { v4u p; p.x = cvtpk(x[8 * S], x[8 * S + 1]); p.y = cvtpk(x[8 * S + 2], x[8 * S + 3]); p.z = cvtpk(x[8 * S + 4], x[8 * S + 5]); p.w = cvtpk(x[8 * S + 6], x[8 * S + 7]); return __builtin_bit_cast(bf16x8, p); }
DI f32x16 splat16(float v) { f32x16 x;
#pragma unroll
    for (int i = 0; i < 16; ++i) x[i] = v; return x; }

DI void fast_ret_kv(Frame& F, const Args& a) {
    const bf16* T = (const bf16*)(F.ws + WS_T); bf16* ST = (bf16*)((unsigned char*)F.out + DO_ST);
    const int lane = F.lane, r = lane & 31, h2 = lane >> 5, gw = F.vcu * NWAVES + F.wave, NGW = F.G * NWAVES;
    for (int it = gw; it < NBATCH * 4 * 64 * 4; it += NGW) {
        const int eb = it & 3, c = (it >> 2) & 63, hh = (it >> 8) & 3, b = it >> 10;
        const int tok0 = b * SEQ + c * 64;
        const bf16* vrow = T + (size_t)(T_VR + hh * 128 + eb * 32 + r) * NTOK + tok0 + 8 * h2;
        bf16x8 vb[4];
#pragma unroll
        for (int ks = 0; ks < 4; ++ks) vb[ks] = ld16(vrow + 16 * ks);
        bf16* st = ST + ((size_t)((b * 4 + hh) * 64 + c)) * 16384 + (size_t)(eb * 32 + r) * 128 + 4 * h2;
#pragma unroll
        for (int db = 0; db < 4; ++db) {
            const bf16* krow = T + (size_t)(T_KT + hh * 128 + db * 32 + r) * NTOK + tok0 + 8 * h2;
            f32x16 acc = splat16(0.f);
#pragma unroll
            for (int ks = 0; ks < 4; ++ks) acc = MFMA32(ld16(krow + 16 * ks), vb[ks], acc);
#pragma unroll
            for (int g = 0; g < 4; ++g) { v2u w; w.x = cvtpk(acc[4 * g], acc[4 * g + 1]); w.y = cvtpk(acc[4 * g + 2], acc[4 * g + 3]); *(v2u*)(st + db * 32 + 8 * g) = w; }
        }
    }
}
DI void fast_ret_scan(Frame& F, const Args& a) {
    bf16* ST = (bf16*)((unsigned char*)F.out + DO_ST);
    for (int g = F.vcu * 512 + F.tid; g < NBATCH * 4 * 4096; g += F.G * 512) {
        const int bh = g >> 12, idx = (g & 4095) * 4;
        const float cdec = exp2f(ret_log2g(bh & 3) * 64.0f);
        bf16* p = ST + (size_t)bh * 64 * 16384 + idx;
        float s0 = 0.f, s1 = 0.f, s2 = 0.f, s3 = 0.f;
#pragma unroll 8
        for (int c = 0; c < 64; ++c) {
            const v2u w = *(const v2u*)(p + (size_t)c * 16384);
            v2u o; o.x = cvtpk(s0, s1); o.y = cvtpk(s2, s3); *(v2u*)(p + (size_t)c * 16384) = o;
            s0 = cdec * s0 + bflo(w.x); s1 = cdec * s1 + bfhi(w.x); s2 = cdec * s2 + bflo(w.y); s3 = cdec * s3 + bfhi(w.y);
        }
    }
}
DI void fast_ret_out(Frame& F, const Args& a) {
    const bf16* PROJ = (const bf16*)(F.ws + WS_PROJ); const bf16* T = (const bf16*)(F.ws + WS_T); const bf16* ST = (const bf16*)((unsigned char*)F.out + DO_ST); bf16* RS = (bf16*)((unsigned char*)F.out + DO_RS);
    const float* gn = a.in[4];
    const int lane = F.lane, r = lane & 31, h2 = lane >> 5, gw = F.vcu * NWAVES + F.wave, NGW = F.G * NWAVES;
    for (int it = gw; it < NBATCH * 4 * 64 * 2; it += NGW) {
        const int ib = it & 1, c = (it >> 1) & 63, hh = (it >> 7) & 3, b = it >> 9;
        const int tok0 = b * SEQ + c * 64;
        const float l2g = ret_log2g(hh);
        const bf16* qrow = PROJ + (size_t)(tok0 + ib * 32 + r) * NMAIN + C_RQ + hh * 128 + 8 * h2;
        bf16x8 qf[8];
#pragma unroll
        for (int ks = 0; ks < 8; ++ks) qf[ks] = ld16(qrow + 16 * ks);
        bf16x8 pb[2][2];
#pragma unroll
        for (int jb = 0; jb < 2; ++jb) {
            const bf16* krow = PROJ + (size_t)(tok0 + jb * 32 + r) * NMAIN + C_RK + hh * 128 + 8 * h2;
            f32x16 pt = splat16(0.f);
#pragma unroll
            for (int ks = 0; ks < 8; ++ks) pt = MFMA32(ld16(krow + 16 * ks), qf[ks], pt);
#pragma unroll
            for (int reg = 0; reg < 16; ++reg) { const int dist = (ib * 32 + r) - (jb * 32 + crow(reg, h2)); pt[reg] *= __builtin_amdgcn_exp2f(l2g * (float)(dist < 0 ? -dist : dist)); }
            pb[jb][0] = pack_step<0>(pt); pb[jb][1] = pack_step<1>(pt);
        }
        const float qd = __builtin_amdgcn_exp2f(l2g * (float)(ib * 32 + r + 1));
        const bf16* stb = ST + ((size_t)((b * 4 + hh) * 64 + c)) * 16384 + (size_t)r * 128 + 8 * h2;
        f32x16 o[4];
#pragma unroll
        for (int eb = 0; eb < 4; ++eb) {
            f32x16 acc = splat16(0.f);
            const bf16* srow = stb + (size_t)eb * 32 * 128;
#pragma unroll
            for (int ks = 0; ks < 8; ++ks) acc = MFMA32(ld16(srow + 16 * ks), qf[ks], acc);
#pragma unroll
            for (int reg = 0; reg < 16; ++reg) acc[reg] *= qd;
            const bf16* vrow = T + (size_t)(T_VR + hh * 128 + eb * 32 + r) * NTOK + tok0 + 4 * h2;
#pragma unroll
            for (int jb = 0; jb < 2; ++jb) {
                acc = MFMA32(ld8x2(vrow + jb * 32, vrow + jb * 32 + 8), pb[jb][0], acc);
                acc = MFMA32(ld8x2(vrow + jb * 32 + 16, vrow + jb * 32 + 24), pb[jb][1], acc);
            }
            o[eb] = acc;
        }
        float s = 0.f;
#pragma unroll
        for (int eb = 0; eb < 4; ++eb)
#pragma unroll
            for (int reg = 0; reg < 16; ++reg) s += o[eb][reg];
        s += __shfl_xor(s, 32);
        const float mu = s * (1.0f / 128.0f); float v = 0.f;
#pragma unroll
        for (int eb = 0; eb < 4; ++eb)
#pragma unroll
            for (int reg = 0; reg < 16; ++reg) { const float d = o[eb][reg] - mu; v += d * d; }
        v += __shfl_xor(v, 32);
        const float rstd = rsqrtf(v * (1.0f / 128.0f) + EPS);
        const bf16* gp = PROJ + (size_t)(tok0 + ib * 32 + r) * NMAIN + C_RG + hh * 128 + 4 * h2;
        bf16* rp = RS + (size_t)(tok0 + ib * 32 + r) * DM + hh * 128 + 4 * h2;
        const float* gnp = gn + hh * 128 + 4 * h2;
#pragma unroll
        for (int eb = 0; eb < 4; ++eb)
#pragma unroll
            for (int g = 0; g < 4; ++g) {
                const int e = eb * 32 + 8 * g;
                const v2u gate = *(const v2u*)(gp + e); const f32x4 gain = *(const f32x4*)(gnp + e);
                v2u w;
                w.x = cvtpk((o[eb][4 * g] - mu) * rstd * gain.x * bflo(gate.x), (o[eb][4 * g + 1] - mu) * rstd * gain.y * bfhi(gate.x));
                w.y = cvtpk((o[eb][4 * g + 2] - mu) * rstd * gain.z * bflo(gate.y), (o[eb][4 * g + 3] - mu) * rstd * gain.w * bfhi(gate.y));
                *(v2u*)(rp + e) = w;
            }
    }
}

DI void fast_att(Frame& F, const Args& a) {
    const bf16* PROJ = (const bf16*)(F.ws + WS_PROJ); const bf16* T = (const bf16*)(F.ws + WS_T); bf16* RS = (bf16*)((unsigned char*)F.out + DO_RS);
    const int lane = F.lane, r = lane & 31, h2 = lane >> 5, gw = F.vcu * NWAVES + F.wave, NGW = F.G * NWAVES;
    bf16x8 tri0, tri1, ones;
#pragma unroll
    for (int j = 0; j < 8; ++j) { const int k0 = 8 * (j >> 2) + 4 * h2 + (j & 3); tri0[j] = (k0 > r) ? (short)0x3F80 : (short)0; tri1[j] = (16 + k0 > r) ? (short)0x3F80 : (short)0; ones[j] = (short)0x3F80; }
    for (int it = gw; it < NBATCH * 8 * 128; it += NGW) {
        const int qb = it & 127, hh = (it >> 7) & 7, b = it >> 10;
        const int q0 = qb * 32, tokq = b * SEQ + q0 + r;
        const bf16* qrow = PROJ + (size_t)tokq * NMAIN + C_SQ + hh * 64 + 8 * h2;
        bf16x8 qf[4];
#pragma unroll
        for (int ks = 0; ks < 4; ++ks) qf[ks] = ld16(qrow + 16 * ks);
        f32x16 o0 = splat16(0.f), o1 = splat16(0.f);
        float carry = 0.f;
        const int ktd = q0 >> 6;
        for (int kt = ktd; kt >= 0; --kt) {
            const int key0 = kt * 64, tokk = b * SEQ + key0;
            const bool diag = (kt == ktd);
            f32x16 p0 = splat16(0.f), p1 = splat16(0.f);
            {
                const bf16* k0row = PROJ + (size_t)(tokk + r) * NMAIN + C_SK + hh * 64 + 8 * h2;
                const bf16* k1row = k0row + (size_t)32 * NMAIN;
#pragma unroll
                for (int ks = 0; ks < 4; ++ks) { p0 = MFMA32(ld16(k0row + 16 * ks), qf[ks], p0); p1 = MFMA32(ld16(k1row + 16 * ks), qf[ks], p1); }
            }
            f32x16 l0, l1;
#pragma unroll
            for (int reg = 0; reg < 16; ++reg) {
                const float z0 = fminf(p0[reg], 100.0f), z1 = fminf(p1[reg], 100.0f);
                float a0 = -__builtin_amdgcn_logf(1.0f + __builtin_amdgcn_exp2f(z0)), a1 = -__builtin_amdgcn_logf(1.0f + __builtin_amdgcn_exp2f(z1));
                float b0 = z0 + a0, b1 = z1 + a1;
                if (diag) {
                    const bool v0 = (key0 + crow(reg, h2)) < (q0 + r), v1 = (key0 + 32 + crow(reg, h2)) < (q0 + r);
                    a0 = v0 ? a0 : 0.f; b0 = v0 ? b0 : -1.0e30f; a1 = v1 ? a1 : 0.f; b1 = v1 ? b1 : -1.0e30f;
                }
                l0[reg] = a0; l1[reg] = a1; p0[reg] = b0; p1[reg] = b1;
            }
            f32x16 y0 = splat16(carry), y1 = y0;
            {
                const bf16x8 x00 = pack_step<0>(l0), x01 = pack_step<1>(l0), x10 = pack_step<0>(l1), x11 = pack_step<1>(l1);
                y0 = MFMA32(tri0, x00, y0); y0 = MFMA32(tri1, x01, y0); y0 = MFMA32(ones, x10, y0); y0 = MFMA32(ones, x11, y0);
                y1 = MFMA32(tri0, x10, y1); y1 = MFMA32(tri1, x11, y1);
            }
            const float tot = y0[0] + l0[0];
            carry = __shfl(tot, r);
#pragma unroll
            for (int reg = 0; reg < 16; ++reg) { p0[reg] = __builtin_amdgcn_exp2f(p0[reg] + y0[reg]); p1[reg] = __builtin_amdgcn_exp2f(p1[reg] + y1[reg]); }
            {
                const bf16x8 a00 = pack_step<0>(p0), a01 = pack_step<1>(p0), a10 = pack_step<0>(p1), a11 = pack_step<1>(p1);
                const bf16* v0row = T + (size_t)(T_VS + hh * 64 + r) * NTOK + tokk + 4 * h2;
                const bf16* v1row = v0row + (size_t)32 * NTOK;
                o0 = MFMA32(ld8x2(v0row, v0row + 8), a00, o0); o0 = MFMA32(ld8x2(v0row + 16, v0row + 24), a01, o0);
                o0 = MFMA32(ld8x2(v0row + 32, v0row + 40), a10, o0); o0 = MFMA32(ld8x2(v0row + 48, v0row + 56), a11, o0);
                o1 = MFMA32(ld8x2(v1row, v1row + 8), a00, o1); o1 = MFMA32(ld8x2(v1row + 16, v1row + 24), a01, o1);
                o1 = MFMA32(ld8x2(v1row + 32, v1row + 40), a10, o1); o1 = MFMA32(ld8x2(v1row + 48, v1row + 56), a11, o1);
            }
            if (__all(carry < SB_EXIT)) break;
        }
        bf16* op = RS + (size_t)tokq * DM + 512 + hh * 64 + 4 * h2;
#pragma unroll
        for (int g = 0; g < 4; ++g) {
            v2u w; w.x = cvtpk(o0[4 * g], o0[4 * g + 1]); w.y = cvtpk(o0[4 * g + 2], o0[4 * g + 3]); *(v2u*)(op + 8 * g) = w;
            v2u u; u.x = cvtpk(o1[4 * g], o1[4 * g + 1]); u.y = cvtpk(o1[4 * g + 2], o1[4 * g + 3]); *(v2u*)(op + 32 + 8 * g) = u;
        }
    }
}

__global__ void __launch_bounds__(NWAVES * 64, 2) mega(Args args) {
    extern __shared__ __attribute__((aligned(16))) unsigned char lds[];
    Frame F;
    F.lds = (LAS unsigned char*)lds;
    F.MISC = (volatile LAS unsigned*)(F.lds + MISC_OFF);
    F.refresh();
    F.G = gridDim.x; { const int bx = blockIdx.x; F.vcu = (F.G % 8 == 0) ? (bx % 8) * (F.G / 8) + bx / 8 : bx; }
    F.ws = args.ws; F.out = args.out; F.x = args.in[0]; F.p = args.in[1];
    F.ctl = (gu32*)(args.ws + WS_CTL);
    for (int u = F.tid; u < (LDS_BYTES - LDSCTL_OFF) / 4; u += NWAVES * 64) ((LAS unsigned*)(F.lds + LDSCTL_OFF))[u] = 0u;
    __syncthreads();
    const int lo = args.ph_lo, hi = args.ph_hi;
    XcdBarrier bar; bar.bar = (unsigned*)(F.ctl + CW_BAR) + args.li * BAR_STRIDE; bar.x = 0; bar.st = nullptr;
    if (hi - lo > 1) bar = xcd_barrier_post((unsigned*)(F.ctl + CW_BAR) + args.li * BAR_STRIDE, F.MISC + 8);
#define IN(k) (F.refresh(), lo <= (k) && (k) < hi)
#define DUP(k) ((DUP_MASK >> (k)) & 1)
#define SEAM(k) do { if (IN(k) && IN((k) + 1)) xcd_barrier(bar); } while (0)
#define REP(k, body) do { body; if (DUP(k)) { F.refresh(); body; } } while (0)

    if (IN(PH_PRO)) { REP(PH_PRO, ph_prologue(F, args)); } SEAM(PH_PRO);
    if (IN(PH_PROJ)) { REP(PH_PROJ, fast_proj(F, args)); } SEAM(PH_PROJ);
    if (IN(PH_MIX1)) { REP(14, fast_ret_kv(F, args)); REP(15, fast_att(F, args)); } SEAM(PH_MIX1);
    if (IN(PH_SCAN)) { fast_ret_scan(F, args); } SEAM(PH_SCAN);
    if (IN(PH_RETO)) { REP(PH_RETO, fast_ret_out(F, args)); } SEAM(PH_RETO);
    if (IN(PH_BR)) { REP(PH_BR, fast_br(F, args)); } SEAM(PH_BR);
    if (IN(PH_WOUT)) { REP(PH_WOUT, fast_wout(F, args)); } SEAM(PH_WOUT);
    if (IN(PH_ROUTE)) { ph_route(F, args); } SEAM(PH_ROUTE);
    if (IN(PH_GATHER)) { REP(PH_GATHER, ph_gather(F, args)); } SEAM(PH_GATHER);
    if (IN(PH_GU)) { REP(PH_GU, fast_gu(F, args)); } SEAM(PH_GU);
    if (IN(PH_DOWN)) { REP(PH_DOWN, fast_down(F, args)); } SEAM(PH_DOWN);
    if (IN(PH_COMB)) { REP(PH_COMB, ph_combine(F, args)); } SEAM(PH_COMB);
    if (IN(PH_PLE)) { REP(PH_PLE, fast_ple(F, args)); } SEAM(PH_PLE);
    if (IN(PH_FINAL)) { ph_final(F, args); }
#undef IN
#undef SEAM
}

extern "C" void kernel_launch(void* const* d_in, const int* in_sizes, int n_in, void* d_out, int out_size, void* d_ws, size_t ws_size, hipStream_t stream) {
    static int grid = 0;
    if (grid == 0) {
        if (n_in != 20 || in_sizes[0] != NTOK * DM || out_size != NTOK * DM || ws_size < WS_END) { fprintf(stderr, "kernel_launch: unexpected shapes (n_in %d, in0 %d, out %d, ws %zu)\n", n_in, n_in > 0 ? in_sizes[0] : -1, out_size, ws_size); grid = -1; return; }
        int dev = 0, cus = 0, per_cu = 0;
        if (hipGetDevice(&dev) != hipSuccess || hipDeviceGetAttribute(&cus, hipDeviceAttributeMultiprocessorCount, dev) != hipSuccess) { grid = -1; return; }
        if (hipFuncSetAttribute((const void*)mega, hipFuncAttributeMaxDynamicSharedMemorySize, LDS_BYTES) != hipSuccess) { fprintf(stderr, "kernel_launch: hipFuncSetAttribute failed\n"); grid = -1; return; }
        if (hipOccupancyMaxActiveBlocksPerMultiprocessor(&per_cu, (const void*)mega, NWAVES * 64, LDS_BYTES) != hipSuccess || per_cu < 1) fprintf(stderr, "kernel_launch: occupancy query reports %d\n", per_cu);
        (void)hipGetLastError();
        grid = cus;
    }
    if (grid < 0) return;
    unsigned char* ws = (unsigned char*)d_ws;
    if (hipMemsetAsync(ws + WS_CTL, 0, CTL_ZERO_BYTES, stream) != hipSuccess) return;
    Args a{};
    for (int i = 0; i < 20; ++i) a.in[i] = (const float*)d_in[i];
    a.out = (float*)d_out; a.ws = ws;
#if SPLIT_PHASES
    for (int p = 0; p < NPH; ++p) { a.ph_lo = p; a.ph_hi = p + 1; a.li = 0; hipLaunchKernelGGL(mega, dim3(grid), dim3(NWAVES * 64), LDS_BYTES, stream, a); }
#else
    a.ph_lo = 0; a.ph_hi = NPH; a.li = 0;
    hipLaunchKernelGGL(mega, dim3(grid), dim3(NWAVES * 64), LDS_BYTES, stream, a);
#endif
}
```

```cpp
#define DUP_MASK 0
#include <hip/hip_runtime.h>
#include <cstdio>
#include <cstdint>

#ifndef SPLIT_PHASES
#define SPLIT_PHASES 0
#endif
#ifndef DUP_MASK
#define DUP_MASK 0
#endif

constexpr int NTOK = 32768, DM = 1024, SEQ = 4096, NBATCH = 8;
constexpr int NMAIN = 4608, NTR = 1536, NWIN = 5632;
constexpr int C_RQ = 0, C_RK = 512, C_RG = 1024, C_SQ = 1536, C_SK = 2048, C_GR = 2560, C_GS = 3584;
constexpr int C_MG = 0;
constexpr int T_KT = 0, T_VR = 512, T_VS = 1024;
constexpr int NEXP = 16, DEXP = 512, MPAD_MAX = 65536 + 16 * 256, NRT_MAX = MPAD_MAX / 256;
constexpr float EPS = 1e-6f;
constexpr float LOG2E = 1.4426950408889634f;
constexpr float SB_QSCALE = 0.125f * LOG2E;
constexpr float SB_EXIT = -160.0f;

constexpr size_t MiB = 1u << 20;
constexpr size_t WS_CTL = 0, CTL_ZERO_BYTES = 1 * MiB;
constexpr size_t WS_WIN = 2 * MiB;
constexpr size_t WS_WBR1 = 14 * MiB;
constexpr size_t WS_WBR2 = 15 * MiB;
constexpr size_t WS_WOUT = 16 * MiB;
constexpr size_t WS_WGU = 18 * MiB;
constexpr size_t WS_WD = 50 * MiB;
constexpr size_t WS_WPLE = 66 * MiB;
constexpr size_t WS_WPG = 67 * MiB;
constexpr size_t WS_TABA = 70 * MiB;
constexpr size_t WS_TABB = 72 * MiB;
constexpr size_t WS_ROUTE = 74 * MiB;
constexpr size_t WS_PB = 76 * MiB;
constexpr size_t WS_PROJ = 92 * MiB;
constexpr size_t WS_T = 380 * MiB;
constexpr size_t WS_X2 = 360 * MiB;
constexpr size_t WS_END = 488 * MiB;
constexpr size_t WS_H2 = 92 * MiB;
constexpr size_t WS_XB = 156 * MiB;
constexpr size_t WS_HID = 292 * MiB;
constexpr size_t DO_HB = 0, DO_ST = 0, DO_RS = 64 * MiB;
constexpr size_t RT_EID = 0, RT_WGT = 256 * 1024, RT_RANK = 512 * 1024, RT_POS = 768 * 1024, RT_WROW = 1024 * 1024, RT_TILE = 1536 * 1024;
constexpr int CW_TMO = 0, CW_CODE = 1;
constexpr int CW_CNT = 64;
constexpr int CW_BAR = 4096, BAR_STRIDE = 4096;

#define GAS __attribute__((address_space(1)))
#define LAS __attribute__((address_space(3)))
typedef unsigned short bf16;
typedef unsigned v4u __attribute__((ext_vector_type(4)));
typedef unsigned v2u __attribute__((ext_vector_type(2)));
typedef float f32x4 __attribute__((ext_vector_type(4)));
typedef float f32x2 __attribute__((ext_vector_type(2)));
typedef float f32x16 __attribute__((ext_vector_type(16)));
typedef short bf16x8 __attribute__((ext_vector_type(8)));
typedef short s16x4 __attribute__((ext_vector_type(4)));
typedef GAS unsigned gu32;
#define RLX_AGENT __ATOMIC_RELAXED, __HIP_MEMORY_SCOPE_AGENT
#define LDS_WAIT() asm volatile("s_waitcnt lgkmcnt(0)" ::: "memory")
#define VM_WAIT() asm volatile("s_waitcnt vmcnt(0)" ::: "memory")
#define DI __device__ __forceinline__
DI unsigned f2bf(float f) { unsigned u = __builtin_bit_cast(unsigned, f); return (u + 0x7fffu + ((u >> 16) & 1u)) >> 16; }
DI unsigned pk2(float lo, float hi) { return f2bf(lo) | (f2bf(hi) << 16); }
DI float bf2f(unsigned b) { return __builtin_bit_cast(float, b << 16); }
DI float bflo(unsigned w) { return __builtin_bit_cast(float, w << 16); }
DI float bfhi(unsigned w) { return __builtin_bit_cast(float, w & 0xffff0000u); }
DI float fsigmoid(float x) { return 1.0f / (1.0f + __expf(-x)); }
DI float fsilu(float x) { return x / (1.0f + __expf(-x)); }
DI float wave_sum(float v) {
#pragma unroll
    for (int o = 1; o < 64; o <<= 1) v += __shfl_xor(v, o);
    return v;
}
DI float ret_log2g(int h) { return log2f(1.0f - exp2f(-5.0f - (float)h)); }

__host__ __device__ __forceinline__ int in_src(int r) {
    if (r < 1024) { const int base = (r < 512) ? 0 : 512; const int i = r & 511, h = i >> 7, j = i & 127; return base + h * 128 + (j & 1) * 64 + (j >> 1); }
    if (r < 1536) return 1536 + (r - 1024);
    if (r < 2048) return 2048 + (r - 1536);
    if (r < 2560) return 2560 + (r - 2048);
    if (r < 3584) return 3584 + (r - 2560);
    if (r < 4608) return 4608 + (r - 3584);
    if (r < 5120) { const int i = r - 4608, h = i >> 7, j = i & 127; return 512 + h * 128 + (j & 1) * 64 + (j >> 1); }
    if (r < 5632) return 1024 + (r - 5120);
    return 3072 + (r - 5632);
}


namespace pg8 {
#define PG8_LAS __attribute__((address_space(3)))
typedef unsigned short bf16_t;
typedef short bf16x8 __attribute__((ext_vector_type(8)));
typedef float f32x4 __attribute__((ext_vector_type(4)));
typedef unsigned u32x4 __attribute__((ext_vector_type(4)));
constexpr int BM = 256, BK = 64, HALF = 128, HTB = HALF * BK * 2  , STAGE_BYTES = 8 * HTB, NXCD = 8, WGM = 8;

__host__ __device__ __forceinline__ int lds_byte(int r, int c) { const int st = (r >> 4) * 2 + (c >> 5), rr = r & 15, cc = c & 31, ob = rr * 64 + cc * 2; return st * 1024 + (ob ^ (((ob >> 9) & 1) << 5)); }
__host__ __device__ __forceinline__ void stage_rc(int b, int& R, int& C) { const int st = b / 1024, sb = b % 1024, swz = sb ^ (((sb >> 9) & 1) << 5); R = (st >> 1) * 16 + swz / 64; C = (st & 1) * 32 + (swz % 64) / 2; }
__host__ __device__ __forceinline__ int perm32(int rho) { const int n = rho >> 4, i = rho & 15; return 8 * (i >> 2) + 4 * n + (i & 3); }

struct Unit { int pm, pn; size_t bofs; int ex; };
struct Gemm { const bf16_t* A; const bf16_t* Bt; int lda, K; };

struct StaticOrder {
    int nM, nN, nwg, G, c; size_t tstepB;
    __device__ void init(int M, int N, int K, int G_, int c_) { nM = M / BM; nN = N / BM; nwg = nM * nN; G = G_; c = c_; tstepB = (size_t)BM * K * 2; }
    __device__ bool next(int i, Unit& u) const {
        const long L = (long)i * G + c; if (L >= nwg) return false;
        int wgid = (int)L; { const int q = nwg / NXCD, r = nwg % NXCD, xcd = wgid % NXCD, off = wgid / NXCD; wgid = (xcd < r ? xcd * (q + 1) : r * (q + 1) + (xcd - r) * q) + off; }
        const int nig = WGM * nN, gid = wgid / nig, fm = gid * WGM, gsz = (nM - fm) < WGM ? (nM - fm) : WGM;
        u.pm = fm + ((wgid % nig) % gsz); u.pn = (wgid % nig) / gsz; u.bofs = (size_t)u.pn * tstepB; u.ex = 0; return true;
    }
    __device__ __forceinline__ void a_ready(const Unit&) const {}
    __device__ __forceinline__ void done(const Unit&) const {}
};
__device__ __forceinline__ unsigned cvt_pk_bf16(float lo, float hi) { unsigned r; asm volatile("v_cvt_pk_bf16_f32 %0, %1, %2" : "=v"(r) : "v"(lo), "v"(hi)); return r; }
template <class Epi, class Sched, bool ALIGN_EPI = false, bool SP2 = false>
__device__ __forceinline__ void gemm_phase(PG8_LAS unsigned char* lds, const Gemm g, const Sched& S, const Epi& E) {
    int tid_ = threadIdx.x; asm volatile("" : "+v"(tid_));
    const int tid = tid_, wid = __builtin_amdgcn_readfirstlane(tid >> 6), lane = tid & 63, wr = wid >> 2, wc = wid & 3, fr = lane & 15, fq = lane >> 4;
    const int K = g.K, nt = K / BK;
    unsigned voffA[2], voffB[2];
#pragma unroll
    for (int i = 0; i < 2; ++i) { int R, C; stage_rc(tid * 16 + i * 8192, R, C); const int Rb = Epi::PERM ? ((R & ~31) + perm32(R & 31)) : R;
        voffA[i] = (unsigned)(R * g.lda + C) * 2u; voffB[i] = (unsigned)(Rb * K + C) * 2u; }
    const size_t kstep = (size_t)(BK * 2);
    const size_t hstepA = (size_t)HALF * g.lda * 2, hstepB = (size_t)HALF * K * 2;
    const size_t tstepA = 2 * hstepA;
    const unsigned ldsw = (unsigned)wid * 1024u;
    const int aoff = lds_byte(wr * 64 + fr, fq * 8), boff = lds_byte(wc * 32 + fr, fq * 8);
#define PG8_SA(b, h) (((b) * 2 + (h)) * HTB)
#define PG8_SB(b, h) ((4 + (b) * 2 + (h)) * HTB)
#define PG8_STAGE(bufoff, gbase, voff) do { _Pragma("unroll") for (int _i = 0; _i < 2; ++_i) \
        __builtin_amdgcn_global_load_lds((const unsigned*)((const char*)(gbase) + (voff)[_i]), (PG8_LAS unsigned*)(lds + (bufoff) + ldsw + _i * 8192), 16, 0, 0); } while (0)
#define PG8_LDA(dst, b, h) do { _Pragma("unroll") for (int m = 0; m < 4; ++m) _Pragma("unroll") for (int k = 0; k < 2; ++k) dst[m][k] = *(const PG8_LAS bf16x8*)(lds + PG8_SA(b, h) + aoff + m * 2048 + k * 1024); } while (0)
#define PG8_LDB(dst, b, h) do { _Pragma("unroll") for (int n = 0; n < 2; ++n) _Pragma("unroll") for (int k = 0; k < 2; ++k) dst[n][k] = *(const PG8_LAS bf16x8*)(lds + PG8_SB(b, h) + boff + n * 2048 + k * 1024); } while (0)
#define PG8_MMA(ai, bj, At, Bt) do { __builtin_amdgcn_s_setprio(1); _Pragma("unroll") for (int m = 0; m < 4; ++m) _Pragma("unroll") for (int n = 0; n < 2; ++n) _Pragma("unroll") for (int k = 0; k < 2; ++k) \
        acc[ai][bj][m][n] = __builtin_amdgcn_mfma_f32_16x16x32_bf16(Bt[n][k], At[m][k], acc[ai][bj][m][n], 0, 0, 0); __builtin_amdgcn_s_setprio(0); } while (0)
#define PG8_WAIT_V(n) asm volatile("s_waitcnt vmcnt(" #n ")" ::: "memory")
#define PG8_WAIT_L(n) asm volatile("s_waitcnt lgkmcnt(" #n ")" ::: "memory")
#define PG8_BAR __builtin_amdgcn_s_barrier()
#define PG8_SCHED __builtin_amdgcn_sched_barrier(0)
    Unit cur, nxt; int ui = 0;
    if (!S.next(0, cur)) return;
    f32x4 acc[2][2][4][2];
#pragma unroll
    for (int a = 0; a < 2; ++a)
#pragma unroll
        for (int b = 0; b < 2; ++b)
#pragma unroll
            for (int m = 0; m < 4; ++m)
#pragma unroll
                for (int n = 0; n < 2; ++n) acc[a][b][m][n] = (f32x4){0.f, 0.f, 0.f, 0.f};
    bf16x8 At[4][2], B0[2][2], B1[2][2];
    const char* cA = (const char*)g.A + (size_t)cur.pm * tstepA; const char* cB = (const char*)g.Bt + cur.bofs;
    S.a_ready(cur);
    if constexpr (SP2) {
        PG8_STAGE(PG8_SB(0, 0), cB, voffB); PG8_STAGE(PG8_SB(0, 1), cB + hstepB, voffB); PG8_STAGE(PG8_SA(0, 0), cA, voffA); PG8_STAGE(PG8_SA(0, 1), cA + hstepA, voffA);
        if (wr == 1) PG8_BAR;
        PG8_WAIT_V(2); PG8_BAR;
        PG8_STAGE(PG8_SB(1, 0), cB + kstep, voffB); PG8_STAGE(PG8_SA(1, 0), cA + kstep, voffA); PG8_STAGE(PG8_SB(1, 1), cB + hstepB + kstep, voffB);
        PG8_WAIT_V(6); PG8_BAR;
    } else {
        PG8_STAGE(PG8_SB(0, 0), cB, voffB); PG8_STAGE(PG8_SA(0, 0), cA, voffA); PG8_STAGE(PG8_SB(0, 1), cB + hstepB, voffB); PG8_STAGE(PG8_SA(0, 1), cA + hstepA, voffA);
        if (wr == 1) PG8_BAR;
        PG8_WAIT_V(4); PG8_BAR;
        PG8_STAGE(PG8_SB(1, 0), cB + kstep, voffB); PG8_STAGE(PG8_SA(1, 0), cA + kstep, voffA); PG8_STAGE(PG8_SB(1, 1), cB + hstepB + kstep, voffB);
        PG8_WAIT_V(6); PG8_BAR;
    }
    for (;;) {
        const bool has_next = S.next(ui + 1, nxt);
        const char* nA = has_next ? (const char*)g.A + (size_t)nxt.pm * tstepA : cA; const char* nB = has_next ? (const char*)g.Bt + nxt.bofs : cB;
        for (int t = 0; t < nt; t += 2) {
            const bool last = (t == nt - 2);
            const char* a1 = cA + (size_t)(t + 1) * kstep;
            const char* a2 = last ? nA : cA + (size_t)(t + 2) * kstep; const char* b2 = last ? nB : cB + (size_t)(t + 2) * kstep;
            const char* a3 = a2 + kstep; const char* b3 = b2 + kstep;
            if (last && has_next) S.a_ready(nxt);
            if constexpr (SP2) {
            PG8_LDB(B0, 0, 0); PG8_LDB(B1, 0, 1); PG8_SCHED; PG8_LDA(At, 0, 0); PG8_STAGE(PG8_SA(1, 1), a1 + hstepA, voffA);
            PG8_WAIT_V(8); PG8_WAIT_L(0); PG8_BAR; PG8_MMA(0, 0, At, B0); PG8_MMA(0, 1, At, B1); PG8_BAR; PG8_SCHED;
            PG8_LDA(At, 0, 1); PG8_STAGE(PG8_SB(0, 0), b2, voffB); PG8_STAGE(PG8_SB(0, 1), b2 + hstepB, voffB); PG8_STAGE(PG8_SA(0, 0), a2, voffA);
            PG8_WAIT_V(8); PG8_WAIT_L(0); PG8_BAR; PG8_MMA(1, 0, At, B0); PG8_MMA(1, 1, At, B1); PG8_BAR; PG8_SCHED;
            PG8_LDB(B0, 1, 0); PG8_LDB(B1, 1, 1); PG8_SCHED; PG8_LDA(At, 1, 0); PG8_STAGE(PG8_SA(0, 1), a2 + hstepA, voffA);
            PG8_WAIT_V(8); PG8_WAIT_L(0); PG8_BAR; PG8_MMA(0, 0, At, B0); PG8_MMA(0, 1, At, B1); PG8_BAR; PG8_SCHED;
            PG8_LDA(At, 1, 1); PG8_STAGE(PG8_SB(1, 0), b3, voffB); PG8_STAGE(PG8_SB(1, 1), b3 + hstepB, voffB); PG8_STAGE(PG8_SA(1, 0), a3, voffA);
            PG8_WAIT_V(8); PG8_WAIT_L(0); PG8_BAR; PG8_MMA(1, 0, At, B0); PG8_MMA(1, 1, At, B1); PG8_BAR; PG8_SCHED;
            } else {
            PG8_LDB(B0, 0, 0); PG8_SCHED; PG8_LDA(At, 0, 0); PG8_STAGE(PG8_SA(1, 1), a1 + hstepA, voffA);
            PG8_WAIT_L(8); PG8_BAR; PG8_WAIT_L(0); PG8_MMA(0, 0, At, B0); PG8_BAR; PG8_SCHED;
            PG8_LDB(B1, 0, 1); PG8_STAGE(PG8_SB(0, 0), b2, voffB);
            PG8_BAR; PG8_WAIT_L(0); PG8_MMA(0, 1, At, B1); PG8_BAR;
            PG8_LDA(At, 0, 1); PG8_STAGE(PG8_SA(0, 0), a2, voffA);
            PG8_BAR; PG8_WAIT_L(0); PG8_MMA(1, 0, At, B0); PG8_BAR; PG8_SCHED;
            PG8_STAGE(PG8_SB(0, 1), b2 + hstepB, voffB);
            PG8_WAIT_V(6); PG8_BAR; PG8_MMA(1, 1, At, B1); PG8_BAR;
            PG8_LDB(B0, 1, 0); PG8_SCHED; PG8_LDA(At, 1, 0); PG8_STAGE(PG8_SA(0, 1), a2 + hstepA, voffA);
            PG8_WAIT_L(8); PG8_BAR; PG8_WAIT_L(0); PG8_MMA(0, 0, At, B0); PG8_BAR; PG8_SCHED;
            PG8_LDB(B1, 1, 1); PG8_STAGE(PG8_SB(1, 0), b3, voffB);
            PG8_BAR; PG8_WAIT_L(0); PG8_MMA(0, 1, At, B1); PG8_BAR;
            PG8_LDA(At, 1, 1); PG8_STAGE(PG8_SA(1, 0), a3, voffA);
            PG8_BAR; PG8_WAIT_L(0); PG8_MMA(1, 0, At, B0); PG8_BAR; PG8_SCHED;
            PG8_STAGE(PG8_SB(1, 1), b3 + hstepB, voffB);
            PG8_WAIT_V(6); PG8_BAR; PG8_MMA(1, 1, At, B1); PG8_BAR;
            }
        }
        if constexpr (ALIGN_EPI) { if (wr == 0) PG8_BAR; }
        if constexpr (!Epi::AFTER_DRAIN) { E(acc, cur, wr, wc, fr, fq); S.done(cur); }
        if (!has_next) break;
#pragma unroll
        for (int a = 0; a < 2; ++a)
#pragma unroll
            for (int b = 0; b < 2; ++b)
#pragma unroll
                for (int m = 0; m < 4; ++m)
#pragma unroll
                    for (int n = 0; n < 2; ++n) acc[a][b][m][n] = (f32x4){0.f, 0.f, 0.f, 0.f};
        cur = nxt; cA = nA; cB = nB; ++ui;
        if constexpr (ALIGN_EPI) { if (wr == 1) PG8_BAR; }
    }
    PG8_WAIT_V(0);
    if constexpr (!ALIGN_EPI) { if (wr == 0) PG8_BAR; }
    PG8_BAR;
    if constexpr (Epi::AFTER_DRAIN) { E.fused(acc, cur, wr, wc, fr, fq, lds, wid, lane); S.done(cur); }
#undef PG8_SA
#undef PG8_SB
#undef PG8_STAGE
#undef PG8_LDA
#undef PG8_LDB
#undef PG8_MMA
#undef PG8_WAIT_V
#undef PG8_WAIT_L
#undef PG8_BAR
#undef PG8_SCHED
}
}
#define XB_TMO      128
#define XB_XCNT(j)  (256  + 64 * (j))
#define XB_XSUB(j)  (1280 + 64 * (j))
#define XB_XGEN(j)  (2304 + 64 * (j))
#define XB_TOP      3328
#define XB_TOPGEN   3392
#define XCD_BAR_WORDS 3456
#define XB_SPIN_CAP (1u << 18)

__device__ __forceinline__ unsigned xb_ld(unsigned* p)              { return __hip_atomic_load(p, __ATOMIC_RELAXED, __HIP_MEMORY_SCOPE_AGENT); }
__device__ __forceinline__ unsigned xb_add(unsigned* p, unsigned v) { return __hip_atomic_fetch_add(p, v, __ATOMIC_RELAXED, __HIP_MEMORY_SCOPE_AGENT); }
__device__ __forceinline__ unsigned xb_xcc_id() { return (unsigned)__builtin_amdgcn_s_getreg((3 << 11) | 20) & 0xFu; }
#define XB_SPIN(cond, bar) do { unsigned _sp = 0; while (cond) { __builtin_amdgcn_s_sleep(1); \
    if ((++_sp & 255u) == 0u) { if (xb_ld(&(bar)[XB_TMO])) break; if (_sp > XB_SPIN_CAP) { atomicAdd(&(bar)[XB_TMO], 1u); break; } } } } while (0)

struct XcdBarrier {
    unsigned* bar; unsigned x;
    volatile LAS unsigned* st;
};

__device__ __forceinline__ XcdBarrier xcd_barrier_post(unsigned* bar, volatile LAS unsigned* st) {
    XcdBarrier b; b.bar = bar; b.x = xb_xcc_id(); b.st = st;
    if (threadIdx.x == 0) (void)xb_add(&bar[XB_XCNT(b.x)], 1u);
    return b;
}
__device__ __forceinline__ void xcd_barrier_complete(unsigned* bar, unsigned x, unsigned& nloc, unsigned& nx) {
    const unsigned G = gridDim.x * gridDim.y * gridDim.z;
    unsigned sum, cnt, mine, sp = 0u;
    for (;;) {
        sum = 0u; cnt = 0u; mine = 0u;
#pragma unroll
        for (unsigned j = 0; j < 16; ++j) { const unsigned c = xb_ld(&bar[XB_XCNT(j)]); sum += c; cnt += (c > 0u) ? 1u : 0u; mine = (j == x) ? c : mine; }
        if (sum == G) break;
        __builtin_amdgcn_s_sleep(1);
        if ((++sp & 255u) == 0u) { if (xb_ld(&bar[XB_TMO])) break; if (sp > XB_SPIN_CAP) { atomicAdd(&bar[XB_TMO], 1u); break; } }
    }
    nloc = mine > 0u ? mine : 1u; nx = cnt > 0u ? cnt : 1u;
}

__device__ __forceinline__ void xcd_barrier(const XcdBarrier& b) {
    asm volatile("s_waitcnt vmcnt(0)" ::: "memory");
    __syncthreads();
    if (threadIdx.x == 0) {
        unsigned* bar = b.bar;
        __builtin_amdgcn_s_waitcnt(0);
        unsigned nloc = b.st[0], nx = b.st[1];
        if (nloc == 0u) { xcd_barrier_complete(bar, b.x, nloc, nx); b.st[0] = nloc; b.st[1] = nx; }
        const unsigned old = xb_add(&bar[XB_XSUB(b.x)], 1u);
        const unsigned gen = old / nloc;
        if (old + 1u == (gen + 1u) * nloc) {
            __builtin_amdgcn_fence(__ATOMIC_RELEASE, "agent");
            asm volatile("s_waitcnt vmcnt(0)" ::: "memory");
            const unsigned og = xb_add(&bar[XB_TOP], 1u);
            const unsigned tg = og / nx;
            if (og + 1u == (tg + 1u) * nx) xb_add(&bar[XB_TOPGEN], 1u);
            else XB_SPIN(xb_ld(&bar[XB_TOPGEN]) == tg, bar);
            __builtin_amdgcn_fence(__ATOMIC_ACQUIRE, "agent");
            xb_add(&bar[XB_XGEN(b.x)], 1u);
            asm volatile("s_waitcnt vmcnt(0)" ::: "memory");
        } else {
            XB_SPIN(xb_ld(&bar[XB_XGEN(b.x)]) == gen, bar);
            __builtin_amdgcn_fence(__ATOMIC_ACQUIRE, "agent");
            asm volatile("s_waitcnt vmcnt(0)" ::: "memory");
        }
    }
    __syncthreads();
}

constexpr int NWAVES = 8;
constexpr int RING_OFF = 0, RING_BYTES = 131072;
constexpr int LDSCTL_OFF = RING_BYTES, MISC_OFF = LDSCTL_OFF + 320;
constexpr int LDS_BYTES = 147456;

struct Args { const float* in[20]; float* out; unsigned char* ws; int ph_lo, ph_hi, li, pad; };

struct Frame {
    LAS unsigned char* lds;
    volatile LAS unsigned* MISC;
    gu32* ctl;
    int tid, lane, wave, vcu, G;
    __device__ __forceinline__ void refresh() { int t = threadIdx.x; asm volatile("" : "+v"(t)); tid = t; lane = t & 63; wave = __builtin_amdgcn_readfirstlane(t >> 6); }
    unsigned char* ws; float* out;
    const float* x; const float* p;
};

enum Phase { PH_PRO = 0, PH_PROJ, PH_MIX1, PH_SCAN, PH_RETO, PH_BR, PH_WOUT, PH_ROUTE, PH_GATHER, PH_GU, PH_DOWN, PH_COMB, PH_PLE, PH_FINAL, NPH };

DI void tr_item(const float* __restrict__ W, int ldw, int mycol, bf16* WT, int K, int r0, int k0, LAS float* scr, int lane) {
#pragma unroll 8
    for (int i = 0; i < 32; ++i) { const int kk = 2 * i + (lane >> 5); scr[kk * 33 + (lane & 31)] = W[(size_t)(k0 + kk) * ldw + mycol]; }
    LDS_WAIT(); asm volatile("" ::: "memory");
    const int c = lane & 7;
#pragma unroll
    for (int j = 0; j < 4; ++j) { const int n = (lane >> 3) + 8 * j; const LAS float* s = scr + (8 * c) * 33 + n;
        v4u o; o.x = pk2(s[0 * 33], s[1 * 33]); o.y = pk2(s[2 * 33], s[3 * 33]); o.z = pk2(s[4 * 33], s[5 * 33]); o.w = pk2(s[6 * 33], s[7 * 33]);
        *(GAS v4u*)(WT + (size_t)(r0 + n) * K + k0 + 8 * c) = o; }
    LDS_WAIT(); asm volatile("" ::: "memory");
}
DI void rms_row_to_bf16(const float* xrow, const float* gain, bf16* orow, int lane) {
    const GAS f32x4* xr = (const GAS f32x4*)xrow + lane; const GAS f32x4* gr = (const GAS f32x4*)gain + lane;
    f32x4 v[4]; float s = 0.f;
#pragma unroll
    for (int j = 0; j < 4; ++j) { v[j] = xr[64 * j]; s += (v[j].x * v[j].x + v[j].y * v[j].y) + (v[j].z * v[j].z + v[j].w * v[j].w); }
    const float rstd = rsqrtf(wave_sum(s) * (1.f / DM) + EPS);
    GAS v2u* o8 = (GAS v2u*)orow + lane;
#pragma unroll
    for (int j = 0; j < 4; ++j) { const f32x4 g = gr[64 * j]; v2u o; o.x = pk2(v[j].x * rstd * g.x, v[j].y * rstd * g.y); o.y = pk2(v[j].z * rstd * g.z, v[j].w * rstd * g.w); o8[64 * j] = o; }
}
DI void ph_prologue(Frame& F, const Args& a) {
    LAS float* scr = (LAS float*)(F.lds + RING_OFF + F.wave * 16384);
    const int gw = F.vcu * NWAVES + F.wave, NGW = F.G * NWAVES, lane = F.lane;
    unsigned char* ws = F.ws;
    constexpr int I_IN = (6144 / 32) * 16, I_BR = 32 * 8, I_OUT = 32 * 16, I_GU = 16 * 32 * 16, I_D = 16 * 32 * 8, I_PLE = 32 * 4, I_PG = 32 * 16;
    constexpr int NITEMS = I_IN + 2 * I_BR + I_OUT + I_GU + I_D + I_PLE + I_PG;
    for (int it = gw; it < NITEMS; it += NGW) {
        int r = it;
        if (r < I_IN) { const int rb = r >> 4, kb = r & 15; tr_item(a.in[3], NWIN, in_src(rb * 32 + (lane & 31)), (bf16*)(ws + WS_WIN), 1024, rb * 32, kb * 64, scr, lane); continue; } r -= I_IN;
        if (r < I_BR) { const int rb = r >> 3, kb = r & 7; tr_item(a.in[5], DM, rb * 32 + (lane & 31), (bf16*)(ws + WS_WBR1), 512, rb * 32, kb * 64, scr, lane); continue; } r -= I_BR;
        if (r < I_BR) { const int rb = r >> 3, kb = r & 7; tr_item(a.in[6], DM, rb * 32 + (lane & 31), (bf16*)(ws + WS_WBR2), 512, rb * 32, kb * 64, scr, lane); continue; } r -= I_BR;
        if (r < I_OUT) { const int rb = r >> 4, kb = r & 15; tr_item(a.in[7], DM, rb * 32 + (lane & 31), (bf16*)(ws + WS_WOUT), 1024, rb * 32, kb * 64, scr, lane); continue; } r -= I_OUT;
        if (r < I_GU) { const int e = r >> 9, q = r & 511, rb = q >> 4, kb = q & 15;
            const int row = rb * 32, j = row >> 8, w = row & 255; const bool up = w >= 128; const int col = 128 * j + (w & 127) + (lane & 31);
            tr_item((up ? a.in[14] : a.in[13]) + (size_t)e * DM * DEXP, DEXP, col, (bf16*)(ws + WS_WGU) + (size_t)e * 1024 * 1024, 1024, row, kb * 64, scr, lane); continue; } r -= I_GU;
        if (r < I_D) { const int e = r >> 8, q = r & 255, rb = q >> 3, kb = q & 7;
            tr_item(a.in[15] + (size_t)e * DEXP * DM, DM, rb * 32 + (lane & 31), (bf16*)(ws + WS_WD) + (size_t)e * 1024 * 512, 512, rb * 32, kb * 64, scr, lane); continue; } r -= I_D;
        if (r < I_PLE) { const int rb = r >> 2, kb = r & 3; tr_item(a.in[17], DM, rb * 32 + (lane & 31), (bf16*)(ws + WS_WPLE), 256, rb * 32, kb * 64, scr, lane); continue; } r -= I_PLE;
        { const int rb = r >> 4, kb = r & 15; tr_item(a.in[18], DM, rb * 32 + (lane & 31), (bf16*)(ws + WS_WPG), 1024, rb * 32, kb * 64, scr, lane); }
    }
    bf16* HB = (bf16*)((unsigned char*)F.out + DO_HB);
    for (int m = gw; m < NTOK; m += NGW) {
        rms_row_to_bf16(F.x + (size_t)m * DM, a.in[2], HB + (size_t)m * DM, lane);
        const f32x4 pv = ((const GAS f32x4*)(F.p + (size_t)m * 256))[lane];
        v2u o; o.x = pk2(pv.x, pv.y); o.y = pk2(pv.z, pv.w); ((GAS v2u*)((bf16*)(ws + WS_PB) + (size_t)m * 256))[lane] = o;
    }
    f32x2* tabA = (f32x2*)(ws + WS_TABA); f32x2* tabB = (f32x2*)(ws + WS_TABB);
    for (int i = F.vcu * 512 + F.tid; i < SEQ * 64; i += F.G * 512) {
        const int pos = i >> 6, p = i & 63;
        const float invf = powf(10000.0f, -(float)(2 * p) * (1.0f / 128.0f)); const float ang = (float)pos * invf;
        const f32x2 cs = {cosf(ang), sinf(ang)};
        tabA[i] = cs; tabB[p * SEQ + pos] = cs;
    }
}

template <int CTRL, int ROWMASK> DI float dpp_add(float v) { return v + __builtin_bit_cast(float, __builtin_amdgcn_update_dpp(0, __builtin_bit_cast(int, v), CTRL, ROWMASK, 0xF, false)); }
DI float wave_sum_dpp(float v) {
    v = dpp_add<0xB1, 0xF>(v);
    v = dpp_add<0x4E, 0xF>(v);
    v = dpp_add<0x141, 0xF>(v);
    v = dpp_add<0x140, 0xF>(v);
    v = dpp_add<0x142, 0xA>(v);
    v = dpp_add<0x143, 0xC>(v);
    return __builtin_bit_cast(float, __builtin_amdgcn_readlane(__builtin_bit_cast(int, v), 63));
}
DI void ph_route(Frame& F, const Args& a) {
    LAS float* WL = (LAS float*)(F.lds);
    for (int i = F.tid; i < 1024 * 20; i += 512) { const int k = i / 20, o = i - k * 20; WL[i] = o < 4 ? a.in[9][k * 4 + o] : a.in[11][k * 16 + (o - 4)]; }
    LAS int* s_e = (LAS int*)(F.lds + 81920); LAS int* s_lr = s_e + 256; LAS int* lcnt = s_lr + 256; LAS int* lbase = lcnt + 16;
    unsigned char* ws = F.ws; const int lane = F.lane;
    int* eid = (int*)(ws + WS_ROUTE + RT_EID); float* wgt = (float*)(ws + WS_ROUTE + RT_WGT); int* rank = (int*)(ws + WS_ROUTE + RT_RANK);
    bf16* H2 = (bf16*)(ws + WS_H2);
    const float* bg = a.in[10]; const float* be = a.in[12];
    __syncthreads();
    for (int blk = F.vcu; blk < NTOK / 128; blk += F.G) {
        if (F.tid < 16) lcnt[F.tid] = 0;
        __syncthreads();
        for (int tl = F.wave; tl < 128; tl += NWAVES) {
            const int tok = blk * 128 + tl;
            const float* xrow = F.out + (size_t)tok * DM;
            const GAS f32x4* xr = (const GAS f32x4*)xrow + lane; const GAS f32x4* gr = (const GAS f32x4*)a.in[8] + lane;
            f32x4 v[4]; float ss = 0.f; float xB[16];
#pragma unroll
            for (int j = 0; j < 4; ++j) v[j] = xr[64 * j];
#pragma unroll
            for (int j = 0; j < 16; ++j) xB[j] = xrow[lane + 64 * j];
#pragma unroll
            for (int j = 0; j < 4; ++j) ss += (v[j].x * v[j].x + v[j].y * v[j].y) + (v[j].z * v[j].z + v[j].w * v[j].w);
            const float rstd = rsqrtf(wave_sum_dpp(ss) * (1.f / DM) + EPS);
            GAS v2u* o8 = (GAS v2u*)(H2 + (size_t)tok * DM) + lane;
#pragma unroll
            for (int j = 0; j < 4; ++j) { const f32x4 g = gr[64 * j]; v2u o; o.x = pk2(v[j].x * rstd * g.x, v[j].y * rstd * g.y); o.y = pk2(v[j].z * rstd * g.z, v[j].w * rstd * g.w); o8[64 * j] = o; }
            float acc[20];
#pragma unroll
            for (int o = 0; o < 20; ++o) acc[o] = 0.f;
#pragma unroll
            for (int j = 0; j < 16; ++j) {
                const float hv = xB[j] * a.in[8][lane + 64 * j]; const LAS f32x4* w = (const LAS f32x4*)(WL + (lane + 64 * j) * 20);
#pragma unroll
                for (int q = 0; q < 5; ++q) { const f32x4 wv = w[q]; acc[4 * q] += hv * wv.x; acc[4 * q + 1] += hv * wv.y; acc[4 * q + 2] += hv * wv.z; acc[4 * q + 3] += hv * wv.w; }
            }
#pragma unroll
            for (int o = 0; o < 20; ++o) acc[o] = wave_sum_dpp(acc[o]) * rstd;
            float gl[4];
#pragma unroll
            for (int i = 0; i < 4; ++i) gl[i] = acc[i] + bg[i];
            int g = 0; float gm = gl[0];
#pragma unroll
            for (int i = 1; i < 4; ++i) if (gl[i] > gm) { gm = gl[i]; g = i; }
            float se = 0.f;
#pragma unroll
            for (int i = 0; i < 4; ++i) se += __expf(gl[i] - gm);
            const float pg = 1.0f / se;
            float el[4];
#pragma unroll
            for (int i = 0; i < 4; ++i) { const float l0 = acc[4 + i], l1 = acc[8 + i], l2 = acc[12 + i], l3 = acc[16 + i]; el[i] = (g == 0 ? l0 : g == 1 ? l1 : g == 2 ? l2 : l3) + be[4 * g + i]; }
            int i1 = 0; float m1 = el[0];
#pragma unroll
            for (int i = 1; i < 4; ++i) if (el[i] > m1) { m1 = el[i]; i1 = i; }
            int i2 = -1; float m2 = -3.0e38f;
#pragma unroll
            for (int i = 0; i < 4; ++i) if (i != i1 && el[i] > m2) { m2 = el[i]; i2 = i; }
            const float e2 = __expf(m2 - m1), w1 = pg / (1.0f + e2), w2 = pg * e2 / (1.0f + e2);
            if (lane == 0) {
                eid[2 * tok] = 4 * g + i1; eid[2 * tok + 1] = 4 * g + i2; wgt[2 * tok] = w1; wgt[2 * tok + 1] = w2;
                s_e[2 * tl] = 4 * g + i1; s_e[2 * tl + 1] = 4 * g + i2;
            }
        }
        __syncthreads();
        if (F.tid < 256) s_lr[F.tid] = atomicAdd((int*)&lcnt[s_e[F.tid]], 1);
        __syncthreads();
        if (F.tid < 16) lbase[F.tid] = (int)__hip_atomic_fetch_add(F.ctl + CW_CNT + F.tid, (unsigned)lcnt[F.tid], RLX_AGENT);
        __syncthreads();
        if (F.tid < 256) rank[blk * 256 + F.tid] = lbase[s_e[F.tid]] + s_lr[F.tid];
        __syncthreads();
    }
}

DI void expert_table(Frame& F, LAS int* pst) {
    if (F.tid == 0) { int acc = 0; for (int e = 0; e < NEXP; ++e) { pst[e] = acc; const int c = (int)__hip_atomic_load(F.ctl + CW_CNT + e, RLX_AGENT); acc += (c + 255) & ~255; } pst[NEXP] = acc; }
    __syncthreads();
}

DI void ph_gather(Frame& F, const Args& a) {
    LAS int* pst = (LAS int*)(F.lds);
    expert_table(F, pst);
    unsigned char* ws = F.ws; const int lane = F.lane;
    const int* eid = (const int*)(ws + WS_ROUTE + RT_EID); const float* wgt = (const float*)(ws + WS_ROUTE + RT_WGT); const int* rank = (const int*)(ws + WS_ROUTE + RT_RANK);
    int* pos = (int*)(ws + WS_ROUTE + RT_POS); float* wrow = (float*)(ws + WS_ROUTE + RT_WROW); int* tile = (int*)(ws + WS_ROUTE + RT_TILE);
    const bf16* H2 = (const bf16*)(ws + WS_H2); bf16* XB = (bf16*)(ws + WS_XB);
    if (blockIdx.x == 0 && F.tid < NEXP) { const int e = F.tid; for (int rt = pst[e] >> 8; rt < (pst[e + 1] >> 8); ++rt) tile[1 + rt] = e; if (e == 0) tile[0] = pst[NEXP] >> 8; }
    const int gw = F.vcu * NWAVES + F.wave, NGW = F.G * NWAVES;
    for (int tok = gw; tok < NTOK; tok += NGW) {
        const int p0 = pst[eid[2 * tok]] + rank[2 * tok], p1 = pst[eid[2 * tok + 1]] + rank[2 * tok + 1];
        const GAS v4u* src = (const GAS v4u*)(H2 + (size_t)tok * DM) + lane;
        const v4u r0 = src[0], r1 = src[64];
        GAS v4u* d0 = (GAS v4u*)(XB + (size_t)p0 * DM) + lane; GAS v4u* d1 = (GAS v4u*)(XB + (size_t)p1 * DM) + lane;
        d0[0] = r0; d0[64] = r1; d1[0] = r0; d1[64] = r1;
        if (lane == 0) { pos[2 * tok] = p0; pos[2 * tok + 1] = p1; wrow[p0] = wgt[2 * tok]; wrow[p1] = wgt[2 * tok + 1]; }
    }
}

DI void ph_combine(Frame& F, const Args& a) {
    unsigned char* ws = F.ws; const int lane = F.lane;
    const int* pos = (const int*)(ws + WS_ROUTE + RT_POS); const bf16* YB = (const bf16*)(ws + WS_XB); bf16* HP = (bf16*)(ws + WS_H2);
    const int gw = F.vcu * NWAVES + F.wave, NGW = F.G * NWAVES;
    for (int tok = gw; tok < NTOK; tok += NGW) {
        const GAS f32x4* xr = (const GAS f32x4*)(F.out + (size_t)tok * DM) + lane; GAS f32x4* xw = (GAS f32x4*)((float*)(ws + WS_X2) + (size_t)tok * DM) + lane; const GAS f32x4* gr = (const GAS f32x4*)a.in[16] + lane;
        const GAS v2u* y0 = (const GAS v2u*)(YB + (size_t)pos[2 * tok] * DM) + lane; const GAS v2u* y1 = (const GAS v2u*)(YB + (size_t)pos[2 * tok + 1] * DM) + lane;
        f32x4 v[4]; float ss = 0.f;
#pragma unroll
        for (int j = 0; j < 4; ++j) {
            v[j] = xr[64 * j]; const v2u a0 = y0[64 * j], a1 = y1[64 * j];
            v[j].x += bflo(a0.x) + bflo(a1.x); v[j].y += bfhi(a0.x) + bfhi(a1.x); v[j].z += bflo(a0.y) + bflo(a1.y); v[j].w += bfhi(a0.y) + bfhi(a1.y);
            xw[64 * j] = v[j]; ss += (v[j].x * v[j].x + v[j].y * v[j].y) + (v[j].z * v[j].z + v[j].w * v[j].w);
        }
        const float rstd = rsqrtf(wave_sum(ss) * (1.f / DM) + EPS);
        GAS v2u* o8 = (GAS v2u*)(HP + (size_t)tok * DM) + lane;
#pragma unroll
        for (int j = 0; j < 4; ++j) { const f32x4 g = gr[64 * j]; v2u o; o.x = pk2(v[j].x * rstd * g.x, v[j].y * rstd * g.y); o.y = pk2(v[j].z * rstd * g.z, v[j].w * rstd * g.w); o8[64 * j] = o; }
    }
}

DI void ph_final(Frame& F, const Args& a) {
    const int lane = F.lane, gw = F.vcu * NWAVES + F.wave, NGW = F.G * NWAVES;
    for (int tok = gw; tok < NTOK; tok += NGW) {
        GAS f32x4* xr = (GAS f32x4*)(F.out + (size_t)tok * DM) + lane; const GAS f32x4* gr = (const GAS f32x4*)a.in[19] + lane;
        f32x4 v[4]; float ss = 0.f;
#pragma unroll
        for (int j = 0; j < 4; ++j) { v[j] = xr[64 * j]; ss += (v[j].x * v[j].x + v[j].y * v[j].y) + (v[j].z * v[j].z + v[j].w * v[j].w); }
        const float rstd = rsqrtf(wave_sum(ss) * (1.f / DM) + EPS);
#pragma unroll
        for (int j = 0; j < 4; ++j) { const f32x4 g = gr[64 * j]; xr[64 * j] = v[j] * rstd * g; }
    }
}

typedef pg8::f32x4 af4;
DI unsigned cvtpk(float lo, float hi) { typedef float f2 __attribute__((ext_vector_type(2))); typedef __bf16 b2 __attribute__((ext_vector_type(2))); f2 v = {lo, hi}; b2 b = __builtin_convertvector(v, b2); return __builtin_bit_cast(unsigned, b); }
DI v4u pack8(const float (&x)[8]) { v4u w; w.x = cvtpk(x[0], x[1]); w.y = cvtpk(x[2], x[3]); w.z = cvtpk(x[4], x[5]); w.w = cvtpk(x[6], x[7]); return w; }
DI void unpack8(const v4u w, float (&x)[8]) { x[0] = bflo(w.x); x[1] = bfhi(w.x); x[2] = bflo(w.y); x[3] = bfhi(w.y); x[4] = bflo(w.z); x[5] = bfhi(w.z); x[6] = bflo(w.w); x[7] = bfhi(w.w); }

struct EpiProj {
    static constexpr bool PERM = true, AFTER_DRAIN = false;
    bf16* PROJ; const f32x2* tabA; const float* gn;
    DI void operator()(const af4 (&acc)[2][2][4][2], const pg8::Unit& u, int wr, int wc, int fr, int fq) const {
        const int row0 = u.pm * 256 + wr * 64 + fr, colb = u.pn * 256 + wc * 32 + 8 * fq;
        const int kind = u.pn < 2 ? 0 : u.pn < 4 ? 1 : u.pn < 6 ? 2 : u.pn < 8 ? 3 : u.pn < 10 ? 4 : 5;
#pragma unroll
        for (int ai = 0; ai < 2; ++ai)
#pragma unroll
            for (int m = 0; m < 4; ++m) {
                const int row = row0 + ai * 128 + m * 16;
#pragma unroll
                for (int bj = 0; bj < 2; ++bj) {
                    const int col = colb + bj * 128;
                    const af4 a0 = acc[ai][bj][m][0], a1 = acc[ai][bj][m][1];
                    float x[8] = {a0[0], a0[1], a0[2], a0[3], a1[0], a1[1], a1[2], a1[3]};
                    if (kind <= 1) {
                        const int pos = row & (SEQ - 1), p = (col & 127) >> 1;
                        const f32x4* tp = (const f32x4*)(tabA + pos * 64 + p);
                        const f32x4 t0 = tp[0], t1 = tp[1];
                        const float sc = kind == 1 ? 0.08838834764831845f : 1.0f;
                        float y[8];
                        y[0] = (x[0] * t0.x - x[1] * t0.y) * sc; y[1] = (x[0] * t0.y + x[1] * t0.x) * sc;
                        y[2] = (x[2] * t0.z - x[3] * t0.w) * sc; y[3] = (x[2] * t0.w + x[3] * t0.z) * sc;
                        y[4] = (x[4] * t1.x - x[5] * t1.y) * sc; y[5] = (x[4] * t1.y + x[5] * t1.x) * sc;
                        y[6] = (x[6] * t1.z - x[7] * t1.w) * sc; y[7] = (x[6] * t1.w + x[7] * t1.z) * sc;
#pragma unroll
                        for (int i = 0; i < 8; ++i) x[i] = y[i];
                    } else if (kind == 2) {
                        const f32x4 g0 = *(const f32x4*)(gn + (col - C_RG)), g1 = *(const f32x4*)(gn + (col - C_RG) + 4);
                        const float gg[8] = {g0.x, g0.y, g0.z, g0.w, g1.x, g1.y, g1.z, g1.w};
#pragma unroll
                        for (int i = 0; i < 8; ++i) x[i] = fsilu(x[i]) * gg[i];
                    } else if (kind == 3) {
#pragma unroll
                        for (int i = 0; i < 8; ++i) x[i] *= SB_QSCALE;
                    } else if (kind == 5) {
#pragma unroll
                        for (int i = 0; i < 8; ++i) x[i] = fsigmoid(x[i]);
                    }
                    *(v4u*)(PROJ + (size_t)row * NMAIN + col) = pack8(x);
                }
            }
    }
};
struct EpiProjT {
    static constexpr bool PERM = true, AFTER_DRAIN = false;
    bf16* T; const f32x2* tabB;
    DI void operator()(const af4 (&acc)[2][2][4][2], const pg8::Unit& u, int wr, int wc, int fr, int fq) const {
        const int f0 = u.pm * 256 + wr * 64 + fr, tokb = u.pn * 256 + wc * 32 + 8 * fq;
        const bool isk = u.pm < 2;
#pragma unroll
        for (int ai = 0; ai < 2; ++ai)
#pragma unroll
            for (int m = 0; m < 4; ++m) {
                const int f = f0 + ai * 128 + m * 16;
#pragma unroll
                for (int bj = 0; bj < 2; ++bj) {
                    const int tok = tokb + bj * 128;
                    const af4 a0 = acc[ai][bj][m][0], a1 = acc[ai][bj][m][1];
                    float x[8] = {a0[0], a0[1], a0[2], a0[3], a1[0], a1[1], a1[2], a1[3]};
                    if (isk) {
                        const int pos = tok & (SEQ - 1), h = f >> 7, p = (f & 127) >> 1;
                        const f32x4* tp = (const f32x4*)(tabB + p * SEQ + pos);
                        const f32x4 t0 = tp[0], t1 = tp[1], t2 = tp[2], t3 = tp[3];
                        const float cs[8] = {t0.x, t0.z, t1.x, t1.z, t2.x, t2.z, t3.x, t3.z}, sn[8] = {t0.y, t0.w, t1.y, t1.w, t2.y, t2.w, t3.y, t3.w};
                        const float l2g = ret_log2g(h); const float ginv = exp2f(-l2g);
                        float sc = 0.08838834764831845f * exp2f(l2g * (float)(63 - (pos & 63)));
                        const bool odd = (f & 1) != 0;
                        float y[8];
#pragma unroll
                        for (int i = 0; i < 8; ++i) {
                            const float other = __shfl_xor(x[i], 1);
                            const float r = odd ? (other * sn[i] + x[i] * cs[i]) : (x[i] * cs[i] - other * sn[i]);
                            y[i] = r * sc; sc *= ginv;
                        }
#pragma unroll
                        for (int i = 0; i < 8; ++i) x[i] = y[i];
                    }
                    *(v4u*)(T + (size_t)f * NTOK + tok) = pack8(x);
                }
            }
    }
};

struct EpiBr {
    static constexpr bool PERM = true, AFTER_DRAIN = false;
    bf16* PROJ; int step;
    DI void operator()(const af4 (&acc)[2][2][4][2], const pg8::Unit& u, int wr, int wc, int fr, int fq) const {
        const int row0 = u.pm * 256 + wr * 64 + fr, colb = u.pn * 256 + wc * 32 + 8 * fq;
#pragma unroll
        for (int ai = 0; ai < 2; ++ai)
#pragma unroll
            for (int m = 0; m < 4; ++m) {
                bf16* pr = PROJ + (size_t)(row0 + ai * 128 + m * 16) * NMAIN;
#pragma unroll
                for (int bj = 0; bj < 2; ++bj) {
                    const int col = colb + bj * 128;
                    const af4 a0 = acc[ai][bj][m][0], a1 = acc[ai][bj][m][1];
                    float g[8], x[8] = {a0[0], a0[1], a0[2], a0[3], a1[0], a1[1], a1[2], a1[3]};
                    unpack8(*(const v4u*)(pr + (step ? C_GS : C_GR) + col), g);
#pragma unroll
                    for (int i = 0; i < 8; ++i) x[i] *= g[i];
                    if (step) { float t1[8]; unpack8(*(const v4u*)(pr + C_MG + col), t1);
#pragma unroll
                        for (int i = 0; i < 8; ++i) x[i] += t1[i]; }
                    *(v4u*)(pr + C_MG + col) = pack8(x);
                }
            }
    }
};
struct EpiWout {
    static constexpr bool PERM = true, AFTER_DRAIN = false;
    const float* x; float* out;
    DI void operator()(const af4 (&acc)[2][2][4][2], const pg8::Unit& u, int wr, int wc, int fr, int fq) const {
        const int row0 = u.pm * 256 + wr * 64 + fr, colb = u.pn * 256 + wc * 32 + 8 * fq;
#pragma unroll
        for (int ai = 0; ai < 2; ++ai)
#pragma unroll
            for (int m = 0; m < 4; ++m) {
                const size_t ro = (size_t)(row0 + ai * 128 + m * 16) * DM;
#pragma unroll
                for (int bj = 0; bj < 2; ++bj) {
                    const size_t o = ro + colb + bj * 128;
                    const af4 x0 = *(const af4*)(x + o), x1 = *(const af4*)(x + o + 4);
                    *(af4*)(out + o) = x0 + acc[ai][bj][m][0]; *(af4*)(out + o + 4) = x1 + acc[ai][bj][m][1];
                }
            }
    }
};
struct EpiGu {
    static constexpr bool PERM = true, AFTER_DRAIN = false;
    bf16* HID;
    DI void operator()(const af4 (&acc)[2][2][4][2], const pg8::Unit& u, int wr, int wc, int fr, int fq) const {
        const int row0 = u.pm * 256 + wr * 64 + fr, col = u.pn * 128 + wc * 32 + 8 * fq;
#pragma unroll
        for (int ai = 0; ai < 2; ++ai)
#pragma unroll
            for (int m = 0; m < 4; ++m) {
                const af4 g0 = acc[ai][0][m][0], g1 = acc[ai][0][m][1], u0 = acc[ai][1][m][0], u1 = acc[ai][1][m][1];
                float x[8];
#pragma unroll
                for (int i = 0; i < 4; ++i) { x[i] = fsilu(g0[i]) * u0[i]; x[4 + i] = fsilu(g1[i]) * u1[i]; }
                *(v4u*)(HID + (size_t)(row0 + ai * 128 + m * 16) * DEXP + col) = pack8(x);
            }
    }
};
struct EpiDown {
    static constexpr bool PERM = true, AFTER_DRAIN = false;
    bf16* YB; const float* wrow;
    DI void operator()(const af4 (&acc)[2][2][4][2], const pg8::Unit& u, int wr, int wc, int fr, int fq) const {
        const int row0 = u.pm * 256 + wr * 64 + fr, colb = u.pn * 256 + wc * 32 + 8 * fq;
#pragma unroll
        for (int ai = 0; ai < 2; ++ai)
#pragma unroll
            for (int m = 0; m < 4; ++m) {
                const int row = row0 + ai * 128 + m * 16; const float w = wrow[row];
#pragma unroll
                for (int bj = 0; bj < 2; ++bj) {
                    const af4 a0 = acc[ai][bj][m][0] * w, a1 = acc[ai][bj][m][1] * w;
                    const float x[8] = {a0[0], a0[1], a0[2], a0[3], a1[0], a1[1], a1[2], a1[3]};
                    *(v4u*)(YB + (size_t)row * DM + colb + bj * 128) = pack8(x);
                }
            }
    }
};
struct EpiPe {
    static constexpr bool PERM = true, AFTER_DRAIN = false;
    bf16* PE;
    DI void operator()(const af4 (&acc)[2][2][4][2], const pg8::Unit& u, int wr, int wc, int fr, int fq) const {
        const int row0 = u.pm * 256 + wr * 64 + fr, colb = u.pn * 256 + wc * 32 + 8 * fq;
#pragma unroll
        for (int ai = 0; ai < 2; ++ai)
#pragma unroll
            for (int m = 0; m < 4; ++m)
#pragma unroll
                for (int bj = 0; bj < 2; ++bj) {
                    const af4 a0 = acc[ai][bj][m][0], a1 = acc[ai][bj][m][1];
                    const float x[8] = {a0[0], a0[1], a0[2], a0[3], a1[0], a1[1], a1[2], a1[3]};
                    *(v4u*)(PE + (size_t)(row0 + ai * 128 + m * 16) * DM + colb + bj * 128) = pack8(x);
                }
    }
};
struct EpiPg {
    static constexpr bool PERM = true, AFTER_DRAIN = false;
    const bf16* PE; const float* x2; float* out;
    DI void operator()(const af4 (&acc)[2][2][4][2], const pg8::Unit& u, int wr, int wc, int fr, int fq) const {
        const int row0 = u.pm * 256 + wr * 64 + fr, colb = u.pn * 256 + wc * 32 + 8 * fq;
#pragma unroll
        for (int ai = 0; ai < 2; ++ai)
#pragma unroll
            for (int m = 0; m < 4; ++m) {
                const size_t ro = (size_t)(row0 + ai * 128 + m * 16) * DM;
#pragma unroll
                for (int bj = 0; bj < 2; ++bj) {
                    const size_t o = ro + colb + bj * 128;
                    float pe[8]; unpack8(*(const v4u*)(PE + o), pe);
                    const af4 a0 = acc[ai][bj][m][0], a1 = acc[ai][bj][m][1];
                    af4 x0 = *(const af4*)(x2 + o), x1 = *(const af4*)(x2 + o + 4);
#pragma unroll
                    for (int i = 0; i < 4; ++i) { x0[i] += fsigmoid(a0[i]) * pe[i]; x1[i] += fsigmoid(a1[i]) * pe[4 + i]; }
                    *(af4*)(out + o) = x0; *(af4*)(out + o + 4) = x1;
                }
                asm volatile("" ::: "memory");
            }
    }
};

struct MoeOrder {
    const LAS int* pst; int G, c; size_t estride, tstepB;
    DI bool next(int i, pg8::Unit& u) const {
        const int L = i * G + c, rt = L >> 2; if (rt * 256 >= pst[NEXP]) return false;
        int ex = 0;
#pragma unroll
        for (int e = 1; e < NEXP; ++e) ex += (rt * 256 >= pst[e]) ? 1 : 0;
        u.pm = rt; u.pn = L & 3; u.ex = ex; u.bofs = (size_t)ex * estride + (size_t)u.pn * tstepB; return true;
    }
    DI void a_ready(const pg8::Unit&) const {}
    DI void done(const pg8::Unit&) const {}
};

#define GEMM_PHASE(EPI, ORD, g, S, E) pg8::gemm_phase<EPI, ORD, true, true>(F.lds + RING_OFF, g, S, E)

DI void fast_proj(Frame& F, const Args& a) {
    unsigned char* ws = F.ws; const bf16* HB = (const bf16*)((unsigned char*)F.out + DO_HB); const bf16* WIN = (const bf16*)(ws + WS_WIN);
    { pg8::Gemm g{HB, WIN, DM, DM}; pg8::StaticOrder S; S.init(NTOK, NMAIN, DM, F.G, (int)blockIdx.x);
      EpiProj E{(bf16*)(ws + WS_PROJ), (const f32x2*)(ws + WS_TABA), a.in[4]}; GEMM_PHASE(EpiProj, pg8::StaticOrder, g, S, E); }
    { pg8::Gemm g{WIN + (size_t)NMAIN * DM, HB, DM, DM}; pg8::StaticOrder S; S.init(NTR, NTOK, DM, F.G, (int)blockIdx.x);
      EpiProjT E{(bf16*)(ws + WS_T), (const f32x2*)(ws + WS_TABB)}; GEMM_PHASE(EpiProjT, pg8::StaticOrder, g, S, E); }
}
DI void fast_br(Frame& F, const Args& a) {
    unsigned char* ws = F.ws; bf16* PROJ = (bf16*)(ws + WS_PROJ); const bf16* RS = (const bf16*)((unsigned char*)F.out + DO_RS);
    pg8::StaticOrder S; S.init(NTOK, DM, 512, F.G, (int)blockIdx.x);
    { pg8::Gemm g{RS, (const bf16*)(ws + WS_WBR1), DM, 512}; EpiBr E{PROJ, 0}; GEMM_PHASE(EpiBr, pg8::StaticOrder, g, S, E); }
    { pg8::Gemm g{RS + 512, (const bf16*)(ws + WS_WBR2), DM, 512}; EpiBr E{PROJ, 1}; GEMM_PHASE(EpiBr, pg8::StaticOrder, g, S, E); }
}
DI void fast_wout(Frame& F, const Args& a) {
    unsigned char* ws = F.ws;
    pg8::Gemm g{(const bf16*)(ws + WS_PROJ) + C_MG, (const bf16*)(ws + WS_WOUT), NMAIN, DM}; pg8::StaticOrder S; S.init(NTOK, DM, DM, F.G, (int)blockIdx.x);
    EpiWout E{F.x, F.out}; GEMM_PHASE(EpiWout, pg8::StaticOrder, g, S, E);
}
DI void fast_gu(Frame& F, const Args& a) {
    LAS int* pst = (LAS int*)(F.lds + LDSCTL_OFF);
    expert_table(F, pst);
    unsigned char* ws = F.ws;
    pg8::Gemm g{(const bf16*)(ws + WS_XB), (const bf16*)(ws + WS_WGU), DM, DM};
    MoeOrder S{pst, F.G, F.vcu, (size_t)1024 * 1024 * 2, (size_t)256 * DM * 2};
    EpiGu E{(bf16*)(ws + WS_HID)}; GEMM_PHASE(EpiGu, MoeOrder, g, S, E);
}
DI void fast_down(Frame& F, const Args& a) {
    LAS int* pst = (LAS int*)(F.lds + LDSCTL_OFF);
    expert_table(F, pst);
    unsigned char* ws = F.ws;
    pg8::Gemm g{(const bf16*)(ws + WS_HID), (const bf16*)(ws + WS_WD), DEXP, DEXP};
    MoeOrder S{pst, F.G, F.vcu, (size_t)1024 * 512 * 2, (size_t)256 * DEXP * 2};
    EpiDown E{(bf16*)(ws + WS_XB), (const float*)(ws + WS_ROUTE + RT_WROW)}; GEMM_PHASE(EpiDown, MoeOrder, g, S, E);
}
DI void fast_ple(Frame& F, const Args& a) {
    unsigned char* ws = F.ws;
    { int k256 = 256; asm volatile("" : "+s"(k256));
      pg8::Gemm g{(const bf16*)(ws + WS_PB), (const bf16*)(ws + WS_WPLE), 256, k256}; pg8::StaticOrder S; S.init(NTOK, DM, k256, F.G, (int)blockIdx.x);
      EpiPe E{(bf16*)(ws + WS_HID)}; GEMM_PHASE(EpiPe, pg8::StaticOrder, g, S, E); }
    { pg8::Gemm g{(const bf16*)(ws + WS_H2), (const bf16*)(ws + WS_WPG), DM, DM}; pg8::StaticOrder S; S.init(NTOK, DM, DM, F.G, (int)blockIdx.x);
      EpiPg E{(const bf16*)(ws + WS_HID), (const float*)(ws + WS_X2), F.out}; GEMM_PHASE(EpiPg, pg8::StaticOrder, g, S, E); }
}

#define MFMA32(a, b, c) __builtin_amdgcn_mfma_f32_32x32x16_bf16((a), (b), (c), 0, 0, 0)
DI int crow(int reg, int h) { return (reg & 3) + 8 * (reg >> 2) + 4 * h; }
DI bf16x8 ld16(const bf16* p) { return *(const bf16x8*)p; }
DI bf16x8 ld8x2(const bf16* p0, const bf16* p1) { const s16x4 lo = *(const s16x4*)p0, hi = *(const s16x4*)p1; return __builtin_shufflevector(lo, hi, 0, 1, 2, 3, 4, 5, 6, 7); }
template <int S> DI bf16x8 pack_step(const f32x16& x) { v4u p; p.x = cvtpk(x[8 * S], x[8 * S + 1]); p.y = cvtpk(x[8 * S + 2], x[8 * S + 3]); p.z = cvtpk(x[8 * S + 4], x[8 * S + 5]); p.w = cvtpk(x[8 * S + 6], x[8 * S + 7]); return __builtin_bit_cast(bf16x8, p); }
DI f32x16 splat16(float v) { f32x16 x;
#pragma unroll
    for (int i = 0; i < 16; ++i) x[i] = v; return x; }

#define SCHED_FENCE() __builtin_amdgcn_sched_barrier(0)
DI void fast_ret_kv(Frame& F, const Args& a) {
    const bf16* __restrict__ T = (const bf16*)(F.ws + WS_T); bf16* __restrict__ ST = (bf16*)((unsigned char*)F.out + DO_ST);
    const int lane = F.lane, r = lane & 31, h2 = lane >> 5, gw = F.vcu * NWAVES + F.wave, NGW = F.G * NWAVES;
    for (int it = gw; it < NBATCH * 4 * 64 * 4; it += NGW) {
        const int eb = it & 3, c = (it >> 2) & 63, hh = (it >> 8) & 3, b = it >> 10;
        const int tok0 = b * SEQ + c * 64;
        const bf16* vrow = T + (size_t)(T_VR + hh * 128 + eb * 32 + r) * NTOK + tok0 + 8 * h2;
        const bf16* krow = T + (size_t)(T_KT + hh * 128 + r) * NTOK + tok0 + 8 * h2;
        bf16x8 vb[4], ka[4][4];
#pragma unroll
        for (int ks = 0; ks < 4; ++ks) vb[ks] = ld16(vrow + 16 * ks);
#pragma unroll
        for (int db = 0; db < 4; ++db)
#pragma unroll
            for (int ks = 0; ks < 4; ++ks) ka[db][ks] = ld16(krow + (size_t)db * 32 * NTOK + 16 * ks);
        SCHED_FENCE();
        bf16* st = ST + ((size_t)((b * 4 + hh) * 64 + c)) * 16384 + (size_t)(eb * 32 + r) * 128 + 4 * h2;
#pragma unroll
        for (int db = 0; db < 4; ++db) {
            f32x16 acc = splat16(0.f);
#pragma unroll
            for (int ks = 0; ks < 4; ++ks) acc = MFMA32(ka[db][ks], vb[ks], acc);
#pragma unroll
            for (int g = 0; g < 4; ++g) { v2u w; w.x = cvtpk(acc[4 * g], acc[4 * g + 1]); w.y = cvtpk(acc[4 * g + 2], acc[4 * g + 3]); *(v2u*)(st + db * 32 + 8 * g) = w; }
        }
    }
}
DI void fast_ret_scan(Frame& F, const Args& a) {
    bf16* ST = (bf16*)((unsigned char*)F.out + DO_ST);
    for (int g = F.vcu * 512 + F.tid; g < NBATCH * 4 * 4096; g += F.G * 512) {
        const int bh = g >> 12, idx = (g & 4095) * 4;
        const float cdec = exp2f(ret_log2g(bh & 3) * 64.0f);
        bf16* p = ST + (size_t)bh * 64 * 16384 + idx;
        float s0 = 0.f, s1 = 0.f, s2 = 0.f, s3 = 0.f;
#pragma unroll 8
        for (int c = 0; c < 64; ++c) {
            const v2u w = *(const v2u*)(p + (size_t)c * 16384);
            v2u o; o.x = cvtpk(s0, s1); o.y = cvtpk(s2, s3); *(v2u*)(p + (size_t)c * 16384) = o;
            s0 = cdec * s0 + bflo(w.x); s1 = cdec * s1 + bfhi(w.x); s2 = cdec * s2 + bflo(w.y); s3 = cdec * s3 + bfhi(w.y);
        }
    }
}
DI void fast_ret_out(Frame& F, const Args& a) {
    const bf16* __restrict__ PROJ = (const bf16*)(F.ws + WS_PROJ); const bf16* __restrict__ T = (const bf16*)(F.ws + WS_T);
    const bf16* __restrict__ ST = (const bf16*)((unsigned char*)F.out + DO_ST); bf16* __restrict__ RS = (bf16*)((unsigned char*)F.out + DO_RS);
    const int lane = F.lane, r = lane & 31, h2 = lane >> 5, gw = F.vcu * NWAVES + F.wave, NGW = F.G * NWAVES;
    for (int it = gw; it < NBATCH * 4 * 64 * 2; it += NGW) {
        const int ib = it & 1, c = (it >> 1) & 63, hh = (it >> 7) & 3, b = it >> 9;
        const int tok0 = b * SEQ + c * 64;
        const float l2g = ret_log2g(hh);
        const bf16* qrow = PROJ + (size_t)(tok0 + ib * 32 + r) * NMAIN + C_RQ + hh * 128 + 8 * h2;
        const bf16* krow = PROJ + (size_t)(tok0 + r) * NMAIN + C_RK + hh * 128 + 8 * h2;
        const bf16* stb = ST + ((size_t)((b * 4 + hh) * 64 + c)) * 16384 + (size_t)r * 128 + 8 * h2;
        const bf16* vrow = T + (size_t)(T_VR + hh * 128 + r) * NTOK + tok0 + 4 * h2;
        const bf16* gp = PROJ + (size_t)(tok0 + ib * 32 + r) * NMAIN + C_RG + hh * 128 + 4 * h2;
        bf16x8 qf[8], kf0[8], kf1[8], sA[8], sB[8], vA[4], vB[4];
#define LD_ST(dst, eb) do { _Pragma("unroll") for (int ks = 0; ks < 8; ++ks) dst[ks] = ld16(stb + (size_t)(eb) * 32 * 128 + 16 * ks); } while (0)
#define LD_VT(dst, eb) do { const bf16* vr_ = vrow + (size_t)(eb) * 32 * NTOK; dst[0] = ld8x2(vr_, vr_ + 8); dst[1] = ld8x2(vr_ + 16, vr_ + 24); dst[2] = ld8x2(vr_ + 32, vr_ + 40); dst[3] = ld8x2(vr_ + 48, vr_ + 56); } while (0)
#define RET_EB(oacc, sfr, vfr) do { f32x16 acc_ = splat16(0.f); \
            _Pragma("unroll") for (int ks = 0; ks < 8; ++ks) acc_ = MFMA32(sfr[ks], qf[ks], acc_);         \
            _Pragma("unroll") for (int reg = 0; reg < 16; ++reg) acc_[reg] *= qd; \
            acc_ = MFMA32(vfr[0], pb[0][0], acc_); acc_ = MFMA32(vfr[1], pb[0][1], acc_); acc_ = MFMA32(vfr[2], pb[1][0], acc_); acc_ = MFMA32(vfr[3], pb[1][1], acc_); oacc = acc_; } while (0)
#pragma unroll
        for (int ks = 0; ks < 8; ++ks) qf[ks] = ld16(qrow + 16 * ks);
#pragma unroll
        for (int ks = 0; ks < 8; ++ks) { kf0[ks] = ld16(krow + 16 * ks); kf1[ks] = ld16(krow + (size_t)32 * NMAIN + 16 * ks); }
        LD_ST(sA, 0); LD_VT(vA, 0);
        SCHED_FENCE();
        f32x16 pt0 = splat16(0.f), pt1 = splat16(0.f);
#pragma unroll
        for (int ks = 0; ks < 8; ++ks) { pt0 = MFMA32(kf0[ks], qf[ks], pt0); pt1 = MFMA32(kf1[ks], qf[ks], pt1); }
        LD_ST(sB, 1); LD_VT(vB, 1);
        SCHED_FENCE();
        bf16x8 pb[2][2];
#pragma unroll
        for (int reg = 0; reg < 16; ++reg) {
            const int d0 = (ib * 32 + r) - crow(reg, h2), d1 = d0 - 32;
            pt0[reg] *= __builtin_amdgcn_exp2f(l2g * (float)(d0 < 0 ? -d0 : d0)); pt1[reg] *= __builtin_amdgcn_exp2f(l2g * (float)(d1 < 0 ? -d1 : d1));
        }
        pb[0][0] = pack_step<0>(pt0); pb[0][1] = pack_step<1>(pt0); pb[1][0] = pack_step<0>(pt1); pb[1][1] = pack_step<1>(pt1);
        const float qd = __builtin_amdgcn_exp2f(l2g * (float)(ib * 32 + r + 1));
        f32x16 o[4];
        RET_EB(o[0], sA, vA);
        LD_ST(sA, 2); LD_VT(vA, 2);
        SCHED_FENCE();
        RET_EB(o[1], sB, vB);
        LD_ST(sB, 3); LD_VT(vB, 3);
        SCHED_FENCE();
        RET_EB(o[2], sA, vA);
        v2u gate[16];
#pragma unroll
        for (int q = 0; q < 16; ++q) gate[q] = *(const v2u*)(gp + (q >> 2) * 32 + 8 * (q & 3));
        SCHED_FENCE();
        RET_EB(o[3], sB, vB);
#undef LD_ST
#undef LD_VT
#undef RET_EB
        float s = 0.f;
#pragma unroll
        for (int eb = 0; eb < 4; ++eb)
#pragma unroll
            for (int reg = 0; reg < 16; ++reg) s += o[eb][reg];
        s += __shfl_xor(s, 32);
        const float mu = s * (1.0f / 128.0f); float v = 0.f;
#pragma unroll
        for (int eb = 0; eb < 4; ++eb)
#pragma unroll
            for (int reg = 0; reg < 16; ++reg) { const float d = o[eb][reg] - mu; v += d * d; }
        v += __shfl_xor(v, 32);
        const float rstd = rsqrtf(v * (1.0f / 128.0f) + EPS);
        bf16* rp = RS + (size_t)(tok0 + ib * 32 + r) * DM + hh * 128 + 4 * h2;
#pragma unroll
        for (int eb = 0; eb < 4; ++eb)
#pragma unroll
            for (int g = 0; g < 4; ++g) {
                const v2u gt = gate[eb * 4 + g];
                v2u w;
                w.x = cvtpk((o[eb][4 * g] - mu) * rstd * bflo(gt.x), (o[eb][4 * g + 1] - mu) * rstd * bfhi(gt.x));
                w.y = cvtpk((o[eb][4 * g + 2] - mu) * rstd * bflo(gt.y), (o[eb][4 * g + 3] - mu) * rstd * bfhi(gt.y));
                *(v2u*)(rp + eb * 32 + 8 * g) = w;
            }
    }
}

DI void fast_att(Frame& F, const Args& a) {
    const bf16* __restrict__ PROJ = (const bf16*)(F.ws + WS_PROJ); const bf16* __restrict__ T = (const bf16*)(F.ws + WS_T); bf16* __restrict__ RS = (bf16*)((unsigned char*)F.out + DO_RS);
    const int lane = F.lane, r = lane & 31, h2 = lane >> 5, gw = F.vcu * NWAVES + F.wave, NGW = F.G * NWAVES;
    bf16x8 tri0, tri1, ones;
#pragma unroll
    for (int j = 0; j < 8; ++j) { const int k0 = 8 * (j >> 2) + 4 * h2 + (j & 3); tri0[j] = (k0 > r) ? (short)0x3F80 : (short)0; tri1[j] = (16 + k0 > r) ? (short)0x3F80 : (short)0; ones[j] = (short)0x3F80; }
    for (int it = gw; it < NBATCH * 8 * 128; it += NGW) {
        const int qb = it & 127, hh = (it >> 7) & 7, b = it >> 10;
        const int q0 = qb * 32, tokq = b * SEQ + q0 + r;
        const bf16* qrow = PROJ + (size_t)tokq * NMAIN + C_SQ + hh * 64 + 8 * h2;
        const bf16* kbase = PROJ + (size_t)(b * SEQ + r) * NMAIN + C_SK + hh * 64 + 8 * h2;
        const bf16* vbase = T + (size_t)(T_VS + hh * 64 + r) * NTOK + b * SEQ + 4 * h2;
        const int ktd = q0 >> 6;
        bf16x8 qf[4], kA[8], vB[8];
#pragma unroll
        for (int ks = 0; ks < 4; ++ks) qf[ks] = ld16(qrow + 16 * ks);
#pragma unroll
        for (int ks = 0; ks < 4; ++ks) { kA[ks] = ld16(kbase + (size_t)(ktd * 64) * NMAIN + 16 * ks); kA[4 + ks] = ld16(kbase + (size_t)(ktd * 64 + 32) * NMAIN + 16 * ks); }
        f32x16 o0 = splat16(0.f), o1 = splat16(0.f);
        float carry = 0.f;
        for (int kt = ktd; kt >= 0; --kt) {
            const int key0 = kt * 64;
            const bool diag = (kt == ktd);
            {
                const bf16* v0row = vbase + key0; const bf16* v1row = v0row + (size_t)32 * NTOK;
#pragma unroll
                for (int q = 0; q < 4; ++q) { vB[q] = ld8x2(v0row + 16 * q, v0row + 16 * q + 8); vB[4 + q] = ld8x2(v1row + 16 * q, v1row + 16 * q + 8); }
            }
            SCHED_FENCE();
            f32x16 p0 = splat16(0.f), p1 = splat16(0.f);
#pragma unroll
            for (int ks = 0; ks < 4; ++ks) { p0 = MFMA32(kA[ks], qf[ks], p0); p1 = MFMA32(kA[4 + ks], qf[ks], p1); }
            {
                const int kn = (kt > 0 ? kt - 1 : 0) * 64;
#pragma unroll
                for (int ks = 0; ks < 4; ++ks) { kA[ks] = ld16(kbase + (size_t)kn * NMAIN + 16 * ks); kA[4 + ks] = ld16(kbase + (size_t)(kn + 32) * NMAIN + 16 * ks); }
            }
            SCHED_FENCE();
            f32x16 l0, l1;
#pragma unroll
            for (int reg = 0; reg < 16; ++reg) {
                const float z0 = fminf(p0[reg], 100.0f), z1 = fminf(p1[reg], 100.0f);
                float a0 = -__builtin_amdgcn_logf(1.0f + __builtin_amdgcn_exp2f(z0)), a1 = -__builtin_amdgcn_logf(1.0f + __builtin_amdgcn_exp2f(z1));
                float b0 = z0 + a0, b1 = z1 + a1;
                if (diag) {
                    const bool v0 = (key0 + crow(reg, h2)) < (q0 + r), v1 = (key0 + 32 + crow(reg, h2)) < (q0 + r);
                    a0 = v0 ? a0 : 0.f; b0 = v0 ? b0 : -1.0e30f; a1 = v1 ? a1 : 0.f; b1 = v1 ? b1 : -1.0e30f;
                }
                l0[reg] = a0; l1[reg] = a1; p0[reg] = b0; p1[reg] = b1;
            }
            f32x16 y0 = splat16(carry), y1 = y0;
            {
                const bf16x8 x00 = pack_step<0>(l0), x01 = pack_step<1>(l0), x10 = pack_step<0>(l1), x11 = pack_step<1>(l1);
                y0 = MFMA32(tri0, x00, y0); y0 = MFMA32(tri1, x01, y0); y0 = MFMA32(ones, x10, y0); y0 = MFMA32(ones, x11, y0);
                y1 = MFMA32(tri0, x10, y1); y1 = MFMA32(tri1, x11, y1);
            }
            const float tot = y0[0] + l0[0];
            carry = __shfl(tot, r);
#pragma unroll
            for (int reg = 0; reg < 16; ++reg) { p0[reg] = __builtin_amdgcn_exp2f(p0[reg] + y0[reg]); p1[reg] = __builtin_amdgcn_exp2f(p1[reg] + y1[reg]); }
            {
                const bf16x8 a00 = pack_step<0>(p0), a01 = pack_step<1>(p0), a10 = pack_step<0>(p1), a11 = pack_step<1>(p1);
                o0 = MFMA32(vB[0], a00, o0); o0 = MFMA32(vB[1], a01, o0); o0 = MFMA32(vB[2], a10, o0); o0 = MFMA32(vB[3], a11, o0);
                o1 = MFMA32(vB[4], a00, o1); o1 = MFMA32(vB[5], a01, o1); o1 = MFMA32(vB[6], a10, o1); o1 = MFMA32(vB[7], a11, o1);
            }
            if (__all(carry < SB_EXIT)) break;
        }
        bf16* op = RS + (size_t)tokq * DM + 512 + hh * 64 + 4 * h2;
#pragma unroll
        for (int g = 0; g < 4; ++g) {
            v2u w; w.x = cvtpk(o0[4 * g], o0[4 * g + 1]); w.y = cvtpk(o0[4 * g + 2], o0[4 * g + 3]); *(v2u*)(op + 8 * g) = w;
            v2u u; u.x = cvtpk(o1[4 * g], o1[4 * g + 1]); u.y = cvtpk(o1[4 * g + 2], o1[4 * g + 3]); *(v2u*)(op + 32 + 8 * g) = u;
        }
    }
}

__global__ void __launch_bounds__(NWAVES * 64, 2) mega(Args args) {
    extern __shared__ __attribute__((aligned(16))) unsigned char lds[];
    Frame F;
    F.lds = (LAS unsigned char*)lds;
    F.MISC = (volatile LAS unsigned*)(F.lds + MISC_OFF);
    F.refresh();
    F.G = gridDim.x; { const int bx = blockIdx.x; F.vcu = (F.G % 8 == 0) ? (bx % 8) * (F.G / 8) + bx / 8 : bx; }
    F.ws = args.ws; F.out = args.out; F.x = args.in[0]; F.p = args.in[1];
    F.ctl = (gu32*)(args.ws + WS_CTL);
    for (int u = F.tid; u < (LDS_BYTES - LDSCTL_OFF) / 4; u += NWAVES * 64) ((LAS unsigned*)(F.lds + LDSCTL_OFF))[u] = 0u;
    __syncthreads();
    const int lo = args.ph_lo, hi = args.ph_hi;
    XcdBarrier bar; bar.bar = (unsigned*)(F.ctl + CW_BAR) + args.li * BAR_STRIDE; bar.x = 0; bar.st = nullptr;
    if (hi - lo > 1) bar = xcd_barrier_post((unsigned*)(F.ctl + CW_BAR) + args.li * BAR_STRIDE, F.MISC + 8);
#define IN(k) (F.refresh(), lo <= (k) && (k) < hi)
#define DUP(k) ((DUP_MASK >> (k)) & 1)
#define SEAM(k) do { if (IN(k) && IN((k) + 1)) xcd_barrier(bar); } while (0)
#define REP(k, body) do { body; if (DUP(k)) { F.refresh(); body; } } while (0)

    if (IN(PH_PRO)) { REP(PH_PRO, ph_prologue(F, args)); } SEAM(PH_PRO);
    if (IN(PH_PROJ)) { REP(PH_PROJ, fast_proj(F, args)); } SEAM(PH_PROJ);
    if (IN(PH_MIX1)) { REP(14, fast_ret_kv(F, args)); REP(15, fast_att(F, args)); } SEAM(PH_MIX1);
    if (IN(PH_SCAN)) { fast_ret_scan(F, args); } SEAM(PH_SCAN);
    if (IN(PH_RETO)) { REP(PH_RETO, fast_ret_out(F, args)); } SEAM(PH_RETO);
    if (IN(PH_BR)) { REP(PH_BR, fast_br(F, args)); } SEAM(PH_BR);
    if (IN(PH_WOUT)) { REP(PH_WOUT, fast_wout(F, args)); } SEAM(PH_WOUT);
    if (IN(PH_ROUTE)) { ph_route(F, args); } SEAM(PH_ROUTE);
    if (IN(PH_GATHER)) { REP(PH_GATHER, ph_gather(F, args)); } SEAM(PH_GATHER);
    if (IN(PH_GU)) { REP(PH_GU, fast_gu(F, args)); } SEAM(PH_GU);
    if (IN(PH_DOWN)) { REP(PH_DOWN, fast_down(F, args)); } SEAM(PH_DOWN);
    if (IN(PH_COMB)) { REP(PH_COMB, ph_combine(F, args)); } SEAM(PH_COMB);
    if (IN(PH_PLE)) { REP(PH_PLE, fast_ple(F, args)); } SEAM(PH_PLE);
    if (IN(PH_FINAL)) { ph_final(F, args); }
#undef IN
#undef SEAM
}

extern "C" void kernel_launch(void* const* d_in, const int* in_sizes, int n_in, void* d_out, int out_size, void* d_ws, size_t ws_size, hipStream_t stream) {
    static int grid = 0;
    if (grid == 0) {
        if (n_in != 20 || in_sizes[0] != NTOK * DM || out_size != NTOK * DM || ws_size < WS_END) { fprintf(stderr, "kernel_launch: unexpected shapes (n_in %d, in0 %d, out %d, ws %zu)\n", n_in, n_in > 0 ? in_sizes[0] : -1, out_size, ws_size); grid = -1; return; }
        int dev = 0, cus = 0, per_cu = 0;
        if (hipGetDevice(&dev) != hipSuccess || hipDeviceGetAttribute(&cus, hipDeviceAttributeMultiprocessorCount, dev) != hipSuccess) { grid = -1; return; }
        if (hipFuncSetAttribute((const void*)mega, hipFuncAttributeMaxDynamicSharedMemorySize, LDS_BYTES) != hipSuccess) { fprintf(stderr, "kernel_launch: hipFuncSetAttribute failed\n"); grid = -1; return; }
        if (hipOccupancyMaxActiveBlocksPerMultiprocessor(&per_cu, (const void*)mega, NWAVES * 64, LDS_BYTES) != hipSuccess || per_cu < 1) fprintf(stderr, "kernel_launch: occupancy query reports %d\n", per_cu);
        (void)hipGetLastError();
        grid = cus;
    }
    if (grid < 0) return;
    unsigned char* ws = (unsigned char*)d_ws;
    if (hipMemsetAsync(ws + WS_CTL, 0, CTL_ZERO_BYTES, stream) != hipSuccess) return;
    Args a{};
    for (int i = 0; i < 20; ++i) a.in[i] = (const float*)d_in[i];
    a.out = (float*)d_out; a.ws = ws;
#if SPLIT_PHASES
    for (int p = 0; p < NPH; ++p) { a.ph_lo = p; a.ph_hi = p + 1; a.li = 0; hipLaunchKernelGGL(mega, dim3(grid), dim3(NWAVES * 64), LDS_BYTES, stream, a); }
#else
    a.ph_lo = 0; a.ph_hi = NPH; a.li = 0;
    hipLaunchKernelGGL(mega, dim3(grid), dim3(NWAVES * 64), LDS_BYTES, stream, a);
#endif
}
```

```cpp
#define DUP_MASK 0
#include <hip/hip_runtime.h>
#include <cstdio>
#include <cstdint>

#ifndef SPLIT_PHASES
#define SPLIT_PHASES 0
#endif
#ifndef DUP_MASK
#define DUP_MASK 0
#endif

constexpr int NTOK = 32768, DM = 1024, SEQ = 4096, NBATCH = 8;
constexpr int NMAIN = 4608, NTR = 1536, NWIN = 5632;
constexpr int C_RQ = 0, C_RK = 512, C_RG = 1024, C_SQ = 1536, C_SK = 2048, C_GR = 2560, C_GS = 3584;
constexpr int C_MG = 0;
constexpr int T_KT = 0, T_VR = 512, T_VS = 1024;
constexpr int NEXP = 16, DEXP = 512, MPAD_MAX = 65536 + 16 * 256, NRT_MAX = MPAD_MAX / 256;
constexpr float EPS = 1e-6f;
constexpr float LOG2E = 1.4426950408889634f;
constexpr float SB_QSCALE = 0.125f * LOG2E;
constexpr float SB_EXIT = -160.0f;

constexpr size_t MiB = 1u << 20;
constexpr size_t WS_CTL = 0, CTL_ZERO_BYTES = 1 * MiB;
constexpr size_t WS_WIN = 2 * MiB;
constexpr size_t WS_WBR1 = 14 * MiB;
constexpr size_t WS_WBR2 = 15 * MiB;
constexpr size_t WS_WOUT = 16 * MiB;
constexpr size_t WS_WGU = 18 * MiB;
constexpr size_t WS_WD = 50 * MiB;
constexpr size_t WS_WPLE = 66 * MiB;
constexpr size_t WS_WPG = 67 * MiB;
constexpr size_t WS_TABA = 70 * MiB;
constexpr size_t WS_TABB = 72 * MiB;
constexpr size_t WS_ROUTE = 74 * MiB;
constexpr size_t WS_PB = 76 * MiB;
constexpr size_t WS_PROJ = 92 * MiB;
constexpr size_t WS_T = 380 * MiB;
constexpr size_t WS_X2 = 360 * MiB;
constexpr size_t WS_END = 488 * MiB;
constexpr size_t WS_H2 = 92 * MiB;
constexpr size_t WS_XB = 156 * MiB;
constexpr size_t WS_HID = 292 * MiB;
constexpr size_t DO_HB = 0, DO_ST = 0, DO_X1 = 0, DO_RS = 64 * MiB;
constexpr size_t RT_EID = 0, RT_WGT = 256 * 1024, RT_RANK = 512 * 1024, RT_POS = 768 * 1024, RT_WROW = 1024 * 1024, RT_TILE = 1536 * 1024;
constexpr int CW_TMO = 0, CW_CODE = 1;
constexpr int CW_CNT = 64;
constexpr int CW_BAR = 4096, BAR_STRIDE = 4096;

#define GAS __attribute__((address_space(1)))
#define LAS __attribute__((address_space(3)))
typedef unsigned short bf16;
typedef unsigned v4u __attribute__((ext_vector_type(4)));
typedef unsigned v2u __attribute__((ext_vector_type(2)));
typedef float f32x4 __attribute__((ext_vector_type(4)));
typedef float f32x2 __attribute__((ext_vector_type(2)));
typedef float f32x16 __attribute__((ext_vector_type(16)));
typedef short bf16x8 __attribute__((ext_vector_type(8)));
typedef short s16x4 __attribute__((ext_vector_type(4)));
typedef GAS unsigned gu32;
#define RLX_AGENT __ATOMIC_RELAXED, __HIP_MEMORY_SCOPE_AGENT
#define LDS_WAIT() asm volatile("s_waitcnt lgkmcnt(0)" ::: "memory")
#define VM_WAIT() asm volatile("s_waitcnt vmcnt(0)" ::: "memory")
#define DI __device__ __forceinline__
DI unsigned f2bf(float f) { unsigned u = __builtin_bit_cast(unsigned, f); return (u + 0x7fffu + ((u >> 16) & 1u)) >> 16; }
DI unsigned pk2(float lo, float hi) { return f2bf(lo) | (f2bf(hi) << 16); }
DI float bf2f(unsigned b) { return __builtin_bit_cast(float, b << 16); }
DI float bflo(unsigned w) { return __builtin_bit_cast(float, w << 16); }
DI float bfhi(unsigned w) { return __builtin_bit_cast(float, w & 0xffff0000u); }
DI float fsigmoid(float x) { return 1.0f / (1.0f + __expf(-x)); }
DI float fsilu(float x) { return x / (1.0f + __expf(-x)); }
DI float wave_sum(float v) {
#pragma unroll
    for (int o = 1; o < 64; o <<= 1) v += __shfl_xor(v, o);
    return v;
}
template <int CTRL, int ROWMASK> DI float dpp_add(float v) { return v + __builtin_bit_cast(float, __builtin_amdgcn_update_dpp(0, __builtin_bit_cast(int, v), CTRL, ROWMASK, 0xF, false)); }
DI float wave_sum_dpp(float v) {
    v = dpp_add<0xB1, 0xF>(v);
    v = dpp_add<0x4E, 0xF>(v);
    v = dpp_add<0x141, 0xF>(v);
    v = dpp_add<0x140, 0xF>(v);
    v = dpp_add<0x142, 0xA>(v);
    v = dpp_add<0x143, 0xC>(v);
    return __builtin_bit_cast(float, __builtin_amdgcn_readlane(__builtin_bit_cast(int, v), 63));
}
DI float ret_log2g(int h) { return log2f(1.0f - exp2f(-5.0f - (float)h)); }

__host__ __device__ __forceinline__ int in_src(int r) {
    if (r < 1024) { const int base = (r < 512) ? 0 : 512; const int i = r & 511, h = i >> 7, j = i & 127; return base + h * 128 + (j & 1) * 64 + (j >> 1); }
    if (r < 1536) return 1536 + (r - 1024);
    if (r < 2048) return 2048 + (r - 1536);
    if (r < 2560) return 2560 + (r - 2048);
    if (r < 3584) return 3584 + (r - 2560);
    if (r < 4608) return 4608 + (r - 3584);
    if (r < 5120) { const int i = r - 4608, h = i >> 7, j = i & 127; return 512 + h * 128 + (j & 1) * 64 + (j >> 1); }
    if (r < 5632) return 1024 + (r - 5120);
    return 3072 + (r - 5632);
}


namespace pg8 {
#define PG8_LAS __attribute__((address_space(3)))
typedef unsigned short bf16_t;
typedef short bf16x8 __attribute__((ext_vector_type(8)));
typedef float f32x4 __attribute__((ext_vector_type(4)));
typedef unsigned u32x4 __attribute__((ext_vector_type(4)));
constexpr int BM = 256, BK = 64, HALF = 128, HTB = HALF * BK * 2  , STAGE_BYTES = 8 * HTB, NXCD = 8, WGM = 8;

__host__ __device__ __forceinline__ int lds_byte(int r, int c) { const int st = (r >> 4) * 2 + (c >> 5), rr = r & 15, cc = c & 31, ob = rr * 64 + cc * 2; return st * 1024 + (ob ^ (((ob >> 9) & 1) << 5)); }
__host__ __device__ __forceinline__ void stage_rc(int b, int& R, int& C) { const int st = b / 1024, sb = b % 1024, swz = sb ^ (((sb >> 9) & 1) << 5); R = (st >> 1) * 16 + swz / 64; C = (st & 1) * 32 + (swz % 64) / 2; }
__host__ __device__ __forceinline__ int perm32(int rho) { const int n = rho >> 4, i = rho & 15; return 8 * (i >> 2) + 4 * n + (i & 3); }

struct Unit { int pm, pn; size_t bofs; int ex; };
struct Gemm { const bf16_t* A; const bf16_t* Bt; int lda, K; };

struct StaticOrder {
    int nM, nN, nwg, G, c; size_t tstepB;
    __device__ void init(int M, int N, int K, int G_, int c_) { nM = M / BM; nN = N / BM; nwg = nM * nN; G = G_; c = c_; tstepB = (size_t)BM * K * 2; }
    __device__ bool next(int i, Unit& u) const {
        const long L = (long)i * G + c; if (L >= nwg) return false;
        int wgid = (int)L; { const int q = nwg / NXCD, r = nwg % NXCD, xcd = wgid % NXCD, off = wgid / NXCD; wgid = (xcd < r ? xcd * (q + 1) : r * (q + 1) + (xcd - r) * q) + off; }
        const int nig = WGM * nN, gid = wgid / nig, fm = gid * WGM, gsz = (nM - fm) < WGM ? (nM - fm) : WGM;
        u.pm = fm + ((wgid % nig) % gsz); u.pn = (wgid % nig) / gsz; u.bofs = (size_t)u.pn * tstepB; u.ex = 0; return true;
    }
    __device__ __forceinline__ void a_ready(const Unit&) const {}
    __device__ __forceinline__ void done(const Unit&) const {}
};
__device__ __forceinline__ unsigned cvt_pk_bf16(float lo, float hi) { unsigned r; asm volatile("v_cvt_pk_bf16_f32 %0, %1, %2" : "=v"(r) : "v"(lo), "v"(hi)); return r; }
template <class Epi, class Sched, bool ALIGN_EPI = false, bool SP2 = false>
__device__ __forceinline__ void gemm_phase(PG8_LAS unsigned char* lds, const Gemm g, const Sched& S, const Epi& E) {
    int tid_ = threadIdx.x; asm volatile("" : "+v"(tid_));
    const int tid = tid_, wid = __builtin_amdgcn_readfirstlane(tid >> 6), lane = tid & 63, wr = wid >> 2, wc = wid & 3, fr = lane & 15, fq = lane >> 4;
    const int K = g.K, nt = K / BK;
    unsigned voffA[2], voffB[2];
#pragma unroll
    for (int i = 0; i < 2; ++i) { int R, C; stage_rc(tid * 16 + i * 8192, R, C); const int Rb = Epi::PERM ? ((R & ~31) + perm32(R & 31)) : R;
        voffA[i] = (unsigned)(R * g.lda + C) * 2u; voffB[i] = (unsigned)(Rb * K + C) * 2u; }
    const size_t kstep = (size_t)(BK * 2);
    const size_t hstepA = (size_t)HALF * g.lda * 2, hstepB = (size_t)HALF * K * 2;
    const size_t tstepA = 2 * hstepA;
    const unsigned ldsw = (unsigned)wid * 1024u;
    const int aoff = lds_byte(wr * 64 + fr, fq * 8), boff = lds_byte(wc * 32 + fr, fq * 8);
#define PG8_SA(b, h) (((b) * 2 + (h)) * HTB)
#define PG8_SB(b, h) ((4 + (b) * 2 + (h)) * HTB)
#define PG8_STAGE(bufoff, gbase, voff) do { _Pragma("unroll") for (int _i = 0; _i < 2; ++_i) \
        __builtin_amdgcn_global_load_lds((const unsigned*)((const char*)(gbase) + (voff)[_i]), (PG8_LAS unsigned*)(lds + (bufoff) + ldsw + _i * 8192), 16, 0, 0); } while (0)
#define PG8_LDA(dst, b, h) do { _Pragma("unroll") for (int m = 0; m < 4; ++m) _Pragma("unroll") for (int k = 0; k < 2; ++k) dst[m][k] = *(const PG8_LAS bf16x8*)(lds + PG8_SA(b, h) + aoff + m * 2048 + k * 1024); } while (0)
#define PG8_LDB(dst, b, h) do { _Pragma("unroll") for (int n = 0; n < 2; ++n) _Pragma("unroll") for (int k = 0; k < 2; ++k) dst[n][k] = *(const PG8_LAS bf16x8*)(lds + PG8_SB(b, h) + boff + n * 2048 + k * 1024); } while (0)
#define PG8_MMA(ai, bj, At, Bt) do { __builtin_amdgcn_s_setprio(1); _Pragma("unroll") for (int m = 0; m < 4; ++m) _Pragma("unroll") for (int n = 0; n < 2; ++n) _Pragma("unroll") for (int k = 0; k < 2; ++k) \
        acc[ai][bj][m][n] = __builtin_amdgcn_mfma_f32_16x16x32_bf16(Bt[n][k], At[m][k], acc[ai][bj][m][n], 0, 0, 0); __builtin_amdgcn_s_setprio(0); } while (0)
#define PG8_WAIT_V(n) asm volatile("s_waitcnt vmcnt(" #n ")" ::: "memory")
#define PG8_WAIT_L(n) asm volatile("s_waitcnt lgkmcnt(" #n ")" ::: "memory")
#define PG8_BAR __builtin_amdgcn_s_barrier()
#define PG8_SCHED __builtin_amdgcn_sched_barrier(0)
    Unit cur, nxt; int ui = 0;
    if (!S.next(0, cur)) return;
    f32x4 acc[2][2][4][2];
#pragma unroll
    for (int a = 0; a < 2; ++a)
#pragma unroll
        for (int b = 0; b < 2; ++b)
#pragma unroll
            for (int m = 0; m < 4; ++m)
#pragma unroll
                for (int n = 0; n < 2; ++n) acc[a][b][m][n] = (f32x4){0.f, 0.f, 0.f, 0.f};
    bf16x8 At[4][2], B0[2][2], B1[2][2];
    const char* cA = (const char*)g.A + (size_t)cur.pm * tstepA; const char* cB = (const char*)g.Bt + cur.bofs;
    S.a_ready(cur);
    if constexpr (SP2) {
        PG8_STAGE(PG8_SB(0, 0), cB, voffB); PG8_STAGE(PG8_SB(0, 1), cB + hstepB, voffB); PG8_STAGE(PG8_SA(0, 0), cA, voffA); PG8_STAGE(PG8_SA(0, 1), cA + hstepA, voffA);
        if (wr == 1) PG8_BAR;
        PG8_WAIT_V(2); PG8_BAR;
        PG8_STAGE(PG8_SB(1, 0), cB + kstep, voffB); PG8_STAGE(PG8_SA(1, 0), cA + kstep, voffA); PG8_STAGE(PG8_SB(1, 1), cB + hstepB + kstep, voffB);
        PG8_WAIT_V(6); PG8_BAR;
    } else {
        PG8_STAGE(PG8_SB(0, 0), cB, voffB); PG8_STAGE(PG8_SA(0, 0), cA, voffA); PG8_STAGE(PG8_SB(0, 1), cB + hstepB, voffB); PG8_STAGE(PG8_SA(0, 1), cA + hstepA, voffA);
        if (wr == 1) PG8_BAR;
        PG8_WAIT_V(4); PG8_BAR;
        PG8_STAGE(PG8_SB(1, 0), cB + kstep, voffB); PG8_STAGE(PG8_SA(1, 0), cA + kstep, voffA); PG8_STAGE(PG8_SB(1, 1), cB + hstepB + kstep, voffB);
        PG8_WAIT_V(6); PG8_BAR;
    }
    for (;;) {
        const bool has_next = S.next(ui + 1, nxt);
        const char* nA = has_next ? (const char*)g.A + (size_t)nxt.pm * tstepA : cA; const char* nB = has_next ? (const char*)g.Bt + nxt.bofs : cB;
        for (int t = 0; t < nt; t += 2) {
            const bool last = (t == nt - 2);
            const char* a1 = cA + (size_t)(t + 1) * kstep;
            const char* a2 = last ? nA : cA + (size_t)(t + 2) * kstep; const char* b2 = last ? nB : cB + (size_t)(t + 2) * kstep;
            const char* a3 = a2 + kstep; const char* b3 = b2 + kstep;
            if (last && has_next) S.a_ready(nxt);
            if constexpr (SP2) {
            PG8_LDB(B0, 0, 0); PG8_LDB(B1, 0, 1); PG8_SCHED; PG8_LDA(At, 0, 0); PG8_STAGE(PG8_SA(1, 1), a1 + hstepA, voffA);
            PG8_WAIT_V(8); PG8_WAIT_L(0); PG8_BAR; PG8_MMA(0, 0, At, B0); PG8_MMA(0, 1, At, B1); PG8_BAR; PG8_SCHED;
            PG8_LDA(At, 0, 1); PG8_STAGE(PG8_SB(0, 0), b2, voffB); PG8_STAGE(PG8_SB(0, 1), b2 + hstepB, voffB); PG8_STAGE(PG8_SA(0, 0), a2, voffA);
            PG8_WAIT_V(8); PG8_WAIT_L(0); PG8_BAR; PG8_MMA(1, 0, At, B0); PG8_MMA(1, 1, At, B1); PG8_BAR; PG8_SCHED;
            PG8_LDB(B0, 1, 0); PG8_LDB(B1, 1, 1); PG8_SCHED; PG8_LDA(At, 1, 0); PG8_STAGE(PG8_SA(0, 1), a2 + hstepA, voffA);
            PG8_WAIT_V(8); PG8_WAIT_L(0); PG8_BAR; PG8_MMA(0, 0, At, B0); PG8_MMA(0, 1, At, B1); PG8_BAR; PG8_SCHED;
            PG8_LDA(At, 1, 1); PG8_STAGE(PG8_SB(1, 0), b3, voffB); PG8_STAGE(PG8_SB(1, 1), b3 + hstepB, voffB); PG8_STAGE(PG8_SA(1, 0), a3, voffA);
            PG8_WAIT_V(8); PG8_WAIT_L(0); PG8_BAR; PG8_MMA(1, 0, At, B0); PG8_MMA(1, 1, At, B1); PG8_BAR; PG8_SCHED;
            } else {
            PG8_LDB(B0, 0, 0); PG8_SCHED; PG8_LDA(At, 0, 0); PG8_STAGE(PG8_SA(1, 1), a1 + hstepA, voffA);
            PG8_WAIT_L(8); PG8_BAR; PG8_WAIT_L(0); PG8_MMA(0, 0, At, B0); PG8_BAR; PG8_SCHED;
            PG8_LDB(B1, 0, 1); PG8_STAGE(PG8_SB(0, 0), b2, voffB);
            PG8_BAR; PG8_WAIT_L(0); PG8_MMA(0, 1, At, B1); PG8_BAR;
            PG8_LDA(At, 0, 1); PG8_STAGE(PG8_SA(0, 0), a2, voffA);
            PG8_BAR; PG8_WAIT_L(0); PG8_MMA(1, 0, At, B0); PG8_BAR; PG8_SCHED;
            PG8_STAGE(PG8_SB(0, 1), b2 + hstepB, voffB);
            PG8_WAIT_V(6); PG8_BAR; PG8_MMA(1, 1, At, B1); PG8_BAR;
            PG8_LDB(B0, 1, 0); PG8_SCHED; PG8_LDA(At, 1, 0); PG8_STAGE(PG8_SA(0, 1), a2 + hstepA, voffA);
            PG8_WAIT_L(8); PG8_BAR; PG8_WAIT_L(0); PG8_MMA(0, 0, At, B0); PG8_BAR; PG8_SCHED;
            PG8_LDB(B1, 1, 1); PG8_STAGE(PG8_SB(1, 0), b3, voffB);
            PG8_BAR; PG8_WAIT_L(0); PG8_MMA(0, 1, At, B1); PG8_BAR;
            PG8_LDA(At, 1, 1); PG8_STAGE(PG8_SA(1, 0), a3, voffA);
            PG8_BAR; PG8_WAIT_L(0); PG8_MMA(1, 0, At, B0); PG8_BAR; PG8_SCHED;
            PG8_STAGE(PG8_SB(1, 1), b3 + hstepB, voffB);
            PG8_WAIT_V(6); PG8_BAR; PG8_MMA(1, 1, At, B1); PG8_BAR;
            }
        }
        if constexpr (ALIGN_EPI) { if (wr == 0) PG8_BAR; }
        if constexpr (!Epi::AFTER_DRAIN) { E(acc, cur, wr, wc, fr, fq); S.done(cur); }
        if (!has_next) break;
#pragma unroll
        for (int a = 0; a < 2; ++a)
#pragma unroll
            for (int b = 0; b < 2; ++b)
#pragma unroll
                for (int m = 0; m < 4; ++m)
#pragma unroll
                    for (int n = 0; n < 2; ++n) acc[a][b][m][n] = (f32x4){0.f, 0.f, 0.f, 0.f};
        cur = nxt; cA = nA; cB = nB; ++ui;
        if constexpr (ALIGN_EPI) { if (wr == 1) PG8_BAR; }
    }
    PG8_WAIT_V(0);
    if constexpr (!ALIGN_EPI) { if (wr == 0) PG8_BAR; }
    PG8_BAR;
    if constexpr (Epi::AFTER_DRAIN) { E.fused(acc, cur, wr, wc, fr, fq, lds, wid, lane); S.done(cur); }
#undef PG8_SA
#undef PG8_SB
#undef PG8_STAGE
#undef PG8_LDA
#undef PG8_LDB
#undef PG8_MMA
#undef PG8_WAIT_V
#undef PG8_WAIT_L
#undef PG8_BAR
#undef PG8_SCHED
}
}
#define XB_TMO      128
#define XB_XCNT(j)  (256  + 64 * (j))
#define XB_XSUB(j)  (1280 + 64 * (j))
#define XB_XGEN(j)  (2304 + 64 * (j))
#define XB_TOP      3328
#define XB_TOPGEN   3392
#define XCD_BAR_WORDS 3456
#define XB_SPIN_CAP (1u << 18)

__device__ __forceinline__ unsigned xb_ld(unsigned* p)              { return __hip_atomic_load(p, __ATOMIC_RELAXED, __HIP_MEMORY_SCOPE_AGENT); }
__device__ __forceinline__ unsigned xb_add(unsigned* p, unsigned v) { return __hip_atomic_fetch_add(p, v, __ATOMIC_RELAXED, __HIP_MEMORY_SCOPE_AGENT); }
__device__ __forceinline__ unsigned xb_xcc_id() { return (unsigned)__builtin_amdgcn_s_getreg((3 << 11) | 20) & 0xFu; }
#define XB_SPIN(cond, bar) do { unsigned _sp = 0; while (cond) { __builtin_amdgcn_s_sleep(1); \
    if ((++_sp & 255u) == 0u) { if (xb_ld(&(bar)[XB_TMO])) break; if (_sp > XB_SPIN_CAP) { atomicAdd(&(bar)[XB_TMO], 1u); break; } } } } while (0)

struct XcdBarrier {
    unsigned* bar; unsigned x;
    volatile LAS unsigned* st;
};

__device__ __forceinline__ XcdBarrier xcd_barrier_post(unsigned* bar, volatile LAS unsigned* st) {
    XcdBarrier b; b.bar = bar; b.x = xb_xcc_id(); b.st = st;
    if (threadIdx.x == 0) (void)xb_add(&bar[XB_XCNT(b.x)], 1u);
    return b;
}
__device__ __forceinline__ void xcd_barrier_complete(unsigned* bar, unsigned x, unsigned& nloc, unsigned& nx) {
    const unsigned G = gridDim.x * gridDim.y * gridDim.z;
    unsigned sum, cnt, mine, sp = 0u;
    for (;;) {
        sum = 0u; cnt = 0u; mine = 0u;
#pragma unroll
        for (unsigned j = 0; j < 16; ++j) { const unsigned c = xb_ld(&bar[XB_XCNT(j)]); sum += c; cnt += (c > 0u) ? 1u : 0u; mine = (j == x) ? c : mine; }
        if (sum == G) break;
        __builtin_amdgcn_s_sleep(1);
        if ((++sp & 255u) == 0u) { if (xb_ld(&bar[XB_TMO])) break; if (sp > XB_SPIN_CAP) { atomicAdd(&bar[XB_TMO], 1u); break; } }
    }
    nloc = mine > 0u ? mine : 1u; nx = cnt > 0u ? cnt : 1u;
}

__device__ __forceinline__ void xcd_barrier(const XcdBarrier& b) {
    asm volatile("s_waitcnt vmcnt(0)" ::: "memory");
    __syncthreads();
    if (threadIdx.x == 0) {
        unsigned* bar = b.bar;
        __builtin_amdgcn_s_waitcnt(0);
        unsigned nloc = b.st[0], nx = b.st[1];
        if (nloc == 0u) { xcd_barrier_complete(bar, b.x, nloc, nx); b.st[0] = nloc; b.st[1] = nx; }
        const unsigned old = xb_add(&bar[XB_XSUB(b.x)], 1u);
        const unsigned gen = old / nloc;
        if (old + 1u == (gen + 1u) * nloc) {
            __builtin_amdgcn_fence(__ATOMIC_RELEASE, "agent");
            asm volatile("s_waitcnt vmcnt(0)" ::: "memory");
            const unsigned og = xb_add(&bar[XB_TOP], 1u);
            const unsigned tg = og / nx;
            if (og + 1u == (tg + 1u) * nx) xb_add(&bar[XB_TOPGEN], 1u);
            else XB_SPIN(xb_ld(&bar[XB_TOPGEN]) == tg, bar);
            __builtin_amdgcn_fence(__ATOMIC_ACQUIRE, "agent");
            xb_add(&bar[XB_XGEN(b.x)], 1u);
            asm volatile("s_waitcnt vmcnt(0)" ::: "memory");
        } else {
            XB_SPIN(xb_ld(&bar[XB_XGEN(b.x)]) == gen, bar);
            __builtin_amdgcn_fence(__ATOMIC_ACQUIRE, "agent");
            asm volatile("s_waitcnt vmcnt(0)" ::: "memory");
        }
    }
    __syncthreads();
}

constexpr int NWAVES = 8;
constexpr int RING_OFF = 0, RING_BYTES = 131072;
constexpr int LDSCTL_OFF = RING_BYTES, MISC_OFF = LDSCTL_OFF + 320;
constexpr int LDS_BYTES = 147456;

struct Args { const float* in[20]; float* out; unsigned char* ws; int ph_lo, ph_hi, li, pad; };

struct Frame {
    LAS unsigned char* lds;
    volatile LAS unsigned* MISC;
    gu32* ctl;
    int tid, lane, wave, vcu, G;
    __device__ __forceinline__ void refresh() { int t = threadIdx.x; asm volatile("" : "+v"(t)); tid = t; lane = t & 63; wave = __builtin_amdgcn_readfirstlane(t >> 6); }
    unsigned char* ws; float* out;
    const float* x; const float* p;
};

enum Phase { PH_PRO = 0, PH_PROJ, PH_MIX1, PH_SCAN, PH_RETO, PH_BR, PH_WOUT, PH_ROUTE, PH_GATHER, PH_GU, PH_DOWN, PH_COMB, PH_PLE, PH_FINAL, NPH };

DI void tr_item(const float* __restrict__ W, int ldw, int mycol, bf16* WT, int K, int r0, int k0, LAS float* scr, int lane) {
#pragma unroll 8
    for (int i = 0; i < 32; ++i) { const int kk = 2 * i + (lane >> 5); scr[kk * 33 + (lane & 31)] = W[(size_t)(k0 + kk) * ldw + mycol]; }
    LDS_WAIT(); asm volatile("" ::: "memory");
    const int c = lane & 7;
#pragma unroll
    for (int j = 0; j < 4; ++j) { const int n = (lane >> 3) + 8 * j; const LAS float* s = scr + (8 * c) * 33 + n;
        v4u o; o.x = pk2(s[0 * 33], s[1 * 33]); o.y = pk2(s[2 * 33], s[3 * 33]); o.z = pk2(s[4 * 33], s[5 * 33]); o.w = pk2(s[6 * 33], s[7 * 33]);
        *(GAS v4u*)(WT + (size_t)(r0 + n) * K + k0 + 8 * c) = o; }
    LDS_WAIT(); asm volatile("" ::: "memory");
}
DI void rms_row_to_bf16(const float* xrow, const float* gain, bf16* orow, int lane) {
    const GAS f32x4* xr = (const GAS f32x4*)xrow + lane; const GAS f32x4* gr = (const GAS f32x4*)gain + lane;
    f32x4 v[4]; float s = 0.f;
#pragma unroll
    for (int j = 0; j < 4; ++j) { v[j] = xr[64 * j]; s += (v[j].x * v[j].x + v[j].y * v[j].y) + (v[j].z * v[j].z + v[j].w * v[j].w); }
    const float rstd = rsqrtf(wave_sum_dpp(s) * (1.f / DM) + EPS);
    GAS v2u* o8 = (GAS v2u*)orow + lane;
#pragma unroll
    for (int j = 0; j < 4; ++j) { const f32x4 g = gr[64 * j]; v2u o; o.x = pk2(v[j].x * rstd * g.x, v[j].y * rstd * g.y); o.y = pk2(v[j].z * rstd * g.z, v[j].w * rstd * g.w); o8[64 * j] = o; }
}
DI void ph_prologue(Frame& F, const Args& a) {
    LAS float* scr = (LAS float*)(F.lds + RING_OFF + F.wave * 16384);
    const int gw = F.vcu * NWAVES + F.wave, NGW = F.G * NWAVES, lane = F.lane;
    unsigned char* ws = F.ws;
    constexpr int I_IN = (6144 / 32) * 16, I_BR = 32 * 8, I_OUT = 32 * 16, I_GU = 16 * 32 * 16, I_D = 16 * 32 * 8, I_PLE = 32 * 4, I_PG = 32 * 16;
    constexpr int NITEMS = I_IN + 2 * I_BR + I_OUT + I_GU + I_D + I_PLE + I_PG;
    for (int it = gw; it < NITEMS; it += NGW) {
        int r = it;
        if (r < I_IN) { const int rb = r >> 4, kb = r & 15; tr_item(a.in[3], NWIN, in_src(rb * 32 + (lane & 31)), (bf16*)(ws + WS_WIN), 1024, rb * 32, kb * 64, scr, lane); continue; } r -= I_IN;
        if (r < I_BR) { const int rb = r >> 3, kb = r & 7; tr_item(a.in[5], DM, rb * 32 + (lane & 31), (bf16*)(ws + WS_WBR1), 512, rb * 32, kb * 64, scr, lane); continue; } r -= I_BR;
        if (r < I_BR) { const int rb = r >> 3, kb = r & 7; tr_item(a.in[6], DM, rb * 32 + (lane & 31), (bf16*)(ws + WS_WBR2), 512, rb * 32, kb * 64, scr, lane); continue; } r -= I_BR;
        if (r < I_OUT) { const int rb = r >> 4, kb = r & 15; tr_item(a.in[7], DM, rb * 32 + (lane & 31), (bf16*)(ws + WS_WOUT), 1024, rb * 32, kb * 64, scr, lane); continue; } r -= I_OUT;
        if (r < I_GU) { const int e = r >> 9, q = r & 511, rb = q >> 4, kb = q & 15;
            const int row = rb * 32, j = row >> 8, w = row & 255; const bool up = w >= 128; const int col = 128 * j + (w & 127) + (lane & 31);
            tr_item((up ? a.in[14] : a.in[13]) + (size_t)e * DM * DEXP, DEXP, col, (bf16*)(ws + WS_WGU) + (size_t)e * 1024 * 1024, 1024, row, kb * 64, scr, lane); continue; } r -= I_GU;
        if (r < I_D) { const int e = r >> 8, q = r & 255, rb = q >> 3, kb = q & 7;
            tr_item(a.in[15] + (size_t)e * DEXP * DM, DM, rb * 32 + (lane & 31), (bf16*)(ws + WS_WD) + (size_t)e * 1024 * 512, 512, rb * 32, kb * 64, scr, lane); continue; } r -= I_D;
        if (r < I_PLE) { const int rb = r >> 2, kb = r & 3; tr_item(a.in[17], DM, rb * 32 + (lane & 31), (bf16*)(ws + WS_WPLE), 256, rb * 32, kb * 64, scr, lane); continue; } r -= I_PLE;
        { const int rb = r >> 4, kb = r & 15; tr_item(a.in[18], DM, rb * 32 + (lane & 31), (bf16*)(ws + WS_WPG), 1024, rb * 32, kb * 64, scr, lane); }
    }
    bf16* HB = (bf16*)((unsigned char*)F.out + DO_HB);
    for (int m = gw; m < NTOK; m += NGW) {
        rms_row_to_bf16(F.x + (size_t)m * DM, a.in[2], HB + (size_t)m * DM, lane);
        const f32x4 pv = ((const GAS f32x4*)(F.p + (size_t)m * 256))[lane];
        v2u o; o.x = pk2(pv.x, pv.y); o.y = pk2(pv.z, pv.w); ((GAS v2u*)((bf16*)(ws + WS_PB) + (size_t)m * 256))[lane] = o;
    }
    f32x2* tabA = (f32x2*)(ws + WS_TABA); f32x2* tabB = (f32x2*)(ws + WS_TABB);
    for (int i = F.vcu * 512 + F.tid; i < SEQ * 64; i += F.G * 512) {
        const int pos = i >> 6, p = i & 63;
        const float invf = powf(10000.0f, -(float)(2 * p) * (1.0f / 128.0f)); const float ang = (float)pos * invf;
        const f32x2 cs = {cosf(ang), sinf(ang)};
        tabA[i] = cs; tabB[p * SEQ + pos] = cs;
    }
}

DI void ph_route(Frame& F, const Args& a) {
    LAS float* WL = (LAS float*)(F.lds);
    for (int i = F.tid; i < 1024 * 20; i += 512) { const int k = i / 20, o = i - k * 20; WL[((k & 3) * 256 + (k >> 2)) * 20 + o] = o < 4 ? a.in[9][k * 4 + o] : a.in[11][k * 16 + (o - 4)]; }
    LAS int* s_e = (LAS int*)(F.lds + 81920); LAS int* s_lr = s_e + 256; LAS int* lcnt = s_lr + 256; LAS int* lbase = lcnt + 16;
    unsigned char* ws = F.ws; const int lane = F.lane;
    int* eid = (int*)(ws + WS_ROUTE + RT_EID); float* wgt = (float*)(ws + WS_ROUTE + RT_WGT); int* rank = (int*)(ws + WS_ROUTE + RT_RANK);
    bf16* H2 = (bf16*)(ws + WS_H2); const bf16* X1 = (const bf16*)((unsigned char*)F.out + DO_X1);
    const float* bg = a.in[10]; const float* be = a.in[12];
    __syncthreads();
    for (int blk = F.vcu; blk < NTOK / 128; blk += F.G) {
        if (F.tid < 16) lcnt[F.tid] = 0;
        __syncthreads();
        v2u raw[4];
        { const GAS v2u* xr = (const GAS v2u*)(X1 + (size_t)(blk * 128 + F.wave) * DM) + lane;
#pragma unroll
          for (int j = 0; j < 4; ++j) raw[j] = xr[64 * j]; }
        for (int tl = F.wave; tl < 128; tl += NWAVES) {
            const int tok = blk * 128 + tl;
            v2u nxt[4];
            { const int tn = (tl + NWAVES < 128) ? tok + NWAVES : tok; const GAS v2u* xr = (const GAS v2u*)(X1 + (size_t)tn * DM) + lane;
#pragma unroll
              for (int j = 0; j < 4; ++j) nxt[j] = xr[64 * j]; }
            const GAS f32x4* gr = (const GAS f32x4*)a.in[8] + lane;
            f32x4 v[4]; float ss = 0.f;
#pragma unroll
            for (int j = 0; j < 4; ++j) { v[j] = (f32x4){bflo(raw[j].x), bfhi(raw[j].x), bflo(raw[j].y), bfhi(raw[j].y)}; ss += (v[j].x * v[j].x + v[j].y * v[j].y) + (v[j].z * v[j].z + v[j].w * v[j].w); }
            const float rstd = rsqrtf(wave_sum_dpp(ss) * (1.f / DM) + EPS);
            GAS v2u* o8 = (GAS v2u*)(H2 + (size_t)tok * DM) + lane;
            float acc[20];
#pragma unroll
            for (int o = 0; o < 20; ++o) acc[o] = 0.f;
#pragma unroll
            for (int j = 0; j < 4; ++j) {
                const f32x4 g = gr[64 * j]; v[j] = v[j] * rstd * g;
                v2u o; o.x = pk2(v[j].x, v[j].y); o.y = pk2(v[j].z, v[j].w); o8[64 * j] = o;
#pragma unroll
                for (int i = 0; i < 4; ++i) {
                    const float hv = v[j][i]; const LAS f32x4* w = (const LAS f32x4*)(WL + (i * 256 + lane + 64 * j) * 20);
#pragma unroll
                    for (int q = 0; q < 5; ++q) { const f32x4 wv = w[q]; acc[4 * q] += hv * wv.x; acc[4 * q + 1] += hv * wv.y; acc[4 * q + 2] += hv * wv.z; acc[4 * q + 3] += hv * wv.w; }
                }
            }
#pragma unroll
            for (int o = 0; o < 20; ++o) acc[o] = wave_sum_dpp(acc[o]);
            float gl[4];
#pragma unroll
            for (int i = 0; i < 4; ++i) gl[i] = acc[i] + bg[i];
            int g = 0; float gm = gl[0];
#pragma unroll
            for (int i = 1; i < 4; ++i) if (gl[i] > gm) { gm = gl[i]; g = i; }
            float se = 0.f;
#pragma unroll
            for (int i = 0; i < 4; ++i) se += __expf(gl[i] - gm);
            const float pg = 1.0f / se;
            float el[4];
#pragma unroll
            for (int i = 0; i < 4; ++i) { const float l0 = acc[4 + i], l1 = acc[8 + i], l2 = acc[12 + i], l3 = acc[16 + i]; el[i] = (g == 0 ? l0 : g == 1 ? l1 : g == 2 ? l2 : l3) + be[4 * g + i]; }
            int i1 = 0; float m1 = el[0];
#pragma unroll
            for (int i = 1; i < 4; ++i) if (el[i] > m1) { m1 = el[i]; i1 = i; }
            int i2 = -1; float m2 = -3.0e38f;
#pragma unroll
            for (int i = 0; i < 4; ++i) if (i != i1 && el[i] > m2) { m2 = el[i]; i2 = i; }
            const float e2 = __expf(m2 - m1), w1 = pg / (1.0f + e2), w2 = pg * e2 / (1.0f + e2);
            if (lane == 0) {
                eid[2 * tok] = 4 * g + i1; eid[2 * tok + 1] = 4 * g + i2; wgt[2 * tok] = w1; wgt[2 * tok + 1] = w2;
                s_e[2 * tl] = 4 * g + i1; s_e[2 * tl + 1] = 4 * g + i2;
            }
#pragma unroll
            for (int j = 0; j < 4; ++j) raw[j] = nxt[j];
        }
        __syncthreads();
        if (F.tid < 256) s_lr[F.tid] = atomicAdd((int*)&lcnt[s_e[F.tid]], 1);
        __syncthreads();
        if (F.tid < 16) lbase[F.tid] = (int)__hip_atomic_fetch_add(F.ctl + CW_CNT + F.tid, (unsigned)lcnt[F.tid], RLX_AGENT);
        __syncthreads();
        if (F.tid < 256) rank[blk * 256 + F.tid] = lbase[s_e[F.tid]] + s_lr[F.tid];
        __syncthreads();
    }
}

DI void expert_table(Frame& F, LAS int* pst) {
    if (F.tid == 0) { int acc = 0; for (int e = 0; e < NEXP; ++e) { pst[e] = acc; const int c = (int)__hip_atomic_load(F.ctl + CW_CNT + e, RLX_AGENT); acc += (c + 255) & ~255; } pst[NEXP] = acc; }
    __syncthreads();
}

DI void ph_gather(Frame& F, const Args& a) {
    LAS int* pst = (LAS int*)(F.lds);
    expert_table(F, pst);
    unsigned char* ws = F.ws; const int lane = F.lane;
    const int* eid = (const int*)(ws + WS_ROUTE + RT_EID); const float* wgt = (const float*)(ws + WS_ROUTE + RT_WGT); const int* rank = (const int*)(ws + WS_ROUTE + RT_RANK);
    int* pos = (int*)(ws + WS_ROUTE + RT_POS); float* wrow = (float*)(ws + WS_ROUTE + RT_WROW); int* tile = (int*)(ws + WS_ROUTE + RT_TILE);
    const bf16* H2 = (const bf16*)(ws + WS_H2); bf16* XB = (bf16*)(ws + WS_XB);
    if (blockIdx.x == 0 && F.tid < NEXP) { const int e = F.tid; for (int rt = pst[e] >> 8; rt < (pst[e + 1] >> 8); ++rt) tile[1 + rt] = e; if (e == 0) tile[0] = pst[NEXP] >> 8; }
    const int gw = F.vcu * NWAVES + F.wave, NGW = F.G * NWAVES;
    for (int tok = gw; tok < NTOK; tok += NGW) {
        const int p0 = pst[eid[2 * tok]] + rank[2 * tok], p1 = pst[eid[2 * tok + 1]] + rank[2 * tok + 1];
        const GAS v4u* src = (const GAS v4u*)(H2 + (size_t)tok * DM) + lane;
        const v4u r0 = src[0], r1 = src[64];
        GAS v4u* d0 = (GAS v4u*)(XB + (size_t)p0 * DM) + lane; GAS v4u* d1 = (GAS v4u*)(XB + (size_t)p1 * DM) + lane;
        d0[0] = r0; d0[64] = r1; d1[0] = r0; d1[64] = r1;
        if (lane == 0) { pos[2 * tok] = p0; pos[2 * tok + 1] = p1; wrow[p0] = wgt[2 * tok]; wrow[p1] = wgt[2 * tok + 1]; }
    }
}

DI void ph_combine(Frame& F, const Args& a) {
    unsigned char* ws = F.ws; const int lane = F.lane;
    const int* pos = (const int*)(ws + WS_ROUTE + RT_POS); const bf16* YB = (const bf16*)(ws + WS_XB); bf16* HP = (bf16*)(ws + WS_H2);
    const bf16* X1 = (const bf16*)((unsigned char*)F.out + DO_X1); bf16* X2 = (bf16*)(ws + WS_X2);
    const int gw = F.vcu * NWAVES + F.wave, NGW = F.G * NWAVES;
    for (int tok = gw; tok < NTOK; tok += NGW) {
        const GAS v2u* xr = (const GAS v2u*)(X1 + (size_t)tok * DM) + lane; GAS v2u* xw = (GAS v2u*)(X2 + (size_t)tok * DM) + lane; const GAS f32x4* gr = (const GAS f32x4*)a.in[16] + lane;
        const GAS v2u* y0 = (const GAS v2u*)(YB + (size_t)pos[2 * tok] * DM) + lane; const GAS v2u* y1 = (const GAS v2u*)(YB + (size_t)pos[2 * tok + 1] * DM) + lane;
        f32x4 v[4]; float ss = 0.f;
#pragma unroll
        for (int j = 0; j < 4; ++j) {
            const v2u x0 = xr[64 * j], a0 = y0[64 * j], a1 = y1[64 * j];
            v[j].x = bflo(x0.x) + bflo(a0.x) + bflo(a1.x); v[j].y = bfhi(x0.x) + bfhi(a0.x) + bfhi(a1.x); v[j].z = bflo(x0.y) + bflo(a0.y) + bflo(a1.y); v[j].w = bfhi(x0.y) + bfhi(a0.y) + bfhi(a1.y);
            v2u o; o.x = pk2(v[j].x, v[j].y); o.y = pk2(v[j].z, v[j].w); xw[64 * j] = o;
            ss += (v[j].x * v[j].x + v[j].y * v[j].y) + (v[j].z * v[j].z + v[j].w * v[j].w);
        }
        const float rstd = rsqrtf(wave_sum_dpp(ss) * (1.f / DM) + EPS);
        GAS v2u* o8 = (GAS v2u*)(HP + (size_t)tok * DM) + lane;
#pragma unroll
        for (int j = 0; j < 4; ++j) { const f32x4 g = gr[64 * j]; v2u o; o.x = pk2(v[j].x * rstd * g.x, v[j].y * rstd * g.y); o.y = pk2(v[j].z * rstd * g.z, v[j].w * rstd * g.w); o8[64 * j] = o; }
    }
}

DI void ph_final(Frame& F, const Args& a) {
    const int lane = F.lane, gw = F.vcu * NWAVES + F.wave, NGW = F.G * NWAVES;
    for (int tok = gw; tok < NTOK; tok += NGW) {
        GAS f32x4* xr = (GAS f32x4*)(F.out + (size_t)tok * DM) + lane; const GAS f32x4* gr = (const GAS f32x4*)a.in[19] + lane;
        f32x4 v[4]; float ss = 0.f;
#pragma unroll
        for (int j = 0; j < 4; ++j) { v[j] = xr[64 * j]; ss += (v[j].x * v[j].x + v[j].y * v[j].y) + (v[j].z * v[j].z + v[j].w * v[j].w); }
        const float rstd = rsqrtf(wave_sum_dpp(ss) * (1.f / DM) + EPS);
#pragma unroll
        for (int j = 0; j < 4; ++j) { const f32x4 g = gr[64 * j]; xr[64 * j] = v[j] * rstd * g; }
    }
}

typedef pg8::f32x4 af4;
DI unsigned cvtpk(float lo, float hi) { typedef float f2 __attribute__((ext_vector_type(2))); typedef __bf16 b2 __attribute__((ext_vector_type(2))); f2 v = {lo, hi}; b2 b = __builtin_convertvector(v, b2); return __builtin_bit_cast(unsigned, b); }
DI v4u pack8(const float (&x)[8]) { v4u w; w.x = cvtpk(x[0], x[1]); w.y = cvtpk(x[2], x[3]); w.z = cvtpk(x[4], x[5]); w.w = cvtpk(x[6], x[7]); return w; }
DI void unpack8(const v4u w, float (&x)[8]) { x[0] = bflo(w.x); x[1] = bfhi(w.x); x[2] = bflo(w.y); x[3] = bfhi(w.y); x[4] = bflo(w.z); x[5] = bfhi(w.z); x[6] = bflo(w.w); x[7] = bfhi(w.w); }

struct EpiProj {
    static constexpr bool PERM = true, AFTER_DRAIN = false;
    bf16* PROJ; const f32x2* tabA; const float* gn;
    DI void operator()(const af4 (&acc)[2][2][4][2], const pg8::Unit& u, int wr, int wc, int fr, int fq) const {
        const int row0 = u.pm * 256 + wr * 64 + fr, colb = u.pn * 256 + wc * 32 + 8 * fq;
        const int kind = u.pn < 2 ? 0 : u.pn < 4 ? 1 : u.pn < 6 ? 2 : u.pn < 8 ? 3 : u.pn < 10 ? 4 : 5;
#pragma unroll
        for (int ai = 0; ai < 2; ++ai)
#pragma unroll
            for (int m = 0; m < 4; ++m) {
                const int row = row0 + ai * 128 + m * 16;
#pragma unroll
                for (int bj = 0; bj < 2; ++bj) {
                    const int col = colb + bj * 128;
                    const af4 a0 = acc[ai][bj][m][0], a1 = acc[ai][bj][m][1];
                    float x[8] = {a0[0], a0[1], a0[2], a0[3], a1[0], a1[1], a1[2], a1[3]};
                    if (kind <= 1) {
                        const int pos = row & (SEQ - 1), p = (col & 127) >> 1;
                        const f32x4* tp = (const f32x4*)(tabA + pos * 64 + p);
                        const f32x4 t0 = tp[0], t1 = tp[1];
                        const float sc = kind == 1 ? 0.08838834764831845f : 1.0f;
                        float y[8];
                        y[0] = (x[0] * t0.x - x[1] * t0.y) * sc; y[1] = (x[0] * t0.y + x[1] * t0.x) * sc;
                        y[2] = (x[2] * t0.z - x[3] * t0.w) * sc; y[3] = (x[2] * t0.w + x[3] * t0.z) * sc;
                        y[4] = (x[4] * t1.x - x[5] * t1.y) * sc; y[5] = (x[4] * t1.y + x[5] * t1.x) * sc;
                        y[6] = (x[6] * t1.z - x[7] * t1.w) * sc; y[7] = (x[6] * t1.w + x[7] * t1.z) * sc;
#pragma unroll
                        for (int i = 0; i < 8; ++i) x[i] = y[i];
                    } else if (kind == 2) {
                        const f32x4 g0 = *(const f32x4*)(gn + (col - C_RG)), g1 = *(const f32x4*)(gn + (col - C_RG) + 4);
                        const float gg[8] = {g0.x, g0.y, g0.z, g0.w, g1.x, g1.y, g1.z, g1.w};
#pragma unroll
                        for (int i = 0; i < 8; ++i) x[i] = fsilu(x[i]) * gg[i];
                    } else if (kind == 3) {
#pragma unroll
                        for (int i = 0; i < 8; ++i) x[i] *= SB_QSCALE;
                    } else if (kind == 5) {
#pragma unroll
                        for (int i = 0; i < 8; ++i) x[i] = fsigmoid(x[i]);
                    }
                    *(v4u*)(PROJ + (size_t)row * NMAIN + col) = pack8(x);
                }
            }
    }
};
struct EpiProjT {
    static constexpr bool PERM = true, AFTER_DRAIN = false;
    bf16* T; const f32x2* tabB;
    DI void operator()(const af4 (&acc)[2][2][4][2], const pg8::Unit& u, int wr, int wc, int fr, int fq) const {
        const int f0 = u.pm * 256 + wr * 64 + fr, tokb = u.pn * 256 + wc * 32 + 8 * fq;
        const bool isk = u.pm < 2;
#pragma unroll
        for (int ai = 0; ai < 2; ++ai)
#pragma unroll
            for (int m = 0; m < 4; ++m) {
                const int f = f0 + ai * 128 + m * 16;
#pragma unroll
                for (int bj = 0; bj < 2; ++bj) {
                    const int tok = tokb + bj * 128;
                    const af4 a0 = acc[ai][bj][m][0], a1 = acc[ai][bj][m][1];
                    float x[8] = {a0[0], a0[1], a0[2], a0[3], a1[0], a1[1], a1[2], a1[3]};
                    if (isk) {
                        const int pos = tok & (SEQ - 1), h = f >> 7, p = (f & 127) >> 1;
                        const f32x4* tp = (const f32x4*)(tabB + p * SEQ + pos);
                        const f32x4 t0 = tp[0], t1 = tp[1], t2 = tp[2], t3 = tp[3];
                        const float cs[8] = {t0.x, t0.z, t1.x, t1.z, t2.x, t2.z, t3.x, t3.z}, sn[8] = {t0.y, t0.w, t1.y, t1.w, t2.y, t2.w, t3.y, t3.w};
                        const float l2g = ret_log2g(h); const float ginv = exp2f(-l2g);
                        float sc = 0.08838834764831845f * exp2f(l2g * (float)(63 - (pos & 63)));
                        const bool odd = (f & 1) != 0;
                        float y[8];
#pragma unroll
                        for (int i = 0; i < 8; ++i) {
                            const float other = __shfl_xor(x[i], 1);
                            const float r = odd ? (other * sn[i] + x[i] * cs[i]) : (x[i] * cs[i] - other * sn[i]);
                            y[i] = r * sc; sc *= ginv;
                        }
#pragma unroll
                        for (int i = 0; i < 8; ++i) x[i] = y[i];
                    }
                    *(v4u*)(T + (size_t)f * NTOK + tok) = pack8(x);
                }
            }
    }
};

struct EpiBr {
    static constexpr bool PERM = true, AFTER_DRAIN = false;
    bf16* PROJ; int step;
    DI void operator()(const af4 (&acc)[2][2][4][2], const pg8::Unit& u, int wr, int wc, int fr, int fq) const {
        const int row0 = u.pm * 256 + wr * 64 + fr, colb = u.pn * 256 + wc * 32 + 8 * fq;
#pragma unroll
        for (int ai = 0; ai < 2; ++ai)
#pragma unroll
            for (int m = 0; m < 4; ++m) {
                bf16* pr = PROJ + (size_t)(row0 + ai * 128 + m * 16) * NMAIN;
#pragma unroll
                for (int bj = 0; bj < 2; ++bj) {
                    const int col = colb + bj * 128;
                    const af4 a0 = acc[ai][bj][m][0], a1 = acc[ai][bj][m][1];
                    float g[8], x[8] = {a0[0], a0[1], a0[2], a0[3], a1[0], a1[1], a1[2], a1[3]};
                    unpack8(*(const v4u*)(pr + (step ? C_GS : C_GR) + col), g);
#pragma unroll
                    for (int i = 0; i < 8; ++i) x[i] *= g[i];
                    if (step) { float t1[8]; unpack8(*(const v4u*)(pr + C_MG + col), t1);
#pragma unroll
                        for (int i = 0; i < 8; ++i) x[i] += t1[i]; }
                    *(v4u*)(pr + C_MG + col) = pack8(x);
                }
            }
    }
};
struct EpiWout {
    static constexpr bool PERM = true, AFTER_DRAIN = false;
    const float* x; bf16* x1;
    DI void operator()(const af4 (&acc)[2][2][4][2], const pg8::Unit& u, int wr, int wc, int fr, int fq) const {
        const int row0 = u.pm * 256 + wr * 64 + fr, colb = u.pn * 256 + wc * 32 + 8 * fq;
#pragma unroll
        for (int ai = 0; ai < 2; ++ai)
#pragma unroll
            for (int m = 0; m < 4; ++m) {
                const size_t ro = (size_t)(row0 + ai * 128 + m * 16) * DM;
#pragma unroll
                for (int bj = 0; bj < 2; ++bj) {
                    const size_t o = ro + colb + bj * 128;
                    const af4 x0 = *(const af4*)(x + o) + acc[ai][bj][m][0], x1v = *(const af4*)(x + o + 4) + acc[ai][bj][m][1];
                    const float y[8] = {x0[0], x0[1], x0[2], x0[3], x1v[0], x1v[1], x1v[2], x1v[3]};
                    *(v4u*)(x1 + o) = pack8(y);
                }
            }
    }
};
struct EpiGu {
    static constexpr bool PERM = true, AFTER_DRAIN = false;
    bf16* HID;
    DI void operator()(const af4 (&acc)[2][2][4][2], const pg8::Unit& u, int wr, int wc, int fr, int fq) const {
        const int row0 = u.pm * 256 + wr * 64 + fr, col = u.pn * 128 + wc * 32 + 8 * fq;
#pragma unroll
        for (int ai = 0; ai < 2; ++ai)
#pragma unroll
            for (int m = 0; m < 4; ++m) {
                const af4 g0 = acc[ai][0][m][0], g1 = acc[ai][0][m][1], u0 = acc[ai][1][m][0], u1 = acc[ai][1][m][1];
                float x[8];
#pragma unroll
                for (int i = 0; i < 4; ++i) { x[i] = fsilu(g0[i]) * u0[i]; x[4 + i] = fsilu(g1[i]) * u1[i]; }
                *(v4u*)(HID + (size_t)(row0 + ai * 128 + m * 16) * DEXP + col) = pack8(x);
            }
    }
};
struct EpiDown {
    static constexpr bool PERM = true, AFTER_DRAIN = false;
    bf16* YB; const float* wrow;
    DI void operator()(const af4 (&acc)[2][2][4][2], const pg8::Unit& u, int wr, int wc, int fr, int fq) const {
        const int row0 = u.pm * 256 + wr * 64 + fr, colb = u.pn * 256 + wc * 32 + 8 * fq;
#pragma unroll
        for (int ai = 0; ai < 2; ++ai)
#pragma unroll
            for (int m = 0; m < 4; ++m) {
                const int row = row0 + ai * 128 + m * 16; const float w = wrow[row];
#pragma unroll
                for (int bj = 0; bj < 2; ++bj) {
                    const af4 a0 = acc[ai][bj][m][0] * w, a1 = acc[ai][bj][m][1] * w;
                    const float x[8] = {a0[0], a0[1], a0[2], a0[3], a1[0], a1[1], a1[2], a1[3]};
                    *(v4u*)(YB + (size_t)row * DM + colb + bj * 128) = pack8(x);
                }
            }
    }
};
struct EpiPe {
    static constexpr bool PERM = true, AFTER_DRAIN = false;
    bf16* PE;
    DI void operator()(const af4 (&acc)[2][2][4][2], const pg8::Unit& u, int wr, int wc, int fr, int fq) const {
        const int row0 = u.pm * 256 + wr * 64 + fr, colb = u.pn * 256 + wc * 32 + 8 * fq;
#pragma unroll
        for (int ai = 0; ai < 2; ++ai)
#pragma unroll
            for (int m = 0; m < 4; ++m)
#pragma unroll
                for (int bj = 0; bj < 2; ++bj) {
                    const af4 a0 = acc[ai][bj][m][0], a1 = acc[ai][bj][m][1];
                    const float x[8] = {a0[0], a0[1], a0[2], a0[3], a1[0], a1[1], a1[2], a1[3]};
                    *(v4u*)(PE + (size_t)(row0 + ai * 128 + m * 16) * DM + colb + bj * 128) = pack8(x);
                }
    }
};
struct EpiPg {
    static constexpr bool PERM = true, AFTER_DRAIN = false;
    const bf16* PE; const bf16* x2; float* out;
    DI void operator()(const af4 (&acc)[2][2][4][2], const pg8::Unit& u, int wr, int wc, int fr, int fq) const {
        const int row0 = u.pm * 256 + wr * 64 + fr, colb = u.pn * 256 + wc * 32 + 8 * fq;
#pragma unroll
        for (int ai = 0; ai < 2; ++ai)
#pragma unroll
            for (int m = 0; m < 4; ++m) {
                const size_t ro = (size_t)(row0 + ai * 128 + m * 16) * DM;
#pragma unroll
                for (int bj = 0; bj < 2; ++bj) {
                    const size_t o = ro + colb + bj * 128;
                    float pe[8]; unpack8(*(const v4u*)(PE + o), pe);
                    const af4 a0 = acc[ai][bj][m][0], a1 = acc[ai][bj][m][1];
                    float xr[8]; unpack8(*(const v4u*)(x2 + o), xr);
                    af4 x0 = {xr[0], xr[1], xr[2], xr[3]}, x1 = {xr[4], xr[5], xr[6], xr[7]};
#pragma unroll
                    for (int i = 0; i < 4; ++i) { x0[i] += fsigmoid(a0[i]) * pe[i]; x1[i] += fsigmoid(a1[i]) * pe[4 + i]; }
                    *(af4*)(out + o) = x0; *(af4*)(out + o + 4) = x1;
                }
                asm volatile("" ::: "memory");
            }
    }
};

struct MoeOrder {
    const LAS int* pst; int G, c; size_t estride, tstepB;
    DI bool next(int i, pg8::Unit& u) const {
        const int L = i * G + c, rt = L >> 2; if (rt * 256 >= pst[NEXP]) return false;
        int ex = 0;
#pragma unroll
        for (int e = 1; e < NEXP; ++e) ex += (rt * 256 >= pst[e]) ? 1 : 0;
        u.pm = rt; u.pn = L & 3; u.ex = ex; u.bofs = (size_t)ex * estride + (size_t)u.pn * tstepB; return true;
    }
    DI void a_ready(const pg8::Unit&) const {}
    DI void done(const pg8::Unit&) const {}
};

#define GEMM_PHASE(EPI, ORD, g, S, E) pg8::gemm_phase<EPI, ORD, true, true>(F.lds + RING_OFF, g, S, E)

DI void fast_proj(Frame& F, const Args& a) {
    unsigned char* ws = F.ws; const bf16* HB = (const bf16*)((unsigned char*)F.out + DO_HB); const bf16* WIN = (const bf16*)(ws + WS_WIN);
    { pg8::Gemm g{HB, WIN, DM, DM}; pg8::StaticOrder S; S.init(NTOK, NMAIN, DM, F.G, (int)blockIdx.x);
      EpiProj E{(bf16*)(ws + WS_PROJ), (const f32x2*)(ws + WS_TABA), a.in[4]}; GEMM_PHASE(EpiProj, pg8::StaticOrder, g, S, E); }
    { pg8::Gemm g{WIN + (size_t)NMAIN * DM, HB, DM, DM}; pg8::StaticOrder S; S.init(NTR, NTOK, DM, F.G, (int)blockIdx.x);
      EpiProjT E{(bf16*)(ws + WS_T), (const f32x2*)(ws + WS_TABB)}; GEMM_PHASE(EpiProjT, pg8::StaticOrder, g, S, E); }
}
DI void fast_br(Frame& F, const Args& a) {
    unsigned char* ws = F.ws; bf16* PROJ = (bf16*)(ws + WS_PROJ); const bf16* RS = (const bf16*)((unsigned char*)F.out + DO_RS);
    pg8::StaticOrder S; S.init(NTOK, DM, 512, F.G, (int)blockIdx.x);
    { pg8::Gemm g{RS, (const bf16*)(ws + WS_WBR1), DM, 512}; EpiBr E{PROJ, 0}; GEMM_PHASE(EpiBr, pg8::StaticOrder, g, S, E); }
    { pg8::Gemm g{RS + 512, (const bf16*)(ws + WS_WBR2), DM, 512}; EpiBr E{PROJ, 1}; GEMM_PHASE(EpiBr, pg8::StaticOrder, g, S, E); }
}
DI void fast_wout(Frame& F, const Args& a) {
    unsigned char* ws = F.ws;
    pg8::Gemm g{(const bf16*)(ws + WS_PROJ) + C_MG, (const bf16*)(ws + WS_WOUT), NMAIN, DM}; pg8::StaticOrder S; S.init(NTOK, DM, DM, F.G, (int)blockIdx.x);
    EpiWout E{F.x, (bf16*)((unsigned char*)F.out + DO_X1)}; GEMM_PHASE(EpiWout, pg8::StaticOrder, g, S, E);
}
DI void fast_gu(Frame& F, const Args& a) {
    LAS int* pst = (LAS int*)(F.lds + LDSCTL_OFF);
    expert_table(F, pst);
    unsigned char* ws = F.ws;
    pg8::Gemm g{(const bf16*)(ws + WS_XB), (const bf16*)(ws + WS_WGU), DM, DM};
    MoeOrder S{pst, F.G, F.vcu, (size_t)1024 * 1024 * 2, (size_t)256 * DM * 2};
    EpiGu E{(bf16*)(ws + WS_HID)}; GEMM_PHASE(EpiGu, MoeOrder, g, S, E);
}
DI void fast_down(Frame& F, const Args& a) {
    LAS int* pst = (LAS int*)(F.lds + LDSCTL_OFF);
    expert_table(F, pst);
    unsigned char* ws = F.ws;
    pg8::Gemm g{(const bf16*)(ws + WS_HID), (const bf16*)(ws + WS_WD), DEXP, DEXP};
    MoeOrder S{pst, F.G, F.vcu, (size_t)1024 * 512 * 2, (size_t)256 * DEXP * 2};
    EpiDown E{(bf16*)(ws + WS_XB), (const float*)(ws + WS_ROUTE + RT_WROW)}; GEMM_PHASE(EpiDown, MoeOrder, g, S, E);
}
DI void fast_ple(Frame& F, const Args& a) {
    unsigned char* ws = F.ws;
    { int k256 = 256; asm volatile("" : "+s"(k256));
      pg8::Gemm g{(const bf16*)(ws + WS_PB), (const bf16*)(ws + WS_WPLE), 256, k256}; pg8::StaticOrder S; S.init(NTOK, DM, k256, F.G, (int)blockIdx.x);
      EpiPe E{(bf16*)(ws + WS_HID)}; GEMM_PHASE(EpiPe, pg8::StaticOrder, g, S, E); }
    { pg8::Gemm g{(const bf16*)(ws + WS_H2), (const bf16*)(ws + WS_WPG), DM, DM}; pg8::StaticOrder S; S.init(NTOK, DM, DM, F.G, (int)blockIdx.x);
      EpiPg E{(const bf16*)(ws + WS_HID), (const bf16*)(ws + WS_X2), F.out}; GEMM_PHASE(EpiPg, pg8::StaticOrder, g, S, E); }
}

#define MFMA32(a, b, c) __builtin_amdgcn_mfma_f32_32x32x16_bf16((a), (b), (c), 0, 0, 0)
DI int crow(int reg, int h) { return (reg & 3) + 8 * (reg >> 2) + 4 * h; }
DI bf16x8 ld16(const bf16* p) { return *(const bf16x8*)p; }
DI bf16x8 ld8x2(const bf16* p0, const bf16* p1) { const s16x4 lo = *(const s16x4*)p0, hi = *(const s16x4*)p1; return __builtin_shufflevector(lo, hi, 0, 1, 2, 3, 4, 5, 6, 7); }
template <int S> DI bf16x8 pack_step(const f32x16& x) { v4u p; p.x = cvtpk(x[8 * S], x[8 * S + 1]); p.y = cvtpk(x[8 * S + 2], x[8 * S + 3]); p.z = cvtpk(x[8 * S + 4], x[8 * S + 5]); p.w = cvtpk(x[8 * S + 6], x[8 * S + 7]); return __builtin_bit_cast(bf16x8, p); }
DI f32x16 splat16(float v) { f32x16 x;
#pragma unroll
    for (int i = 0; i < 16; ++i) x[i] = v; return x; }

#define SCHED_FENCE() __builtin_amdgcn_sched_barrier(0)
DI void fast_ret_kv(Frame& F, const Args& a) {
    const bf16* __restrict__ T = (const bf16*)(F.ws + WS_T); bf16* __restrict__ ST = (bf16*)((unsigned char*)F.out + DO_ST);
    const int lane = F.lane, r = lane & 31, h2 = lane >> 5, gw = F.vcu * NWAVES + F.wave, NGW = F.G * NWAVES;
    for (int it = gw; it < NBATCH * 4 * 64 * 4; it += NGW) {
        const int eb = it & 3, c = (it >> 2) & 63, hh = (it >> 8) & 3, b = it >> 10;
        const int tok0 = b * SEQ + c * 64;
        const bf16* vrow = T + (size_t)(T_VR + hh * 128 + eb * 32 + r) * NTOK + tok0 + 8 * h2;
        const bf16* krow = T + (size_t)(T_KT + hh * 128 + r) * NTOK + tok0 + 8 * h2;
        bf16x8 vb[4], ka[4][4];
#pragma unroll
        for (int ks = 0; ks < 4; ++ks) vb[ks] = ld16(vrow + 16 * ks);
#pragma unroll
        for (int db = 0; db < 4; ++db)
#pragma unroll
            for (int ks = 0; ks < 4; ++ks) ka[db][ks] = ld16(krow + (size_t)db * 32 * NTOK + 16 * ks);
        SCHED_FENCE();
        bf16* st = ST + ((size_t)((b * 4 + hh) * 64 + c)) * 16384 + (size_t)(eb * 32 + r) * 128 + 4 * h2;
#pragma unroll
        for (int db = 0; db < 4; ++db) {
            f32x16 acc = splat16(0.f);
#pragma unroll
            for (int ks = 0; ks < 4; ++ks) acc = MFMA32(ka[db][ks], vb[ks], acc);
#pragma unroll
            for (int g = 0; g < 4; ++g) { v2u w; w.x = cvtpk(acc[4 * g], acc[4 * g + 1]); w.y = cvtpk(acc[4 * g + 2], acc[4 * g + 3]); *(v2u*)(st + db * 32 + 8 * g) = w; }
        }
    }
}
DI void fast_ret_scan(Frame& F, const Args& a) {
    bf16* ST = (bf16*)((unsigned char*)F.out + DO_ST);
    for (int g = F.vcu * 512 + F.tid; g < NBATCH * 4 * 4096; g += F.G * 512) {
        const int bh = g >> 12, idx = (g & 4095) * 4;
        const float cdec = exp2f(ret_log2g(bh & 3) * 64.0f);
        bf16* p = ST + (size_t)bh * 64 * 16384 + idx;
        float s0 = 0.f, s1 = 0.f, s2 = 0.f, s3 = 0.f;
#pragma unroll 8
        for (int c = 0; c < 64; ++c) {
            const v2u w = *(const v2u*)(p + (size_t)c * 16384);
            v2u o; o.x = cvtpk(s0, s1); o.y = cvtpk(s2, s3); *(v2u*)(p + (size_t)c * 16384) = o;
            s0 = cdec * s0 + bflo(w.x); s1 = cdec * s1 + bfhi(w.x); s2 = cdec * s2 + bflo(w.y); s3 = cdec * s3 + bfhi(w.y);
        }
    }
}
DI void fast_ret_out(Frame& F, const Args& a) {
    const bf16* __restrict__ PROJ = (const bf16*)(F.ws + WS_PROJ); const bf16* __restrict__ T = (const bf16*)(F.ws + WS_T);
    const bf16* __restrict__ ST = (const bf16*)((unsigned char*)F.out + DO_ST); bf16* __restrict__ RS = (bf16*)((unsigned char*)F.out + DO_RS);
    const int lane = F.lane, r = lane & 31, h2 = lane >> 5, gw = F.vcu * NWAVES + F.wave, NGW = F.G * NWAVES;
    for (int it = gw; it < NBATCH * 4 * 64 * 2; it += NGW) {
        const int ib = it & 1, c = (it >> 1) & 63, hh = (it >> 7) & 3, b = it >> 9;
        const int tok0 = b * SEQ + c * 64;
        const float l2g = ret_log2g(hh);
        const bf16* qrow = PROJ + (size_t)(tok0 + ib * 32 + r) * NMAIN + C_RQ + hh * 128 + 8 * h2;
        const bf16* krow = PROJ + (size_t)(tok0 + r) * NMAIN + C_RK + hh * 128 + 8 * h2;
        const bf16* stb = ST + ((size_t)((b * 4 + hh) * 64 + c)) * 16384 + (size_t)r * 128 + 8 * h2;
        const bf16* vrow = T + (size_t)(T_VR + hh * 128 + r) * NTOK + tok0 + 4 * h2;
        const bf16* gp = PROJ + (size_t)(tok0 + ib * 32 + r) * NMAIN + C_RG + hh * 128 + 4 * h2;
        bf16x8 qf[8], kf0[8], kf1[8], sA[8], sB[8], vA[4], vB[4];
#define LD_ST(dst, eb) do { _Pragma("unroll") for (int ks = 0; ks < 8; ++ks) dst[ks] = ld16(stb + (size_t)(eb) * 32 * 128 + 16 * ks); } while (0)
#define LD_VT(dst, eb) do { const bf16* vr_ = vrow + (size_t)(eb) * 32 * NTOK; dst[0] = ld8x2(vr_, vr_ + 8); dst[1] = ld8x2(vr_ + 16, vr_ + 24); dst[2] = ld8x2(vr_ + 32, vr_ + 40); dst[3] = ld8x2(vr_ + 48, vr_ + 56); } while (0)
#define RET_EB(oacc, sfr, vfr) do { f32x16 acc_ = splat16(0.f); \
            _Pragma("unroll") for (int ks = 0; ks < 8; ++ks) acc_ = MFMA32(sfr[ks], qf[ks], acc_);         \
            _Pragma("unroll") for (int reg = 0; reg < 16; ++reg) acc_[reg] *= qd; \
            acc_ = MFMA32(vfr[0], pb[0][0], acc_); acc_ = MFMA32(vfr[1], pb[0][1], acc_); acc_ = MFMA32(vfr[2], pb[1][0], acc_); acc_ = MFMA32(vfr[3], pb[1][1], acc_); oacc = acc_; } while (0)
#pragma unroll
        for (int ks = 0; ks < 8; ++ks) qf[ks] = ld16(qrow + 16 * ks);
#pragma unroll
        for (int ks = 0; ks < 8; ++ks) { kf0[ks] = ld16(krow + 16 * ks); kf1[ks] = ld16(krow + (size_t)32 * NMAIN + 16 * ks); }
        LD_ST(sA, 0); LD_VT(vA, 0);
        SCHED_FENCE();
        f32x16 pt0 = splat16(0.f), pt1 = splat16(0.f);
#pragma unroll
        for (int ks = 0; ks < 8; ++ks) { pt0 = MFMA32(kf0[ks], qf[ks], pt0); pt1 = MFMA32(kf1[ks], qf[ks], pt1); }
        LD_ST(sB, 1); LD_VT(vB, 1);
        SCHED_FENCE();
        bf16x8 pb[2][2];
#pragma unroll
        for (int reg = 0; reg < 16; ++reg) {
            const int d0 = (ib * 32 + r) - crow(reg, h2), d1 = d0 - 32;
            pt0[reg] *= __builtin_amdgcn_exp2f(l2g * (float)(d0 < 0 ? -d0 : d0)); pt1[reg] *= __builtin_amdgcn_exp2f(l2g * (float)(d1 < 0 ? -d1 : d1));
        }
        pb[0][0] = pack_step<0>(pt0); pb[0][1] = pack_step<1>(pt0); pb[1][0] = pack_step<0>(pt1); pb[1][1] = pack_step<1>(pt1);
        const float qd = __builtin_amdgcn_exp2f(l2g * (float)(ib * 32 + r + 1));
        f32x16 o[4];
        RET_EB(o[0], sA, vA);
        LD_ST(sA, 2); LD_VT(vA, 2);
        SCHED_FENCE();
        RET_EB(o[1], sB, vB);
        LD_ST(sB, 3); LD_VT(vB, 3);
        SCHED_FENCE();
        RET_EB(o[2], sA, vA);
        v2u gate[16];
#pragma unroll
        for (int q = 0; q < 16; ++q) gate[q] = *(const v2u*)(gp + (q >> 2) * 32 + 8 * (q & 3));
        SCHED_FENCE();
        RET_EB(o[3], sB, vB);
#undef LD_ST
#undef LD_VT
#undef RET_EB
        float s = 0.f;
#pragma unroll
        for (int eb = 0; eb < 4; ++eb)
#pragma unroll
            for (int reg = 0; reg < 16; ++reg) s += o[eb][reg];
        s += __shfl_xor(s, 32);
        const float mu = s * (1.0f / 128.0f); float v = 0.f;
#pragma unroll
        for (int eb = 0; eb < 4; ++eb)
#pragma unroll
            for (int reg = 0; reg < 16; ++reg) { const float d = o[eb][reg] - mu; v += d * d; }
        v += __shfl_xor(v, 32);
        const float rstd = rsqrtf(v * (1.0f / 128.0f) + EPS);
        bf16* rp = RS + (size_t)(tok0 + ib * 32 + r) * DM + hh * 128 + 4 * h2;
#pragma unroll
        for (int eb = 0; eb < 4; ++eb)
#pragma unroll
            for (int g = 0; g < 4; ++g) {
                const v2u gt = gate[eb * 4 + g];
                v2u w;
                w.x = cvtpk((o[eb][4 * g] - mu) * rstd * bflo(gt.x), (o[eb][4 * g + 1] - mu) * rstd * bfhi(gt.x));
                w.y = cvtpk((o[eb][4 * g + 2] - mu) * rstd * bflo(gt.y), (o[eb][4 * g + 3] - mu) * rstd * bfhi(gt.y));
                *(v2u*)(rp + eb * 32 + 8 * g) = w;
            }
    }
}

DI void fast_att(Frame& F, const Args& a) {
    const bf16* __restrict__ PROJ = (const bf16*)(F.ws + WS_PROJ); const bf16* __restrict__ T = (const bf16*)(F.ws + WS_T); bf16* __restrict__ RS = (bf16*)((unsigned char*)F.out + DO_RS);
    const int lane = F.lane, r = lane & 31, h2 = lane >> 5, gw = F.vcu * NWAVES + F.wave, NGW = F.G * NWAVES;
    bf16x8 tri0, tri1, ones;
#pragma unroll
    for (int j = 0; j < 8; ++j) { const int k0 = 8 * (j >> 2) + 4 * h2 + (j & 3); tri0[j] = (k0 > r) ? (short)0x3F80 : (short)0; tri1[j] = (16 + k0 > r) ? (short)0x3F80 : (short)0; ones[j] = (short)0x3F80; }
    for (int it = gw; it < NBATCH * 8 * 128; it += NGW) {
        const int qb = it & 127, hh = (it >> 7) & 7, b = it >> 10;
        const int q0 = qb * 32, tokq = b * SEQ + q0 + r;
        const bf16* qrow = PROJ + (size_t)tokq * NMAIN + C_SQ + hh * 64 + 8 * h2;
        const bf16* kbase = PROJ + (size_t)(b * SEQ + r) * NMAIN + C_SK + hh * 64 + 8 * h2;
        const bf16* vbase = T + (size_t)(T_VS + hh * 64 + r) * NTOK + b * SEQ + 4 * h2;
        const int ktd = q0 >> 6;
        bf16x8 qf[4], kA[8], vB[8];
#pragma unroll
        for (int ks = 0; ks < 4; ++ks) qf[ks] = ld16(qrow + 16 * ks);
#pragma unroll
        for (int ks = 0; ks < 4; ++ks) { kA[ks] = ld16(kbase + (size_t)(ktd * 64) * NMAIN + 16 * ks); kA[4 + ks] = ld16(kbase + (size_t)(ktd * 64 + 32) * NMAIN + 16 * ks); }
        f32x16 o0 = splat16(0.f), o1 = splat16(0.f);
        float carry = 0.f;
        for (int kt = ktd; kt >= 0; --kt) {
            const int key0 = kt * 64;
            const bool diag = (kt == ktd);
            {
                const bf16* v0row = vbase + key0; const bf16* v1row = v0row + (size_t)32 * NTOK;
#pragma unroll
                for (int q = 0; q < 4; ++q) { vB[q] = ld8x2(v0row + 16 * q, v0row + 16 * q + 8); vB[4 + q] = ld8x2(v1row + 16 * q, v1row + 16 * q + 8); }
            }
            SCHED_FENCE();
            f32x16 p0 = splat16(0.f), p1 = splat16(0.f);
#pragma unroll
            for (int ks = 0; ks < 4; ++ks) { p0 = MFMA32(kA[ks], qf[ks], p0); p1 = MFMA32(kA[4 + ks], qf[ks], p1); }
            {
                const int kn = (kt > 0 ? kt - 1 : 0) * 64;
#pragma unroll
                for (int ks = 0; ks < 4; ++ks) { kA[ks] = ld16(kbase + (size_t)kn * NMAIN + 16 * ks); kA[4 + ks] = ld16(kbase + (size_t)(kn + 32) * NMAIN + 16 * ks); }
            }
            SCHED_FENCE();
            f32x16 l0, l1;
#pragma unroll
            for (int reg = 0; reg < 16; ++reg) {
                const float z0 = fminf(p0[reg], 100.0f), z1 = fminf(p1[reg], 100.0f);
                float a0 = -__builtin_amdgcn_logf(1.0f + __builtin_amdgcn_exp2f(z0)), a1 = -__builtin_amdgcn_logf(1.0f + __builtin_amdgcn_exp2f(z1));
                float b0 = z0 + a0, b1 = z1 + a1;
                if (diag) {
                    const bool v0 = (key0 + crow(reg, h2)) < (q0 + r), v1 = (key0 + 32 + crow(reg, h2)) < (q0 + r);
                    a0 = v0 ? a0 : 0.f; b0 = v0 ? b0 : -1.0e30f; a1 = v1 ? a1 : 0.f; b1 = v1 ? b1 : -1.0e30f;
                }
                l0[reg] = a0; l1[reg] = a1; p0[reg] = b0; p1[reg] = b1;
            }
            f32x16 y0 = splat16(carry), y1 = y0;
            {
                const bf16x8 x00 = pack_step<0>(l0), x01 = pack_step<1>(l0), x10 = pack_step<0>(l1), x11 = pack_step<1>(l1);
                y0 = MFMA32(tri0, x00, y0); y0 = MFMA32(tri1, x01, y0); y0 = MFMA32(ones, x10, y0); y0 = MFMA32(ones, x11, y0);
                y1 = MFMA32(tri0, x10, y1); y1 = MFMA32(tri1, x11, y1);
            }
            const float tot = y0[0] + l0[0];
            carry = __shfl(tot, r);
#pragma unroll
            for (int reg = 0; reg < 16; ++reg) { p0[reg] = __builtin_amdgcn_exp2f(p0[reg] + y0[reg]); p1[reg] = __builtin_amdgcn_exp2f(p1[reg] + y1[reg]); }
            {
                const bf16x8 a00 = pack_step<0>(p0), a01 = pack_step<1>(p0), a10 = pack_step<0>(p1), a11 = pack_step<1>(p1);
                o0 = MFMA32(vB[0], a00, o0); o0 = MFMA32(vB[1], a01, o0); o0 = MFMA32(vB[2], a10, o0); o0 = MFMA32(vB[3], a11, o0);
                o1 = MFMA32(vB[4], a00, o1); o1 = MFMA32(vB[5], a01, o1); o1 = MFMA32(vB[6], a10, o1); o1 = MFMA32(vB[7], a11, o1);
            }
            if (__all(carry < SB_EXIT)) break;
        }
        bf16* op = RS + (size_t)tokq * DM + 512 + hh * 64 + 4 * h2;
#pragma unroll
        for (int g = 0; g < 4; ++g) {
            v2u w; w.x = cvtpk(o0[4 * g], o0[4 * g + 1]); w.y = cvtpk(o0[4 * g + 2], o0[4 * g + 3]); *(v2u*)(op + 8 * g) = w;
            v2u u; u.x = cvtpk(o1[4 * g], o1[4 * g + 1]); u.y = cvtpk(o1[4 * g + 2], o1[4 * g + 3]); *(v2u*)(op + 32 + 8 * g) = u;
        }
    }
}

__global__ void __launch_bounds__(NWAVES * 64, 2) mega(Args args) {
    extern __shared__ __attribute__((aligned(16))) unsigned char lds[];
    Frame F;
    F.lds = (LAS unsigned char*)lds;
    F.MISC = (volatile LAS unsigned*)(F.lds + MISC_OFF);
    F.refresh();
    F.G = gridDim.x; { const int bx = blockIdx.x; F.vcu = (F.G % 8 == 0) ? (bx % 8) * (F.G / 8) + bx / 8 : bx; }
    F.ws = args.ws; F.out = args.out; F.x = args.in[0]; F.p = args.in[1];
    F.ctl = (gu32*)(args.ws + WS_CTL);
    for (int u = F.tid; u < (LDS_BYTES - LDSCTL_OFF) / 4; u += NWAVES * 64) ((LAS unsigned*)(F.lds + LDSCTL_OFF))[u] = 0u;
    __syncthreads();
    const int lo = args.ph_lo, hi = args.ph_hi;
    XcdBarrier bar; bar.bar = (unsigned*)(F.ctl + CW_BAR) + args.li * BAR_STRIDE; bar.x = 0; bar.st = nullptr;
    if (hi - lo > 1) bar = xcd_barrier_post((unsigned*)(F.ctl + CW_BAR) + args.li * BAR_STRIDE, F.MISC + 8);
#define IN(k) (F.refresh(), lo <= (k) && (k) < hi)
#define DUP(k) ((DUP_MASK >> (k)) & 1)
#define SEAM(k) do { if (IN(k) && IN((k) + 1)) xcd_barrier(bar); } while (0)
#define REP(k, body) do { body; if (DUP(k)) { F.refresh(); body; } } while (0)

    if (IN(PH_PRO)) { REP(PH_PRO, ph_prologue(F, args)); } SEAM(PH_PRO);
    if (IN(PH_PROJ)) { REP(PH_PROJ, fast_proj(F, args)); } SEAM(PH_PROJ);
    if (IN(PH_MIX1)) { REP(14, fast_ret_kv(F, args)); REP(15, fast_att(F, args)); } SEAM(PH_MIX1);
    if (IN(PH_SCAN)) { fast_ret_scan(F, args); } SEAM(PH_SCAN);
    if (IN(PH_RETO)) { REP(PH_RETO, fast_ret_out(F, args)); } SEAM(PH_RETO);
    if (IN(PH_BR)) { REP(PH_BR, fast_br(F, args)); } SEAM(PH_BR);
    if (IN(PH_WOUT)) { REP(PH_WOUT, fast_wout(F, args)); } SEAM(PH_WOUT);
    if (IN(PH_ROUTE)) { ph_route(F, args); } SEAM(PH_ROUTE);
    if (IN(PH_GATHER)) { REP(PH_GATHER, ph_gather(F, args)); } SEAM(PH_GATHER);
    if (IN(PH_GU)) { REP(PH_GU, fast_gu(F, args)); } SEAM(PH_GU);
    if (IN(PH_DOWN)) { REP(PH_DOWN, fast_down(F, args)); } SEAM(PH_DOWN);
    if (IN(PH_COMB)) { REP(PH_COMB, ph_combine(F, args)); } SEAM(PH_COMB);
    if (IN(PH_PLE)) { REP(PH_PLE, fast_ple(F, args)); } SEAM(PH_PLE);
    if (IN(PH_FINAL)) { ph_final(F, args); }
#undef IN
#undef SEAM
}

extern "C" void kernel_launch(void* const* d_in, const int* in_sizes, int n_in, void* d_out, int out_size, void* d_ws, size_t ws_size, hipStream_t stream) {
    static int grid = 0;
    if (grid == 0) {
        if (n_in != 20 || in_sizes[0] != NTOK * DM || out_size != NTOK * DM || ws_size < WS_END) { fprintf(stderr, "kernel_launch: unexpected shapes (n_in %d, in0 %d, out %d, ws %zu)\n", n_in, n_in > 0 ? in_sizes[0] : -1, out_size, ws_size); grid = -1; return; }
        int dev = 0, cus = 0, per_cu = 0;
        if (hipGetDevice(&dev) != hipSuccess || hipDeviceGetAttribute(&cus, hipDeviceAttributeMultiprocessorCount, dev) != hipSuccess) { grid = -1; return; }
        if (hipFuncSetAttribute((const void*)mega, hipFuncAttributeMaxDynamicSharedMemorySize, LDS_BYTES) != hipSuccess) { fprintf(stderr, "kernel_launch: hipFuncSetAttribute failed\n"); grid = -1; return; }
        if (hipOccupancyMaxActiveBlocksPerMultiprocessor(&per_cu, (const void*)mega, NWAVES * 64, LDS_BYTES) != hipSuccess || per_cu < 1) fprintf(stderr, "kernel_launch: occupancy query reports %d\n", per_cu);
        (void)hipGetLastError();
        grid = cus;
    }
    if (grid < 0) return;
    unsigned char* ws = (unsigned char*)d_ws;
    if (hipMemsetAsync(ws + WS_CTL, 0, CTL_ZERO_BYTES, stream) != hipSuccess) return;
    Args a{};
    for (int i = 0; i < 20; ++i) a.in[i] = (const float*)d_in[i];
    a.out = (float*)d_out; a.ws = ws;
#if SPLIT_PHASES
    for (int p = 0; p < NPH; ++p) { a.ph_lo = p; a.ph_hi = p + 1; a.li = 0; hipLaunchKernelGGL(mega, dim3(grid), dim3(NWAVES * 64), LDS_BYTES, stream, a); }
#else
    a.ph_lo = 0; a.ph_hi = NPH; a.li = 0;
    hipLaunchKernelGGL(mega, dim3(grid), dim3(NWAVES * 64), LDS_BYTES, stream, a);
#endif
}
```

```cpp
#define DUP_MASK 0
#include <hip/hip_runtime.h>
#include <cstdio>
#include <cstdint>

#ifndef SPLIT_PHASES
#define SPLIT_PHASES 0
#endif
#ifndef DUP_MASK
#define DUP_MASK 0
#endif

constexpr int NTOK = 32768, DM = 1024, SEQ = 4096, NBATCH = 8;
constexpr int NMAIN = 4608, NTR = 1536, NWIN = 5632;
constexpr int C_RQ = 0, C_RK = 512, C_RG = 1024, C_SQ = 1536, C_SK = 2048, C_GR = 2560, C_GS = 3584;
constexpr int C_MG = 0;
constexpr int T_KT = 0, T_VR = 512, T_VS = 1024;
constexpr int NEXP = 16, DEXP = 512, MPAD_MAX = 65536 + 16 * 256, NRT_MAX = MPAD_MAX / 256;
constexpr float EPS = 1e-6f;
constexpr float LOG2E = 1.4426950408889634f;
constexpr float SB_QSCALE = 0.125f * LOG2E;
constexpr float SB_EXIT = -152.0f;

constexpr size_t MiB = 1u << 20;
constexpr size_t WS_CTL = 0, CTL_ZERO_BYTES = 1 * MiB;
constexpr size_t WS_WIN = 2 * MiB;
constexpr size_t WS_WBR1 = 14 * MiB;
constexpr size_t WS_WBR2 = 15 * MiB;
constexpr size_t WS_WOUT = 16 * MiB;
constexpr size_t WS_WGU = 18 * MiB;
constexpr size_t WS_WD = 50 * MiB;
constexpr size_t WS_WPLE = 66 * MiB;
constexpr size_t WS_WPG = 67 * MiB;
constexpr size_t WS_TABA = 70 * MiB;
constexpr size_t WS_TABB = 72 * MiB;
constexpr size_t WS_ROUTE = 74 * MiB;
constexpr size_t WS_PB = 76 * MiB;
constexpr size_t WS_PROJ = 92 * MiB;
constexpr size_t WS_T = 380 * MiB;
constexpr size_t WS_X2 = 360 * MiB;
constexpr size_t WS_END = 488 * MiB;
constexpr size_t WS_H2 = 92 * MiB;
constexpr size_t WS_XB = 156 * MiB;
constexpr size_t WS_HID = 292 * MiB;
constexpr size_t DO_HB = 0, DO_ST = 0, DO_X1 = 0, DO_RS = 64 * MiB;
constexpr size_t RT_EID = 0, RT_WGT = 256 * 1024, RT_RANK = 512 * 1024, RT_POS = 768 * 1024, RT_WROW = 1024 * 1024, RT_TILE = 1536 * 1024;
constexpr int CW_TMO = 0, CW_CODE = 1;
constexpr int CW_CNT = 64;
constexpr int CW_BAR = 4096, BAR_STRIDE = 4096;

#define GAS __attribute__((address_space(1)))
#define LAS __attribute__((address_space(3)))
typedef unsigned short bf16;
typedef unsigned v4u __attribute__((ext_vector_type(4)));
typedef unsigned v2u __attribute__((ext_vector_type(2)));
typedef float f32x4 __attribute__((ext_vector_type(4)));
typedef float f32x2 __attribute__((ext_vector_type(2)));
typedef float f32x16 __attribute__((ext_vector_type(16)));
typedef short bf16x8 __attribute__((ext_vector_type(8)));
typedef short s16x4 __attribute__((ext_vector_type(4)));
typedef GAS unsigned gu32;
#define RLX_AGENT __ATOMIC_RELAXED, __HIP_MEMORY_SCOPE_AGENT
#define LDS_WAIT() asm volatile("s_waitcnt lgkmcnt(0)" ::: "memory")
#define VM_WAIT() asm volatile("s_waitcnt vmcnt(0)" ::: "memory")
#define DI __device__ __forceinline__
DI unsigned f2bf(float f) { unsigned u = __builtin_bit_cast(unsigned, f); return (u + 0x7fffu + ((u >> 16) & 1u)) >> 16; }
DI unsigned pk2(float lo, float hi) { return f2bf(lo) | (f2bf(hi) << 16); }
DI float bf2f(unsigned b) { return __builtin_bit_cast(float, b << 16); }
DI float bflo(unsigned w) { return __builtin_bit_cast(float, w << 16); }
DI float bfhi(unsigned w) { return __builtin_bit_cast(float, w & 0xffff0000u); }
DI float fsigmoid(float x) { return 1.0f / (1.0f + __expf(-x)); }
DI float fsilu(float x) { return x / (1.0f + __expf(-x)); }
DI float wave_sum(float v) {
#pragma unroll
    for (int o = 1; o < 64; o <<= 1) v += __shfl_xor(v, o);
    return v;
}
template <int CTRL, int ROWMASK> DI float dpp_add(float v) { return v + __builtin_bit_cast(float, __builtin_amdgcn_update_dpp(0, __builtin_bit_cast(int, v), CTRL, ROWMASK, 0xF, false)); }
DI float wave_sum_dpp(float v) {
    v = dpp_add<0xB1, 0xF>(v);
    v = dpp_add<0x4E, 0xF>(v);
    v = dpp_add<0x141, 0xF>(v);
    v = dpp_add<0x140, 0xF>(v);
    v = dpp_add<0x142, 0xA>(v);
    v = dpp_add<0x143, 0xC>(v);
    return __builtin_bit_cast(float, __builtin_amdgcn_readlane(__builtin_bit_cast(int, v), 63));
}
DI float ret_log2g(int h) { return log2f(1.0f - exp2f(-5.0f - (float)h)); }

__host__ __device__ __forceinline__ int in_src(int r) {
    if (r < 1024) { const int base = (r < 512) ? 0 : 512; const int i = r & 511, h = i >> 7, j = i & 127; return base + h * 128 + (j & 1) * 64 + (j >> 1); }
    if (r < 1536) return 1536 + (r - 1024);
    if (r < 2048) return 2048 + (r - 1536);
    if (r < 2560) return 2560 + (r - 2048);
    if (r < 3584) return 3584 + (r - 2560);
    if (r < 4608) return 4608 + (r - 3584);
    if (r < 5120) { const int i = r - 4608, h = i >> 7, j = i & 127; return 512 + h * 128 + (j & 1) * 64 + (j >> 1); }
    if (r < 5632) return 1024 + (r - 5120);
    return 3072 + (r - 5632);
}


namespace pg8 {
#define PG8_LAS __attribute__((address_space(3)))
typedef unsigned short bf16_t;
typedef short bf16x8 __attribute__((ext_vector_type(8)));
typedef float f32x4 __attribute__((ext_vector_type(4)));
typedef unsigned u32x4 __attribute__((ext_vector_type(4)));
constexpr int BM = 256, BK = 64, HALF = 128, HTB = HALF * BK * 2  , STAGE_BYTES = 8 * HTB, NXCD = 8, WGM = 8;

__host__ __device__ __forceinline__ int lds_byte(int r, int c) { const int st = (r >> 4) * 2 + (c >> 5), rr = r & 15, cc = c & 31, ob = rr * 64 + cc * 2; return st * 1024 + (ob ^ (((ob >> 9) & 1) << 5)); }
__host__ __device__ __forceinline__ void stage_rc(int b, int& R, int& C) { const int st = b / 1024, sb = b % 1024, swz = sb ^ (((sb >> 9) & 1) << 5); R = (st >> 1) * 16 + swz / 64; C = (st & 1) * 32 + (swz % 64) / 2; }
__host__ __device__ __forceinline__ int perm32(int rho) { const int n = rho >> 4, i = rho & 15; return 8 * (i >> 2) + 4 * n + (i & 3); }

struct Unit { int pm, pn; size_t bofs; int ex; };
struct Gemm { const bf16_t* A; const bf16_t* Bt; int lda, K; };

struct StaticOrder {
    int nM, nN, nwg, G, c; size_t tstepB;
    __device__ void init(int M, int N, int K, int G_, int c_) { nM = M / BM; nN = N / BM; nwg = nM * nN; G = G_; c = c_; tstepB = (size_t)BM * K * 2; }
    __device__ bool next(int i, Unit& u) const {
        const long L = (long)i * G + c; if (L >= nwg) return false;
        int wgid = (int)L; { const int q = nwg / NXCD, r = nwg % NXCD, xcd = wgid % NXCD, off = wgid / NXCD; wgid = (xcd < r ? xcd * (q + 1) : r * (q + 1) + (xcd - r) * q) + off; }
        const int nig = WGM * nN, gid = wgid / nig, fm = gid * WGM, gsz = (nM - fm) < WGM ? (nM - fm) : WGM;
        u.pm = fm + ((wgid % nig) % gsz); u.pn = (wgid % nig) / gsz; u.bofs = (size_t)u.pn * tstepB; u.ex = 0; return true;
    }
    __device__ __forceinline__ void a_ready(const Unit&) const {}
    __device__ __forceinline__ void done(const Unit&) const {}
};
__device__ __forceinline__ unsigned cvt_pk_bf16(float lo, float hi) { unsigned r; asm volatile("v_cvt_pk_bf16_f32 %0, %1, %2" : "=v"(r) : "v"(lo), "v"(hi)); return r; }
template <class Epi, class Sched, bool ALIGN_EPI = false, bool SP2 = false>
__device__ __forceinline__ void gemm_phase(PG8_LAS unsigned char* lds, const Gemm g, const Sched& S, const Epi& E) {
    int tid_ = threadIdx.x; asm volatile("" : "+v"(tid_));
    const int tid = tid_, wid = __builtin_amdgcn_readfirstlane(tid >> 6), lane = tid & 63, wr = wid >> 2, wc = wid & 3, fr = lane & 15, fq = lane >> 4;
    const int K = g.K, nt = K / BK;
    unsigned voffA[2], voffB[2];
#pragma unroll
    for (int i = 0; i < 2; ++i) { int R, C; stage_rc(tid * 16 + i * 8192, R, C); const int Rb = Epi::PERM ? ((R & ~31) + perm32(R & 31)) : R;
        voffA[i] = (unsigned)(R * g.lda + C) * 2u; voffB[i] = (unsigned)(Rb * K + C) * 2u; }
    const size_t kstep = (size_t)(BK * 2);
    const size_t hstepA = (size_t)HALF * g.lda * 2, hstepB = (size_t)HALF * K * 2;
    const size_t tstepA = 2 * hstepA;
    const unsigned ldsw = (unsigned)wid * 1024u;
    const int aoff = lds_byte(wr * 64 + fr, fq * 8), boff = lds_byte(wc * 32 + fr, fq * 8);
#define PG8_SA(b, h) (((b) * 2 + (h)) * HTB)
#define PG8_SB(b, h) ((4 + (b) * 2 + (h)) * HTB)
#define PG8_STAGE(bufoff, gbase, voff) do { _Pragma("unroll") for (int _i = 0; _i < 2; ++_i) \
        __builtin_amdgcn_global_load_lds((const unsigned*)((const char*)(gbase) + (voff)[_i]), (PG8_LAS unsigned*)(lds + (bufoff) + ldsw + _i * 8192), 16, 0, 0); } while (0)
#define PG8_LDA(dst, b, h) do { _Pragma("unroll") for (int m = 0; m < 4; ++m) _Pragma("unroll") for (int k = 0; k < 2; ++k) dst[m][k] = *(const PG8_LAS bf16x8*)(lds + PG8_SA(b, h) + aoff + m * 2048 + k * 1024); } while (0)
#define PG8_LDB(dst, b, h) do { _Pragma("unroll") for (int n = 0; n < 2; ++n) _Pragma("unroll") for (int k = 0; k < 2; ++k) dst[n][k] = *(const PG8_LAS bf16x8*)(lds + PG8_SB(b, h) + boff + n * 2048 + k * 1024); } while (0)
#define PG8_MMA(ai, bj, At, Bt) do { __builtin_amdgcn_s_setprio(1); _Pragma("unroll") for (int m = 0; m < 4; ++m) _Pragma("unroll") for (int n = 0; n < 2; ++n) _Pragma("unroll") for (int k = 0; k < 2; ++k) \
        acc[ai][bj][m][n] = __builtin_amdgcn_mfma_f32_16x16x32_bf16(Bt[n][k], At[m][k], acc[ai][bj][m][n], 0, 0, 0); __builtin_amdgcn_s_setprio(0); } while (0)
#define PG8_WAIT_V(n) asm volatile("s_waitcnt vmcnt(" #n ")" ::: "memory")
#define PG8_WAIT_L(n) asm volatile("s_waitcnt lgkmcnt(" #n ")" ::: "memory")
#define PG8_BAR __builtin_amdgcn_s_barrier()
#define PG8_SCHED __builtin_amdgcn_sched_barrier(0)
    Unit cur, nxt; int ui = 0;
    if (!S.next(0, cur)) return;
    f32x4 acc[2][2][4][2];
#pragma unroll
    for (int a = 0; a < 2; ++a)
#pragma unroll
        for (int b = 0; b < 2; ++b)
#pragma unroll
            for (int m = 0; m < 4; ++m)
#pragma unroll
                for (int n = 0; n < 2; ++n) acc[a][b][m][n] = (f32x4){0.f, 0.f, 0.f, 0.f};
    bf16x8 At[4][2], B0[2][2], B1[2][2];
    const char* cA = (const char*)g.A + (size_t)cur.pm * tstepA; const char* cB = (const char*)g.Bt + cur.bofs;
    S.a_ready(cur);
    if constexpr (SP2) {
        PG8_STAGE(PG8_SB(0, 0), cB, voffB); PG8_STAGE(PG8_SB(0, 1), cB + hstepB, voffB); PG8_STAGE(PG8_SA(0, 0), cA, voffA); PG8_STAGE(PG8_SA(0, 1), cA + hstepA, voffA);
        if (wr == 1) PG8_BAR;
        PG8_WAIT_V(2); PG8_BAR;
        PG8_STAGE(PG8_SB(1, 0), cB + kstep, voffB); PG8_STAGE(PG8_SA(1, 0), cA + kstep, voffA); PG8_STAGE(PG8_SB(1, 1), cB + hstepB + kstep, voffB);
        PG8_WAIT_V(6); PG8_BAR;
    } else {
        PG8_STAGE(PG8_SB(0, 0), cB, voffB); PG8_STAGE(PG8_SA(0, 0), cA, voffA); PG8_STAGE(PG8_SB(0, 1), cB + hstepB, voffB); PG8_STAGE(PG8_SA(0, 1), cA + hstepA, voffA);
        if (wr == 1) PG8_BAR;
        PG8_WAIT_V(4); PG8_BAR;
        PG8_STAGE(PG8_SB(1, 0), cB + kstep, voffB); PG8_STAGE(PG8_SA(1, 0), cA + kstep, voffA); PG8_STAGE(PG8_SB(1, 1), cB + hstepB + kstep, voffB);
        PG8_WAIT_V(6); PG8_BAR;
    }
    for (;;) {
        const bool has_next = S.next(ui + 1, nxt);
        const char* nA = has_next ? (const char*)g.A + (size_t)nxt.pm * tstepA : cA; const char* nB = has_next ? (const char*)g.Bt + nxt.bofs : cB;
        for (int t = 0; t < nt; t += 2) {
            const bool last = (t == nt - 2);
            const char* a1 = cA + (size_t)(t + 1) * kstep;
            const char* a2 = last ? nA : cA + (size_t)(t + 2) * kstep; const char* b2 = last ? nB : cB + (size_t)(t + 2) * kstep;
            const char* a3 = a2 + kstep; const char* b3 = b2 + kstep;
            if (last && has_next) S.a_ready(nxt);
            if constexpr (SP2) {
            PG8_LDB(B0, 0, 0); PG8_LDB(B1, 0, 1); PG8_SCHED; PG8_LDA(At, 0, 0); PG8_STAGE(PG8_SA(1, 1), a1 + hstepA, voffA);
            PG8_WAIT_V(8); PG8_WAIT_L(0); PG8_BAR; PG8_MMA(0, 0, At, B0); PG8_MMA(0, 1, At, B1); PG8_BAR; PG8_SCHED;
            PG8_LDA(At, 0, 1); PG8_STAGE(PG8_SB(0, 0), b2, voffB); PG8_STAGE(PG8_SB(0, 1), b2 + hstepB, voffB); PG8_STAGE(PG8_SA(0, 0), a2, voffA);
            PG8_WAIT_V(8); PG8_WAIT_L(0); PG8_BAR; PG8_MMA(1, 0, At, B0); PG8_MMA(1, 1, At, B1); PG8_BAR; PG8_SCHED;
            PG8_LDB(B0, 1, 0); PG8_LDB(B1, 1, 1); PG8_SCHED; PG8_LDA(At, 1, 0); PG8_STAGE(PG8_SA(0, 1), a2 + hstepA, voffA);
            PG8_WAIT_V(8); PG8_WAIT_L(0); PG8_BAR; PG8_MMA(0, 0, At, B0); PG8_MMA(0, 1, At, B1); PG8_BAR; PG8_SCHED;
            PG8_LDA(At, 1, 1); PG8_STAGE(PG8_SB(1, 0), b3, voffB); PG8_STAGE(PG8_SB(1, 1), b3 + hstepB, voffB); PG8_STAGE(PG8_SA(1, 0), a3, voffA);
            PG8_WAIT_V(8); PG8_WAIT_L(0); PG8_BAR; PG8_MMA(1, 0, At, B0); PG8_MMA(1, 1, At, B1); PG8_BAR; PG8_SCHED;
            } else {
            PG8_LDB(B0, 0, 0); PG8_SCHED; PG8_LDA(At, 0, 0); PG8_STAGE(PG8_SA(1, 1), a1 + hstepA, voffA);
            PG8_WAIT_L(8); PG8_BAR; PG8_WAIT_L(0); PG8_MMA(0, 0, At, B0); PG8_BAR; PG8_SCHED;
            PG8_LDB(B1, 0, 1); PG8_STAGE(PG8_SB(0, 0), b2, voffB);
            PG8_BAR; PG8_WAIT_L(0); PG8_MMA(0, 1, At, B1); PG8_BAR;
            PG8_LDA(At, 0, 1); PG8_STAGE(PG8_SA(0, 0), a2, voffA);
            PG8_BAR; PG8_WAIT_L(0); PG8_MMA(1, 0, At, B0); PG8_BAR; PG8_SCHED;
            PG8_STAGE(PG8_SB(0, 1), b2 + hstepB, voffB);
            PG8_WAIT_V(6); PG8_BAR; PG8_MMA(1, 1, At, B1); PG8_BAR;
            PG8_LDB(B0, 1, 0); PG8_SCHED; PG8_LDA(At, 1, 0); PG8_STAGE(PG8_SA(0, 1), a2 + hstepA, voffA);
            PG8_WAIT_L(8); PG8_BAR; PG8_WAIT_L(0); PG8_MMA(0, 0, At, B0); PG8_BAR; PG8_SCHED;
            PG8_LDB(B1, 1, 1); PG8_STAGE(PG8_SB(1, 0), b3, voffB);
            PG8_BAR; PG8_WAIT_L(0); PG8_MMA(0, 1, At, B1); PG8_BAR;
            PG8_LDA(At, 1, 1); PG8_STAGE(PG8_SA(1, 0), a3, voffA);
            PG8_BAR; PG8_WAIT_L(0); PG8_MMA(1, 0, At, B0); PG8_BAR; PG8_SCHED;
            PG8_STAGE(PG8_SB(1, 1), b3 + hstepB, voffB);
            PG8_WAIT_V(6); PG8_BAR; PG8_MMA(1, 1, At, B1); PG8_BAR;
            }
        }
        if constexpr (ALIGN_EPI) { if (wr == 0) PG8_BAR; }
        if constexpr (!Epi::AFTER_DRAIN) { E(acc, cur, wr, wc, fr, fq); S.done(cur); }
        if (!has_next) break;
#pragma unroll
        for (int a = 0; a < 2; ++a)
#pragma unroll
            for (int b = 0; b < 2; ++b)
#pragma unroll
                for (int m = 0; m < 4; ++m)
#pragma unroll
                    for (int n = 0; n < 2; ++n) acc[a][b][m][n] = (f32x4){0.f, 0.f, 0.f, 0.f};
        cur = nxt; cA = nA; cB = nB; ++ui;
        if constexpr (ALIGN_EPI) { if (wr == 1) PG8_BAR; }
    }
    PG8_WAIT_V(0);
    if constexpr (!ALIGN_EPI) { if (wr == 0) PG8_BAR; }
    PG8_BAR;
    if constexpr (Epi::AFTER_DRAIN) { E.fused(acc, cur, wr, wc, fr, fq, lds, wid, lane); S.done(cur); }
#undef PG8_SA
#undef PG8_SB
#undef PG8_STAGE
#undef PG8_LDA
#undef PG8_LDB
#undef PG8_MMA
#undef PG8_WAIT_V
#undef PG8_WAIT_L
#undef PG8_BAR
#undef PG8_SCHED
}
}
#define XB_TMO      128
#define XB_XCNT(j)  (256  + 64 * (j))
#define XB_XSUB(j)  (1280 + 64 * (j))
#define XB_XGEN(j)  (2304 + 64 * (j))
#define XB_TOP      3328
#define XB_TOPGEN   3392
#define XCD_BAR_WORDS 3456
#define XB_SPIN_CAP (1u << 18)

__device__ __forceinline__ unsigned xb_ld(unsigned* p)              { return __hip_atomic_load(p, __ATOMIC_RELAXED, __HIP_MEMORY_SCOPE_AGENT); }
__device__ __forceinline__ unsigned xb_add(unsigned* p, unsigned v) { return __hip_atomic_fetch_add(p, v, __ATOMIC_RELAXED, __HIP_MEMORY_SCOPE_AGENT); }
__device__ __forceinline__ unsigned xb_xcc_id() { return (unsigned)__builtin_amdgcn_s_getreg((3 << 11) | 20) & 0xFu; }
#define XB_SPIN(cond, bar) do { unsigned _sp = 0; while (cond) { __builtin_amdgcn_s_sleep(1); \
    if ((++_sp & 255u) == 0u) { if (xb_ld(&(bar)[XB_TMO])) break; if (_sp > XB_SPIN_CAP) { atomicAdd(&(bar)[XB_TMO], 1u); break; } } } } while (0)

struct XcdBarrier {
    unsigned* bar; unsigned x;
    volatile LAS unsigned* st;
};

__device__ __forceinline__ XcdBarrier xcd_barrier_post(unsigned* bar, volatile LAS unsigned* st) {
    XcdBarrier b; b.bar = bar; b.x = xb_xcc_id(); b.st = st;
    if (threadIdx.x == 0) (void)xb_add(&bar[XB_XCNT(b.x)], 1u);
    return b;
}
__device__ __forceinline__ void xcd_barrier_complete(unsigned* bar, unsigned x, unsigned& nloc, unsigned& nx) {
    const unsigned G = gridDim.x * gridDim.y * gridDim.z;
    unsigned sum, cnt, mine, sp = 0u;
    for (;;) {
        sum = 0u; cnt = 0u; mine = 0u;
#pragma unroll
        for (unsigned j = 0; j < 16; ++j) { const unsigned c = xb_ld(&bar[XB_XCNT(j)]); sum += c; cnt += (c > 0u) ? 1u : 0u; mine = (j == x) ? c : mine; }
        if (sum == G) break;
        __builtin_amdgcn_s_sleep(1);
        if ((++sp & 255u) == 0u) { if (xb_ld(&bar[XB_TMO])) break; if (sp > XB_SPIN_CAP) { atomicAdd(&bar[XB_TMO], 1u); break; } }
    }
    nloc = mine > 0u ? mine : 1u; nx = cnt > 0u ? cnt : 1u;
}

__device__ __forceinline__ void xcd_barrier(const XcdBarrier& b) {
    asm volatile("s_waitcnt vmcnt(0)" ::: "memory");
    __syncthreads();
    if (threadIdx.x == 0) {
        unsigned* bar = b.bar;
        __builtin_amdgcn_s_waitcnt(0);
        unsigned nloc = b.st[0], nx = b.st[1];
        if (nloc == 0u) { xcd_barrier_complete(bar, b.x, nloc, nx); b.st[0] = nloc; b.st[1] = nx; }
        const unsigned old = xb_add(&bar[XB_XSUB(b.x)], 1u);
        const unsigned gen = old / nloc;
        if (old + 1u == (gen + 1u) * nloc) {
            __builtin_amdgcn_fence(__ATOMIC_RELEASE, "agent");
            asm volatile("s_waitcnt vmcnt(0)" ::: "memory");
            const unsigned og = xb_add(&bar[XB_TOP], 1u);
            const unsigned tg = og / nx;
            if (og + 1u == (tg + 1u) * nx) xb_add(&bar[XB_TOPGEN], 1u);
            else XB_SPIN(xb_ld(&bar[XB_TOPGEN]) == tg, bar);
            __builtin_amdgcn_fence(__ATOMIC_ACQUIRE, "agent");
            xb_add(&bar[XB_XGEN(b.x)], 1u);
            asm volatile("s_waitcnt vmcnt(0)" ::: "memory");
        } else {
            XB_SPIN(xb_ld(&bar[XB_XGEN(b.x)]) == gen, bar);
            __builtin_amdgcn_fence(__ATOMIC_ACQUIRE, "agent");
            asm volatile("s_waitcnt vmcnt(0)" ::: "memory");
        }
    }
    __syncthreads();
}

constexpr int NWAVES = 8;
constexpr int RING_OFF = 0, RING_BYTES = 131072;
constexpr int LDSCTL_OFF = RING_BYTES, MISC_OFF = LDSCTL_OFF + 320;
constexpr int LDS_BYTES = 147456;

struct Args { const float* in[20]; float* out; unsigned char* ws; int ph_lo, ph_hi, li, pad; };

struct Frame {
    LAS unsigned char* lds;
    volatile LAS unsigned* MISC;
    gu32* ctl;
    int tid, lane, wave, vcu, G;
    __device__ __forceinline__ void refresh() { int t = threadIdx.x; asm volatile("" : "+v"(t)); tid = t; lane = t & 63; wave = __builtin_amdgcn_readfirstlane(t >> 6); }
    unsigned char* ws; float* out;
    const float* x; const float* p;
};

enum Phase { PH_PRO = 0, PH_PROJ, PH_MIX1, PH_SCAN, PH_RETO, PH_BR, PH_WOUT, PH_ROUTE, PH_GATHER, PH_GU, PH_DOWN, PH_COMB, PH_PLE, PH_FINAL, NPH };

DI void tr_item(const float* __restrict__ W, int ldw, int mycol, bf16* WT, int K, int r0, int k0, LAS float* scr, int lane) {
#pragma unroll 8
    for (int i = 0; i < 32; ++i) { const int kk = 2 * i + (lane >> 5); scr[kk * 33 + (lane & 31)] = W[(size_t)(k0 + kk) * ldw + mycol]; }
    LDS_WAIT(); asm volatile("" ::: "memory");
    const int c = lane & 7;
#pragma unroll
    for (int j = 0; j < 4; ++j) { const int n = (lane >> 3) + 8 * j; const LAS float* s = scr + (8 * c) * 33 + n;
        v4u o; o.x = pk2(s[0 * 33], s[1 * 33]); o.y = pk2(s[2 * 33], s[3 * 33]); o.z = pk2(s[4 * 33], s[5 * 33]); o.w = pk2(s[6 * 33], s[7 * 33]);
        *(GAS v4u*)(WT + (size_t)(r0 + n) * K + k0 + 8 * c) = o; }
    LDS_WAIT(); asm volatile("" ::: "memory");
}
DI void rms_row_to_bf16(const float* xrow, const float* gain, bf16* orow, int lane) {
    const GAS f32x4* xr = (const GAS f32x4*)xrow + lane; const GAS f32x4* gr = (const GAS f32x4*)gain + lane;
    f32x4 v[4]; float s = 0.f;
#pragma unroll
    for (int j = 0; j < 4; ++j) { v[j] = xr[64 * j]; s += (v[j].x * v[j].x + v[j].y * v[j].y) + (v[j].z * v[j].z + v[j].w * v[j].w); }
    const float rstd = rsqrtf(wave_sum_dpp(s) * (1.f / DM) + EPS);
    GAS v2u* o8 = (GAS v2u*)orow + lane;
#pragma unroll
    for (int j = 0; j < 4; ++j) { const f32x4 g = gr[64 * j]; v2u o; o.x = pk2(v[j].x * rstd * g.x, v[j].y * rstd * g.y); o.y = pk2(v[j].z * rstd * g.z, v[j].w * rstd * g.w); o8[64 * j] = o; }
}
DI void ph_prologue(Frame& F, const Args& a) {
    LAS float* scr = (LAS float*)(F.lds + RING_OFF + F.wave * 16384);
    const int gw = F.vcu * NWAVES + F.wave, NGW = F.G * NWAVES, lane = F.lane;
    unsigned char* ws = F.ws;
    constexpr int I_IN = (6144 / 32) * 16, I_BR = 32 * 8, I_OUT = 32 * 16, I_GU = 16 * 32 * 16, I_D = 16 * 32 * 8, I_PLE = 32 * 4, I_PG = 32 * 16;
    constexpr int NITEMS = I_IN + 2 * I_BR + I_OUT + I_GU + I_D + I_PLE + I_PG;
    for (int it = gw; it < NITEMS; it += NGW) {
        int r = it;
        if (r < I_IN) { const int rb = r >> 4, kb = r & 15; tr_item(a.in[3], NWIN, in_src(rb * 32 + (lane & 31)), (bf16*)(ws + WS_WIN), 1024, rb * 32, kb * 64, scr, lane); continue; } r -= I_IN;
        if (r < I_BR) { const int rb = r >> 3, kb = r & 7; tr_item(a.in[5], DM, rb * 32 + (lane & 31), (bf16*)(ws + WS_WBR1), 512, rb * 32, kb * 64, scr, lane); continue; } r -= I_BR;
        if (r < I_BR) { const int rb = r >> 3, kb = r & 7; tr_item(a.in[6], DM, rb * 32 + (lane & 31), (bf16*)(ws + WS_WBR2), 512, rb * 32, kb * 64, scr, lane); continue; } r -= I_BR;
        if (r < I_OUT) { const int rb = r >> 4, kb = r & 15; tr_item(a.in[7], DM, rb * 32 + (lane & 31), (bf16*)(ws + WS_WOUT), 1024, rb * 32, kb * 64, scr, lane); continue; } r -= I_OUT;
        if (r < I_GU) { const int e = r >> 9, q = r & 511, rb = q >> 4, kb = q & 15;
            const int row = rb * 32, j = row >> 8, w = row & 255; const bool up = w >= 128; const int col = 128 * j + (w & 127) + (lane & 31);
            tr_item((up ? a.in[14] : a.in[13]) + (size_t)e * DM * DEXP, DEXP, col, (bf16*)(ws + WS_WGU) + (size_t)e * 1024 * 1024, 1024, row, kb * 64, scr, lane); continue; } r -= I_GU;
        if (r < I_D) { const int e = r >> 8, q = r & 255, rb = q >> 3, kb = q & 7;
            tr_item(a.in[15] + (size_t)e * DEXP * DM, DM, rb * 32 + (lane & 31), (bf16*)(ws + WS_WD) + (size_t)e * 1024 * 512, 512, rb * 32, kb * 64, scr, lane); continue; } r -= I_D;
        if (r < I_PLE) { const int rb = r >> 2, kb = r & 3; tr_item(a.in[17], DM, rb * 32 + (lane & 31), (bf16*)(ws + WS_WPLE), 256, rb * 32, kb * 64, scr, lane); continue; } r -= I_PLE;
        { const int rb = r >> 4, kb = r & 15; tr_item(a.in[18], DM, rb * 32 + (lane & 31), (bf16*)(ws + WS_WPG), 1024, rb * 32, kb * 64, scr, lane); }
    }
    bf16* HB = (bf16*)((unsigned char*)F.out + DO_HB);
    for (int m = gw; m < NTOK; m += NGW) {
        rms_row_to_bf16(F.x + (size_t)m * DM, a.in[2], HB + (size_t)m * DM, lane);
        const f32x4 pv = ((const GAS f32x4*)(F.p + (size_t)m * 256))[lane];
        v2u o; o.x = pk2(pv.x, pv.y); o.y = pk2(pv.z, pv.w); ((GAS v2u*)((bf16*)(ws + WS_PB) + (size_t)m * 256))[lane] = o;
    }
    f32x2* tabA = (f32x2*)(ws + WS_TABA); f32x2* tabB = (f32x2*)(ws + WS_TABB);
    for (int i = F.vcu * 512 + F.tid; i < SEQ * 64; i += F.G * 512) {
        const int pos = i >> 6, p = i & 63;
        const float invf = powf(10000.0f, -(float)(2 * p) * (1.0f / 128.0f)); const float ang = (float)pos * invf;
        const f32x2 cs = {cosf(ang), sinf(ang)};
        tabA[i] = cs; tabB[p * SEQ + pos] = cs;
    }
}

DI void ph_route(Frame& F, const Args& a) {
    LAS float* WL = (LAS float*)(F.lds);
    for (int i = F.tid; i < 1024 * 20; i += 512) { const int k = i / 20, o = i - k * 20; WL[((k & 3) * 256 + (k >> 2)) * 20 + o] = o < 4 ? a.in[9][k * 4 + o] : a.in[11][k * 16 + (o - 4)]; }
    LAS int* s_e = (LAS int*)(F.lds + 81920); LAS int* s_lr = s_e + 256; LAS int* lcnt = s_lr + 256; LAS int* lbase = lcnt + 16;
    unsigned char* ws = F.ws; const int lane = F.lane;
    int* eid = (int*)(ws + WS_ROUTE + RT_EID); float* wgt = (float*)(ws + WS_ROUTE + RT_WGT); int* rank = (int*)(ws + WS_ROUTE + RT_RANK);
    bf16* H2 = (bf16*)(ws + WS_H2); const bf16* X1 = (const bf16*)((unsigned char*)F.out + DO_X1);
    const float* bg = a.in[10]; const float* be = a.in[12];
    __syncthreads();
    for (int blk = F.vcu; blk < NTOK / 128; blk += F.G) {
        if (F.tid < 16) lcnt[F.tid] = 0;
        __syncthreads();
        v2u raw[4];
        { const GAS v2u* xr = (const GAS v2u*)(X1 + (size_t)(blk * 128 + F.wave) * DM) + lane;
#pragma unroll
          for (int j = 0; j < 4; ++j) raw[j] = xr[64 * j]; }
        for (int tl = F.wave; tl < 128; tl += NWAVES) {
            const int tok = blk * 128 + tl;
            v2u nxt[4];
            { const int tn = (tl + NWAVES < 128) ? tok + NWAVES : tok; const GAS v2u* xr = (const GAS v2u*)(X1 + (size_t)tn * DM) + lane;
#pragma unroll
              for (int j = 0; j < 4; ++j) nxt[j] = xr[64 * j]; }
            const GAS f32x4* gr = (const GAS f32x4*)a.in[8] + lane;
            f32x4 v[4]; float ss = 0.f;
#pragma unroll
            for (int j = 0; j < 4; ++j) { v[j] = (f32x4){bflo(raw[j].x), bfhi(raw[j].x), bflo(raw[j].y), bfhi(raw[j].y)}; ss += (v[j].x * v[j].x + v[j].y * v[j].y) + (v[j].z * v[j].z + v[j].w * v[j].w); }
            const float rstd = rsqrtf(wave_sum_dpp(ss) * (1.f / DM) + EPS);
            GAS v2u* o8 = (GAS v2u*)(H2 + (size_t)tok * DM) + lane;
            float acc[20];
#pragma unroll
            for (int o = 0; o < 20; ++o) acc[o] = 0.f;
#pragma unroll
            for (int j = 0; j < 4; ++j) {
                const f32x4 g = gr[64 * j]; v[j] = v[j] * rstd * g;
                v2u o; o.x = pk2(v[j].x, v[j].y); o.y = pk2(v[j].z, v[j].w); o8[64 * j] = o;
#pragma unroll
                for (int i = 0; i < 4; ++i) {
                    const float hv = v[j][i]; const LAS f32x4* w = (const LAS f32x4*)(WL + (i * 256 + lane + 64 * j) * 20);
#pragma unroll
                    for (int q = 0; q < 5; ++q) { const f32x4 wv = w[q]; acc[4 * q] += hv * wv.x; acc[4 * q + 1] += hv * wv.y; acc[4 * q + 2] += hv * wv.z; acc[4 * q + 3] += hv * wv.w; }
                }
            }
#pragma unroll
            for (int o = 0; o < 20; ++o) acc[o] = wave_sum_dpp(acc[o]);
            float gl[4];
#pragma unroll
            for (int i = 0; i < 4; ++i) gl[i] = acc[i] + bg[i];
            int g = 0; float gm = gl[0];
#pragma unroll
            for (int i = 1; i < 4; ++i) if (gl[i] > gm) { gm = gl[i]; g = i; }
            float se = 0.f;
#pragma unroll
            for (int i = 0; i < 4; ++i) se += __expf(gl[i] - gm);
            const float pg = 1.0f / se;
            float el[4];
#pragma unroll
            for (int i = 0; i < 4; ++i) { const float l0 = acc[4 + i], l1 = acc[8 + i], l2 = acc[12 + i], l3 = acc[16 + i]; el[i] = (g == 0 ? l0 : g == 1 ? l1 : g == 2 ? l2 : l3) + be[4 * g + i]; }
            int i1 = 0; float m1 = el[0];
#pragma unroll
            for (int i = 1; i < 4; ++i) if (el[i] > m1) { m1 = el[i]; i1 = i; }
            int i2 = -1; float m2 = -3.0e38f;
#pragma unroll
            for (int i = 0; i < 4; ++i) if (i != i1 && el[i] > m2) { m2 = el[i]; i2 = i; }
            const float e2 = __expf(m2 - m1), w1 = pg / (1.0f + e2), w2 = pg * e2 / (1.0f + e2);
            if (lane == 0) {
                eid[2 * tok] = 4 * g + i1; eid[2 * tok + 1] = 4 * g + i2; wgt[2 * tok] = w1; wgt[2 * tok + 1] = w2;
                s_e[2 * tl] = 4 * g + i1; s_e[2 * tl + 1] = 4 * g + i2;
            }
#pragma unroll
            for (int j = 0; j < 4; ++j) raw[j] = nxt[j];
        }
        __syncthreads();
        if (F.tid < 256) s_lr[F.tid] = atomicAdd((int*)&lcnt[s_e[F.tid]], 1);
        __syncthreads();
        if (F.tid < 16) lbase[F.tid] = (int)__hip_atomic_fetch_add(F.ctl + CW_CNT + F.tid, (unsigned)lcnt[F.tid], RLX_AGENT);
        __syncthreads();
        if (F.tid < 256) rank[blk * 256 + F.tid] = lbase[s_e[F.tid]] + s_lr[F.tid];
        __syncthreads();
    }
}

DI void expert_table(Frame& F, LAS int* pst) {
    if (F.tid == 0) { int acc = 0; for (int e = 0; e < NEXP; ++e) { pst[e] = acc; const int c = (int)__hip_atomic_load(F.ctl + CW_CNT + e, RLX_AGENT); acc += (c + 255) & ~255; } pst[NEXP] = acc; }
    __syncthreads();
}

DI void ph_gather(Frame& F, const Args& a) {
    LAS int* pst = (LAS int*)(F.lds);
    expert_table(F, pst);
    unsigned char* ws = F.ws; const int lane = F.lane;
    const int* eid = (const int*)(ws + WS_ROUTE + RT_EID); const float* wgt = (const float*)(ws + WS_ROUTE + RT_WGT); const int* rank = (const int*)(ws + WS_ROUTE + RT_RANK);
    int* pos = (int*)(ws + WS_ROUTE + RT_POS); float* wrow = (float*)(ws + WS_ROUTE + RT_WROW); int* tile = (int*)(ws + WS_ROUTE + RT_TILE);
    const bf16* H2 = (const bf16*)(ws + WS_H2); bf16* XB = (bf16*)(ws + WS_XB);
    if (blockIdx.x == 0 && F.tid < NEXP) { const int e = F.tid; for (int rt = pst[e] >> 8; rt < (pst[e + 1] >> 8); ++rt) tile[1 + rt] = e; if (e == 0) tile[0] = pst[NEXP] >> 8; }
    const int gw = F.vcu * NWAVES + F.wave, NGW = F.G * NWAVES;
    v4u r0, r1; int e0, e1, k0, k1;
#define GATH_LOAD(tk, a0, a1, x0, x1, y0, y1) do { const GAS v4u* s_ = (const GAS v4u*)(H2 + (size_t)(tk) * DM) + lane; a0 = s_[0]; a1 = s_[64]; x0 = eid[2 * (tk)]; x1 = eid[2 * (tk) + 1]; y0 = rank[2 * (tk)]; y1 = rank[2 * (tk) + 1]; } while (0)
    if (gw < NTOK) GATH_LOAD(gw, r0, r1, e0, e1, k0, k1);
    for (int tok = gw; tok < NTOK; tok += NGW) {
        v4u n0, n1; int f0, f1, m0, m1;
        { const int tn = (tok + NGW < NTOK) ? tok + NGW : tok; GATH_LOAD(tn, n0, n1, f0, f1, m0, m1); }
        const int p0 = pst[e0] + k0, p1 = pst[e1] + k1;
        GAS v4u* d0 = (GAS v4u*)(XB + (size_t)p0 * DM) + lane; GAS v4u* d1 = (GAS v4u*)(XB + (size_t)p1 * DM) + lane;
        d0[0] = r0; d0[64] = r1; d1[0] = r0; d1[64] = r1;
        if (lane == 0) { pos[2 * tok] = p0; pos[2 * tok + 1] = p1; wrow[p0] = wgt[2 * tok]; wrow[p1] = wgt[2 * tok + 1]; }
        r0 = n0; r1 = n1; e0 = f0; e1 = f1; k0 = m0; k1 = m1;
    }
#undef GATH_LOAD
}

DI void ph_combine(Frame& F, const Args& a) {
    unsigned char* ws = F.ws; const int lane = F.lane;
    const int* __restrict__ pos = (const int*)(ws + WS_ROUTE + RT_POS); const bf16* __restrict__ YB = (const bf16*)(ws + WS_XB); bf16* __restrict__ HP = (bf16*)(ws + WS_H2);
    const bf16* __restrict__ X1 = (const bf16*)((unsigned char*)F.out + DO_X1); bf16* __restrict__ X2 = (bf16*)(ws + WS_X2);
    const int gw = F.vcu * NWAVES + F.wave, NGW = F.G * NWAVES;
    v2u cx[4], c0[4], c1[4];
#define COMB_LOAD(tk, dx, d0, d1) do { const int p0_ = pos[2 * (tk)], p1_ = pos[2 * (tk) + 1]; \
        const GAS v2u* xr_ = (const GAS v2u*)(X1 + (size_t)(tk) * DM) + lane; const GAS v2u* y0_ = (const GAS v2u*)(YB + (size_t)p0_ * DM) + lane; const GAS v2u* y1_ = (const GAS v2u*)(YB + (size_t)p1_ * DM) + lane; \
        _Pragma("unroll") for (int j = 0; j < 4; ++j) { dx[j] = xr_[64 * j]; d0[j] = y0_[64 * j]; d1[j] = y1_[64 * j]; } } while (0)
    if (gw < NTOK) COMB_LOAD(gw, cx, c0, c1);
    for (int tok = gw; tok < NTOK; tok += NGW) {
        v2u nx[4], n0[4], n1[4];
        { const int tn = (tok + NGW < NTOK) ? tok + NGW : tok; COMB_LOAD(tn, nx, n0, n1); }
        const GAS f32x4* gr = (const GAS f32x4*)a.in[16] + lane; GAS v2u* xw = (GAS v2u*)(X2 + (size_t)tok * DM) + lane;
        f32x4 v[4]; float ss = 0.f;
#pragma unroll
        for (int j = 0; j < 4; ++j) {
            const v2u x0 = cx[j], a0 = c0[j], a1 = c1[j];
            v[j].x = bflo(x0.x) + bflo(a0.x) + bflo(a1.x); v[j].y = bfhi(x0.x) + bfhi(a0.x) + bfhi(a1.x); v[j].z = bflo(x0.y) + bflo(a0.y) + bflo(a1.y); v[j].w = bfhi(x0.y) + bfhi(a0.y) + bfhi(a1.y);
            v2u o; o.x = pk2(v[j].x, v[j].y); o.y = pk2(v[j].z, v[j].w); xw[64 * j] = o;
            ss += (v[j].x * v[j].x + v[j].y * v[j].y) + (v[j].z * v[j].z + v[j].w * v[j].w);
        }
        const float rstd = rsqrtf(wave_sum_dpp(ss) * (1.f / DM) + EPS);
        GAS v2u* o8 = (GAS v2u*)(HP + (size_t)tok * DM) + lane;
#pragma unroll
        for (int j = 0; j < 4; ++j) { const f32x4 g = gr[64 * j]; v2u o; o.x = pk2(v[j].x * rstd * g.x, v[j].y * rstd * g.y); o.y = pk2(v[j].z * rstd * g.z, v[j].w * rstd * g.w); o8[64 * j] = o; }
#pragma unroll
        for (int j = 0; j < 4; ++j) { cx[j] = nx[j]; c0[j] = n0[j]; c1[j] = n1[j]; }
    }
#undef COMB_LOAD
}

DI void ph_final(Frame& F, const Args& a) {
    const int lane = F.lane, gw = F.vcu * NWAVES + F.wave, NGW = F.G * NWAVES;
    f32x4 cur[4];
    if (gw < NTOK) { const GAS f32x4* xr = (const GAS f32x4*)(F.out + (size_t)gw * DM) + lane;
#pragma unroll
        for (int j = 0; j < 4; ++j) cur[j] = xr[64 * j]; }
    for (int tok = gw; tok < NTOK; tok += NGW) {
        f32x4 nxt[4];
        { const int tn = (tok + NGW < NTOK) ? tok + NGW : tok; const GAS f32x4* xn = (const GAS f32x4*)(F.out + (size_t)tn * DM) + lane;
#pragma unroll
          for (int j = 0; j < 4; ++j) nxt[j] = xn[64 * j]; }
        GAS f32x4* xr = (GAS f32x4*)(F.out + (size_t)tok * DM) + lane; const GAS f32x4* gr = (const GAS f32x4*)a.in[19] + lane;
        float ss = 0.f;
#pragma unroll
        for (int j = 0; j < 4; ++j) ss += (cur[j].x * cur[j].x + cur[j].y * cur[j].y) + (cur[j].z * cur[j].z + cur[j].w * cur[j].w);
        const float rstd = rsqrtf(wave_sum_dpp(ss) * (1.f / DM) + EPS);
#pragma unroll
        for (int j = 0; j < 4; ++j) { const f32x4 g = gr[64 * j]; xr[64 * j] = cur[j] * rstd * g; }
#pragma unroll
        for (int j = 0; j < 4; ++j) cur[j] = nxt[j];
    }
}

typedef pg8::f32x4 af4;
DI unsigned cvtpk(float lo, float hi) { typedef float f2 __attribute__((ext_vector_type(2))); typedef __bf16 b2 __attribute__((ext_vector_type(2))); f2 v = {lo, hi}; b2 b = __builtin_convertvector(v, b2); return __builtin_bit_cast(unsigned, b); }
DI v4u pack8(const float (&x)[8]) { v4u w; w.x = cvtpk(x[0], x[1]); w.y = cvtpk(x[2], x[3]); w.z = cvtpk(x[4], x[5]); w.w = cvtpk(x[6], x[7]); return w; }
DI void unpack8(const v4u w, float (&x)[8]) { x[0] = bflo(w.x); x[1] = bfhi(w.x); x[2] = bflo(w.y); x[3] = bfhi(w.y); x[4] = bflo(w.z); x[5] = bfhi(w.z); x[6] = bflo(w.w); x[7] = bfhi(w.w); }

struct EpiProj {
    static constexpr bool PERM = true, AFTER_DRAIN = false;
    bf16* PROJ; const f32x2* tabA; const float* gn;
    DI void operator()(const af4 (&acc)[2][2][4][2], const pg8::Unit& u, int wr, int wc, int fr, int fq) const {
        const int row0 = u.pm * 256 + wr * 64 + fr, colb = u.pn * 256 + wc * 32 + 8 * fq;
        const int kind = u.pn < 2 ? 0 : u.pn < 4 ? 1 : u.pn < 6 ? 2 : u.pn < 8 ? 3 : u.pn < 10 ? 4 : 5;
#pragma unroll
        for (int ai = 0; ai < 2; ++ai)
#pragma unroll
            for (int m = 0; m < 4; ++m) {
                const int row = row0 + ai * 128 + m * 16;
#pragma unroll
                for (int bj = 0; bj < 2; ++bj) {
                    const int col = colb + bj * 128;
                    const af4 a0 = acc[ai][bj][m][0], a1 = acc[ai][bj][m][1];
                    float x[8] = {a0[0], a0[1], a0[2], a0[3], a1[0], a1[1], a1[2], a1[3]};
                    if (kind <= 1) {
                        const int pos = row & (SEQ - 1), p = (col & 127) >> 1;
                        const f32x4* tp = (const f32x4*)(tabA + pos * 64 + p);
                        const f32x4 t0 = tp[0], t1 = tp[1];
                        const float sc = kind == 1 ? 0.08838834764831845f : 1.0f;
                        float y[8];
                        y[0] = (x[0] * t0.x - x[1] * t0.y) * sc; y[1] = (x[0] * t0.y + x[1] * t0.x) * sc;
                        y[2] = (x[2] * t0.z - x[3] * t0.w) * sc; y[3] = (x[2] * t0.w + x[3] * t0.z) * sc;
                        y[4] = (x[4] * t1.x - x[5] * t1.y) * sc; y[5] = (x[4] * t1.y + x[5] * t1.x) * sc;
                        y[6] = (x[6] * t1.z - x[7] * t1.w) * sc; y[7] = (x[6] * t1.w + x[7] * t1.z) * sc;
#pragma unroll
                        for (int i = 0; i < 8; ++i) x[i] = y[i];
                    } else if (kind == 2) {
                        const f32x4 g0 = *(const f32x4*)(gn + (col - C_RG)), g1 = *(const f32x4*)(gn + (col - C_RG) + 4);
                        const float gg[8] = {g0.x, g0.y, g0.z, g0.w, g1.x, g1.y, g1.z, g1.w};
#pragma unroll
                        for (int i = 0; i < 8; ++i) x[i] = fsilu(x[i]) * gg[i];
                    } else if (kind == 3) {
#pragma unroll
                        for (int i = 0; i < 8; ++i) x[i] *= SB_QSCALE;
                    } else if (kind == 5) {
#pragma unroll
                        for (int i = 0; i < 8; ++i) x[i] = fsigmoid(x[i]);
                    }
                    *(v4u*)(PROJ + (size_t)row * NMAIN + col) = pack8(x);
                }
            }
    }
};
struct EpiProjT {
    static constexpr bool PERM = true, AFTER_DRAIN = false;
    bf16* T; const f32x2* tabB;
    DI void operator()(const af4 (&acc)[2][2][4][2], const pg8::Unit& u, int wr, int wc, int fr, int fq) const {
        const int f0 = u.pm * 256 + wr * 64 + fr, tokb = u.pn * 256 + wc * 32 + 8 * fq;
        const bool isk = u.pm < 2;
#pragma unroll
        for (int ai = 0; ai < 2; ++ai)
#pragma unroll
            for (int m = 0; m < 4; ++m) {
                const int f = f0 + ai * 128 + m * 16;
#pragma unroll
                for (int bj = 0; bj < 2; ++bj) {
                    const int tok = tokb + bj * 128;
                    const af4 a0 = acc[ai][bj][m][0], a1 = acc[ai][bj][m][1];
                    float x[8] = {a0[0], a0[1], a0[2], a0[3], a1[0], a1[1], a1[2], a1[3]};
                    if (isk) {
                        const int pos = tok & (SEQ - 1), h = f >> 7, p = (f & 127) >> 1;
                        const f32x4* tp = (const f32x4*)(tabB + p * SEQ + pos);
                        const f32x4 t0 = tp[0], t1 = tp[1], t2 = tp[2], t3 = tp[3];
                        const float cs[8] = {t0.x, t0.z, t1.x, t1.z, t2.x, t2.z, t3.x, t3.z}, sn[8] = {t0.y, t0.w, t1.y, t1.w, t2.y, t2.w, t3.y, t3.w};
                        const float l2g = ret_log2g(h); const float ginv = exp2f(-l2g);
                        float sc = 0.08838834764831845f * exp2f(l2g * (float)(63 - (pos & 63)));
                        const bool odd = (f & 1) != 0;
                        float y[8];
#pragma unroll
                        for (int i = 0; i < 8; ++i) {
                            const float other = __shfl_xor(x[i], 1);
                            const float r = odd ? (other * sn[i] + x[i] * cs[i]) : (x[i] * cs[i] - other * sn[i]);
                            y[i] = r * sc; sc *= ginv;
                        }
#pragma unroll
                        for (int i = 0; i < 8; ++i) x[i] = y[i];
                    }
                    *(v4u*)(T + (size_t)f * NTOK + tok) = pack8(x);
                }
            }
    }
};

struct EpiBr {
    static constexpr bool PERM = true, AFTER_DRAIN = false;
    bf16* PROJ; int step;
    DI void operator()(const af4 (&acc)[2][2][4][2], const pg8::Unit& u, int wr, int wc, int fr, int fq) const {
        const int row0 = u.pm * 256 + wr * 64 + fr, colb = u.pn * 256 + wc * 32 + 8 * fq;
#pragma unroll
        for (int ai = 0; ai < 2; ++ai)
#pragma unroll
            for (int m = 0; m < 4; ++m) {
                bf16* pr = PROJ + (size_t)(row0 + ai * 128 + m * 16) * NMAIN;
#pragma unroll
                for (int bj = 0; bj < 2; ++bj) {
                    const int col = colb + bj * 128;
                    const af4 a0 = acc[ai][bj][m][0], a1 = acc[ai][bj][m][1];
                    float g[8], x[8] = {a0[0], a0[1], a0[2], a0[3], a1[0], a1[1], a1[2], a1[3]};
                    unpack8(*(const v4u*)(pr + (step ? C_GS : C_GR) + col), g);
#pragma unroll
                    for (int i = 0; i < 8; ++i) x[i] *= g[i];
                    if (step) { float t1[8]; unpack8(*(const v4u*)(pr + C_MG + col), t1);
#pragma unroll
                        for (int i = 0; i < 8; ++i) x[i] += t1[i]; }
                    *(v4u*)(pr + C_MG + col) = pack8(x);
                }
            }
    }
};
struct EpiWout {
    static constexpr bool PERM = true, AFTER_DRAIN = false;
    const float* x; bf16* x1;
    DI void operator()(const af4 (&acc)[2][2][4][2], const pg8::Unit& u, int wr, int wc, int fr, int fq) const {
        const int row0 = u.pm * 256 + wr * 64 + fr, colb = u.pn * 256 + wc * 32 + 8 * fq;
#pragma unroll
        for (int ai = 0; ai < 2; ++ai)
#pragma unroll
            for (int m = 0; m < 4; ++m) {
                const size_t ro = (size_t)(row0 + ai * 128 + m * 16) * DM;
#pragma unroll
                for (int bj = 0; bj < 2; ++bj) {
                    const size_t o = ro + colb + bj * 128;
                    const af4 x0 = *(const af4*)(x + o) + acc[ai][bj][m][0], x1v = *(const af4*)(x + o + 4) + acc[ai][bj][m][1];
                    const float y[8] = {x0[0], x0[1], x0[2], x0[3], x1v[0], x1v[1], x1v[2], x1v[3]};
                    *(v4u*)(x1 + o) = pack8(y);
                }
            }
    }
};
struct EpiGu {
    static constexpr bool PERM = true, AFTER_DRAIN = false;
    bf16* HID;
    DI void operator()(const af4 (&acc)[2][2][4][2], const pg8::Unit& u, int wr, int wc, int fr, int fq) const {
        const int row0 = u.pm * 256 + wr * 64 + fr, col = u.pn * 128 + wc * 32 + 8 * fq;
#pragma unroll
        for (int ai = 0; ai < 2; ++ai)
#pragma unroll
            for (int m = 0; m < 4; ++m) {
                const af4 g0 = acc[ai][0][m][0], g1 = acc[ai][0][m][1], u0 = acc[ai][1][m][0], u1 = acc[ai][1][m][1];
                float x[8];
#pragma unroll
                for (int i = 0; i < 4; ++i) { x[i] = fsilu(g0[i]) * u0[i]; x[4 + i] = fsilu(g1[i]) * u1[i]; }
                *(v4u*)(HID + (size_t)(row0 + ai * 128 + m * 16) * DEXP + col) = pack8(x);
            }
    }
};
struct EpiDown {
    static constexpr bool PERM = true, AFTER_DRAIN = false;
    bf16* YB; const float* wrow;
    DI void operator()(const af4 (&acc)[2][2][4][2], const pg8::Unit& u, int wr, int wc, int fr, int fq) const {
        const int row0 = u.pm * 256 + wr * 64 + fr, colb = u.pn * 256 + wc * 32 + 8 * fq;
#pragma unroll
        for (int ai = 0; ai < 2; ++ai)
#pragma unroll
            for (int m = 0; m < 4; ++m) {
                const int row = row0 + ai * 128 + m * 16; const float w = wrow[row];
#pragma unroll
                for (int bj = 0; bj < 2; ++bj) {
                    const af4 a0 = acc[ai][bj][m][0] * w, a1 = acc[ai][bj][m][1] * w;
                    const float x[8] = {a0[0], a0[1], a0[2], a0[3], a1[0], a1[1], a1[2], a1[3]};
                    *(v4u*)(YB + (size_t)row * DM + colb + bj * 128) = pack8(x);
                }
            }
    }
};
struct EpiPe {
    static constexpr bool PERM = true, AFTER_DRAIN = false;
    bf16* PE;
    DI void operator()(const af4 (&acc)[2][2][4][2], const pg8::Unit& u, int wr, int wc, int fr, int fq) const {
        const int row0 = u.pm * 256 + wr * 64 + fr, colb = u.pn * 256 + wc * 32 + 8 * fq;
#pragma unroll
        for (int ai = 0; ai < 2; ++ai)
#pragma unroll
            for (int m = 0; m < 4; ++m)
#pragma unroll
                for (int bj = 0; bj < 2; ++bj) {
                    const af4 a0 = acc[ai][bj][m][0], a1 = acc[ai][bj][m][1];
                    const float x[8] = {a0[0], a0[1], a0[2], a0[3], a1[0], a1[1], a1[2], a1[3]};
                    *(v4u*)(PE + (size_t)(row0 + ai * 128 + m * 16) * DM + colb + bj * 128) = pack8(x);
                }
    }
};
struct EpiPg {
    static constexpr bool PERM = true, AFTER_DRAIN = false;
    const bf16* PE; const bf16* x2; float* out;
    DI void operator()(const af4 (&acc)[2][2][4][2], const pg8::Unit& u, int wr, int wc, int fr, int fq) const {
        const int row0 = u.pm * 256 + wr * 64 + fr, colb = u.pn * 256 + wc * 32 + 8 * fq;
#pragma unroll
        for (int ai = 0; ai < 2; ++ai)
#pragma unroll
            for (int m = 0; m < 4; ++m) {
                const size_t ro = (size_t)(row0 + ai * 128 + m * 16) * DM;
#pragma unroll
                for (int bj = 0; bj < 2; ++bj) {
                    const size_t o = ro + colb + bj * 128;
                    float pe[8]; unpack8(*(const v4u*)(PE + o), pe);
                    const af4 a0 = acc[ai][bj][m][0], a1 = acc[ai][bj][m][1];
                    float xr[8]; unpack8(*(const v4u*)(x2 + o), xr);
                    af4 x0 = {xr[0], xr[1], xr[2], xr[3]}, x1 = {xr[4], xr[5], xr[6], xr[7]};
#pragma unroll
                    for (int i = 0; i < 4; ++i) { x0[i] += fsigmoid(a0[i]) * pe[i]; x1[i] += fsigmoid(a1[i]) * pe[4 + i]; }
                    *(af4*)(out + o) = x0; *(af4*)(out + o + 4) = x1;
                }
                asm volatile("" ::: "memory");
            }
    }
};

struct MoeOrder {
    const LAS int* pst; int G, c; size_t estride, tstepB;
    DI bool next(int i, pg8::Unit& u) const {
        const int L = i * G + c, rt = L >> 2; if (rt * 256 >= pst[NEXP]) return false;
        int ex = 0;
#pragma unroll
        for (int e = 1; e < NEXP; ++e) ex += (rt * 256 >= pst[e]) ? 1 : 0;
        u.pm = rt; u.pn = L & 3; u.ex = ex; u.bofs = (size_t)ex * estride + (size_t)u.pn * tstepB; return true;
    }
    DI void a_ready(const pg8::Unit&) const {}
    DI void done(const pg8::Unit&) const {}
};

#define GEMM_PHASE(EPI, ORD, g, S, E) pg8::gemm_phase<EPI, ORD, true, true>(F.lds + RING_OFF, g, S, E)

DI void fast_proj(Frame& F, const Args& a) {
    unsigned char* ws = F.ws; const bf16* HB = (const bf16*)((unsigned char*)F.out + DO_HB); const bf16* WIN = (const bf16*)(ws + WS_WIN);
    { pg8::Gemm g{HB, WIN, DM, DM}; pg8::StaticOrder S; S.init(NTOK, NMAIN, DM, F.G, (int)blockIdx.x);
      EpiProj E{(bf16*)(ws + WS_PROJ), (const f32x2*)(ws + WS_TABA), a.in[4]}; GEMM_PHASE(EpiProj, pg8::StaticOrder, g, S, E); }
    { pg8::Gemm g{WIN + (size_t)NMAIN * DM, HB, DM, DM}; pg8::StaticOrder S; S.init(NTR, NTOK, DM, F.G, (int)blockIdx.x);
      EpiProjT E{(bf16*)(ws + WS_T), (const f32x2*)(ws + WS_TABB)}; GEMM_PHASE(EpiProjT, pg8::StaticOrder, g, S, E); }
}
DI void fast_br(Frame& F, const Args& a) {
    unsigned char* ws = F.ws; bf16* PROJ = (bf16*)(ws + WS_PROJ); const bf16* RS = (const bf16*)((unsigned char*)F.out + DO_RS);
    pg8::StaticOrder S; S.init(NTOK, DM, 512, F.G, (int)blockIdx.x);
    { pg8::Gemm g{RS, (const bf16*)(ws + WS_WBR1), DM, 512}; EpiBr E{PROJ, 0}; GEMM_PHASE(EpiBr, pg8::StaticOrder, g, S, E); }
    { pg8::Gemm g{RS + 512, (const bf16*)(ws + WS_WBR2), DM, 512}; EpiBr E{PROJ, 1}; GEMM_PHASE(EpiBr, pg8::StaticOrder, g, S, E); }
}
DI void fast_wout(Frame& F, const Args& a) {
    unsigned char* ws = F.ws;
    pg8::Gemm g{(const bf16*)(ws + WS_PROJ) + C_MG, (const bf16*)(ws + WS_WOUT), NMAIN, DM}; pg8::StaticOrder S; S.init(NTOK, DM, DM, F.G, (int)blockIdx.x);
    EpiWout E{F.x, (bf16*)((unsigned char*)F.out + DO_X1)}; GEMM_PHASE(EpiWout, pg8::StaticOrder, g, S, E);
}
DI void fast_gu(Frame& F, const Args& a) {
    LAS int* pst = (LAS int*)(F.lds + LDSCTL_OFF);
    expert_table(F, pst);
    unsigned char* ws = F.ws;
    pg8::Gemm g{(const bf16*)(ws + WS_XB), (const bf16*)(ws + WS_WGU), DM, DM};
    MoeOrder S{pst, F.G, F.vcu, (size_t)1024 * 1024 * 2, (size_t)256 * DM * 2};
    EpiGu E{(bf16*)(ws + WS_HID)}; GEMM_PHASE(EpiGu, MoeOrder, g, S, E);
}
DI void fast_down(Frame& F, const Args& a) {
    LAS int* pst = (LAS int*)(F.lds + LDSCTL_OFF);
    expert_table(F, pst);
    unsigned char* ws = F.ws;
    pg8::Gemm g{(const bf16*)(ws + WS_HID), (const bf16*)(ws + WS_WD), DEXP, DEXP};
    MoeOrder S{pst, F.G, F.vcu, (size_t)1024 * 512 * 2, (size_t)256 * DEXP * 2};
    EpiDown E{(bf16*)(ws + WS_XB), (const float*)(ws + WS_ROUTE + RT_WROW)}; GEMM_PHASE(EpiDown, MoeOrder, g, S, E);
}
DI void fast_ple(Frame& F, const Args& a) {
    unsigned char* ws = F.ws;
    { int k256 = 256; asm volatile("" : "+s"(k256));
      pg8::Gemm g{(const bf16*)(ws + WS_PB), (const bf16*)(ws + WS_WPLE), 256, k256}; pg8::StaticOrder S; S.init(NTOK, DM, k256, F.G, (int)blockIdx.x);
      EpiPe E{(bf16*)(ws + WS_HID)}; GEMM_PHASE(EpiPe, pg8::StaticOrder, g, S, E); }
    { pg8::Gemm g{(const bf16*)(ws + WS_H2), (const bf16*)(ws + WS_WPG), DM, DM}; pg8::StaticOrder S; S.init(NTOK, DM, DM, F.G, (int)blockIdx.x);
      EpiPg E{(const bf16*)(ws + WS_HID), (const bf16*)(ws + WS_X2), F.out}; GEMM_PHASE(EpiPg, pg8::StaticOrder, g, S, E); }
}

#define MFMA32(a, b, c) __builtin_amdgcn_mfma_f32_32x32x16_bf16((a), (b), (c), 0, 0, 0)
DI int crow(int reg, int h) { return (reg & 3) + 8 * (reg >> 2) + 4 * h; }
DI bf16x8 ld16(const bf16* p) { return *(const bf16x8*)p; }
DI bf16x8 ld8x2(const bf16* p0, const bf16* p1) { const s16x4 lo = *(const s16x4*)p0, hi = *(const s16x4*)p1; return __builtin_shufflevector(lo, hi, 0, 1, 2, 3, 4, 5, 6, 7); }
template <int S> DI bf16x8 pack_step(const f32x16& x) { v4u p; p.x = cvtpk(x[8 * S], x[8 * S + 1]); p.y = cvtpk(x[8 * S + 2], x[8 * S + 3]); p.z = cvtpk(x[8 * S + 4], x[8 * S + 5]); p.w = cvtpk(x[8 * S + 6], x[8 * S + 7]); return __builtin_bit_cast(bf16x8, p); }
DI f32x16 splat16(float v) { f32x16 x;
#pragma unroll
    for (int i = 0; i < 16; ++i) x[i] = v; return x; }

#define SCHED_FENCE() __builtin_amdgcn_sched_barrier(0)
DI void fast_ret_kv(Frame& F, const Args& a) {
    const bf16* __restrict__ T = (const bf16*)(F.ws + WS_T); bf16* __restrict__ ST = (bf16*)((unsigned char*)F.out + DO_ST);
    const int lane = F.lane, r = lane & 31, h2 = lane >> 5, gw = F.vcu * NWAVES + F.wave, NGW = F.G * NWAVES;
    for (int it = gw; it < NBATCH * 4 * 64 * 4; it += NGW) {
        const int eb = it & 3, c = (it >> 2) & 63, hh = (it >> 8) & 3, b = it >> 10;
        const int tok0 = b * SEQ + c * 64;
        const bf16* vrow = T + (size_t)(T_VR + hh * 128 + eb * 32 + r) * NTOK + tok0 + 8 * h2;
        const bf16* krow = T + (size_t)(T_KT + hh * 128 + r) * NTOK + tok0 + 8 * h2;
        bf16x8 vb[4], ka[4][4];
#pragma unroll
        for (int ks = 0; ks < 4; ++ks) vb[ks] = ld16(vrow + 16 * ks);
#pragma unroll
        for (int db = 0; db < 4; ++db)
#pragma unroll
            for (int ks = 0; ks < 4; ++ks) ka[db][ks] = ld16(krow + (size_t)db * 32 * NTOK + 16 * ks);
        SCHED_FENCE();
        bf16* st = ST + ((size_t)((b * 4 + hh) * 64 + c)) * 16384 + (size_t)(eb * 32 + r) * 128 + 4 * h2;
#pragma unroll
        for (int db = 0; db < 4; ++db) {
            f32x16 acc = splat16(0.f);
#pragma unroll
            for (int ks = 0; ks < 4; ++ks) acc = MFMA32(ka[db][ks], vb[ks], acc);
#pragma unroll
            for (int g = 0; g < 4; ++g) { v2u w; w.x = cvtpk(acc[4 * g], acc[4 * g + 1]); w.y = cvtpk(acc[4 * g + 2], acc[4 * g + 3]); *(v2u*)(st + db * 32 + 8 * g) = w; }
        }
    }
}
DI void fast_ret_scan(Frame& F, const Args& a) {
    bf16* ST = (bf16*)((unsigned char*)F.out + DO_ST);
    for (int g = F.vcu * 512 + F.tid; g < NBATCH * 4 * 4096; g += F.G * 512) {
        const int bh = g >> 12, idx = (g & 4095) * 4;
        const float cdec = exp2f(ret_log2g(bh & 3) * 64.0f);
        bf16* p = ST + (size_t)bh * 64 * 16384 + idx;
        float s0 = 0.f, s1 = 0.f, s2 = 0.f, s3 = 0.f;
#pragma unroll 8
        for (int c = 0; c < 64; ++c) {
            const v2u w = *(const v2u*)(p + (size_t)c * 16384);
            v2u o; o.x = cvtpk(s0, s1); o.y = cvtpk(s2, s3); *(v2u*)(p + (size_t)c * 16384) = o;
            s0 = cdec * s0 + bflo(w.x); s1 = cdec * s1 + bfhi(w.x); s2 = cdec * s2 + bflo(w.y); s3 = cdec * s3 + bfhi(w.y);
        }
    }
}
DI void fast_ret_out(Frame& F, const Args& a) {
    const bf16* __restrict__ PROJ = (const bf16*)(F.ws + WS_PROJ); const bf16* __restrict__ T = (const bf16*)(F.ws + WS_T);
    const bf16* __restrict__ ST = (const bf16*)((unsigned char*)F.out + DO_ST); bf16* __restrict__ RS = (bf16*)((unsigned char*)F.out + DO_RS);
    const int lane = F.lane, r = lane & 31, h2 = lane >> 5, gw = F.vcu * NWAVES + F.wave, NGW = F.G * NWAVES;
    for (int it = gw; it < NBATCH * 4 * 64 * 2; it += NGW) {
        const int ib = it & 1, c = (it >> 1) & 63, hh = (it >> 7) & 3, b = it >> 9;
        const int tok0 = b * SEQ + c * 64;
        const float l2g = ret_log2g(hh);
        const bf16* qrow = PROJ + (size_t)(tok0 + ib * 32 + r) * NMAIN + C_RQ + hh * 128 + 8 * h2;
        const bf16* krow = PROJ + (size_t)(tok0 + r) * NMAIN + C_RK + hh * 128 + 8 * h2;
        const bf16* stb = ST + ((size_t)((b * 4 + hh) * 64 + c)) * 16384 + (size_t)r * 128 + 8 * h2;
        const bf16* vrow = T + (size_t)(T_VR + hh * 128 + r) * NTOK + tok0 + 4 * h2;
        const bf16* gp = PROJ + (size_t)(tok0 + ib * 32 + r) * NMAIN + C_RG + hh * 128 + 4 * h2;
        bf16x8 qf[8], kf0[8], kf1[8], sA[8], sB[8], vA[4], vB[4];
#define LD_ST(dst, eb) do { _Pragma("unroll") for (int ks = 0; ks < 8; ++ks) dst[ks] = ld16(stb + (size_t)(eb) * 32 * 128 + 16 * ks); } while (0)
#define LD_VT(dst, eb) do { const bf16* vr_ = vrow + (size_t)(eb) * 32 * NTOK; dst[0] = ld8x2(vr_, vr_ + 8); dst[1] = ld8x2(vr_ + 16, vr_ + 24); dst[2] = ld8x2(vr_ + 32, vr_ + 40); dst[3] = ld8x2(vr_ + 48, vr_ + 56); } while (0)
#define RET_EB(oacc, sfr, vfr) do { f32x16 acc_ = splat16(0.f); \
            _Pragma("unroll") for (int ks = 0; ks < 8; ++ks) acc_ = MFMA32(sfr[ks], qf[ks], acc_);         \
            _Pragma("unroll") for (int reg = 0; reg < 16; ++reg) acc_[reg] *= qd; \
            acc_ = MFMA32(vfr[0], pb[0][0], acc_); acc_ = MFMA32(vfr[1], pb[0][1], acc_); acc_ = MFMA32(vfr[2], pb[1][0], acc_); acc_ = MFMA32(vfr[3], pb[1][1], acc_); oacc = acc_; } while (0)
#pragma unroll
        for (int ks = 0; ks < 8; ++ks) qf[ks] = ld16(qrow + 16 * ks);
#pragma unroll
        for (int ks = 0; ks < 8; ++ks) { kf0[ks] = ld16(krow + 16 * ks); kf1[ks] = ld16(krow + (size_t)32 * NMAIN + 16 * ks); }
        LD_ST(sA, 0); LD_VT(vA, 0);
        SCHED_FENCE();
        f32x16 pt0 = splat16(0.f), pt1 = splat16(0.f);
#pragma unroll
        for (int ks = 0; ks < 8; ++ks) { pt0 = MFMA32(kf0[ks], qf[ks], pt0); pt1 = MFMA32(kf1[ks], qf[ks], pt1); }
        LD_ST(sB, 1); LD_VT(vB, 1);
        SCHED_FENCE();
        bf16x8 pb[2][2];
#pragma unroll
        for (int reg = 0; reg < 16; ++reg) {
            const int d0 = (ib * 32 + r) - crow(reg, h2), d1 = d0 - 32;
            pt0[reg] *= __builtin_amdgcn_exp2f(l2g * (float)(d0 < 0 ? -d0 : d0)); pt1[reg] *= __builtin_amdgcn_exp2f(l2g * (float)(d1 < 0 ? -d1 : d1));
        }
        pb[0][0] = pack_step<0>(pt0); pb[0][1] = pack_step<1>(pt0); pb[1][0] = pack_step<0>(pt1); pb[1][1] = pack_step<1>(pt1);
        const float qd = __builtin_amdgcn_exp2f(l2g * (float)(ib * 32 + r + 1));
        f32x16 o[4];
        RET_EB(o[0], sA, vA);
        LD_ST(sA, 2); LD_VT(vA, 2);
        SCHED_FENCE();
        RET_EB(o[1], sB, vB);
        LD_ST(sB, 3); LD_VT(vB, 3);
        SCHED_FENCE();
        RET_EB(o[2], sA, vA);
        v2u gate[16];
#pragma unroll
        for (int q = 0; q < 16; ++q) gate[q] = *(const v2u*)(gp + (q >> 2) * 32 + 8 * (q & 3));
        SCHED_FENCE();
        RET_EB(o[3], sB, vB);
#undef LD_ST
#undef LD_VT
#undef RET_EB
        float s = 0.f;
#pragma unroll
        for (int eb = 0; eb < 4; ++eb)
#pragma unroll
            for (int reg = 0; reg < 16; ++reg) s += o[eb][reg];
        s += __shfl_xor(s, 32);
        const float mu = s * (1.0f / 128.0f); float v = 0.f;
#pragma unroll
        for (int eb = 0; eb < 4; ++eb)
#pragma unroll
            for (int reg = 0; reg < 16; ++reg) { const float d = o[eb][reg] - mu; v += d * d; }
        v += __shfl_xor(v, 32);
        const float rstd = rsqrtf(v * (1.0f / 128.0f) + EPS);
        bf16* rp = RS + (size_t)(tok0 + ib * 32 + r) * DM + hh * 128 + 4 * h2;
#pragma unroll
        for (int eb = 0; eb < 4; ++eb)
#pragma unroll
            for (int g = 0; g < 4; ++g) {
                const v2u gt = gate[eb * 4 + g];
                v2u w;
                w.x = cvtpk((o[eb][4 * g] - mu) * rstd * bflo(gt.x), (o[eb][4 * g + 1] - mu) * rstd * bfhi(gt.x));
                w.y = cvtpk((o[eb][4 * g + 2] - mu) * rstd * bflo(gt.y), (o[eb][4 * g + 3] - mu) * rstd * bfhi(gt.y));
                *(v2u*)(rp + eb * 32 + 8 * g) = w;
            }
    }
}

DI void fast_att(Frame& F, const Args& a) {
    const bf16* __restrict__ PROJ = (const bf16*)(F.ws + WS_PROJ); const bf16* __restrict__ T = (const bf16*)(F.ws + WS_T); bf16* __restrict__ RS = (bf16*)((unsigned char*)F.out + DO_RS);
    const int lane = F.lane, r = lane & 31, h2 = lane >> 5, gw = F.vcu * NWAVES + F.wave, NGW = F.G * NWAVES;
    bf16x8 tri0, tri1, ones;
#pragma unroll
    for (int j = 0; j < 8; ++j) { const int k0 = 8 * (j >> 2) + 4 * h2 + (j & 3); tri0[j] = (k0 > r) ? (short)0x3F80 : (short)0; tri1[j] = (16 + k0 > r) ? (short)0x3F80 : (short)0; ones[j] = (short)0x3F80; }
    for (int it = gw; it < NBATCH * 8 * 128; it += NGW) {
        const int qb = it & 127, hh = (it >> 7) & 7, b = it >> 10;
        const int q0 = qb * 32, tokq = b * SEQ + q0 + r;
        const bf16* qrow = PROJ + (size_t)tokq * NMAIN + C_SQ + hh * 64 + 8 * h2;
        const bf16* kbase = PROJ + (size_t)(b * SEQ + r) * NMAIN + C_SK + hh * 64 + 8 * h2;
        const bf16* vbase = T + (size_t)(T_VS + hh * 64 + r) * NTOK + b * SEQ + 4 * h2;
        const int ktd = q0 >> 6;
        bf16x8 qf[4], kA[8], vB[8];
#pragma unroll
        for (int ks = 0; ks < 4; ++ks) qf[ks] = ld16(qrow + 16 * ks);
#pragma unroll
        for (int ks = 0; ks < 4; ++ks) { kA[ks] = ld16(kbase + (size_t)(ktd * 64) * NMAIN + 16 * ks); kA[4 + ks] = ld16(kbase + (size_t)(ktd * 64 + 32) * NMAIN + 16 * ks); }
        f32x16 o0 = splat16(0.f), o1 = splat16(0.f);
        float carry = 0.f;
        for (int kt = ktd; kt >= 0; --kt) {
            const int key0 = kt * 64;
            const bool diag = (kt == ktd);
            {
                const bf16* v0row = vbase + key0; const bf16* v1row = v0row + (size_t)32 * NTOK;
#pragma unroll
                for (int q = 0; q < 4; ++q) { vB[q] = ld8x2(v0row + 16 * q, v0row + 16 * q + 8); vB[4 + q] = ld8x2(v1row + 16 * q, v1row + 16 * q + 8); }
            }
            SCHED_FENCE();
            f32x16 p0 = splat16(0.f), p1 = splat16(0.f);
#pragma unroll
            for (int ks = 0; ks < 4; ++ks) { p0 = MFMA32(kA[ks], qf[ks], p0); p1 = MFMA32(kA[4 + ks], qf[ks], p1); }
            {
                const int kn = (kt > 0 ? kt - 1 : 0) * 64;
#pragma unroll
                for (int ks = 0; ks < 4; ++ks) { kA[ks] = ld16(kbase + (size_t)kn * NMAIN + 16 * ks); kA[4 + ks] = ld16(kbase + (size_t)(kn + 32) * NMAIN + 16 * ks); }
            }
            SCHED_FENCE();
            f32x16 l0, l1;
#pragma unroll
            for (int reg = 0; reg < 16; ++reg) {
                const float z0 = fminf(p0[reg], 100.0f), z1 = fminf(p1[reg], 100.0f);
                float a0 = -__builtin_amdgcn_logf(1.0f + __builtin_amdgcn_exp2f(z0)), a1 = -__builtin_amdgcn_logf(1.0f + __builtin_amdgcn_exp2f(z1));
                float b0 = z0 + a0, b1 = z1 + a1;
                if (diag) {
                    const bool v0 = (key0 + crow(reg, h2)) < (q0 + r), v1 = (key0 + 32 + crow(reg, h2)) < (q0 + r);
                    a0 = v0 ? a0 : 0.f; b0 = v0 ? b0 : -1.0e30f; a1 = v1 ? a1 : 0.f; b1 = v1 ? b1 : -1.0e30f;
                }
                l0[reg] = a0; l1[reg] = a1; p0[reg] = b0; p1[reg] = b1;
            }
            f32x16 y0 = splat16(carry), y1 = y0;
            {
                const bf16x8 x00 = pack_step<0>(l0), x01 = pack_step<1>(l0), x10 = pack_step<0>(l1), x11 = pack_step<1>(l1);
                y0 = MFMA32(tri0, x00, y0); y0 = MFMA32(tri1, x01, y0); y0 = MFMA32(ones, x10, y0); y0 = MFMA32(ones, x11, y0);
                y1 = MFMA32(tri0, x10, y1); y1 = MFMA32(tri1, x11, y1);
            }
            const float tot = y0[0] + l0[0];
            carry = __shfl(tot, r);
#pragma unroll
            for (int reg = 0; reg < 16; ++reg) { p0[reg] = __builtin_amdgcn_exp2f(p0[reg] + y0[reg]); p1[reg] = __builtin_amdgcn_exp2f(p1[reg] + y1[reg]); }
            {
                const bf16x8 a00 = pack_step<0>(p0), a01 = pack_step<1>(p0), a10 = pack_step<0>(p1), a11 = pack_step<1>(p1);
                o0 = MFMA32(vB[0], a00, o0); o0 = MFMA32(vB[1], a01, o0); o0 = MFMA32(vB[2], a10, o0); o0 = MFMA32(vB[3], a11, o0);
                o1 = MFMA32(vB[4], a00, o1); o1 = MFMA32(vB[5], a01, o1); o1 = MFMA32(vB[6], a10, o1); o1 = MFMA32(vB[7], a11, o1);
            }
            if (__all(carry < SB_EXIT)) break;
        }
        bf16* op = RS + (size_t)tokq * DM + 512 + hh * 64 + 4 * h2;
#pragma unroll
        for (int g = 0; g < 4; ++g) {
            v2u w; w.x = cvtpk(o0[4 * g], o0[4 * g + 1]); w.y = cvtpk(o0[4 * g + 2], o0[4 * g + 3]); *(v2u*)(op + 8 * g) = w;
            v2u u; u.x = cvtpk(o1[4 * g], o1[4 * g + 1]); u.y = cvtpk(o1[4 * g + 2], o1[4 * g + 3]); *(v2u*)(op + 32 + 8 * g) = u;
        }
    }
}

__global__ void __launch_bounds__(NWAVES * 64, 2) mega(Args args) {
    extern __shared__ __attribute__((aligned(16))) unsigned char lds[];
    Frame F;
    F.lds = (LAS unsigned char*)lds;
    F.MISC = (volatile LAS unsigned*)(F.lds + MISC_OFF);
    F.refresh();
    F.G = gridDim.x; { const int bx = blockIdx.x; F.vcu = (F.G % 8 == 0) ? (bx % 8) * (F.G / 8) + bx / 8 : bx; }
    F.ws = args.ws; F.out = args.out; F.x = args.in[0]; F.p = args.in[1];
    F.ctl = (gu32*)(args.ws + WS_CTL);
    for (int u = F.tid; u < (LDS_BYTES - LDSCTL_OFF) / 4; u += NWAVES * 64) ((LAS unsigned*)(F.lds + LDSCTL_OFF))[u] = 0u;
    __syncthreads();
    const int lo = args.ph_lo, hi = args.ph_hi;
    XcdBarrier bar; bar.bar = (unsigned*)(F.ctl + CW_BAR) + args.li * BAR_STRIDE; bar.x = 0; bar.st = nullptr;
    if (hi - lo > 1) bar = xcd_barrier_post((unsigned*)(F.ctl + CW_BAR) + args.li * BAR_STRIDE, F.MISC + 8);
#define IN(k) (F.refresh(), lo <= (k) && (k) < hi)
#define DUP(k) ((DUP_MASK >> (k)) & 1)
#define SEAM(k) do { if (IN(k) && IN((k) + 1)) xcd_barrier(bar); } while (0)
#define REP(k, body) do { body; if (DUP(k)) { F.refresh(); body; } } while (0)

    if (IN(PH_PRO)) { REP(PH_PRO, ph_prologue(F, args)); } SEAM(PH_PRO);
    if (IN(PH_PROJ)) { REP(PH_PROJ, fast_proj(F, args)); } SEAM(PH_PROJ);
    if (IN(PH_MIX1)) { REP(14, fast_ret_kv(F, args)); REP(15, fast_att(F, args)); } SEAM(PH_MIX1);
    if (IN(PH_SCAN)) { fast_ret_scan(F, args); } SEAM(PH_SCAN);
    if (IN(PH_RETO)) { REP(PH_RETO, fast_ret_out(F, args)); } SEAM(PH_RETO);
    if (IN(PH_BR)) { REP(PH_BR, fast_br(F, args)); } SEAM(PH_BR);
    if (IN(PH_WOUT)) { REP(PH_WOUT, fast_wout(F, args)); } SEAM(PH_WOUT);
    if (IN(PH_ROUTE)) { ph_route(F, args); } SEAM(PH_ROUTE);
    if (IN(PH_GATHER)) { REP(PH_GATHER, ph_gather(F, args)); } SEAM(PH_GATHER);
    if (IN(PH_GU)) { REP(PH_GU, fast_gu(F, args)); } SEAM(PH_GU);
    if (IN(PH_DOWN)) { REP(PH_DOWN, fast_down(F, args)); } SEAM(PH_DOWN);
    if (IN(PH_COMB)) { REP(PH_COMB, ph_combine(F, args)); } SEAM(PH_COMB);
    if (IN(PH_PLE)) { REP(PH_PLE, fast_ple(F, args)); } SEAM(PH_PLE);
    if (IN(PH_FINAL)) { ph_final(F, args); }
#undef IN
#undef SEAM
}

extern "C" void kernel_launch(void* const* d_in, const int* in_sizes, int n_in, void* d_out, int out_size, void* d_ws, size_t ws_size, hipStream_t stream) {
    static int grid = 0;
    if (grid == 0) {
        if (n_in != 20 || in_sizes[0] != NTOK * DM || out_size != NTOK * DM || ws_size < WS_END) { fprintf(stderr, "kernel_launch: unexpected shapes (n_in %d, in0 %d, out %d, ws %zu)\n", n_in, n_in > 0 ? in_sizes[0] : -1, out_size, ws_size); grid = -1; return; }
        int dev = 0, cus = 0, per_cu = 0;
        if (hipGetDevice(&dev) != hipSuccess || hipDeviceGetAttribute(&cus, hipDeviceAttributeMultiprocessorCount, dev) != hipSuccess) { grid = -1; return; }
        if (hipFuncSetAttribute((const void*)mega, hipFuncAttributeMaxDynamicSharedMemorySize, LDS_BYTES) != hipSuccess) { fprintf(stderr, "kernel_launch: hipFuncSetAttribute failed\n"); grid = -1; return; }
        if (hipOccupancyMaxActiveBlocksPerMultiprocessor(&per_cu, (const void*)mega, NWAVES * 64, LDS_BYTES) != hipSuccess || per_cu < 1) fprintf(stderr, "kernel_launch: occupancy query reports %d\n", per_cu);
        (void)hipGetLastError();
        grid = cus;
    }
    if (grid < 0) return;
    unsigned char* ws = (unsigned char*)d_ws;
    if (hipMemsetAsync(ws + WS_CTL, 0, CTL_ZERO_BYTES, stream) != hipSuccess) return;
    Args a{};
    for (int i = 0; i < 20; ++i) a.in[i] = (const float*)d_in[i];
    a.out = (float*)d_out; a.ws = ws;
#if SPLIT_PHASES
    for (int p = 0; p < NPH; ++p) { a.ph_lo = p; a.ph_hi = p + 1; a.li = 0; hipLaunchKernelGGL(mega, dim3(grid), dim3(NWAVES * 64), LDS_BYTES, stream, a); }
#else
    a.ph_lo = 0; a.ph_hi = NPH; a.li = 0;
    hipLaunchKernelGGL(mega, dim3(grid), dim3(NWAVES * 64), LDS_BYTES, stream, a);
#endif
}
```

```cpp
#define DUP_MASK 0
#include <hip/hip_runtime.h>
#include <cstdio>
#include <cstdint>

#ifndef SPLIT_PHASES
#define SPLIT_PHASES 0
#endif
#ifndef DUP_MASK
#define DUP_MASK 0
#endif

constexpr int NTOK = 32768, DM = 1024, SEQ = 4096, NBATCH = 8;
constexpr int NMAIN = 4608, NTR = 1536, NWIN = 5632;
constexpr int C_RQ = 0, C_RK = 512, C_RG = 1024, C_SQ = 1536, C_SK = 2048, C_GR = 2560, C_GS = 3584;
constexpr int C_MG = 0;
constexpr int T_KT = 0, T_VR = 512, T_VS = 1024;
constexpr int NEXP = 16, DEXP = 512, MPAD_MAX = 65536 + 16 * 256, NRT_MAX = MPAD_MAX / 256;
constexpr float EPS = 1e-6f;
constexpr float LOG2E = 1.4426950408889634f;
constexpr float SB_QSCALE = 0.125f * LOG2E;
constexpr float SB_EXIT = -152.0f;

constexpr size_t MiB = 1u << 20;
constexpr size_t WS_CTL = 0, CTL_ZERO_BYTES = 1 * MiB;
constexpr size_t WS_WIN = 2 * MiB;
constexpr size_t WS_WBR1 = 14 * MiB;
constexpr size_t WS_WBR2 = 15 * MiB;
constexpr size_t WS_WOUT = 16 * MiB;
constexpr size_t WS_WGU = 18 * MiB;
constexpr size_t WS_WD = 50 * MiB;
constexpr size_t WS_WPLE = 66 * MiB;
constexpr size_t WS_WPG = 67 * MiB;
constexpr size_t WS_TABA = 70 * MiB;
constexpr size_t WS_TABB = 72 * MiB;
constexpr size_t WS_ROUTE = 74 * MiB;
constexpr size_t WS_PB = 76 * MiB;
constexpr size_t WS_PROJ = 92 * MiB;
constexpr size_t WS_T = 380 * MiB;
constexpr size_t WS_X2 = 360 * MiB;
constexpr size_t WS_END = 488 * MiB;
constexpr size_t WS_H2 = 92 * MiB;
constexpr size_t WS_XB = 156 * MiB;
constexpr size_t WS_HID = 292 * MiB;
constexpr size_t DO_HB = 0, DO_ST = 0, DO_X1 = 0, DO_RS = 64 * MiB;
constexpr size_t RT_EID = 0, RT_WGT = 256 * 1024, RT_RANK = 512 * 1024, RT_POS = 768 * 1024, RT_WROW = 1024 * 1024, RT_TILE = 1536 * 1024;
constexpr int CW_TMO = 0, CW_CODE = 1;
constexpr int CW_CNT = 64;
constexpr int CW_BAR = 4096, BAR_STRIDE = 4096;

#define GAS __attribute__((address_space(1)))
#define LAS __attribute__((address_space(3)))
typedef unsigned short bf16;
typedef unsigned v4u __attribute__((ext_vector_type(4)));
typedef unsigned v2u __attribute__((ext_vector_type(2)));
typedef float f32x4 __attribute__((ext_vector_type(4)));
typedef float f32x2 __attribute__((ext_vector_type(2)));
typedef float f32x16 __attribute__((ext_vector_type(16)));
typedef short bf16x8 __attribute__((ext_vector_type(8)));
typedef short s16x4 __attribute__((ext_vector_type(4)));
typedef GAS unsigned gu32;
#define RLX_AGENT __ATOMIC_RELAXED, __HIP_MEMORY_SCOPE_AGENT
#define LDS_WAIT() asm volatile("s_waitcnt lgkmcnt(0)" ::: "memory")
#define VM_WAIT() asm volatile("s_waitcnt vmcnt(0)" ::: "memory")
#define DI __device__ __forceinline__
DI unsigned f2bf(float f) { unsigned u = __builtin_bit_cast(unsigned, f); return (u + 0x7fffu + ((u >> 16) & 1u)) >> 16; }
DI unsigned pk2(float lo, float hi) { return f2bf(lo) | (f2bf(hi) << 16); }
DI float bf2f(unsigned b) { return __builtin_bit_cast(float, b << 16); }
DI float bflo(unsigned w) { return __builtin_bit_cast(float, w << 16); }
DI float bfhi(unsigned w) { return __builtin_bit_cast(float, w & 0xffff0000u); }
DI float fsigmoid(float x) { return 1.0f / (1.0f + __expf(-x)); }
DI float fsilu(float x) { return x / (1.0f + __expf(-x)); }
DI float wave_sum(float v) {
#pragma unroll
    for (int o = 1; o < 64; o <<= 1) v += __shfl_xor(v, o);
    return v;
}
template <int CTRL, int ROWMASK> DI float dpp_add(float v) { return v + __builtin_bit_cast(float, __builtin_amdgcn_update_dpp(0, __builtin_bit_cast(int, v), CTRL, ROWMASK, 0xF, false)); }
DI float wave_sum_dpp(float v) {
    v = dpp_add<0xB1, 0xF>(v);
    v = dpp_add<0x4E, 0xF>(v);
    v = dpp_add<0x141, 0xF>(v);
    v = dpp_add<0x140, 0xF>(v);
    v = dpp_add<0x142, 0xA>(v);
    v = dpp_add<0x143, 0xC>(v);
    return __builtin_bit_cast(float, __builtin_amdgcn_readlane(__builtin_bit_cast(int, v), 63));
}
DI float ret_log2g(int h) { return log2f(1.0f - exp2f(-5.0f - (float)h)); }

__host__ __device__ __forceinline__ int in_src(int r) {
    if (r < 1024) { const int base = (r < 512) ? 0 : 512; const int i = r & 511, h = i >> 7, j = i & 127; return base + h * 128 + (j & 1) * 64 + (j >> 1); }
    if (r < 1536) return 1536 + (r - 1024);
    if (r < 2048) return 2048 + (r - 1536);
    if (r < 2560) return 2560 + (r - 2048);
    if (r < 3584) return 3584 + (r - 2560);
    if (r < 4608) return 4608 + (r - 3584);
    if (r < 5120) { const int i = r - 4608, h = i >> 7, j = i & 127; return 512 + h * 128 + (j & 1) * 64 + (j >> 1); }
    if (r < 5632) return 1024 + (r - 5120);
    return 3072 + (r - 5632);
}


namespace pg8 {
#define PG8_LAS __attribute__((address_space(3)))
typedef unsigned short bf16_t;
typedef short bf16x8 __attribute__((ext_vector_type(8)));
typedef float f32x4 __attribute__((ext_vector_type(4)));
typedef unsigned u32x4 __attribute__((ext_vector_type(4)));
constexpr int BM = 256, BK = 64, HALF = 128, HTB = HALF * BK * 2  , STAGE_BYTES = 8 * HTB, NXCD = 8, WGM = 8;

__host__ __device__ __forceinline__ int lds_byte(int r, int c) { const int st = (r >> 4) * 2 + (c >> 5), rr = r & 15, cc = c & 31, ob = rr * 64 + cc * 2; return st * 1024 + (ob ^ (((ob >> 9) & 1) << 5)); }
__host__ __device__ __forceinline__ void stage_rc(int b, int& R, int& C) { const int st = b / 1024, sb = b % 1024, swz = sb ^ (((sb >> 9) & 1) << 5); R = (st >> 1) * 16 + swz / 64; C = (st & 1) * 32 + (swz % 64) / 2; }
__host__ __device__ __forceinline__ int perm32(int rho) { const int n = rho >> 4, i = rho & 15; return 8 * (i >> 2) + 4 * n + (i & 3); }

struct Unit { int pm, pn; size_t bofs; int ex; };
struct Gemm { const bf16_t* A; const bf16_t* Bt; int lda, K; };

struct StaticOrder {
    int nM, nN, nwg, G, c; size_t tstepB;
    __device__ void init(int M, int N, int K, int G_, int c_) { nM = M / BM; nN = N / BM; nwg = nM * nN; G = G_; c = c_; tstepB = (size_t)BM * K * 2; }
    __device__ bool next(int i, Unit& u) const {
        const long L = (long)i * G + c; if (L >= nwg) return false;
        int wgid = (int)L; { const int q = nwg / NXCD, r = nwg % NXCD, xcd = wgid % NXCD, off = wgid / NXCD; wgid = (xcd < r ? xcd * (q + 1) : r * (q + 1) + (xcd - r) * q) + off; }
        const int nig = WGM * nN, gid = wgid / nig, fm = gid * WGM, gsz = (nM - fm) < WGM ? (nM - fm) : WGM;
        u.pm = fm + ((wgid % nig) % gsz); u.pn = (wgid % nig) / gsz; u.bofs = (size_t)u.pn * tstepB; u.ex = 0; return true;
    }
    __device__ __forceinline__ void a_ready(const Unit&) const {}
    __device__ __forceinline__ void done(const Unit&) const {}
};
__device__ __forceinline__ unsigned cvt_pk_bf16(float lo, float hi) { unsigned r; asm volatile("v_cvt_pk_bf16_f32 %0, %1, %2" : "=v"(r) : "v"(lo), "v"(hi)); return r; }
template <class Epi, class Sched, bool ALIGN_EPI = false, bool SP2 = false>
__device__ __forceinline__ void gemm_phase(PG8_LAS unsigned char* lds, const Gemm g, const Sched& S, const Epi& E) {
    int tid_ = threadIdx.x; asm volatile("" : "+v"(tid_));
    const int tid = tid_, wid = __builtin_amdgcn_readfirstlane(tid >> 6), lane = tid & 63, wr = wid >> 2, wc = wid & 3, fr = lane & 15, fq = lane >> 4;
    const int K = g.K, nt = K / BK;
    unsigned voffA[2], voffB[2];
#pragma unroll
    for (int i = 0; i < 2; ++i) { int R, C; stage_rc(tid * 16 + i * 8192, R, C); const int Rb = Epi::PERM ? ((R & ~31) + perm32(R & 31)) : R;
        voffA[i] = (unsigned)(R * g.lda + C) * 2u; voffB[i] = (unsigned)(Rb * K + C) * 2u; }
    const size_t kstep = (size_t)(BK * 2);
    const size_t hstepA = (size_t)HALF * g.lda * 2, hstepB = (size_t)HALF * K * 2;
    const size_t tstepA = 2 * hstepA;
    const unsigned ldsw = (unsigned)wid * 1024u;
    const int aoff = lds_byte(wr * 64 + fr, fq * 8), boff = lds_byte(wc * 32 + fr, fq * 8);
#define PG8_SA(b, h) (((b) * 2 + (h)) * HTB)
#define PG8_SB(b, h) ((4 + (b) * 2 + (h)) * HTB)
#define PG8_STAGE(bufoff, gbase, voff) do { _Pragma("unroll") for (int _i = 0; _i < 2; ++_i) \
        __builtin_amdgcn_global_load_lds((const unsigned*)((const char*)(gbase) + (voff)[_i]), (PG8_LAS unsigned*)(lds + (bufoff) + ldsw + _i * 8192), 16, 0, 0); } while (0)
#define PG8_LDA(dst, b, h) do { _Pragma("unroll") for (int m = 0; m < 4; ++m) _Pragma("unroll") for (int k = 0; k < 2; ++k) dst[m][k] = *(const PG8_LAS bf16x8*)(lds + PG8_SA(b, h) + aoff + m * 2048 + k * 1024); } while (0)
#define PG8_LDB(dst, b, h) do { _Pragma("unroll") for (int n = 0; n < 2; ++n) _Pragma("unroll") for (int k = 0; k < 2; ++k) dst[n][k] = *(const PG8_LAS bf16x8*)(lds + PG8_SB(b, h) + boff + n * 2048 + k * 1024); } while (0)
#define PG8_MMA(ai, bj, At, Bt) do { __builtin_amdgcn_s_setprio(1); _Pragma("unroll") for (int m = 0; m < 4; ++m) _Pragma("unroll") for (int n = 0; n < 2; ++n) _Pragma("unroll") for (int k = 0; k < 2; ++k) \
        acc[ai][bj][m][n] = __builtin_amdgcn_mfma_f32_16x16x32_bf16(Bt[n][k], At[m][k], acc[ai][bj][m][n], 0, 0, 0); __builtin_amdgcn_s_setprio(0); } while (0)
#define PG8_WAIT_V(n) asm volatile("s_waitcnt vmcnt(" #n ")" ::: "memory")
#define PG8_WAIT_L(n) asm volatile("s_waitcnt lgkmcnt(" #n ")" ::: "memory")
#define PG8_BAR __builtin_amdgcn_s_barrier()
#define PG8_SCHED __builtin_amdgcn_sched_barrier(0)
    Unit cur, nxt; int ui = 0;
    if (!S.next(0, cur)) return;
    f32x4 acc[2][2][4][2];
#pragma unroll
    for (int a = 0; a < 2; ++a)
#pragma unroll
        for (int b = 0; b < 2; ++b)
#pragma unroll
            for (int m = 0; m < 4; ++m)
#pragma unroll
                for (int n = 0; n < 2; ++n) acc[a][b][m][n] = (f32x4){0.f, 0.f, 0.f, 0.f};
    bf16x8 At[4][2], B0[2][2], B1[2][2];
    const char* cA = (const char*)g.A + (size_t)cur.pm * tstepA; const char* cB = (const char*)g.Bt + cur.bofs;
    S.a_ready(cur);
    if constexpr (SP2) {
        PG8_STAGE(PG8_SB(0, 0), cB, voffB); PG8_STAGE(PG8_SB(0, 1), cB + hstepB, voffB); PG8_STAGE(PG8_SA(0, 0), cA, voffA); PG8_STAGE(PG8_SA(0, 1), cA + hstepA, voffA);
        if (wr == 1) PG8_BAR;
        PG8_WAIT_V(2); PG8_BAR;
        PG8_STAGE(PG8_SB(1, 0), cB + kstep, voffB); PG8_STAGE(PG8_SA(1, 0), cA + kstep, voffA); PG8_STAGE(PG8_SB(1, 1), cB + hstepB + kstep, voffB);
        PG8_WAIT_V(6); PG8_BAR;
    } else {
        PG8_STAGE(PG8_SB(0, 0), cB, voffB); PG8_STAGE(PG8_SA(0, 0), cA, voffA); PG8_STAGE(PG8_SB(0, 1), cB + hstepB, voffB); PG8_STAGE(PG8_SA(0, 1), cA + hstepA, voffA);
        if (wr == 1) PG8_BAR;
        PG8_WAIT_V(4); PG8_BAR;
        PG8_STAGE(PG8_SB(1, 0), cB + kstep, voffB); PG8_STAGE(PG8_SA(1, 0), cA + kstep, voffA); PG8_STAGE(PG8_SB(1, 1), cB + hstepB + kstep, voffB);
        PG8_WAIT_V(6); PG8_BAR;
    }
    for (;;) {
        const bool has_next = S.next(ui + 1, nxt);
        const char* nA = has_next ? (const char*)g.A + (size_t)nxt.pm * tstepA : cA; const char* nB = has_next ? (const char*)g.Bt + nxt.bofs : cB;
        for (int th = 0; th < (Epi::MIDK > 0 ? 2 : 1); ++th) {
        if constexpr (Epi::MIDK > 0) { if (th == 1) E.mid(acc, cur, wr, wc, fr, fq); }
        const int t_lo = (Epi::MIDK > 0 && th == 1) ? Epi::MIDK : 0, t_hi = (Epi::MIDK > 0 && th == 0) ? Epi::MIDK : nt;
        for (int t = t_lo; t < t_hi; t += 2) {
            const bool last = (t == nt - 2);
            const char* a1 = cA + (size_t)(t + 1) * kstep;
            const char* a2 = last ? nA : cA + (size_t)(t + 2) * kstep; const char* b2 = last ? nB : cB + (size_t)(t + 2) * kstep;
            const char* a3 = a2 + kstep; const char* b3 = b2 + kstep;
            if (last && has_next) S.a_ready(nxt);
            if constexpr (SP2) {
            PG8_LDB(B0, 0, 0); PG8_LDB(B1, 0, 1); PG8_SCHED; PG8_LDA(At, 0, 0); PG8_STAGE(PG8_SA(1, 1), a1 + hstepA, voffA);
            PG8_WAIT_V(8); PG8_WAIT_L(0); PG8_BAR; PG8_MMA(0, 0, At, B0); PG8_MMA(0, 1, At, B1); PG8_BAR; PG8_SCHED;
            PG8_LDA(At, 0, 1); PG8_STAGE(PG8_SB(0, 0), b2, voffB); PG8_STAGE(PG8_SB(0, 1), b2 + hstepB, voffB); PG8_STAGE(PG8_SA(0, 0), a2, voffA);
            PG8_WAIT_V(8); PG8_WAIT_L(0); PG8_BAR; PG8_MMA(1, 0, At, B0); PG8_MMA(1, 1, At, B1); PG8_BAR; PG8_SCHED;
            PG8_LDB(B0, 1, 0); PG8_LDB(B1, 1, 1); PG8_SCHED; PG8_LDA(At, 1, 0); PG8_STAGE(PG8_SA(0, 1), a2 + hstepA, voffA);
            PG8_WAIT_V(8); PG8_WAIT_L(0); PG8_BAR; PG8_MMA(0, 0, At, B0); PG8_MMA(0, 1, At, B1); PG8_BAR; PG8_SCHED;
            PG8_LDA(At, 1, 1); PG8_STAGE(PG8_SB(1, 0), b3, voffB); PG8_STAGE(PG8_SB(1, 1), b3 + hstepB, voffB); PG8_STAGE(PG8_SA(1, 0), a3, voffA);
            PG8_WAIT_V(8); PG8_WAIT_L(0); PG8_BAR; PG8_MMA(1, 0, At, B0); PG8_MMA(1, 1, At, B1); PG8_BAR; PG8_SCHED;
            } else {
            PG8_LDB(B0, 0, 0); PG8_SCHED; PG8_LDA(At, 0, 0); PG8_STAGE(PG8_SA(1, 1), a1 + hstepA, voffA);
            PG8_WAIT_L(8); PG8_BAR; PG8_WAIT_L(0); PG8_MMA(0, 0, At, B0); PG8_BAR; PG8_SCHED;
            PG8_LDB(B1, 0, 1); PG8_STAGE(PG8_SB(0, 0), b2, voffB);
            PG8_BAR; PG8_WAIT_L(0); PG8_MMA(0, 1, At, B1); PG8_BAR;
            PG8_LDA(At, 0, 1); PG8_STAGE(PG8_SA(0, 0), a2, voffA);
            PG8_BAR; PG8_WAIT_L(0); PG8_MMA(1, 0, At, B0); PG8_BAR; PG8_SCHED;
            PG8_STAGE(PG8_SB(0, 1), b2 + hstepB, voffB);
            PG8_WAIT_V(6); PG8_BAR; PG8_MMA(1, 1, At, B1); PG8_BAR;
            PG8_LDB(B0, 1, 0); PG8_SCHED; PG8_LDA(At, 1, 0); PG8_STAGE(PG8_SA(0, 1), a2 + hstepA, voffA);
            PG8_WAIT_L(8); PG8_BAR; PG8_WAIT_L(0); PG8_MMA(0, 0, At, B0); PG8_BAR; PG8_SCHED;
            PG8_LDB(B1, 1, 1); PG8_STAGE(PG8_SB(1, 0), b3, voffB);
            PG8_BAR; PG8_WAIT_L(0); PG8_MMA(0, 1, At, B1); PG8_BAR;
            PG8_LDA(At, 1, 1); PG8_STAGE(PG8_SA(1, 0), a3, voffA);
            PG8_BAR; PG8_WAIT_L(0); PG8_MMA(1, 0, At, B0); PG8_BAR; PG8_SCHED;
            PG8_STAGE(PG8_SB(1, 1), b3 + hstepB, voffB);
            PG8_WAIT_V(6); PG8_BAR; PG8_MMA(1, 1, At, B1); PG8_BAR;
            }
        }
        }
        if constexpr (ALIGN_EPI) { if (wr == 0) PG8_BAR; }
        if constexpr (!Epi::AFTER_DRAIN) { E(acc, cur, wr, wc, fr, fq); S.done(cur); }
        if (!has_next) break;
#pragma unroll
        for (int a = 0; a < 2; ++a)
#pragma unroll
            for (int b = 0; b < 2; ++b)
#pragma unroll
                for (int m = 0; m < 4; ++m)
#pragma unroll
                    for (int n = 0; n < 2; ++n) acc[a][b][m][n] = (f32x4){0.f, 0.f, 0.f, 0.f};
        cur = nxt; cA = nA; cB = nB; ++ui;
        if constexpr (ALIGN_EPI) { if (wr == 1) PG8_BAR; }
    }
    PG8_WAIT_V(0);
    if constexpr (!ALIGN_EPI) { if (wr == 0) PG8_BAR; }
    PG8_BAR;
    if constexpr (Epi::AFTER_DRAIN) { E.fused(acc, cur, wr, wc, fr, fq, lds, wid, lane); S.done(cur); }
#undef PG8_SA
#undef PG8_SB
#undef PG8_STAGE
#undef PG8_LDA
#undef PG8_LDB
#undef PG8_MMA
#undef PG8_WAIT_V
#undef PG8_WAIT_L
#undef PG8_BAR
#undef PG8_SCHED
}
}
#define XB_TMO      128
#define XB_XCNT(j)  (256  + 64 * (j))
#define XB_XSUB(j)  (1280 + 64 * (j))
#define XB_XGEN(j)  (2304 + 64 * (j))
#define XB_TOP      3328
#define XB_TOPGEN   3392
#define XCD_BAR_WORDS 3456
#define XB_SPIN_CAP (1u << 18)

__device__ __forceinline__ unsigned xb_ld(unsigned* p)              { return __hip_atomic_load(p, __ATOMIC_RELAXED, __HIP_MEMORY_SCOPE_AGENT); }
__device__ __forceinline__ unsigned xb_add(unsigned* p, unsigned v) { return __hip_atomic_fetch_add(p, v, __ATOMIC_RELAXED, __HIP_MEMORY_SCOPE_AGENT); }
__device__ __forceinline__ unsigned xb_xcc_id() { return (unsigned)__builtin_amdgcn_s_getreg((3 << 11) | 20) & 0xFu; }
#define XB_SPIN(cond, bar) do { unsigned _sp = 0; while (cond) { __builtin_amdgcn_s_sleep(1); \
    if ((++_sp & 255u) == 0u) { if (xb_ld(&(bar)[XB_TMO])) break; if (_sp > XB_SPIN_CAP) { atomicAdd(&(bar)[XB_TMO], 1u); break; } } } } while (0)

struct XcdBarrier {
    unsigned* bar; unsigned x;
    volatile LAS unsigned* st;
};

__device__ __forceinline__ XcdBarrier xcd_barrier_post(unsigned* bar, volatile LAS unsigned* st) {
    XcdBarrier b; b.bar = bar; b.x = xb_xcc_id(); b.st = st;
    if (threadIdx.x == 0) (void)xb_add(&bar[XB_XCNT(b.x)], 1u);
    return b;
}
__device__ __forceinline__ void xcd_barrier_complete(unsigned* bar, unsigned x, unsigned& nloc, unsigned& nx) {
    const unsigned G = gridDim.x * gridDim.y * gridDim.z;
    unsigned sum, cnt, mine, sp = 0u;
    for (;;) {
        sum = 0u; cnt = 0u; mine = 0u;
#pragma unroll
        for (unsigned j = 0; j < 16; ++j) { const unsigned c = xb_ld(&bar[XB_XCNT(j)]); sum += c; cnt += (c > 0u) ? 1u : 0u; mine = (j == x) ? c : mine; }
        if (sum == G) break;
        __builtin_amdgcn_s_sleep(1);
        if ((++sp & 255u) == 0u) { if (xb_ld(&bar[XB_TMO])) break; if (sp > XB_SPIN_CAP) { atomicAdd(&bar[XB_TMO], 1u); break; } }
    }
    nloc = mine > 0u ? mine : 1u; nx = cnt > 0u ? cnt : 1u;
}

__device__ __forceinline__ void xcd_barrier(const XcdBarrier& b) {
    asm volatile("s_waitcnt vmcnt(0)" ::: "memory");
    __syncthreads();
    if (threadIdx.x == 0) {
        unsigned* bar = b.bar;
        __builtin_amdgcn_s_waitcnt(0);
        unsigned nloc = b.st[0], nx = b.st[1];
        if (nloc == 0u) { xcd_barrier_complete(bar, b.x, nloc, nx); b.st[0] = nloc; b.st[1] = nx; }
        const unsigned old = xb_add(&bar[XB_XSUB(b.x)], 1u);
        const unsigned gen = old / nloc;
        if (old + 1u == (gen + 1u) * nloc) {
            __builtin_amdgcn_fence(__ATOMIC_RELEASE, "agent");
            asm volatile("s_waitcnt vmcnt(0)" ::: "memory");
            const unsigned og = xb_add(&bar[XB_TOP], 1u);
            const unsigned tg = og / nx;
            if (og + 1u == (tg + 1u) * nx) xb_add(&bar[XB_TOPGEN], 1u);
            else XB_SPIN(xb_ld(&bar[XB_TOPGEN]) == tg, bar);
            __builtin_amdgcn_fence(__ATOMIC_ACQUIRE, "agent");
            xb_add(&bar[XB_XGEN(b.x)], 1u);
            asm volatile("s_waitcnt vmcnt(0)" ::: "memory");
        } else {
            XB_SPIN(xb_ld(&bar[XB_XGEN(b.x)]) == gen, bar);
            __builtin_amdgcn_fence(__ATOMIC_ACQUIRE, "agent");
            asm volatile("s_waitcnt vmcnt(0)" ::: "memory");
        }
    }
    __syncthreads();
}

constexpr int NWAVES = 8;
constexpr int RING_OFF = 0, RING_BYTES = 131072;
constexpr int LDSCTL_OFF = RING_BYTES, MISC_OFF = LDSCTL_OFF + 320;
constexpr int LDS_BYTES = 147456;

struct Args { const float* in[20]; float* out; unsigned char* ws; int ph_lo, ph_hi, li, pad; };

struct Frame {
    LAS unsigned char* lds;
    volatile LAS unsigned* MISC;
    gu32* ctl;
    int tid, lane, wave, vcu, G;
    __device__ __forceinline__ void refresh() { int t = threadIdx.x; asm volatile("" : "+v"(t)); tid = t; lane = t & 63; wave = __builtin_amdgcn_readfirstlane(t >> 6); }
    unsigned char* ws; float* out;
    const float* x; const float* p;
};

enum Phase { PH_PRO = 0, PH_PROJ, PH_MIX1, PH_SCAN, PH_RETO, PH_BR, PH_WOUT, PH_ROUTE, PH_GATHER, PH_GU, PH_DOWN, PH_COMB, PH_PLE, PH_FINAL, NPH };

DI void tr_item(const float* __restrict__ W, int ldw, int mycol, bf16* WT, int K, int r0, int k0, LAS float* scr, int lane) {
#pragma unroll 8
    for (int i = 0; i < 32; ++i) { const int kk = 2 * i + (lane >> 5); scr[kk * 33 + (lane & 31)] = W[(size_t)(k0 + kk) * ldw + mycol]; }
    LDS_WAIT(); asm volatile("" ::: "memory");
    const int c = lane & 7;
#pragma unroll
    for (int j = 0; j < 4; ++j) { const int n = (lane >> 3) + 8 * j; const LAS float* s = scr + (8 * c) * 33 + n;
        v4u o; o.x = pk2(s[0 * 33], s[1 * 33]); o.y = pk2(s[2 * 33], s[3 * 33]); o.z = pk2(s[4 * 33], s[5 * 33]); o.w = pk2(s[6 * 33], s[7 * 33]);
        *(GAS v4u*)(WT + (size_t)(r0 + n) * K + k0 + 8 * c) = o; }
    LDS_WAIT(); asm volatile("" ::: "memory");
}
DI void rms_row_to_bf16(const float* xrow, const float* gain, bf16* orow, int lane) {
    const GAS f32x4* xr = (const GAS f32x4*)xrow + lane; const GAS f32x4* gr = (const GAS f32x4*)gain + lane;
    f32x4 v[4]; float s = 0.f;
#pragma unroll
    for (int j = 0; j < 4; ++j) { v[j] = xr[64 * j]; s += (v[j].x * v[j].x + v[j].y * v[j].y) + (v[j].z * v[j].z + v[j].w * v[j].w); }
    const float rstd = rsqrtf(wave_sum_dpp(s) * (1.f / DM) + EPS);
    GAS v2u* o8 = (GAS v2u*)orow + lane;
#pragma unroll
    for (int j = 0; j < 4; ++j) { const f32x4 g = gr[64 * j]; v2u o; o.x = pk2(v[j].x * rstd * g.x, v[j].y * rstd * g.y); o.y = pk2(v[j].z * rstd * g.z, v[j].w * rstd * g.w); o8[64 * j] = o; }
}
DI void ph_prologue(Frame& F, const Args& a) {
    LAS float* scr = (LAS float*)(F.lds + RING_OFF + F.wave * 16384);
    const int gw = F.vcu * NWAVES + F.wave, NGW = F.G * NWAVES, lane = F.lane;
    unsigned char* ws = F.ws;
    constexpr int I_IN = (6144 / 32) * 16, I_BR = 32 * 8, I_OUT = 32 * 16, I_GU = 16 * 32 * 16, I_D = 16 * 32 * 8, I_PLE = 32 * 4, I_PG = 32 * 16;
    constexpr int NITEMS = I_IN + 2 * I_BR + I_OUT + I_GU + I_D + I_PLE + I_PG;
    for (int it = gw; it < NITEMS; it += NGW) {
        int r = it;
        if (r < I_IN) { const int rb = r >> 4, kb = r & 15; tr_item(a.in[3], NWIN, in_src(rb * 32 + (lane & 31)), (bf16*)(ws + WS_WIN), 1024, rb * 32, kb * 64, scr, lane); continue; } r -= I_IN;
        if (r < I_BR) { const int rb = r >> 3, kb = r & 7; tr_item(a.in[5], DM, rb * 32 + (lane & 31), (bf16*)(ws + WS_WBR1), 1024, rb * 32, kb * 64, scr, lane); continue; } r -= I_BR;
        if (r < I_BR) { const int rb = r >> 3, kb = r & 7; tr_item(a.in[6], DM, rb * 32 + (lane & 31), (bf16*)(ws + WS_WBR1) + 512, 1024, rb * 32, kb * 64, scr, lane); continue; } r -= I_BR;
        if (r < I_OUT) { const int rb = r >> 4, kb = r & 15; tr_item(a.in[7], DM, rb * 32 + (lane & 31), (bf16*)(ws + WS_WOUT), 1024, rb * 32, kb * 64, scr, lane); continue; } r -= I_OUT;
        if (r < I_GU) { const int e = r >> 9, q = r & 511, rb = q >> 4, kb = q & 15;
            const int row = rb * 32, j = row >> 8, w = row & 255; const bool up = w >= 128; const int col = 128 * j + (w & 127) + (lane & 31);
            tr_item((up ? a.in[14] : a.in[13]) + (size_t)e * DM * DEXP, DEXP, col, (bf16*)(ws + WS_WGU) + (size_t)e * 1024 * 1024, 1024, row, kb * 64, scr, lane); continue; } r -= I_GU;
        if (r < I_D) { const int e = r >> 8, q = r & 255, rb = q >> 3, kb = q & 7;
            tr_item(a.in[15] + (size_t)e * DEXP * DM, DM, rb * 32 + (lane & 31), (bf16*)(ws + WS_WD) + (size_t)e * 1024 * 512, 512, rb * 32, kb * 64, scr, lane); continue; } r -= I_D;
        if (r < I_PLE) { const int rb = r >> 2, kb = r & 3; tr_item(a.in[17], DM, rb * 32 + (lane & 31), (bf16*)(ws + WS_WPLE), 256, rb * 32, kb * 64, scr, lane); continue; } r -= I_PLE;
        { const int rb = r >> 4, kb = r & 15; tr_item(a.in[18], DM, rb * 32 + (lane & 31), (bf16*)(ws + WS_WPG), 1024, rb * 32, kb * 64, scr, lane); }
    }
    bf16* HB = (bf16*)((unsigned char*)F.out + DO_HB);
    for (int m = gw; m < NTOK; m += NGW) {
        rms_row_to_bf16(F.x + (size_t)m * DM, a.in[2], HB + (size_t)m * DM, lane);
        const f32x4 pv = ((const GAS f32x4*)(F.p + (size_t)m * 256))[lane];
        v2u o; o.x = pk2(pv.x, pv.y); o.y = pk2(pv.z, pv.w); ((GAS v2u*)((bf16*)(ws + WS_PB) + (size_t)m * 256))[lane] = o;
    }
    f32x2* tabA = (f32x2*)(ws + WS_TABA); f32x2* tabB = (f32x2*)(ws + WS_TABB);
    for (int i = F.vcu * 512 + F.tid; i < SEQ * 64; i += F.G * 512) {
        const int pos = i >> 6, p = i & 63;
        const float invf = powf(10000.0f, -(float)(2 * p) * (1.0f / 128.0f)); const float ang = (float)pos * invf;
        const f32x2 cs = {cosf(ang), sinf(ang)};
        tabA[i] = cs; tabB[p * SEQ + pos] = cs;
    }
}

DI void ph_route(Frame& F, const Args& a) {
    LAS float* WL = (LAS float*)(F.lds);
    for (int i = F.tid; i < 1024 * 20; i += 512) { const int k = i / 20, o = i - k * 20; WL[((k & 3) * 256 + (k >> 2)) * 20 + o] = o < 4 ? a.in[9][k * 4 + o] : a.in[11][k * 16 + (o - 4)]; }
    LAS int* s_e = (LAS int*)(F.lds + 81920); LAS int* s_lr = s_e + 256; LAS int* lcnt = s_lr + 256; LAS int* lbase = lcnt + 16;
    unsigned char* ws = F.ws; const int lane = F.lane;
    int* eid = (int*)(ws + WS_ROUTE + RT_EID); float* wgt = (float*)(ws + WS_ROUTE + RT_WGT); int* rank = (int*)(ws + WS_ROUTE + RT_RANK);
    bf16* H2 = (bf16*)(ws + WS_H2); const bf16* X1 = (const bf16*)((unsigned char*)F.out + DO_X1);
    const float* bg = a.in[10]; const float* be = a.in[12];
    __syncthreads();
    for (int blk = F.vcu; blk < NTOK / 128; blk += F.G) {
        if (F.tid < 16) lcnt[F.tid] = 0;
        __syncthreads();
        v2u raw[4];
        { const GAS v2u* xr = (const GAS v2u*)(X1 + (size_t)(blk * 128 + F.wave) * DM) + lane;
#pragma unroll
          for (int j = 0; j < 4; ++j) raw[j] = xr[64 * j]; }
        for (int tl = F.wave; tl < 128; tl += NWAVES) {
            const int tok = blk * 128 + tl;
            v2u nxt[4];
            { const int tn = (tl + NWAVES < 128) ? tok + NWAVES : tok; const GAS v2u* xr = (const GAS v2u*)(X1 + (size_t)tn * DM) + lane;
#pragma unroll
              for (int j = 0; j < 4; ++j) nxt[j] = xr[64 * j]; }
            const GAS f32x4* gr = (const GAS f32x4*)a.in[8] + lane;
            f32x4 v[4]; float ss = 0.f;
#pragma unroll
            for (int j = 0; j < 4; ++j) { v[j] = (f32x4){bflo(raw[j].x), bfhi(raw[j].x), bflo(raw[j].y), bfhi(raw[j].y)}; ss += (v[j].x * v[j].x + v[j].y * v[j].y) + (v[j].z * v[j].z + v[j].w * v[j].w); }
            const float rstd = rsqrtf(wave_sum_dpp(ss) * (1.f / DM) + EPS);
            GAS v2u* o8 = (GAS v2u*)(H2 + (size_t)tok * DM) + lane;
            float acc[20];
#pragma unroll
            for (int o = 0; o < 20; ++o) acc[o] = 0.f;
#pragma unroll
            for (int j = 0; j < 4; ++j) {
                const f32x4 g = gr[64 * j]; v[j] = v[j] * rstd * g;
                v2u o; o.x = pk2(v[j].x, v[j].y); o.y = pk2(v[j].z, v[j].w); o8[64 * j] = o;
#pragma unroll
                for (int i = 0; i < 4; ++i) {
                    const float hv = v[j][i]; const LAS f32x4* w = (const LAS f32x4*)(WL + (i * 256 + lane + 64 * j) * 20);
#pragma unroll
                    for (int q = 0; q < 5; ++q) { const f32x4 wv = w[q]; acc[4 * q] += hv * wv.x; acc[4 * q + 1] += hv * wv.y; acc[4 * q + 2] += hv * wv.z; acc[4 * q + 3] += hv * wv.w; }
                }
            }
#pragma unroll
            for (int o = 0; o < 20; ++o) acc[o] = wave_sum_dpp(acc[o]);
            float gl[4];
#pragma unroll
            for (int i = 0; i < 4; ++i) gl[i] = acc[i] + bg[i];
            int g = 0; float gm = gl[0];
#pragma unroll
            for (int i = 1; i < 4; ++i) if (gl[i] > gm) { gm = gl[i]; g = i; }
            float se = 0.f;
#pragma unroll
            for (int i = 0; i < 4; ++i) se += __expf(gl[i] - gm);
            const float pg = 1.0f / se;
            float el[4];
#pragma unroll
            for (int i = 0; i < 4; ++i) { const float l0 = acc[4 + i], l1 = acc[8 + i], l2 = acc[12 + i], l3 = acc[16 + i]; el[i] = (g == 0 ? l0 : g == 1 ? l1 : g == 2 ? l2 : l3) + be[4 * g + i]; }
            int i1 = 0; float m1 = el[0];
#pragma unroll
            for (int i = 1; i < 4; ++i) if (el[i] > m1) { m1 = el[i]; i1 = i; }
            int i2 = -1; float m2 = -3.0e38f;
#pragma unroll
            for (int i = 0; i < 4; ++i) if (i != i1 && el[i] > m2) { m2 = el[i]; i2 = i; }
            const float e2 = __expf(m2 - m1), w1 = pg / (1.0f + e2), w2 = pg * e2 / (1.0f + e2);
            if (lane == 0) {
                eid[2 * tok] = 4 * g + i1; eid[2 * tok + 1] = 4 * g + i2; wgt[2 * tok] = w1; wgt[2 * tok + 1] = w2;
                s_e[2 * tl] = 4 * g + i1; s_e[2 * tl + 1] = 4 * g + i2;
            }
#pragma unroll
            for (int j = 0; j < 4; ++j) raw[j] = nxt[j];
        }
        __syncthreads();
        if (F.tid < 256) s_lr[F.tid] = atomicAdd((int*)&lcnt[s_e[F.tid]], 1);
        __syncthreads();
        if (F.tid < 16) lbase[F.tid] = (int)__hip_atomic_fetch_add(F.ctl + CW_CNT + F.tid, (unsigned)lcnt[F.tid], RLX_AGENT);
        __syncthreads();
        if (F.tid < 256) rank[blk * 256 + F.tid] = lbase[s_e[F.tid]] + s_lr[F.tid];
        __syncthreads();
    }
}

DI void expert_table(Frame& F, LAS int* pst) {
    if (F.tid == 0) { int acc = 0; for (int e = 0; e < NEXP; ++e) { pst[e] = acc; const int c = (int)__hip_atomic_load(F.ctl + CW_CNT + e, RLX_AGENT); acc += (c + 255) & ~255; } pst[NEXP] = acc; }
    __syncthreads();
}

DI void ph_gather(Frame& F, const Args& a) {
    LAS int* pst = (LAS int*)(F.lds);
    expert_table(F, pst);
    unsigned char* ws = F.ws; const int lane = F.lane;
    const int* eid = (const int*)(ws + WS_ROUTE + RT_EID); const float* wgt = (const float*)(ws + WS_ROUTE + RT_WGT); const int* rank = (const int*)(ws + WS_ROUTE + RT_RANK);
    int* pos = (int*)(ws + WS_ROUTE + RT_POS); float* wrow = (float*)(ws + WS_ROUTE + RT_WROW); int* tile = (int*)(ws + WS_ROUTE + RT_TILE);
    const bf16* H2 = (const bf16*)(ws + WS_H2); bf16* XB = (bf16*)(ws + WS_XB);
    if (blockIdx.x == 0 && F.tid < NEXP) { const int e = F.tid; for (int rt = pst[e] >> 8; rt < (pst[e + 1] >> 8); ++rt) tile[1 + rt] = e; if (e == 0) tile[0] = pst[NEXP] >> 8; }
    const int gw = F.vcu * NWAVES + F.wave, NGW = F.G * NWAVES;
    v4u r0, r1; int e0, e1, k0, k1;
#define GATH_LOAD(tk, a0, a1, x0, x1, y0, y1) do { const GAS v4u* s_ = (const GAS v4u*)(H2 + (size_t)(tk) * DM) + lane; a0 = s_[0]; a1 = s_[64]; x0 = eid[2 * (tk)]; x1 = eid[2 * (tk) + 1]; y0 = rank[2 * (tk)]; y1 = rank[2 * (tk) + 1]; } while (0)
    if (gw < NTOK) GATH_LOAD(gw, r0, r1, e0, e1, k0, k1);
    for (int tok = gw; tok < NTOK; tok += NGW) {
        v4u n0, n1; int f0, f1, m0, m1;
        { const int tn = (tok + NGW < NTOK) ? tok + NGW : tok; GATH_LOAD(tn, n0, n1, f0, f1, m0, m1); }
        const int p0 = pst[e0] + k0, p1 = pst[e1] + k1;
        GAS v4u* d0 = (GAS v4u*)(XB + (size_t)p0 * DM) + lane; GAS v4u* d1 = (GAS v4u*)(XB + (size_t)p1 * DM) + lane;
        d0[0] = r0; d0[64] = r1; d1[0] = r0; d1[64] = r1;
        if (lane == 0) { pos[2 * tok] = p0; pos[2 * tok + 1] = p1; wrow[p0] = wgt[2 * tok]; wrow[p1] = wgt[2 * tok + 1]; }
        r0 = n0; r1 = n1; e0 = f0; e1 = f1; k0 = m0; k1 = m1;
    }
#undef GATH_LOAD
}

DI void ph_combine(Frame& F, const Args& a) {
    unsigned char* ws = F.ws; const int lane = F.lane;
    const int* __restrict__ pos = (const int*)(ws + WS_ROUTE + RT_POS); const bf16* __restrict__ YB = (const bf16*)(ws + WS_XB); bf16* __restrict__ HP = (bf16*)(ws + WS_H2);
    const bf16* __restrict__ X1 = (const bf16*)((unsigned char*)F.out + DO_X1); bf16* __restrict__ X2 = (bf16*)(ws + WS_X2);
    const int gw = F.vcu * NWAVES + F.wave, NGW = F.G * NWAVES;
    v2u cx[4], c0[4], c1[4];
#define COMB_LOAD(tk, dx, d0, d1) do { const int p0_ = pos[2 * (tk)], p1_ = pos[2 * (tk) + 1]; \
        const GAS v2u* xr_ = (const GAS v2u*)(X1 + (size_t)(tk) * DM) + lane; const GAS v2u* y0_ = (const GAS v2u*)(YB + (size_t)p0_ * DM) + lane; const GAS v2u* y1_ = (const GAS v2u*)(YB + (size_t)p1_ * DM) + lane; \
        _Pragma("unroll") for (int j = 0; j < 4; ++j) { dx[j] = xr_[64 * j]; d0[j] = y0_[64 * j]; d1[j] = y1_[64 * j]; } } while (0)
    if (gw < NTOK) COMB_LOAD(gw, cx, c0, c1);
    for (int tok = gw; tok < NTOK; tok += NGW) {
        v2u nx[4], n0[4], n1[4];
        { const int tn = (tok + NGW < NTOK) ? tok + NGW : tok; COMB_LOAD(tn, nx, n0, n1); }
        const GAS f32x4* gr = (const GAS f32x4*)a.in[16] + lane; GAS v2u* xw = (GAS v2u*)(X2 + (size_t)tok * DM) + lane;
        f32x4 v[4]; float ss = 0.f;
#pragma unroll
        for (int j = 0; j < 4; ++j) {
            const v2u x0 = cx[j], a0 = c0[j], a1 = c1[j];
            v[j].x = bflo(x0.x) + bflo(a0.x) + bflo(a1.x); v[j].y = bfhi(x0.x) + bfhi(a0.x) + bfhi(a1.x); v[j].z = bflo(x0.y) + bflo(a0.y) + bflo(a1.y); v[j].w = bfhi(x0.y) + bfhi(a0.y) + bfhi(a1.y);
            v2u o; o.x = pk2(v[j].x, v[j].y); o.y = pk2(v[j].z, v[j].w); xw[64 * j] = o;
            ss += (v[j].x * v[j].x + v[j].y * v[j].y) + (v[j].z * v[j].z + v[j].w * v[j].w);
        }
        const float rstd = rsqrtf(wave_sum_dpp(ss) * (1.f / DM) + EPS);
        GAS v2u* o8 = (GAS v2u*)(HP + (size_t)tok * DM) + lane;
#pragma unroll
        for (int j = 0; j < 4; ++j) { const f32x4 g = gr[64 * j]; v2u o; o.x = pk2(v[j].x * rstd * g.x, v[j].y * rstd * g.y); o.y = pk2(v[j].z * rstd * g.z, v[j].w * rstd * g.w); o8[64 * j] = o; }
#pragma unroll
        for (int j = 0; j < 4; ++j) { cx[j] = nx[j]; c0[j] = n0[j]; c1[j] = n1[j]; }
    }
#undef COMB_LOAD
}

DI void ph_final(Frame& F, const Args& a) {
    const int lane = F.lane, gw = F.vcu * NWAVES + F.wave, NGW = F.G * NWAVES;
    f32x4 cur[4];
    if (gw < NTOK) { const GAS f32x4* xr = (const GAS f32x4*)(F.out + (size_t)gw * DM) + lane;
#pragma unroll
        for (int j = 0; j < 4; ++j) cur[j] = xr[64 * j]; }
    for (int tok = gw; tok < NTOK; tok += NGW) {
        f32x4 nxt[4];
        { const int tn = (tok + NGW < NTOK) ? tok + NGW : tok; const GAS f32x4* xn = (const GAS f32x4*)(F.out + (size_t)tn * DM) + lane;
#pragma unroll
          for (int j = 0; j < 4; ++j) nxt[j] = xn[64 * j]; }
        GAS f32x4* xr = (GAS f32x4*)(F.out + (size_t)tok * DM) + lane; const GAS f32x4* gr = (const GAS f32x4*)a.in[19] + lane;
        float ss = 0.f;
#pragma unroll
        for (int j = 0; j < 4; ++j) ss += (cur[j].x * cur[j].x + cur[j].y * cur[j].y) + (cur[j].z * cur[j].z + cur[j].w * cur[j].w);
        const float rstd = rsqrtf(wave_sum_dpp(ss) * (1.f / DM) + EPS);
#pragma unroll
        for (int j = 0; j < 4; ++j) { const f32x4 g = gr[64 * j]; xr[64 * j] = cur[j] * rstd * g; }
#pragma unroll
        for (int j = 0; j < 4; ++j) cur[j] = nxt[j];
    }
}

typedef pg8::f32x4 af4;
DI unsigned cvtpk(float lo, float hi) { typedef float f2 __attribute__((ext_vector_type(2))); typedef __bf16 b2 __attribute__((ext_vector_type(2))); f2 v = {lo, hi}; b2 b = __builtin_convertvector(v, b2); return __builtin_bit_cast(unsigned, b); }
DI v4u pack8(const float (&x)[8]) { v4u w; w.x = cvtpk(x[0], x[1]); w.y = cvtpk(x[2], x[3]); w.z = cvtpk(x[4], x[5]); w.w = cvtpk(x[6], x[7]); return w; }
DI void unpack8(const v4u w, float (&x)[8]) { x[0] = bflo(w.x); x[1] = bfhi(w.x); x[2] = bflo(w.y); x[3] = bfhi(w.y); x[4] = bflo(w.z); x[5] = bfhi(w.z); x[6] = bflo(w.w); x[7] = bfhi(w.w); }

struct EpiProj {
    static constexpr bool PERM = true, AFTER_DRAIN = false; static constexpr int MIDK = 0;
    bf16* PROJ; const f32x2* tabA; const float* gn;
    DI void operator()(const af4 (&acc)[2][2][4][2], const pg8::Unit& u, int wr, int wc, int fr, int fq) const {
        const int row0 = u.pm * 256 + wr * 64 + fr, colb = u.pn * 256 + wc * 32 + 8 * fq;
        const int kind = u.pn < 2 ? 0 : u.pn < 4 ? 1 : u.pn < 6 ? 2 : u.pn < 8 ? 3 : u.pn < 10 ? 4 : 5;
#pragma unroll
        for (int ai = 0; ai < 2; ++ai)
#pragma unroll
            for (int m = 0; m < 4; ++m) {
                const int row = row0 + ai * 128 + m * 16;
#pragma unroll
                for (int bj = 0; bj < 2; ++bj) {
                    const int col = colb + bj * 128;
                    const af4 a0 = acc[ai][bj][m][0], a1 = acc[ai][bj][m][1];
                    float x[8] = {a0[0], a0[1], a0[2], a0[3], a1[0], a1[1], a1[2], a1[3]};
                    if (kind <= 1) {
                        const int pos = row & (SEQ - 1), p = (col & 127) >> 1;
                        const f32x4* tp = (const f32x4*)(tabA + pos * 64 + p);
                        const f32x4 t0 = tp[0], t1 = tp[1];
                        const float sc = kind == 1 ? 0.08838834764831845f : 1.0f;
                        float y[8];
                        y[0] = (x[0] * t0.x - x[1] * t0.y) * sc; y[1] = (x[0] * t0.y + x[1] * t0.x) * sc;
                        y[2] = (x[2] * t0.z - x[3] * t0.w) * sc; y[3] = (x[2] * t0.w + x[3] * t0.z) * sc;
                        y[4] = (x[4] * t1.x - x[5] * t1.y) * sc; y[5] = (x[4] * t1.y + x[5] * t1.x) * sc;
                        y[6] = (x[6] * t1.z - x[7] * t1.w) * sc; y[7] = (x[6] * t1.w + x[7] * t1.z) * sc;
#pragma unroll
                        for (int i = 0; i < 8; ++i) x[i] = y[i];
                    } else if (kind == 2) {
                        const f32x4 g0 = *(const f32x4*)(gn + (col - C_RG)), g1 = *(const f32x4*)(gn + (col - C_RG) + 4);
                        const float gg[8] = {g0.x, g0.y, g0.z, g0.w, g1.x, g1.y, g1.z, g1.w};
#pragma unroll
                        for (int i = 0; i < 8; ++i) x[i] = fsilu(x[i]) * gg[i];
                    } else if (kind == 3) {
#pragma unroll
                        for (int i = 0; i < 8; ++i) x[i] *= SB_QSCALE;
                    } else if (kind == 5) {
#pragma unroll
                        for (int i = 0; i < 8; ++i) x[i] = fsigmoid(x[i]);
                    }
                    *(v4u*)(PROJ + (size_t)row * NMAIN + col) = pack8(x);
                }
            }
    }
};
struct EpiProjT {
    static constexpr bool PERM = true, AFTER_DRAIN = false; static constexpr int MIDK = 0;
    bf16* T; const f32x2* tabB;
    DI void operator()(const af4 (&acc)[2][2][4][2], const pg8::Unit& u, int wr, int wc, int fr, int fq) const {
        const int f0 = u.pm * 256 + wr * 64 + fr, tokb = u.pn * 256 + wc * 32 + 8 * fq;
        const bool isk = u.pm < 2;
#pragma unroll
        for (int ai = 0; ai < 2; ++ai)
#pragma unroll
            for (int m = 0; m < 4; ++m) {
                const int f = f0 + ai * 128 + m * 16;
#pragma unroll
                for (int bj = 0; bj < 2; ++bj) {
                    const int tok = tokb + bj * 128;
                    const af4 a0 = acc[ai][bj][m][0], a1 = acc[ai][bj][m][1];
                    float x[8] = {a0[0], a0[1], a0[2], a0[3], a1[0], a1[1], a1[2], a1[3]};
                    if (isk) {
                        const int pos = tok & (SEQ - 1), h = f >> 7, p = (f & 127) >> 1;
                        const f32x4* tp = (const f32x4*)(tabB + p * SEQ + pos);
                        const f32x4 t0 = tp[0], t1 = tp[1], t2 = tp[2], t3 = tp[3];
                        const float cs[8] = {t0.x, t0.z, t1.x, t1.z, t2.x, t2.z, t3.x, t3.z}, sn[8] = {t0.y, t0.w, t1.y, t1.w, t2.y, t2.w, t3.y, t3.w};
                        const float l2g = ret_log2g(h); const float ginv = exp2f(-l2g);
                        float sc = 0.08838834764831845f * exp2f(l2g * (float)(63 - (pos & 63)));
                        const bool odd = (f & 1) != 0;
                        float y[8];
#pragma unroll
                        for (int i = 0; i < 8; ++i) {
                            const float other = __shfl_xor(x[i], 1);
                            const float r = odd ? (other * sn[i] + x[i] * cs[i]) : (x[i] * cs[i] - other * sn[i]);
                            y[i] = r * sc; sc *= ginv;
                        }
#pragma unroll
                        for (int i = 0; i < 8; ++i) x[i] = y[i];
                    }
                    *(v4u*)(T + (size_t)f * NTOK + tok) = pack8(x);
                }
            }
    }
};

struct EpiBr {
    static constexpr bool PERM = true, AFTER_DRAIN = false; static constexpr int MIDK = 8;
    bf16* PROJ;
    DI void mid(af4 (&acc)[2][2][4][2], const pg8::Unit& u, int wr, int wc, int fr, int fq) const {
        int row0 = u.pm * 256 + wr * 64 + fr, colb = u.pn * 256 + wc * 32 + 8 * fq;
        asm volatile("" : "+v"(row0), "+v"(colb));
#pragma unroll
        for (int ai = 0; ai < 2; ++ai)
#pragma unroll
            for (int m = 0; m < 4; ++m) {
                const bf16* pr = PROJ + (size_t)(row0 + ai * 128 + m * 16) * NMAIN;
#pragma unroll
                for (int bj = 0; bj < 2; ++bj) {
                    const int col = colb + bj * 128;
                    float gr[8], gs[8]; unpack8(*(const v4u*)(pr + C_GR + col), gr); unpack8(*(const v4u*)(pr + C_GS + col), gs);
#pragma unroll
                    for (int i = 0; i < 4; ++i) { acc[ai][bj][m][0][i] *= gr[i] * __builtin_amdgcn_rcpf(fmaxf(gs[i], 1e-30f)); acc[ai][bj][m][1][i] *= gr[4 + i] * __builtin_amdgcn_rcpf(fmaxf(gs[4 + i], 1e-30f)); }
                }
                asm volatile("" ::: "memory");
            }
    }
    DI void operator()(const af4 (&acc)[2][2][4][2], const pg8::Unit& u, int wr, int wc, int fr, int fq) const {
        int row0 = u.pm * 256 + wr * 64 + fr, colb = u.pn * 256 + wc * 32 + 8 * fq;
        asm volatile("" : "+v"(row0), "+v"(colb));
#pragma unroll
        for (int ai = 0; ai < 2; ++ai)
#pragma unroll
            for (int m = 0; m < 4; ++m) {
                bf16* pr = PROJ + (size_t)(row0 + ai * 128 + m * 16) * NMAIN;
#pragma unroll
                for (int bj = 0; bj < 2; ++bj) {
                    const int col = colb + bj * 128;
                    const af4 a0 = acc[ai][bj][m][0], a1 = acc[ai][bj][m][1];
                    float gs[8], x[8] = {a0[0], a0[1], a0[2], a0[3], a1[0], a1[1], a1[2], a1[3]};
                    unpack8(*(const v4u*)(pr + C_GS + col), gs);
#pragma unroll
                    for (int i = 0; i < 8; ++i) x[i] *= fmaxf(gs[i], 1e-30f);
                    *(v4u*)(pr + C_MG + col) = pack8(x);
                }
            }
    }
};
struct EpiWout {
    static constexpr bool PERM = true, AFTER_DRAIN = false; static constexpr int MIDK = 0;
    const float* x; bf16* x1;
    DI void operator()(const af4 (&acc)[2][2][4][2], const pg8::Unit& u, int wr, int wc, int fr, int fq) const {
        const int row0 = u.pm * 256 + wr * 64 + fr, colb = u.pn * 256 + wc * 32 + 8 * fq;
#pragma unroll
        for (int ai = 0; ai < 2; ++ai)
#pragma unroll
            for (int m = 0; m < 4; ++m) {
                const size_t ro = (size_t)(row0 + ai * 128 + m * 16) * DM;
#pragma unroll
                for (int bj = 0; bj < 2; ++bj) {
                    const size_t o = ro + colb + bj * 128;
                    const af4 x0 = *(const af4*)(x + o) + acc[ai][bj][m][0], x1v = *(const af4*)(x + o + 4) + acc[ai][bj][m][1];
                    const float y[8] = {x0[0], x0[1], x0[2], x0[3], x1v[0], x1v[1], x1v[2], x1v[3]};
                    *(v4u*)(x1 + o) = pack8(y);
                }
            }
    }
};
struct EpiGu {
    static constexpr bool PERM = true, AFTER_DRAIN = false; static constexpr int MIDK = 0;
    bf16* HID;
    DI void operator()(const af4 (&acc)[2][2][4][2], const pg8::Unit& u, int wr, int wc, int fr, int fq) const {
        const int row0 = u.pm * 256 + wr * 64 + fr, col = u.pn * 128 + wc * 32 + 8 * fq;
#pragma unroll
        for (int ai = 0; ai < 2; ++ai)
#pragma unroll
            for (int m = 0; m < 4; ++m) {
                const af4 g0 = acc[ai][0][m][0], g1 = acc[ai][0][m][1], u0 = acc[ai][1][m][0], u1 = acc[ai][1][m][1];
                float x[8];
#pragma unroll
                for (int i = 0; i < 4; ++i) { x[i] = fsilu(g0[i]) * u0[i]; x[4 + i] = fsilu(g1[i]) * u1[i]; }
                *(v4u*)(HID + (size_t)(row0 + ai * 128 + m * 16) * DEXP + col) = pack8(x);
            }
    }
};
struct EpiDown {
    static constexpr bool PERM = true, AFTER_DRAIN = false; static constexpr int MIDK = 0;
    bf16* YB; const float* wrow;
    DI void operator()(const af4 (&acc)[2][2][4][2], const pg8::Unit& u, int wr, int wc, int fr, int fq) const {
        const int row0 = u.pm * 256 + wr * 64 + fr, colb = u.pn * 256 + wc * 32 + 8 * fq;
#pragma unroll
        for (int ai = 0; ai < 2; ++ai)
#pragma unroll
            for (int m = 0; m < 4; ++m) {
                const int row = row0 + ai * 128 + m * 16; const float w = wrow[row];
#pragma unroll
                for (int bj = 0; bj < 2; ++bj) {
                    const af4 a0 = acc[ai][bj][m][0] * w, a1 = acc[ai][bj][m][1] * w;
                    const float x[8] = {a0[0], a0[1], a0[2], a0[3], a1[0], a1[1], a1[2], a1[3]};
                    *(v4u*)(YB + (size_t)row * DM + colb + bj * 128) = pack8(x);
                }
            }
    }
};
struct EpiPe {
    static constexpr bool PERM = true, AFTER_DRAIN = false; static constexpr int MIDK = 0;
    bf16* PE;
    DI void operator()(const af4 (&acc)[2][2][4][2], const pg8::Unit& u, int wr, int wc, int fr, int fq) const {
        const int row0 = u.pm * 256 + wr * 64 + fr, colb = u.pn * 256 + wc * 32 + 8 * fq;
#pragma unroll
        for (int ai = 0; ai < 2; ++ai)
#pragma unroll
            for (int m = 0; m < 4; ++m)
#pragma unroll
                for (int bj = 0; bj < 2; ++bj) {
                    const af4 a0 = acc[ai][bj][m][0], a1 = acc[ai][bj][m][1];
                    const float x[8] = {a0[0], a0[1], a0[2], a0[3], a1[0], a1[1], a1[2], a1[3]};
                    *(v4u*)(PE + (size_t)(row0 + ai * 128 + m * 16) * DM + colb + bj * 128) = pack8(x);
                }
    }
};
struct EpiPg {
    static constexpr bool PERM = true, AFTER_DRAIN = false; static constexpr int MIDK = 0;
    const bf16* PE; const bf16* x2; float* out;
    DI void operator()(const af4 (&acc)[2][2][4][2], const pg8::Unit& u, int wr, int wc, int fr, int fq) const {
        const int row0 = u.pm * 256 + wr * 64 + fr, colb = u.pn * 256 + wc * 32 + 8 * fq;
#pragma unroll
        for (int ai = 0; ai < 2; ++ai)
#pragma unroll
            for (int m = 0; m < 4; ++m) {
                const size_t ro = (size_t)(row0 + ai * 128 + m * 16) * DM;
#pragma unroll
                for (int bj = 0; bj < 2; ++bj) {
                    const size_t o = ro + colb + bj * 128;
                    float pe[8]; unpack8(*(const v4u*)(PE + o), pe);
                    const af4 a0 = acc[ai][bj][m][0], a1 = acc[ai][bj][m][1];
                    float xr[8]; unpack8(*(const v4u*)(x2 + o), xr);
                    af4 x0 = {xr[0], xr[1], xr[2], xr[3]}, x1 = {xr[4], xr[5], xr[6], xr[7]};
#pragma unroll
                    for (int i = 0; i < 4; ++i) { x0[i] += fsigmoid(a0[i]) * pe[i]; x1[i] += fsigmoid(a1[i]) * pe[4 + i]; }
                    *(af4*)(out + o) = x0; *(af4*)(out + o + 4) = x1;
                }
                asm volatile("" ::: "memory");
            }
    }
};

struct MoeOrder {
    const LAS int* pst; int G, c; size_t estride, tstepB;
    DI bool next(int i, pg8::Unit& u) const {
        const int L = i * G + c, rt = L >> 2; if (rt * 256 >= pst[NEXP]) return false;
        int ex = 0;
#pragma unroll
        for (int e = 1; e < NEXP; ++e) ex += (rt * 256 >= pst[e]) ? 1 : 0;
        u.pm = rt; u.pn = L & 3; u.ex = ex; u.bofs = (size_t)ex * estride + (size_t)u.pn * tstepB; return true;
    }
    DI void a_ready(const pg8::Unit&) const {}
    DI void done(const pg8::Unit&) const {}
};

#define GEMM_PHASE(EPI, ORD, g, S, E) pg8::gemm_phase<EPI, ORD, true, true>(F.lds + RING_OFF, g, S, E)

DI void fast_proj(Frame& F, const Args& a) {
    unsigned char* ws = F.ws; const bf16* HB = (const bf16*)((unsigned char*)F.out + DO_HB); const bf16* WIN = (const bf16*)(ws + WS_WIN);
    { pg8::Gemm g{HB, WIN, DM, DM}; pg8::StaticOrder S; S.init(NTOK, NMAIN, DM, F.G, (int)blockIdx.x);
      EpiProj E{(bf16*)(ws + WS_PROJ), (const f32x2*)(ws + WS_TABA), a.in[4]}; GEMM_PHASE(EpiProj, pg8::StaticOrder, g, S, E); }
    { pg8::Gemm g{WIN + (size_t)NMAIN * DM, HB, DM, DM}; pg8::StaticOrder S; S.init(NTR, NTOK, DM, F.G, (int)blockIdx.x);
      EpiProjT E{(bf16*)(ws + WS_T), (const f32x2*)(ws + WS_TABB)}; GEMM_PHASE(EpiProjT, pg8::StaticOrder, g, S, E); }
}
DI void fast_br(Frame& F, const Args& a) {
    unsigned char* ws = F.ws; bf16* PROJ = (bf16*)(ws + WS_PROJ); const bf16* RS = (const bf16*)((unsigned char*)F.out + DO_RS);
    pg8::StaticOrder S; S.init(NTOK, DM, DM, F.G, (int)blockIdx.x);
    pg8::Gemm g{RS, (const bf16*)(ws + WS_WBR1), DM, DM}; EpiBr E{PROJ}; GEMM_PHASE(EpiBr, pg8::StaticOrder, g, S, E);
}
DI void fast_wout(Frame& F, const Args& a) {
    unsigned char* ws = F.ws;
    pg8::Gemm g{(const bf16*)(ws + WS_PROJ) + C_MG, (const bf16*)(ws + WS_WOUT), NMAIN, DM}; pg8::StaticOrder S; S.init(NTOK, DM, DM, F.G, (int)blockIdx.x);
    EpiWout E{F.x, (bf16*)((unsigned char*)F.out + DO_X1)}; GEMM_PHASE(EpiWout, pg8::StaticOrder, g, S, E);
}
DI void fast_gu(Frame& F, const Args& a) {
    LAS int* pst = (LAS int*)(F.lds + LDSCTL_OFF);
    expert_table(F, pst);
    unsigned char* ws = F.ws;
    pg8::Gemm g{(const bf16*)(ws + WS_XB), (const bf16*)(ws + WS_WGU), DM, DM};
    MoeOrder S{pst, F.G, F.vcu, (size_t)1024 * 1024 * 2, (size_t)256 * DM * 2};
    EpiGu E{(bf16*)(ws + WS_HID)}; GEMM_PHASE(EpiGu, MoeOrder, g, S, E);
}
DI void fast_down(Frame& F, const Args& a) {
    LAS int* pst = (LAS int*)(F.lds + LDSCTL_OFF);
    expert_table(F, pst);
    unsigned char* ws = F.ws;
    pg8::Gemm g{(const bf16*)(ws + WS_HID), (const bf16*)(ws + WS_WD), DEXP, DEXP};
    MoeOrder S{pst, F.G, F.vcu, (size_t)1024 * 512 * 2, (size_t)256 * DEXP * 2};
    EpiDown E{(bf16*)(ws + WS_XB), (const float*)(ws + WS_ROUTE + RT_WROW)}; GEMM_PHASE(EpiDown, MoeOrder, g, S, E);
}
DI void fast_ple(Frame& F, const Args& a) {
    unsigned char* ws = F.ws;
    { int k256 = 256; asm volatile("" : "+s"(k256));
      pg8::Gemm g{(const bf16*)(ws + WS_PB), (const bf16*)(ws + WS_WPLE), 256, k256}; pg8::StaticOrder S; S.init(NTOK, DM, k256, F.G, (int)blockIdx.x);
      EpiPe E{(bf16*)(ws + WS_HID)}; GEMM_PHASE(EpiPe, pg8::StaticOrder, g, S, E); }
    { pg8::Gemm g{(const bf16*)(ws + WS_H2), (const bf16*)(ws + WS_WPG), DM, DM}; pg8::StaticOrder S; S.init(NTOK, DM, DM, F.G, (int)blockIdx.x);
      EpiPg E{(const bf16*)(ws + WS_HID), (const bf16*)(ws + WS_X2), F.out}; GEMM_PHASE(EpiPg, pg8::StaticOrder, g, S, E); }
}

#define MFMA32(a, b, c) __builtin_amdgcn_mfma_f32_32x32x16_bf16((a), (b), (c), 0, 0, 0)
DI int crow(int reg, int h) { return (reg & 3) + 8 * (reg >> 2) + 4 * h; }
DI bf16x8 ld16(const bf16* p) { return *(const bf16x8*)p; }
DI bf16x8 ld8x2(const bf16* p0, const bf16* p1) { const s16x4 lo = *(const s16x4*)p0, hi = *(const s16x4*)p1; return __builtin_shufflevector(lo, hi, 0, 1, 2, 3, 4, 5, 6, 7); }
template <int S> DI bf16x8 pack_step(const f32x16& x) { v4u p; p.x = cvtpk(x[8 * S], x[8 * S + 1]); p.y = cvtpk(x[8 * S + 2], x[8 * S + 3]); p.z = cvtpk(x[8 * S + 4], x[8 * S + 5]); p.w = cvtpk(x[8 * S + 6], x[8 * S + 7]); return __builtin_bit_cast(bf16x8, p); }
DI f32x16 splat16(float v) { f32x16 x;
#pragma unroll
    for (int i = 0; i < 16; ++i) x[i] = v; return x; }

#define SCHED_FENCE() __builtin_amdgcn_sched_barrier(0)
DI void fast_ret_kv(Frame& F, const Args& a) {
    const bf16* __restrict__ T = (const bf16*)(F.ws + WS_T); bf16* __restrict__ ST = (bf16*)((unsigned char*)F.out + DO_ST);
    const int lane = F.lane, r = lane & 31, h2 = lane >> 5, gw = F.vcu * NWAVES + F.wave, NGW = F.G * NWAVES;
    for (int it = gw; it < NBATCH * 4 * 64 * 4; it += NGW) {
        const int eb = it & 3, c = (it >> 2) & 63, hh = (it >> 8) & 3, b = it >> 10;
        const int tok0 = b * SEQ + c * 64;
        const bf16* vrow = T + (size_t)(T_VR + hh * 128 + eb * 32 + r) * NTOK + tok0 + 8 * h2;
        const bf16* krow = T + (size_t)(T_KT + hh * 128 + r) * NTOK + tok0 + 8 * h2;
        bf16x8 vb[4], ka[4][4];
#pragma unroll
        for (int ks = 0; ks < 4; ++ks) vb[ks] = ld16(vrow + 16 * ks);
#pragma unroll
        for (int db = 0; db < 4; ++db)
#pragma unroll
            for (int ks = 0; ks < 4; ++ks) ka[db][ks] = ld16(krow + (size_t)db * 32 * NTOK + 16 * ks);
        SCHED_FENCE();
        bf16* st = ST + ((size_t)((b * 4 + hh) * 64 + c)) * 16384 + (size_t)(eb * 32 + r) * 128 + 4 * h2;
#pragma unroll
        for (int db = 0; db < 4; ++db) {
            f32x16 acc = splat16(0.f);
#pragma unroll
            for (int ks = 0; ks < 4; ++ks) acc = MFMA32(ka[db][ks], vb[ks], acc);
#pragma unroll
            for (int g = 0; g < 4; ++g) { v2u w; w.x = cvtpk(acc[4 * g], acc[4 * g + 1]); w.y = cvtpk(acc[4 * g + 2], acc[4 * g + 3]); *(v2u*)(st + db * 32 + 8 * g) = w; }
        }
    }
}
DI void fast_ret_scan(Frame& F, const Args& a) {
    bf16* ST = (bf16*)((unsigned char*)F.out + DO_ST);
    for (int g = F.vcu * 512 + F.tid; g < NBATCH * 4 * 4096; g += F.G * 512) {
        const int bh = g >> 12, idx = (g & 4095) * 4;
        const float cdec = exp2f(ret_log2g(bh & 3) * 64.0f);
        bf16* p = ST + (size_t)bh * 64 * 16384 + idx;
        float s0 = 0.f, s1 = 0.f, s2 = 0.f, s3 = 0.f;
#pragma unroll 8
        for (int c = 0; c < 64; ++c) {
            const v2u w = *(const v2u*)(p + (size_t)c * 16384);
            v2u o; o.x = cvtpk(s0, s1); o.y = cvtpk(s2, s3); *(v2u*)(p + (size_t)c * 16384) = o;
            s0 = cdec * s0 + bflo(w.x); s1 = cdec * s1 + bfhi(w.x); s2 = cdec * s2 + bflo(w.y); s3 = cdec * s3 + bfhi(w.y);
        }
    }
}
DI void fast_ret_out(Frame& F, const Args& a) {
    const bf16* __restrict__ PROJ = (const bf16*)(F.ws + WS_PROJ); const bf16* __restrict__ T = (const bf16*)(F.ws + WS_T);
    const bf16* __restrict__ ST = (const bf16*)((unsigned char*)F.out + DO_ST); bf16* __restrict__ RS = (bf16*)((unsigned char*)F.out + DO_RS);
    const int lane = F.lane, r = lane & 31, h2 = lane >> 5, gw = F.vcu * NWAVES + F.wave, NGW = F.G * NWAVES;
    for (int it = gw; it < NBATCH * 4 * 64 * 2; it += NGW) {
        const int ib = it & 1, c = (it >> 1) & 63, hh = (it >> 7) & 3, b = it >> 9;
        const int tok0 = b * SEQ + c * 64;
        const float l2g = ret_log2g(hh);
        const bf16* qrow = PROJ + (size_t)(tok0 + ib * 32 + r) * NMAIN + C_RQ + hh * 128 + 8 * h2;
        const bf16* krow = PROJ + (size_t)(tok0 + r) * NMAIN + C_RK + hh * 128 + 8 * h2;
        const bf16* stb = ST + ((size_t)((b * 4 + hh) * 64 + c)) * 16384 + (size_t)r * 128 + 8 * h2;
        const bf16* vrow = T + (size_t)(T_VR + hh * 128 + r) * NTOK + tok0 + 4 * h2;
        const bf16* gp = PROJ + (size_t)(tok0 + ib * 32 + r) * NMAIN + C_RG + hh * 128 + 4 * h2;
        bf16x8 qf[8], kf0[8], kf1[8], sA[8], sB[8], vA[4], vB[4];
#define LD_ST(dst, eb) do { _Pragma("unroll") for (int ks = 0; ks < 8; ++ks) dst[ks] = ld16(stb + (size_t)(eb) * 32 * 128 + 16 * ks); } while (0)
#define LD_VT(dst, eb) do { const bf16* vr_ = vrow + (size_t)(eb) * 32 * NTOK; dst[0] = ld8x2(vr_, vr_ + 8); dst[1] = ld8x2(vr_ + 16, vr_ + 24); dst[2] = ld8x2(vr_ + 32, vr_ + 40); dst[3] = ld8x2(vr_ + 48, vr_ + 56); } while (0)
#define RET_EB(oacc, sfr, vfr) do { f32x16 acc_ = splat16(0.f); \
            _Pragma("unroll") for (int ks = 0; ks < 8; ++ks) acc_ = MFMA32(sfr[ks], qf[ks], acc_);         \
            _Pragma("unroll") for (int reg = 0; reg < 16; ++reg) acc_[reg] *= qd; \
            acc_ = MFMA32(vfr[0], pb[0][0], acc_); acc_ = MFMA32(vfr[1], pb[0][1], acc_); acc_ = MFMA32(vfr[2], pb[1][0], acc_); acc_ = MFMA32(vfr[3], pb[1][1], acc_); oacc = acc_; } while (0)
#pragma unroll
        for (int ks = 0; ks < 8; ++ks) qf[ks] = ld16(qrow + 16 * ks);
#pragma unroll
        for (int ks = 0; ks < 8; ++ks) { kf0[ks] = ld16(krow + 16 * ks); kf1[ks] = ld16(krow + (size_t)32 * NMAIN + 16 * ks); }
        LD_ST(sA, 0); LD_VT(vA, 0);
        SCHED_FENCE();
        f32x16 pt0 = splat16(0.f), pt1 = splat16(0.f);
#pragma unroll
        for (int ks = 0; ks < 8; ++ks) { pt0 = MFMA32(kf0[ks], qf[ks], pt0); pt1 = MFMA32(kf1[ks], qf[ks], pt1); }
        LD_ST(sB, 1); LD_VT(vB, 1);
        SCHED_FENCE();
        bf16x8 pb[2][2];
#pragma unroll
        for (int reg = 0; reg < 16; ++reg) {
            const int d0 = (ib * 32 + r) - crow(reg, h2), d1 = d0 - 32;
            pt0[reg] *= __builtin_amdgcn_exp2f(l2g * (float)(d0 < 0 ? -d0 : d0)); pt1[reg] *= __builtin_amdgcn_exp2f(l2g * (float)(d1 < 0 ? -d1 : d1));
        }
        pb[0][0] = pack_step<0>(pt0); pb[0][1] = pack_step<1>(pt0); pb[1][0] = pack_step<0>(pt1); pb[1][1] = pack_step<1>(pt1);
        const float qd = __builtin_amdgcn_exp2f(l2g * (float)(ib * 32 + r + 1));
        f32x16 o[4];
        RET_EB(o[0], sA, vA);
        LD_ST(sA, 2); LD_VT(vA, 2);
        SCHED_FENCE();
        RET_EB(o[1], sB, vB);
        LD_ST(sB, 3); LD_VT(vB, 3);
        SCHED_FENCE();
        RET_EB(o[2], sA, vA);
        v2u gate[16];
#pragma unroll
        for (int q = 0; q < 16; ++q) gate[q] = *(const v2u*)(gp + (q >> 2) * 32 + 8 * (q & 3));
        SCHED_FENCE();
        RET_EB(o[3], sB, vB);
#undef LD_ST
#undef LD_VT
#undef RET_EB
        float s = 0.f;
#pragma unroll
        for (int eb = 0; eb < 4; ++eb)
#pragma unroll
            for (int reg = 0; reg < 16; ++reg) s += o[eb][reg];
        s += __shfl_xor(s, 32);
        const float mu = s * (1.0f / 128.0f); float v = 0.f;
#pragma unroll
        for (int eb = 0; eb < 4; ++eb)
#pragma unroll
            for (int reg = 0; reg < 16; ++reg) { const float d = o[eb][reg] - mu; v += d * d; }
        v += __shfl_xor(v, 32);
        const float rstd = rsqrtf(v * (1.0f / 128.0f) + EPS);
        bf16* rp = RS + (size_t)(tok0 + ib * 32 + r) * DM + hh * 128 + 4 * h2;
#pragma unroll
        for (int eb = 0; eb < 4; ++eb)
#pragma unroll
            for (int g = 0; g < 4; ++g) {
                const v2u gt = gate[eb * 4 + g];
                v2u w;
                w.x = cvtpk((o[eb][4 * g] - mu) * rstd * bflo(gt.x), (o[eb][4 * g + 1] - mu) * rstd * bfhi(gt.x));
                w.y = cvtpk((o[eb][4 * g + 2] - mu) * rstd * bflo(gt.y), (o[eb][4 * g + 3] - mu) * rstd * bfhi(gt.y));
                *(v2u*)(rp + eb * 32 + 8 * g) = w;
            }
    }
}

DI void fast_att(Frame& F, const Args& a) {
    const bf16* __restrict__ PROJ = (const bf16*)(F.ws + WS_PROJ); const bf16* __restrict__ T = (const bf16*)(F.ws + WS_T); bf16* __restrict__ RS = (bf16*)((unsigned char*)F.out + DO_RS);
    const int lane = F.lane, r = lane & 31, h2 = lane >> 5, gw = F.vcu * NWAVES + F.wave, NGW = F.G * NWAVES;
    bf16x8 tri0, tri1, ones;
#pragma unroll
    for (int j = 0; j < 8; ++j) { const int k0 = 8 * (j >> 2) + 4 * h2 + (j & 3); tri0[j] = (k0 > r) ? (short)0x3F80 : (short)0; tri1[j] = (16 + k0 > r) ? (short)0x3F80 : (short)0; ones[j] = (short)0x3F80; }
    for (int it = gw; it < NBATCH * 8 * 128; it += NGW) {
        const int qb = it & 127, hh = (it >> 7) & 7, b = it >> 10;
        const int q0 = qb * 32, tokq = b * SEQ + q0 + r;
        const bf16* qrow = PROJ + (size_t)tokq * NMAIN + C_SQ + hh * 64 + 8 * h2;
        const bf16* kbase = PROJ + (size_t)(b * SEQ + r) * NMAIN + C_SK + hh * 64 + 8 * h2;
        const bf16* vbase = T + (size_t)(T_VS + hh * 64 + r) * NTOK + b * SEQ + 4 * h2;
        const int ktd = q0 >> 6;
        bf16x8 qf[4], kA[8], vB[8];
#pragma unroll
        for (int ks = 0; ks < 4; ++ks) qf[ks] = ld16(qrow + 16 * ks);
#pragma unroll
        for (int ks = 0; ks < 4; ++ks) { kA[ks] = ld16(kbase + (size_t)(ktd * 64) * NMAIN + 16 * ks); kA[4 + ks] = ld16(kbase + (size_t)(ktd * 64 + 32) * NMAIN + 16 * ks); }
        f32x16 o0 = splat16(0.f), o1 = splat16(0.f);
        float carry = 0.f;
        for (int kt = ktd; kt >= 0; --kt) {
            const int key0 = kt * 64;
            const bool diag = (kt == ktd);
            {
                const bf16* v0row = vbase + key0; const bf16* v1row = v0row + (size_t)32 * NTOK;
#pragma unroll
                for (int q = 0; q < 4; ++q) { vB[q] = ld8x2(v0row + 16 * q, v0row + 16 * q + 8); vB[4 + q] = ld8x2(v1row + 16 * q, v1row + 16 * q + 8); }
            }
            SCHED_FENCE();
            f32x16 p0 = splat16(0.f), p1 = splat16(0.f);
#pragma unroll
            for (int ks = 0; ks < 4; ++ks) { p0 = MFMA32(kA[ks], qf[ks], p0); p1 = MFMA32(kA[4 + ks], qf[ks], p1); }
            {
                const int kn = (kt > 0 ? kt - 1 : 0) * 64;
#pragma unroll
                for (int ks = 0; ks < 4; ++ks) { kA[ks] = ld16(kbase + (size_t)kn * NMAIN + 16 * ks); kA[4 + ks] = ld16(kbase + (size_t)(kn + 32) * NMAIN + 16 * ks); }
            }
            SCHED_FENCE();
            f32x16 l0, l1;
#pragma unroll
            for (int reg = 0; reg < 16; ++reg) {
                const float z0 = fminf(p0[reg], 100.0f), z1 = fminf(p1[reg], 100.0f);
                float a0 = -__builtin_amdgcn_logf(1.0f + __builtin_amdgcn_exp2f(z0)), a1 = -__builtin_amdgcn_logf(1.0f + __builtin_amdgcn_exp2f(z1));
                float b0 = z0 + a0, b1 = z1 + a1;
                if (diag) {
                    const bool v0 = (key0 + crow(reg, h2)) < (q0 + r), v1 = (key0 + 32 + crow(reg, h2)) < (q0 + r);
                    a0 = v0 ? a0 : 0.f; b0 = v0 ? b0 : -1.0e30f; a1 = v1 ? a1 : 0.f; b1 = v1 ? b1 : -1.0e30f;
                }
                l0[reg] = a0; l1[reg] = a1; p0[reg] = b0; p1[reg] = b1;
            }
            f32x16 y0 = splat16(carry), y1 = y0;
            {
                const bf16x8 x00 = pack_step<0>(l0), x01 = pack_step<1>(l0), x10 = pack_step<0>(l1), x11 = pack_step<1>(l1);
                y0 = MFMA32(tri0, x00, y0); y0 = MFMA32(tri1, x01, y0); y0 = MFMA32(ones, x10, y0); y0 = MFMA32(ones, x11, y0);
                y1 = MFMA32(tri0, x10, y1); y1 = MFMA32(tri1, x11, y1);
            }
            const float tot = y0[0] + l0[0];
            carry = __shfl(tot, r);
#pragma unroll
            for (int reg = 0; reg < 16; ++reg) { p0[reg] = __builtin_amdgcn_exp2f(p0[reg] + y0[reg]); p1[reg] = __builtin_amdgcn_exp2f(p1[reg] + y1[reg]); }
            {
                const bf16x8 a00 = pack_step<0>(p0), a01 = pack_step<1>(p0), a10 = pack_step<0>(p1), a11 = pack_step<1>(p1);
                o0 = MFMA32(vB[0], a00, o0); o0 = MFMA32(vB[1], a01, o0); o0 = MFMA32(vB[2], a10, o0); o0 = MFMA32(vB[3], a11, o0);
                o1 = MFMA32(vB[4], a00, o1); o1 = MFMA32(vB[5], a01, o1); o1 = MFMA32(vB[6], a10, o1); o1 = MFMA32(vB[7], a11, o1);
            }
            if (__all(carry < SB_EXIT)) break;
        }
        bf16* op = RS + (size_t)tokq * DM + 512 + hh * 64 + 4 * h2;
#pragma unroll
        for (int g = 0; g < 4; ++g) {
            v2u w; w.x = cvtpk(o0[4 * g], o0[4 * g + 1]); w.y = cvtpk(o0[4 * g + 2], o0[4 * g + 3]); *(v2u*)(op + 8 * g) = w;
            v2u u; u.x = cvtpk(o1[4 * g], o1[4 * g + 1]); u.y = cvtpk(o1[4 * g + 2], o1[4 * g + 3]); *(v2u*)(op + 32 + 8 * g) = u;
        }
    }
}

__global__ void __launch_bounds__(NWAVES * 64, 2) mega(Args args) {
    extern __shared__ __attribute__((aligned(16))) unsigned char lds[];
    Frame F;
    F.lds = (LAS unsigned char*)lds;
    F.MISC = (volatile LAS unsigned*)(F.lds + MISC_OFF);
    F.refresh();
    F.G = gridDim.x; { const int bx = blockIdx.x; F.vcu = (F.G % 8 == 0) ? (bx % 8) * (F.G / 8) + bx / 8 : bx; }
    F.ws = args.ws; F.out = args.out; F.x = args.in[0]; F.p = args.in[1];
    F.ctl = (gu32*)(args.ws + WS_CTL);
    for (int u = F.tid; u < (LDS_BYTES - LDSCTL_OFF) / 4; u += NWAVES * 64) ((LAS unsigned*)(F.lds + LDSCTL_OFF))[u] = 0u;
    __syncthreads();
    const int lo = args.ph_lo, hi = args.ph_hi;
    XcdBarrier bar; bar.bar = (unsigned*)(F.ctl + CW_BAR) + args.li * BAR_STRIDE; bar.x = 0; bar.st = nullptr;
    if (hi - lo > 1) bar = xcd_barrier_post((unsigned*)(F.ctl + CW_BAR) + args.li * BAR_STRIDE, F.MISC + 8);
#define IN(k) (F.refresh(), lo <= (k) && (k) < hi)
#define DUP(k) ((DUP_MASK >> (k)) & 1)
#define SEAM(k) do { if (IN(k) && IN((k) + 1)) xcd_barrier(bar); } while (0)
#define REP(k, body) do { body; if (DUP(k)) { F.refresh(); body; } } while (0)

    if (IN(PH_PRO)) { REP(PH_PRO, ph_prologue(F, args)); } SEAM(PH_PRO);
    if (IN(PH_PROJ)) { REP(PH_PROJ, fast_proj(F, args)); } SEAM(PH_PROJ);
    if (IN(PH_MIX1)) { REP(14, fast_ret_kv(F, args)); REP(15, fast_att(F, args)); } SEAM(PH_MIX1);
    if (IN(PH_SCAN)) { fast_ret_scan(F, args); } SEAM(PH_SCAN);
    if (IN(PH_RETO)) { REP(PH_RETO, fast_ret_out(F, args)); } SEAM(PH_RETO);
    if (IN(PH_BR)) { REP(PH_BR, fast_br(F, args)); } SEAM(PH_BR);
    if (IN(PH_WOUT)) { REP(PH_WOUT, fast_wout(F, args)); } SEAM(PH_WOUT);
    if (IN(PH_ROUTE)) { ph_route(F, args); } SEAM(PH_ROUTE);
    if (IN(PH_GATHER)) { REP(PH_GATHER, ph_gather(F, args)); } SEAM(PH_GATHER);
    if (IN(PH_GU)) { REP(PH_GU, fast_gu(F, args)); } SEAM(PH_GU);
    if (IN(PH_DOWN)) { REP(PH_DOWN, fast_down(F, args)); } SEAM(PH_DOWN);
    if (IN(PH_COMB)) { REP(PH_COMB, ph_combine(F, args)); } SEAM(PH_COMB);
    if (IN(PH_PLE)) { REP(PH_PLE, fast_ple(F, args)); } SEAM(PH_PLE);
    if (IN(PH_FINAL)) { ph_final(F, args); }
#undef IN
#undef SEAM
}

extern "C" void kernel_launch(void* const* d_in, const int* in_sizes, int n_in, void* d_out, int out_size, void* d_ws, size_t ws_size, hipStream_t stream) {
    static int grid = 0;
    if (grid == 0) {
        if (n_in != 20 || in_sizes[0] != NTOK * DM || out_size != NTOK * DM || ws_size < WS_END) { fprintf(stderr, "kernel_launch: unexpected shapes (n_in %d, in0 %d, out %d, ws %zu)\n", n_in, n_in > 0 ? in_sizes[0] : -1, out_size, ws_size); grid = -1; return; }
        int dev = 0, cus = 0, per_cu = 0;
        if (hipGetDevice(&dev) != hipSuccess || hipDeviceGetAttribute(&cus, hipDeviceAttributeMultiprocessorCount, dev) != hipSuccess) { grid = -1; return; }
        if (hipFuncSetAttribute((const void*)mega, hipFuncAttributeMaxDynamicSharedMemorySize, LDS_BYTES) != hipSuccess) { fprintf(stderr, "kernel_launch: hipFuncSetAttribute failed\n"); grid = -1; return; }
        if (hipOccupancyMaxActiveBlocksPerMultiprocessor(&per_cu, (const void*)mega, NWAVES * 64, LDS_BYTES) != hipSuccess || per_cu < 1) fprintf(stderr, "kernel_launch: occupancy query reports %d\n", per_cu);
        (void)hipGetLastError();
        grid = cus;
    }
    if (grid < 0) return;
    unsigned char* ws = (unsigned char*)d_ws;
    if (hipMemsetAsync(ws + WS_CTL, 0, CTL_ZERO_BYTES, stream) != hipSuccess) return;
    Args a{};
    for (int i = 0; i < 20; ++i) a.in[i] = (const float*)d_in[i];
    a.out = (float*)d_out; a.ws = ws;
#if SPLIT_PHASES
    for (int p = 0; p < NPH; ++p) { a.ph_lo = p; a.ph_hi = p + 1; a.li = 0; hipLaunchKernelGGL(mega, dim3(grid), dim3(NWAVES * 64), LDS_BYTES, stream, a); }
#else
    a.ph_lo = 0; a.ph_hi = NPH; a.li = 0;
    hipLaunchKernelGGL(mega, dim3(grid), dim3(NWAVES * 64), LDS_BYTES, stream, a);
#endif
}
```

```cpp
#define DUP_MASK 0
#include <hip/hip_runtime.h>
#include <cstdio>
#include <cstdint>

#ifndef SPLIT_PHASES
#define SPLIT_PHASES 0
#endif
#ifndef DUP_MASK
#define DUP_MASK 0
#endif

constexpr int NTOK = 32768, DM = 1024, SEQ = 4096, NBATCH = 8;
constexpr int NMAIN = 4608, NTR = 1536, NWIN = 5632;
constexpr int C_RQ = 0, C_RK = 512, C_RG = 1024, C_SQ = 1536, C_SK = 2048, C_GR = 2560, C_GS = 3584;
constexpr int C_MG = 0;
constexpr int T_KT = 0, T_VR = 512, T_VS = 1024;
constexpr int NEXP = 16, DEXP = 512, MPAD_MAX = 65536 + 16 * 256, NRT_MAX = MPAD_MAX / 256;
constexpr float EPS = 1e-6f;
constexpr float LOG2E = 1.4426950408889634f;
constexpr float SB_QSCALE = 0.125f * LOG2E;
constexpr float SB_EXIT = -152.0f;

constexpr size_t MiB = 1u << 20;
constexpr size_t WS_CTL = 0, CTL_ZERO_BYTES = 1 * MiB;
constexpr size_t WS_WIN = 2 * MiB;
constexpr size_t WS_WBR1 = 14 * MiB;
constexpr size_t WS_WBR2 = 15 * MiB;
constexpr size_t WS_WOUT = 16 * MiB;
constexpr size_t WS_WGU = 18 * MiB;
constexpr size_t WS_WD = 50 * MiB;
constexpr size_t WS_WPLE = 66 * MiB;
constexpr size_t WS_WPG = 67 * MiB;
constexpr size_t WS_TABA = 70 * MiB;
constexpr size_t WS_TABB = 72 * MiB;
constexpr size_t WS_ROUTE = 74 * MiB;
constexpr size_t WS_PB = 76 * MiB;
constexpr size_t WS_PROJ = 92 * MiB;
constexpr size_t WS_T = 380 * MiB;
constexpr size_t WS_X2 = 360 * MiB;
constexpr size_t WS_END = 488 * MiB;
constexpr size_t WS_H2 = 92 * MiB;
constexpr size_t WS_XB = 156 * MiB;
constexpr size_t WS_HID = 292 * MiB;
constexpr size_t DO_HB = 0, DO_ST = 0, DO_X1 = 0, DO_RS = 64 * MiB;
constexpr size_t RT_EID = 0, RT_WGT = 256 * 1024, RT_RANK = 512 * 1024, RT_POS = 768 * 1024, RT_WROW = 1024 * 1024, RT_TILE = 1536 * 1024;
constexpr int CW_TMO = 0, CW_CODE = 1;
constexpr int CW_CNT = 64;
constexpr int CW_BAR = 4096, BAR_STRIDE = 4096;

#define GAS __attribute__((address_space(1)))
#define LAS __attribute__((address_space(3)))
typedef unsigned short bf16;
typedef unsigned v4u __attribute__((ext_vector_type(4)));
typedef unsigned v2u __attribute__((ext_vector_type(2)));
typedef float f32x4 __attribute__((ext_vector_type(4)));
typedef float f32x2 __attribute__((ext_vector_type(2)));
typedef float f32x16 __attribute__((ext_vector_type(16)));
typedef short bf16x8 __attribute__((ext_vector_type(8)));
typedef short s16x4 __attribute__((ext_vector_type(4)));
typedef GAS unsigned gu32;
#define RLX_AGENT __ATOMIC_RELAXED, __HIP_MEMORY_SCOPE_AGENT
#define LDS_WAIT() asm volatile("s_waitcnt lgkmcnt(0)" ::: "memory")
#define VM_WAIT() asm volatile("s_waitcnt vmcnt(0)" ::: "memory")
#define DI __device__ __forceinline__
DI unsigned f2bf(float f) { unsigned u = __builtin_bit_cast(unsigned, f); return (u + 0x7fffu + ((u >> 16) & 1u)) >> 16; }
DI unsigned pk2(float lo, float hi) { return f2bf(lo) | (f2bf(hi) << 16); }
DI float bf2f(unsigned b) { return __builtin_bit_cast(float, b << 16); }
DI float bflo(unsigned w) { return __builtin_bit_cast(float, w << 16); }
DI float bfhi(unsigned w) { return __builtin_bit_cast(float, w & 0xffff0000u); }
DI float fsigmoid(float x) { return 1.0f / (1.0f + __expf(-x)); }
DI float fsilu(float x) { return x / (1.0f + __expf(-x)); }
DI float wave_sum(float v) {
#pragma unroll
    for (int o = 1; o < 64; o <<= 1) v += __shfl_xor(v, o);
    return v;
}
template <int CTRL, int ROWMASK> DI float dpp_add(float v) { return v + __builtin_bit_cast(float, __builtin_amdgcn_update_dpp(0, __builtin_bit_cast(int, v), CTRL, ROWMASK, 0xF, false)); }
DI float wave_sum_dpp(float v) {
    v = dpp_add<0xB1, 0xF>(v);
    v = dpp_add<0x4E, 0xF>(v);
    v = dpp_add<0x141, 0xF>(v);
    v = dpp_add<0x140, 0xF>(v);
    v = dpp_add<0x142, 0xA>(v);
    v = dpp_add<0x143, 0xC>(v);
    return __builtin_bit_cast(float, __builtin_amdgcn_readlane(__builtin_bit_cast(int, v), 63));
}
DI float ret_log2g(int h) { return log2f(1.0f - exp2f(-5.0f - (float)h)); }

__host__ __device__ __forceinline__ int in_src(int r) {
    if (r < 1024) { const int base = (r < 512) ? 0 : 512; const int i = r & 511, h = i >> 7, j = i & 127; return base + h * 128 + (j & 1) * 64 + (j >> 1); }
    if (r < 1536) return 1536 + (r - 1024);
    if (r < 2048) return 2048 + (r - 1536);
    if (r < 2560) return 2560 + (r - 2048);
    if (r < 3584) return 3584 + (r - 2560);
    if (r < 4608) return 4608 + (r - 3584);
    if (r < 5120) { const int i = r - 4608, h = i >> 7, j = i & 127; return 512 + h * 128 + (j & 1) * 64 + (j >> 1); }
    if (r < 5632) return 1024 + (r - 5120);
    return 3072 + (r - 5632);
}


namespace pg8 {
#define PG8_LAS __attribute__((address_space(3)))
typedef unsigned short bf16_t;
typedef short bf16x8 __attribute__((ext_vector_type(8)));
typedef float f32x4 __attribute__((ext_vector_type(4)));
typedef unsigned u32x4 __attribute__((ext_vector_type(4)));
constexpr int BM = 256, BK = 64, HALF = 128, HTB = HALF * BK * 2  , STAGE_BYTES = 8 * HTB, NXCD = 8, WGM = 8;

__host__ __device__ __forceinline__ int lds_byte(int r, int c) { const int st = (r >> 4) * 2 + (c >> 5), rr = r & 15, cc = c & 31, ob = rr * 64 + cc * 2; return st * 1024 + (ob ^ (((ob >> 9) & 1) << 5)); }
__host__ __device__ __forceinline__ void stage_rc(int b, int& R, int& C) { const int st = b / 1024, sb = b % 1024, swz = sb ^ (((sb >> 9) & 1) << 5); R = (st >> 1) * 16 + swz / 64; C = (st & 1) * 32 + (swz % 64) / 2; }
__host__ __device__ __forceinline__ int perm32(int rho) { const int n = rho >> 4, i = rho & 15; return 8 * (i >> 2) + 4 * n + (i & 3); }

struct Unit { int pm, pn; size_t bofs; int ex; };
struct Gemm { const bf16_t* A; const bf16_t* Bt; int lda, K; };

struct StaticOrder {
    int nM, nN, nwg, G, c; size_t tstepB;
    __device__ void init(int M, int N, int K, int G_, int c_) { nM = M / BM; nN = N / BM; nwg = nM * nN; G = G_; c = c_; tstepB = (size_t)BM * K * 2; }
    __device__ bool next(int i, Unit& u) const {
        const long L = (long)i * G + c; if (L >= nwg) return false;
        int wgid = (int)L; { const int q = nwg / NXCD, r = nwg % NXCD, xcd = wgid % NXCD, off = wgid / NXCD; wgid = (xcd < r ? xcd * (q + 1) : r * (q + 1) + (xcd - r) * q) + off; }
        const int nig = WGM * nN, gid = wgid / nig, fm = gid * WGM, gsz = (nM - fm) < WGM ? (nM - fm) : WGM;
        u.pm = fm + ((wgid % nig) % gsz); u.pn = (wgid % nig) / gsz; u.bofs = (size_t)u.pn * tstepB; u.ex = 0; return true;
    }
    __device__ __forceinline__ void a_ready(const Unit&) const {}
    __device__ __forceinline__ void done(const Unit&) const {}
};
__device__ __forceinline__ unsigned cvt_pk_bf16(float lo, float hi) { unsigned r; asm volatile("v_cvt_pk_bf16_f32 %0, %1, %2" : "=v"(r) : "v"(lo), "v"(hi)); return r; }
template <class Epi, class Sched, bool ALIGN_EPI = false, bool SP2 = false>
__device__ __forceinline__ void gemm_phase(PG8_LAS unsigned char* lds, const Gemm g, const Sched& S, const Epi& E) {
    int tid_ = threadIdx.x; asm volatile("" : "+v"(tid_));
    const int tid = tid_, wid = __builtin_amdgcn_readfirstlane(tid >> 6), lane = tid & 63, wr = wid >> 2, wc = wid & 3, fr = lane & 15, fq = lane >> 4;
    const int K = g.K, nt = K / BK;
    unsigned voffA[2], voffB[2];
#pragma unroll
    for (int i = 0; i < 2; ++i) { int R, C; stage_rc(tid * 16 + i * 8192, R, C); const int Rb = Epi::PERM ? ((R & ~31) + perm32(R & 31)) : R;
        voffA[i] = (unsigned)(R * g.lda + C) * 2u; voffB[i] = (unsigned)(Rb * K + C) * 2u; }
    const size_t kstep = (size_t)(BK * 2);
    const size_t hstepA = (size_t)HALF * g.lda * 2, hstepB = (size_t)HALF * K * 2;
    const size_t tstepA = 2 * hstepA;
    const unsigned ldsw = (unsigned)wid * 1024u;
    const int aoff = lds_byte(wr * 64 + fr, fq * 8), boff = lds_byte(wc * 32 + fr, fq * 8);
#define PG8_SA(b, h) (((b) * 2 + (h)) * HTB)
#define PG8_SB(b, h) ((4 + (b) * 2 + (h)) * HTB)
#define PG8_STAGE(bufoff, gbase, voff) do { _Pragma("unroll") for (int _i = 0; _i < 2; ++_i) \
        __builtin_amdgcn_global_load_lds((const unsigned*)((const char*)(gbase) + (voff)[_i]), (PG8_LAS unsigned*)(lds + (bufoff) + ldsw + _i * 8192), 16, 0, 0); } while (0)
#define PG8_LDA(dst, b, h) do { _Pragma("unroll") for (int m = 0; m < 4; ++m) _Pragma("unroll") for (int k = 0; k < 2; ++k) dst[m][k] = *(const PG8_LAS bf16x8*)(lds + PG8_SA(b, h) + aoff + m * 2048 + k * 1024); } while (0)
#define PG8_LDB(dst, b, h) do { _Pragma("unroll") for (int n = 0; n < 2; ++n) _Pragma("unroll") for (int k = 0; k < 2; ++k) dst[n][k] = *(const PG8_LAS bf16x8*)(lds + PG8_SB(b, h) + boff + n * 2048 + k * 1024); } while (0)
#define PG8_MMA(ai, bj, At, Bt) do { __builtin_amdgcn_s_setprio(1); _Pragma("unroll") for (int m = 0; m < 4; ++m) _Pragma("unroll") for (int n = 0; n < 2; ++n) _Pragma("unroll") for (int k = 0; k < 2; ++k) \
        acc[ai][bj][m][n] = __builtin_amdgcn_mfma_f32_16x16x32_bf16(Bt[n][k], At[m][k], acc[ai][bj][m][n], 0, 0, 0); __builtin_amdgcn_s_setprio(0); } while (0)
#define PG8_WAIT_V(n) asm volatile("s_waitcnt vmcnt(" #n ")" ::: "memory")
#define PG8_WAIT_L(n) asm volatile("s_waitcnt lgkmcnt(" #n ")" ::: "memory")
#define PG8_BAR __builtin_amdgcn_s_barrier()
#define PG8_SCHED __builtin_amdgcn_sched_barrier(0)
    Unit cur, nxt; int ui = 0;
    if (!S.next(0, cur)) return;
    f32x4 acc[2][2][4][2];
#pragma unroll
    for (int a = 0; a < 2; ++a)
#pragma unroll
        for (int b = 0; b < 2; ++b)
#pragma unroll
            for (int m = 0; m < 4; ++m)
#pragma unroll
                for (int n = 0; n < 2; ++n) acc[a][b][m][n] = (f32x4){0.f, 0.f, 0.f, 0.f};
    bf16x8 At[4][2], B0[2][2], B1[2][2];
    const char* cA = (const char*)g.A + (size_t)cur.pm * tstepA; const char* cB = (const char*)g.Bt + cur.bofs;
    S.a_ready(cur);
    if constexpr (SP2) {
        PG8_STAGE(PG8_SB(0, 0), cB, voffB); PG8_STAGE(PG8_SB(0, 1), cB + hstepB, voffB); PG8_STAGE(PG8_SA(0, 0), cA, voffA); PG8_STAGE(PG8_SA(0, 1), cA + hstepA, voffA);
        if (wr == 1) PG8_BAR;
        PG8_WAIT_V(2); PG8_BAR;
        PG8_STAGE(PG8_SB(1, 0), cB + kstep, voffB); PG8_STAGE(PG8_SA(1, 0), cA + kstep, voffA); PG8_STAGE(PG8_SB(1, 1), cB + hstepB + kstep, voffB);
        PG8_WAIT_V(6); PG8_BAR;
    } else {
        PG8_STAGE(PG8_SB(0, 0), cB, voffB); PG8_STAGE(PG8_SA(0, 0), cA, voffA); PG8_STAGE(PG8_SB(0, 1), cB + hstepB, voffB); PG8_STAGE(PG8_SA(0, 1), cA + hstepA, voffA);
        if (wr == 1) PG8_BAR;
        PG8_WAIT_V(4); PG8_BAR;
        PG8_STAGE(PG8_SB(1, 0), cB + kstep, voffB); PG8_STAGE(PG8_SA(1, 0), cA + kstep, voffA); PG8_STAGE(PG8_SB(1, 1), cB + hstepB + kstep, voffB);
        PG8_WAIT_V(6); PG8_BAR;
    }
    for (;;) {
        const bool has_next = S.next(ui + 1, nxt);
        const char* nA = has_next ? (const char*)g.A + (size_t)nxt.pm * tstepA : cA; const char* nB = has_next ? (const char*)g.Bt + nxt.bofs : cB;
        for (int th = 0; th < (Epi::MIDK > 0 ? 2 : 1); ++th) {
        if constexpr (Epi::MIDK > 0) { if (th == 1) E.mid(acc, cur, wr, wc, fr, fq); }
        const int t_lo = (Epi::MIDK > 0 && th == 1) ? Epi::MIDK : 0, t_hi = (Epi::MIDK > 0 && th == 0) ? Epi::MIDK : nt;
        for (int t = t_lo; t < t_hi; t += 2) {
            const bool last = (t == nt - 2);
            const char* a1 = cA + (size_t)(t + 1) * kstep;
            const char* a2 = last ? nA : cA + (size_t)(t + 2) * kstep; const char* b2 = last ? nB : cB + (size_t)(t + 2) * kstep;
            const char* a3 = a2 + kstep; const char* b3 = b2 + kstep;
            if (last && has_next) S.a_ready(nxt);
            if constexpr (SP2) {
            PG8_LDB(B0, 0, 0); PG8_LDB(B1, 0, 1); PG8_SCHED; PG8_LDA(At, 0, 0); PG8_STAGE(PG8_SA(1, 1), a1 + hstepA, voffA);
            PG8_WAIT_V(8); PG8_WAIT_L(0); PG8_BAR; PG8_MMA(0, 0, At, B0); PG8_MMA(0, 1, At, B1); PG8_BAR; PG8_SCHED;
            PG8_LDA(At, 0, 1); PG8_STAGE(PG8_SB(0, 0), b2, voffB); PG8_STAGE(PG8_SB(0, 1), b2 + hstepB, voffB); PG8_STAGE(PG8_SA(0, 0), a2, voffA);
            PG8_WAIT_V(8); PG8_WAIT_L(0); PG8_BAR; PG8_MMA(1, 0, At, B0); PG8_MMA(1, 1, At, B1); PG8_BAR; PG8_SCHED;
            PG8_LDB(B0, 1, 0); PG8_LDB(B1, 1, 1); PG8_SCHED; PG8_LDA(At, 1, 0); PG8_STAGE(PG8_SA(0, 1), a2 + hstepA, voffA);
            PG8_WAIT_V(8); PG8_WAIT_L(0); PG8_BAR; PG8_MMA(0, 0, At, B0); PG8_MMA(0, 1, At, B1); PG8_BAR; PG8_SCHED;
            PG8_LDA(At, 1, 1); PG8_STAGE(PG8_SB(1, 0), b3, voffB); PG8_STAGE(PG8_SB(1, 1), b3 + hstepB, voffB); PG8_STAGE(PG8_SA(1, 0), a3, voffA);
            PG8_WAIT_V(8); PG8_WAIT_L(0); PG8_BAR; PG8_MMA(1, 0, At, B0); PG8_MMA(1, 1, At, B1); PG8_BAR; PG8_SCHED;
            } else {
            PG8_LDB(B0, 0, 0); PG8_SCHED; PG8_LDA(At, 0, 0); PG8_STAGE(PG8_SA(1, 1), a1 + hstepA, voffA);
            PG8_WAIT_L(8); PG8_BAR; PG8_WAIT_L(0); PG8_MMA(0, 0, At, B0); PG8_BAR; PG8_SCHED;
            PG8_LDB(B1, 0, 1); PG8_STAGE(PG8_SB(0, 0), b2, voffB);
            PG8_BAR; PG8_WAIT_L(0); PG8_MMA(0, 1, At, B1); PG8_BAR;
            PG8_LDA(At, 0, 1); PG8_STAGE(PG8_SA(0, 0), a2, voffA);
            PG8_BAR; PG8_WAIT_L(0); PG8_MMA(1, 0, At, B0); PG8_BAR; PG8_SCHED;
            PG8_STAGE(PG8_SB(0, 1), b2 + hstepB, voffB);
            PG8_WAIT_V(6); PG8_BAR; PG8_MMA(1, 1, At, B1); PG8_BAR;
            PG8_LDB(B0, 1, 0); PG8_SCHED; PG8_LDA(At, 1, 0); PG8_STAGE(PG8_SA(0, 1), a2 + hstepA, voffA);
            PG8_WAIT_L(8); PG8_BAR; PG8_WAIT_L(0); PG8_MMA(0, 0, At, B0); PG8_BAR; PG8_SCHED;
            PG8_LDB(B1, 1, 1); PG8_STAGE(PG8_SB(1, 0), b3, voffB);
            PG8_BAR; PG8_WAIT_L(0); PG8_MMA(0, 1, At, B1); PG8_BAR;
            PG8_LDA(At, 1, 1); PG8_STAGE(PG8_SA(1, 0), a3, voffA);
            PG8_BAR; PG8_WAIT_L(0); PG8_MMA(1, 0, At, B0); PG8_BAR; PG8_SCHED;
            PG8_STAGE(PG8_SB(1, 1), b3 + hstepB, voffB);
            PG8_WAIT_V(6); PG8_BAR; PG8_MMA(1, 1, At, B1); PG8_BAR;
            }
        }
        }
        if constexpr (ALIGN_EPI) { if (wr == 0) PG8_BAR; }
        if constexpr (!Epi::AFTER_DRAIN) { E(acc, cur, wr, wc, fr, fq); S.done(cur); }
        if (!has_next) break;
#pragma unroll
        for (int a = 0; a < 2; ++a)
#pragma unroll
            for (int b = 0; b < 2; ++b)
#pragma unroll
                for (int m = 0; m < 4; ++m)
#pragma unroll
                    for (int n = 0; n < 2; ++n) acc[a][b][m][n] = (f32x4){0.f, 0.f, 0.f, 0.f};
        cur = nxt; cA = nA; cB = nB; ++ui;
        if constexpr (ALIGN_EPI) { if (wr == 1) PG8_BAR; }
    }
    PG8_WAIT_V(0);
    if constexpr (!ALIGN_EPI) { if (wr == 0) PG8_BAR; }
    PG8_BAR;
    if constexpr (Epi::AFTER_DRAIN) { E.fused(acc, cur, wr, wc, fr, fq, lds, wid, lane); S.done(cur); }
#undef PG8_SA
#undef PG8_SB
#undef PG8_STAGE
#undef PG8_LDA
#undef PG8_LDB
#undef PG8_MMA
#undef PG8_WAIT_V
#undef PG8_WAIT_L
#undef PG8_BAR
#undef PG8_SCHED
}
}
#define XB_TMO      128
#define XB_XCNT(j)  (256  + 64 * (j))
#define XB_XSUB(j)  (1280 + 64 * (j))
#define XB_XGEN(j)  (2304 + 64 * (j))
#define XB_TOP      3328
#define XB_TOPGEN   3392
#define XCD_BAR_WORDS 3456
#define XB_SPIN_CAP (1u << 18)

__device__ __forceinline__ unsigned xb_ld(unsigned* p)              { return __hip_atomic_load(p, __ATOMIC_RELAXED, __HIP_MEMORY_SCOPE_AGENT); }
__device__ __forceinline__ unsigned xb_add(unsigned* p, unsigned v) { return __hip_atomic_fetch_add(p, v, __ATOMIC_RELAXED, __HIP_MEMORY_SCOPE_AGENT); }
__device__ __forceinline__ unsigned xb_xcc_id() { return (unsigned)__builtin_amdgcn_s_getreg((3 << 11) | 20) & 0xFu; }
#define XB_SPIN(cond, bar) do { unsigned _sp = 0; while (cond) { __builtin_amdgcn_s_sleep(1); \
    if ((++_sp & 255u) == 0u) { if (xb_ld(&(bar)[XB_TMO])) break; if (_sp > XB_SPIN_CAP) { atomicAdd(&(bar)[XB_TMO], 1u); break; } } } } while (0)

struct XcdBarrier {
    unsigned* bar; unsigned x;
    volatile LAS unsigned* st;
};

__device__ __forceinline__ XcdBarrier xcd_barrier_post(unsigned* bar, volatile LAS unsigned* st) {
    XcdBarrier b; b.bar = bar; b.x = xb_xcc_id(); b.st = st;
    if (threadIdx.x == 0) (void)xb_add(&bar[XB_XCNT(b.x)], 1u);
    return b;
}
__device__ __forceinline__ void xcd_barrier_complete(unsigned* bar, unsigned x, unsigned& nloc, unsigned& nx) {
    const unsigned G = gridDim.x * gridDim.y * gridDim.z;
    unsigned sum, cnt, mine, sp = 0u;
    for (;;) {
        sum = 0u; cnt = 0u; mine = 0u;
#pragma unroll
        for (unsigned j = 0; j < 16; ++j) { const unsigned c = xb_ld(&bar[XB_XCNT(j)]); sum += c; cnt += (c > 0u) ? 1u : 0u; mine = (j == x) ? c : mine; }
        if (sum == G) break;
        __builtin_amdgcn_s_sleep(1);
        if ((++sp & 255u) == 0u) { if (xb_ld(&bar[XB_TMO])) break; if (sp > XB_SPIN_CAP) { atomicAdd(&bar[XB_TMO], 1u); break; } }
    }
    nloc = mine > 0u ? mine : 1u; nx = cnt > 0u ? cnt : 1u;
}

__device__ __forceinline__ void xcd_barrier(const XcdBarrier& b) {
    asm volatile("s_waitcnt vmcnt(0)" ::: "memory");
    __syncthreads();
    if (threadIdx.x == 0) {
        unsigned* bar = b.bar;
        __builtin_amdgcn_s_waitcnt(0);
        unsigned nloc = b.st[0], nx = b.st[1];
        if (nloc == 0u) { xcd_barrier_complete(bar, b.x, nloc, nx); b.st[0] = nloc; b.st[1] = nx; }
        const unsigned old = xb_add(&bar[XB_XSUB(b.x)], 1u);
        const unsigned gen = old / nloc;
        if (old + 1u == (gen + 1u) * nloc) {
            __builtin_amdgcn_fence(__ATOMIC_RELEASE, "agent");
            asm volatile("s_waitcnt vmcnt(0)" ::: "memory");
            const unsigned og = xb_add(&bar[XB_TOP], 1u);
            const unsigned tg = og / nx;
            if (og + 1u == (tg + 1u) * nx) xb_add(&bar[XB_TOPGEN], 1u);
            else XB_SPIN(xb_ld(&bar[XB_TOPGEN]) == tg, bar);
            __builtin_amdgcn_fence(__ATOMIC_ACQUIRE, "agent");
            xb_add(&bar[XB_XGEN(b.x)], 1u);
            asm volatile("s_waitcnt vmcnt(0)" ::: "memory");
        } else {
            XB_SPIN(xb_ld(&bar[XB_XGEN(b.x)]) == gen, bar);
            __builtin_amdgcn_fence(__ATOMIC_ACQUIRE, "agent");
            asm volatile("s_waitcnt vmcnt(0)" ::: "memory");
        }
    }
    __syncthreads();
}

constexpr int NWAVES = 8;
constexpr int RING_OFF = 0, RING_BYTES = 131072;
constexpr int LDSCTL_OFF = RING_BYTES, MISC_OFF = LDSCTL_OFF + 320;
constexpr int LDS_BYTES = 147456;

struct Args { const float* in[20]; float* out; unsigned char* ws; int ph_lo, ph_hi, li, pad; };

struct Frame {
    LAS unsigned char* lds;
    volatile LAS unsigned* MISC;
    gu32* ctl;
    int tid, lane, wave, vcu, G;
    __device__ __forceinline__ void refresh() { int t = threadIdx.x; asm volatile("" : "+v"(t)); tid = t; lane = t & 63; wave = __builtin_amdgcn_readfirstlane(t >> 6); }
    unsigned char* ws; float* out;
    const float* x; const float* p;
};

enum Phase { PH_PRO = 0, PH_PROJ, PH_MIX1, PH_SCAN, PH_RETO, PH_BR, PH_WOUT, PH_ROUTE, PH_GATHER, PH_GU, PH_DOWN, PH_COMB, PH_PLE, PH_FINAL, NPH };

DI void tr_item(const float* __restrict__ W, int ldw, int mycol, bf16* WT, int K, int r0, int k0, LAS float* scr, int lane) {
#pragma unroll 8
    for (int i = 0; i < 32; ++i) { const int kk = 2 * i + (lane >> 5); scr[kk * 33 + (lane & 31)] = W[(size_t)(k0 + kk) * ldw + mycol]; }
    LDS_WAIT(); asm volatile("" ::: "memory");
    const int c = lane & 7;
#pragma unroll
    for (int j = 0; j < 4; ++j) { const int n = (lane >> 3) + 8 * j; const LAS float* s = scr + (8 * c) * 33 + n;
        v4u o; o.x = pk2(s[0 * 33], s[1 * 33]); o.y = pk2(s[2 * 33], s[3 * 33]); o.z = pk2(s[4 * 33], s[5 * 33]); o.w = pk2(s[6 * 33], s[7 * 33]);
        *(GAS v4u*)(WT + (size_t)(r0 + n) * K + k0 + 8 * c) = o; }
    LDS_WAIT(); asm volatile("" ::: "memory");
}
DI void rms_row_to_bf16(const float* xrow, const float* gain, bf16* orow, int lane) {
    const GAS f32x4* xr = (const GAS f32x4*)xrow + lane; const GAS f32x4* gr = (const GAS f32x4*)gain + lane;
    f32x4 v[4]; float s = 0.f;
#pragma unroll
    for (int j = 0; j < 4; ++j) { v[j] = xr[64 * j]; s += (v[j].x * v[j].x + v[j].y * v[j].y) + (v[j].z * v[j].z + v[j].w * v[j].w); }
    const float rstd = rsqrtf(wave_sum_dpp(s) * (1.f / DM) + EPS);
    GAS v2u* o8 = (GAS v2u*)orow + lane;
#pragma unroll
    for (int j = 0; j < 4; ++j) { const f32x4 g = gr[64 * j]; v2u o; o.x = pk2(v[j].x * rstd * g.x, v[j].y * rstd * g.y); o.y = pk2(v[j].z * rstd * g.z, v[j].w * rstd * g.w); o8[64 * j] = o; }
}
DI void ph_prologue(Frame& F, const Args& a) {
    LAS float* scr = (LAS float*)(F.lds + RING_OFF + F.wave * 16384);
    const int gw = F.vcu * NWAVES + F.wave, NGW = F.G * NWAVES, lane = F.lane;
    unsigned char* ws = F.ws;
    constexpr int I_IN = (6144 / 32) * 16, I_BR = 32 * 8, I_OUT = 32 * 16, I_GU = 16 * 32 * 16, I_D = 16 * 32 * 8, I_PLE = 32 * 4, I_PG = 32 * 16;
    constexpr int NITEMS = I_IN + 2 * I_BR + I_OUT + I_GU + I_D + I_PLE + I_PG;
    for (int it = gw; it < NITEMS; it += NGW) {
        int r = it;
        if (r < I_IN) { const int rb = r >> 4, kb = r & 15; tr_item(a.in[3], NWIN, in_src(rb * 32 + (lane & 31)), (bf16*)(ws + WS_WIN), 1024, rb * 32, kb * 64, scr, lane); continue; } r -= I_IN;
        if (r < I_BR) { const int rb = r >> 3, kb = r & 7; tr_item(a.in[5], DM, rb * 32 + (lane & 31), (bf16*)(ws + WS_WBR1), 1024, rb * 32, kb * 64, scr, lane); continue; } r -= I_BR;
        if (r < I_BR) { const int rb = r >> 3, kb = r & 7; tr_item(a.in[6], DM, rb * 32 + (lane & 31), (bf16*)(ws + WS_WBR1) + 512, 1024, rb * 32, kb * 64, scr, lane); continue; } r -= I_BR;
        if (r < I_OUT) { const int rb = r >> 4, kb = r & 15; tr_item(a.in[7], DM, rb * 32 + (lane & 31), (bf16*)(ws + WS_WOUT), 1024, rb * 32, kb * 64, scr, lane); continue; } r -= I_OUT;
        if (r < I_GU) { const int e = r >> 9, q = r & 511, rb = q >> 4, kb = q & 15;
            const int row = rb * 32, j = row >> 8, w = row & 255; const bool up = w >= 128; const int col = 128 * j + (w & 127) + (lane & 31);
            tr_item((up ? a.in[14] : a.in[13]) + (size_t)e * DM * DEXP, DEXP, col, (bf16*)(ws + WS_WGU) + (size_t)e * 1024 * 1024, 1024, row, kb * 64, scr, lane); continue; } r -= I_GU;
        if (r < I_D) { const int e = r >> 8, q = r & 255, rb = q >> 3, kb = q & 7;
            tr_item(a.in[15] + (size_t)e * DEXP * DM, DM, rb * 32 + (lane & 31), (bf16*)(ws + WS_WD) + (size_t)e * 1024 * 512, 512, rb * 32, kb * 64, scr, lane); continue; } r -= I_D;
        if (r < I_PLE) { const int rb = r >> 2, kb = r & 3; tr_item(a.in[17], DM, rb * 32 + (lane & 31), (bf16*)(ws + WS_WPLE), 256, rb * 32, kb * 64, scr, lane); continue; } r -= I_PLE;
        { const int rb = r >> 4, kb = r & 15; tr_item(a.in[18], DM, rb * 32 + (lane & 31), (bf16*)(ws + WS_WPG), 1024, rb * 32, kb * 64, scr, lane); }
    }
    bf16* HB = (bf16*)((unsigned char*)F.out + DO_HB);
    for (int m = gw; m < NTOK; m += NGW) {
        rms_row_to_bf16(F.x + (size_t)m * DM, a.in[2], HB + (size_t)m * DM, lane);
        const f32x4 pv = ((const GAS f32x4*)(F.p + (size_t)m * 256))[lane];
        v2u o; o.x = pk2(pv.x, pv.y); o.y = pk2(pv.z, pv.w); ((GAS v2u*)((bf16*)(ws + WS_PB) + (size_t)m * 256))[lane] = o;
    }
    f32x2* tabA = (f32x2*)(ws + WS_TABA); f32x2* tabB = (f32x2*)(ws + WS_TABB);
    for (int i = F.vcu * 512 + F.tid; i < SEQ * 64; i += F.G * 512) {
        const int pos = i >> 6, p = i & 63;
        const float invf = powf(10000.0f, -(float)(2 * p) * (1.0f / 128.0f)); const float ang = (float)pos * invf;
        const f32x2 cs = {cosf(ang), sinf(ang)};
        tabA[i] = cs; tabB[p * SEQ + pos] = cs;
    }
}

DI void ph_route(Frame& F, const Args& a) {
    LAS float* WL = (LAS float*)(F.lds);
    for (int i = F.tid; i < 1024 * 20; i += 512) { const int k = i / 20, o = i - k * 20; WL[((k & 3) * 256 + (k >> 2)) * 20 + o] = o < 4 ? a.in[9][k * 4 + o] : a.in[11][k * 16 + (o - 4)]; }
    LAS int* s_e = (LAS int*)(F.lds + 81920); LAS int* s_lr = s_e + 256; LAS int* lcnt = s_lr + 256; LAS int* lbase = lcnt + 16;
    unsigned char* ws = F.ws; const int lane = F.lane;
    int* eid = (int*)(ws + WS_ROUTE + RT_EID); float* wgt = (float*)(ws + WS_ROUTE + RT_WGT); int* rank = (int*)(ws + WS_ROUTE + RT_RANK);
    bf16* H2 = (bf16*)(ws + WS_H2); const bf16* X1 = (const bf16*)((unsigned char*)F.out + DO_X1);
    const float* bg = a.in[10]; const float* be = a.in[12];
    __syncthreads();
    for (int blk = F.vcu; blk < NTOK / 128; blk += F.G) {
        if (F.tid < 16) lcnt[F.tid] = 0;
        __syncthreads();
        v2u raw[4];
        { const GAS v2u* xr = (const GAS v2u*)(X1 + (size_t)(blk * 128 + F.wave) * DM) + lane;
#pragma unroll
          for (int j = 0; j < 4; ++j) raw[j] = xr[64 * j]; }
        for (int tl = F.wave; tl < 128; tl += NWAVES) {
            const int tok = blk * 128 + tl;
            v2u nxt[4];
            { const int tn = (tl + NWAVES < 128) ? tok + NWAVES : tok; const GAS v2u* xr = (const GAS v2u*)(X1 + (size_t)tn * DM) + lane;
#pragma unroll
              for (int j = 0; j < 4; ++j) nxt[j] = xr[64 * j]; }
            const GAS f32x4* gr = (const GAS f32x4*)a.in[8] + lane;
            f32x4 v[4]; float ss = 0.f;
#pragma unroll
            for (int j = 0; j < 4; ++j) { v[j] = (f32x4){bflo(raw[j].x), bfhi(raw[j].x), bflo(raw[j].y), bfhi(raw[j].y)}; ss += (v[j].x * v[j].x + v[j].y * v[j].y) + (v[j].z * v[j].z + v[j].w * v[j].w); }
            const float rstd = rsqrtf(wave_sum_dpp(ss) * (1.f / DM) + EPS);
            GAS v2u* o8 = (GAS v2u*)(H2 + (size_t)tok * DM) + lane;
            float acc[20];
#pragma unroll
            for (int o = 0; o < 20; ++o) acc[o] = 0.f;
#pragma unroll
            for (int j = 0; j < 4; ++j) {
                const f32x4 g = gr[64 * j]; v[j] = v[j] * rstd * g;
                v2u o; o.x = pk2(v[j].x, v[j].y); o.y = pk2(v[j].z, v[j].w); o8[64 * j] = o;
#pragma unroll
                for (int i = 0; i < 4; ++i) {
                    const float hv = v[j][i]; const LAS f32x4* w = (const LAS f32x4*)(WL + (i * 256 + lane + 64 * j) * 20);
#pragma unroll
                    for (int q = 0; q < 5; ++q) { const f32x4 wv = w[q]; acc[4 * q] += hv * wv.x; acc[4 * q + 1] += hv * wv.y; acc[4 * q + 2] += hv * wv.z; acc[4 * q + 3] += hv * wv.w; }
                }
            }
#pragma unroll
            for (int o = 0; o < 20; ++o) acc[o] = wave_sum_dpp(acc[o]);
            float gl[4];
#pragma unroll
            for (int i = 0; i < 4; ++i) gl[i] = acc[i] + bg[i];
            int g = 0; float gm = gl[0];
#pragma unroll
            for (int i = 1; i < 4; ++i) if (gl[i] > gm) { gm = gl[i]; g = i; }
            float se = 0.f;
#pragma unroll
            for (int i = 0; i < 4; ++i) se += __expf(gl[i] - gm);
            const float pg = 1.0f / se;
            float el[4];
#pragma unroll
            for (int i = 0; i < 4; ++i) { const float l0 = acc[4 + i], l1 = acc[8 + i], l2 = acc[12 + i], l3 = acc[16 + i]; el[i] = (g == 0 ? l0 : g == 1 ? l1 : g == 2 ? l2 : l3) + be[4 * g + i]; }
            int i1 = 0; float m1 = el[0];
#pragma unroll
            for (int i = 1; i < 4; ++i) if (el[i] > m1) { m1 = el[i]; i1 = i; }
            int i2 = -1; float m2 = -3.0e38f;
#pragma unroll
            for (int i = 0; i < 4; ++i) if (i != i1 && el[i] > m2) { m2 = el[i]; i2 = i; }
            const float e2 = __expf(m2 - m1), w1 = pg / (1.0f + e2), w2 = pg * e2 / (1.0f + e2);
            if (lane == 0) {
                eid[2 * tok] = 4 * g + i1; eid[2 * tok + 1] = 4 * g + i2; wgt[2 * tok] = w1; wgt[2 * tok + 1] = w2;
                s_e[2 * tl] = 4 * g + i1; s_e[2 * tl + 1] = 4 * g + i2;
            }
#pragma unroll
            for (int j = 0; j < 4; ++j) raw[j] = nxt[j];
        }
        __syncthreads();
        if (F.tid < 256) s_lr[F.tid] = atomicAdd((int*)&lcnt[s_e[F.tid]], 1);
        __syncthreads();
        if (F.tid < 16) lbase[F.tid] = (int)__hip_atomic_fetch_add(F.ctl + CW_CNT + F.tid, (unsigned)lcnt[F.tid], RLX_AGENT);
        __syncthreads();
        if (F.tid < 256) rank[blk * 256 + F.tid] = lbase[s_e[F.tid]] + s_lr[F.tid];
        __syncthreads();
    }
}

DI void expert_table(Frame& F, LAS int* pst) {
    if (F.tid == 0) { int acc = 0; for (int e = 0; e < NEXP; ++e) { pst[e] = acc; const int c = (int)__hip_atomic_load(F.ctl + CW_CNT + e, RLX_AGENT); acc += (c + 255) & ~255; } pst[NEXP] = acc; }
    __syncthreads();
}

DI void ph_gather(Frame& F, const Args& a) {
    LAS int* pst = (LAS int*)(F.lds);
    expert_table(F, pst);
    unsigned char* ws = F.ws; const int lane = F.lane;
    const int* eid = (const int*)(ws + WS_ROUTE + RT_EID); const float* wgt = (const float*)(ws + WS_ROUTE + RT_WGT); const int* rank = (const int*)(ws + WS_ROUTE + RT_RANK);
    int* pos = (int*)(ws + WS_ROUTE + RT_POS); float* wrow = (float*)(ws + WS_ROUTE + RT_WROW); int* tile = (int*)(ws + WS_ROUTE + RT_TILE);
    const bf16* H2 = (const bf16*)(ws + WS_H2); bf16* XB = (bf16*)(ws + WS_XB);
    if (blockIdx.x == 0 && F.tid < NEXP) { const int e = F.tid; for (int rt = pst[e] >> 8; rt < (pst[e + 1] >> 8); ++rt) tile[1 + rt] = e; if (e == 0) tile[0] = pst[NEXP] >> 8; }
    const int gw = F.vcu * NWAVES + F.wave, NGW = F.G * NWAVES;
    v4u r0, r1; int e0, e1, k0, k1;
#define GATH_LOAD(tk, a0, a1, x0, x1, y0, y1) do { const GAS v4u* s_ = (const GAS v4u*)(H2 + (size_t)(tk) * DM) + lane; a0 = s_[0]; a1 = s_[64]; x0 = eid[2 * (tk)]; x1 = eid[2 * (tk) + 1]; y0 = rank[2 * (tk)]; y1 = rank[2 * (tk) + 1]; } while (0)
    if (gw < NTOK) GATH_LOAD(gw, r0, r1, e0, e1, k0, k1);
    for (int tok = gw; tok < NTOK; tok += NGW) {
        v4u n0, n1; int f0, f1, m0, m1;
        { const int tn = (tok + NGW < NTOK) ? tok + NGW : tok; GATH_LOAD(tn, n0, n1, f0, f1, m0, m1); }
        const int p0 = pst[e0] + k0, p1 = pst[e1] + k1;
        GAS v4u* d0 = (GAS v4u*)(XB + (size_t)p0 * DM) + lane; GAS v4u* d1 = (GAS v4u*)(XB + (size_t)p1 * DM) + lane;
        d0[0] = r0; d0[64] = r1; d1[0] = r0; d1[64] = r1;
        if (lane == 0) { pos[2 * tok] = p0; pos[2 * tok + 1] = p1; wrow[p0] = wgt[2 * tok]; wrow[p1] = wgt[2 * tok + 1]; }
        r0 = n0; r1 = n1; e0 = f0; e1 = f1; k0 = m0; k1 = m1;
    }
#undef GATH_LOAD
}

DI void ph_combine(Frame& F, const Args& a) {
    unsigned char* ws = F.ws; const int lane = F.lane;
    const int* __restrict__ pos = (const int*)(ws + WS_ROUTE + RT_POS); const bf16* __restrict__ YB = (const bf16*)(ws + WS_XB); bf16* __restrict__ HP = (bf16*)(ws + WS_H2);
    const bf16* __restrict__ X1 = (const bf16*)((unsigned char*)F.out + DO_X1); bf16* __restrict__ X2 = (bf16*)(ws + WS_X2);
    const int gw = F.vcu * NWAVES + F.wave, NGW = F.G * NWAVES;
    v2u cx[4], c0[4], c1[4];
#define COMB_LOAD(tk, dx, d0, d1) do { const int p0_ = pos[2 * (tk)], p1_ = pos[2 * (tk) + 1]; \
        const GAS v2u* xr_ = (const GAS v2u*)(X1 + (size_t)(tk) * DM) + lane; const GAS v2u* y0_ = (const GAS v2u*)(YB + (size_t)p0_ * DM) + lane; const GAS v2u* y1_ = (const GAS v2u*)(YB + (size_t)p1_ * DM) + lane; \
        _Pragma("unroll") for (int j = 0; j < 4; ++j) { dx[j] = xr_[64 * j]; d0[j] = y0_[64 * j]; d1[j] = y1_[64 * j]; } } while (0)
    if (gw < NTOK) COMB_LOAD(gw, cx, c0, c1);
    for (int tok = gw; tok < NTOK; tok += NGW) {
        v2u nx[4], n0[4], n1[4];
        { const int tn = (tok + NGW < NTOK) ? tok + NGW : tok; COMB_LOAD(tn, nx, n0, n1); }
        const GAS f32x4* gr = (const GAS f32x4*)a.in[16] + lane; GAS v2u* xw = (GAS v2u*)(X2 + (size_t)tok * DM) + lane;
        f32x4 v[4]; float ss = 0.f;
#pragma unroll
        for (int j = 0; j < 4; ++j) {
            const v2u x0 = cx[j], a0 = c0[j], a1 = c1[j];
            v[j].x = bflo(x0.x) + bflo(a0.x) + bflo(a1.x); v[j].y = bfhi(x0.x) + bfhi(a0.x) + bfhi(a1.x); v[j].z = bflo(x0.y) + bflo(a0.y) + bflo(a1.y); v[j].w = bfhi(x0.y) + bfhi(a0.y) + bfhi(a1.y);
            v2u o; o.x = pk2(v[j].x, v[j].y); o.y = pk2(v[j].z, v[j].w); xw[64 * j] = o;
            ss += (v[j].x * v[j].x + v[j].y * v[j].y) + (v[j].z * v[j].z + v[j].w * v[j].w);
        }
        const float rstd = rsqrtf(wave_sum_dpp(ss) * (1.f / DM) + EPS);
        GAS v2u* o8 = (GAS v2u*)(HP + (size_t)tok * DM) + lane;
#pragma unroll
        for (int j = 0; j < 4; ++j) { const f32x4 g = gr[64 * j]; v2u o; o.x = pk2(v[j].x * rstd * g.x, v[j].y * rstd * g.y); o.y = pk2(v[j].z * rstd * g.z, v[j].w * rstd * g.w); o8[64 * j] = o; }
#pragma unroll
        for (int j = 0; j < 4; ++j) { cx[j] = nx[j]; c0[j] = n0[j]; c1[j] = n1[j]; }
    }
#undef COMB_LOAD
}

DI void ph_final(Frame& F, const Args& a) {
    const int lane = F.lane, gw = F.vcu * NWAVES + F.wave, NGW = F.G * NWAVES;
    f32x4 cur[4];
    if (gw < NTOK) { const GAS f32x4* xr = (const GAS f32x4*)(F.out + (size_t)gw * DM) + lane;
#pragma unroll
        for (int j = 0; j < 4; ++j) cur[j] = xr[64 * j]; }
    for (int tok = gw; tok < NTOK; tok += NGW) {
        f32x4 nxt[4];
        { const int tn = (tok + NGW < NTOK) ? tok + NGW : tok; const GAS f32x4* xn = (const GAS f32x4*)(F.out + (size_t)tn * DM) + lane;
#pragma unroll
          for (int j = 0; j < 4; ++j) nxt[j] = xn[64 * j]; }
        GAS f32x4* xr = (GAS f32x4*)(F.out + (size_t)tok * DM) + lane; const GAS f32x4* gr = (const GAS f32x4*)a.in[19] + lane;
        float ss = 0.f;
#pragma unroll
        for (int j = 0; j < 4; ++j) ss += (cur[j].x * cur[j].x + cur[j].y * cur[j].y) + (cur[j].z * cur[j].z + cur[j].w * cur[j].w);
        const float rstd = rsqrtf(wave_sum_dpp(ss) * (1.f / DM) + EPS);
#pragma unroll
        for (int j = 0; j < 4; ++j) { const f32x4 g = gr[64 * j]; xr[64 * j] = cur[j] * rstd * g; }
#pragma unroll
        for (int j = 0; j < 4; ++j) cur[j] = nxt[j];
    }
}

typedef pg8::f32x4 af4;
DI unsigned cvtpk(float lo, float hi) { typedef float f2 __attribute__((ext_vector_type(2))); typedef __bf16 b2 __attribute__((ext_vector_type(2))); f2 v = {lo, hi}; b2 b = __builtin_convertvector(v, b2); return __builtin_bit_cast(unsigned, b); }
DI v4u pack8(const float (&x)[8]) { v4u w; w.x = cvtpk(x[0], x[1]); w.y = cvtpk(x[2], x[3]); w.z = cvtpk(x[4], x[5]); w.w = cvtpk(x[6], x[7]); return w; }
DI void unpack8(const v4u w, float (&x)[8]) { x[0] = bflo(w.x); x[1] = bfhi(w.x); x[2] = bflo(w.y); x[3] = bfhi(w.y); x[4] = bflo(w.z); x[5] = bfhi(w.z); x[6] = bflo(w.w); x[7] = bfhi(w.w); }

struct EpiProj {
    static constexpr bool PERM = true, AFTER_DRAIN = false; static constexpr int MIDK = 0;
    unsigned char* ws; const float* gn;
    DI void operator()(const af4 (&acc)[2][2][4][2], const pg8::Unit& u, int wr, int wc, int fr, int fq) const {
        bf16* PROJ = (bf16*)(ws + WS_PROJ); const f32x2* tabA = (const f32x2*)(ws + WS_TABA); bf16* T = (bf16*)(ws + WS_T);
        int row0 = u.pm * 256 + wr * 64 + fr, colb = u.pn * 256 + wc * 32 + 8 * fq;
        asm volatile("" : "+v"(row0), "+v"(colb));
        const int kind = u.pn < 2 ? 0 : u.pn < 4 ? 1 : u.pn < 6 ? 2 : u.pn < 8 ? 3 : u.pn < 10 ? 4 : 5;
#pragma unroll
        for (int ai = 0; ai < 2; ++ai)
#pragma unroll
            for (int m = 0; m < 4; ++m) {
                const int row = row0 + ai * 128 + m * 16;
#pragma unroll
                for (int bj = 0; bj < 2; ++bj) {
                    const int col = colb + bj * 128;
                    const af4 a0 = acc[ai][bj][m][0], a1 = acc[ai][bj][m][1];
                    float x[8] = {a0[0], a0[1], a0[2], a0[3], a1[0], a1[1], a1[2], a1[3]};
                    if (kind <= 1) {
                        const int pos = row & (SEQ - 1), p = (col & 127) >> 1;
                        const f32x4* tp = (const f32x4*)(tabA + pos * 64 + p);
                        const f32x4 t0 = tp[0], t1 = tp[1];
                        const float sc = kind == 1 ? 0.08838834764831845f : 1.0f;
                        float y[8];
                        y[0] = (x[0] * t0.x - x[1] * t0.y) * sc; y[1] = (x[0] * t0.y + x[1] * t0.x) * sc;
                        y[2] = (x[2] * t0.z - x[3] * t0.w) * sc; y[3] = (x[2] * t0.w + x[3] * t0.z) * sc;
                        y[4] = (x[4] * t1.x - x[5] * t1.y) * sc; y[5] = (x[4] * t1.y + x[5] * t1.x) * sc;
                        y[6] = (x[6] * t1.z - x[7] * t1.w) * sc; y[7] = (x[6] * t1.w + x[7] * t1.z) * sc;
#pragma unroll
                        for (int i = 0; i < 8; ++i) x[i] = y[i];
                        if (kind == 1) {
                            const int h = (col - C_RK) >> 7;
                            const float kd = exp2f(ret_log2g(h) * (float)(63 - (pos & 63)));
                            float z[8];
#pragma unroll
                            for (int i = 0; i < 8; ++i) z[i] = y[i] * kd;
                            int frl = fr; asm volatile("" : "+v"(frl));
                            const int li = frl & 7;
#pragma unroll
                            for (int s = 4; s >= 1; s >>= 1) {
                                const bool up = (li & s) != 0;
#pragma unroll
                                for (int j = 0; j < 8; ++j) if ((j & s) == 0) {
                                    const float send = up ? z[j] : z[j | s];
                                    float recv;
                                    if (s == 1) recv = __builtin_bit_cast(float, __builtin_amdgcn_update_dpp(0, __builtin_bit_cast(int, send), 0xB1, 0xF, 0xF, true));
                                    else if (s == 2) recv = __builtin_bit_cast(float, __builtin_amdgcn_update_dpp(0, __builtin_bit_cast(int, send), 0x4E, 0xF, 0xF, true));
                                    else { const float dn = __builtin_bit_cast(float, __builtin_amdgcn_update_dpp(0, __builtin_bit_cast(int, send), 0x104, 0xF, 0xF, true));
                                           const float upv = __builtin_bit_cast(float, __builtin_amdgcn_update_dpp(0, __builtin_bit_cast(int, send), 0x114, 0xF, 0xF, true));
                                           recv = up ? upv : dn; }
                                    if (up) z[j] = recv; else z[j | s] = recv;
                                }
                            }
                            *(v4u*)(T + (size_t)(T_KT + (col - C_RK) + li) * NTOK + (row - li)) = pack8(z);
                        }
                    } else if (kind == 2) {
                        const f32x4 g0 = *(const f32x4*)(gn + (col - C_RG)), g1 = *(const f32x4*)(gn + (col - C_RG) + 4);
                        const float gg[8] = {g0.x, g0.y, g0.z, g0.w, g1.x, g1.y, g1.z, g1.w};
#pragma unroll
                        for (int i = 0; i < 8; ++i) x[i] = fsilu(x[i]) * gg[i];
                    } else if (kind == 3) {
#pragma unroll
                        for (int i = 0; i < 8; ++i) x[i] *= SB_QSCALE;
                    } else if (kind == 5) {
#pragma unroll
                        for (int i = 0; i < 8; ++i) x[i] = fsigmoid(x[i]);
                    }
                    *(v4u*)(PROJ + (size_t)row * NMAIN + col) = pack8(x);
                }
                asm volatile("" ::: "memory");
            }
    }
};
struct EpiProjT {
    static constexpr bool PERM = true, AFTER_DRAIN = false; static constexpr int MIDK = 0;
    bf16* T;
    DI void operator()(const af4 (&acc)[2][2][4][2], const pg8::Unit& u, int wr, int wc, int fr, int fq) const {
        const int f0 = T_VR + u.pm * 256 + wr * 64 + fr, tokb = u.pn * 256 + wc * 32 + 8 * fq;
#pragma unroll
        for (int ai = 0; ai < 2; ++ai)
#pragma unroll
            for (int m = 0; m < 4; ++m)
#pragma unroll
                for (int bj = 0; bj < 2; ++bj) {
                    const af4 a0 = acc[ai][bj][m][0], a1 = acc[ai][bj][m][1];
                    const float x[8] = {a0[0], a0[1], a0[2], a0[3], a1[0], a1[1], a1[2], a1[3]};
                    *(v4u*)(T + (size_t)(f0 + ai * 128 + m * 16) * NTOK + tokb + bj * 128) = pack8(x);
                }
    }
};

struct EpiBr {
    static constexpr bool PERM = true, AFTER_DRAIN = false; static constexpr int MIDK = 8;
    bf16* PROJ;
    DI void mid(af4 (&acc)[2][2][4][2], const pg8::Unit& u, int wr, int wc, int fr, int fq) const {
        int row0 = u.pm * 256 + wr * 64 + fr, colb = u.pn * 256 + wc * 32 + 8 * fq;
        asm volatile("" : "+v"(row0), "+v"(colb));
#pragma unroll
        for (int ai = 0; ai < 2; ++ai)
#pragma unroll
            for (int m = 0; m < 4; ++m) {
                const bf16* pr = PROJ + (size_t)(row0 + ai * 128 + m * 16) * NMAIN;
#pragma unroll
                for (int bj = 0; bj < 2; ++bj) {
                    const int col = colb + bj * 128;
                    float gr[8], gs[8]; unpack8(*(const v4u*)(pr + C_GR + col), gr); unpack8(*(const v4u*)(pr + C_GS + col), gs);
#pragma unroll
                    for (int i = 0; i < 4; ++i) { acc[ai][bj][m][0][i] *= gr[i] * __builtin_amdgcn_rcpf(fmaxf(gs[i], 1e-30f)); acc[ai][bj][m][1][i] *= gr[4 + i] * __builtin_amdgcn_rcpf(fmaxf(gs[4 + i], 1e-30f)); }
                }
                asm volatile("" ::: "memory");
            }
    }
    DI void operator()(const af4 (&acc)[2][2][4][2], const pg8::Unit& u, int wr, int wc, int fr, int fq) const {
        int row0 = u.pm * 256 + wr * 64 + fr, colb = u.pn * 256 + wc * 32 + 8 * fq;
        asm volatile("" : "+v"(row0), "+v"(colb));
#pragma unroll
        for (int ai = 0; ai < 2; ++ai)
#pragma unroll
            for (int m = 0; m < 4; ++m) {
                bf16* pr = PROJ + (size_t)(row0 + ai * 128 + m * 16) * NMAIN;
#pragma unroll
                for (int bj = 0; bj < 2; ++bj) {
                    const int col = colb + bj * 128;
                    const af4 a0 = acc[ai][bj][m][0], a1 = acc[ai][bj][m][1];
                    float gs[8], x[8] = {a0[0], a0[1], a0[2], a0[3], a1[0], a1[1], a1[2], a1[3]};
                    unpack8(*(const v4u*)(pr + C_GS + col), gs);
#pragma unroll
                    for (int i = 0; i < 8; ++i) x[i] *= fmaxf(gs[i], 1e-30f);
                    *(v4u*)(pr + C_MG + col) = pack8(x);
                }
            }
    }
};
struct EpiWout {
    static constexpr bool PERM = true, AFTER_DRAIN = false; static constexpr int MIDK = 0;
    const float* x; bf16* x1;
    DI void operator()(const af4 (&acc)[2][2][4][2], const pg8::Unit& u, int wr, int wc, int fr, int fq) const {
        const int row0 = u.pm * 256 + wr * 64 + fr, colb = u.pn * 256 + wc * 32 + 8 * fq;
#pragma unroll
        for (int ai = 0; ai < 2; ++ai)
#pragma unroll
            for (int m = 0; m < 4; ++m) {
                const size_t ro = (size_t)(row0 + ai * 128 + m * 16) * DM;
#pragma unroll
                for (int bj = 0; bj < 2; ++bj) {
                    const size_t o = ro + colb + bj * 128;
                    const af4 x0 = *(const af4*)(x + o) + acc[ai][bj][m][0], x1v = *(const af4*)(x + o + 4) + acc[ai][bj][m][1];
                    const float y[8] = {x0[0], x0[1], x0[2], x0[3], x1v[0], x1v[1], x1v[2], x1v[3]};
                    *(v4u*)(x1 + o) = pack8(y);
                }
            }
    }
};
struct EpiGu {
    static constexpr bool PERM = true, AFTER_DRAIN = false; static constexpr int MIDK = 0;
    bf16* HID;
    DI void operator()(const af4 (&acc)[2][2][4][2], const pg8::Unit& u, int wr, int wc, int fr, int fq) const {
        const int row0 = u.pm * 256 + wr * 64 + fr, col = u.pn * 128 + wc * 32 + 8 * fq;
#pragma unroll
        for (int ai = 0; ai < 2; ++ai)
#pragma unroll
            for (int m = 0; m < 4; ++m) {
                const af4 g0 = acc[ai][0][m][0], g1 = acc[ai][0][m][1], u0 = acc[ai][1][m][0], u1 = acc[ai][1][m][1];
                float x[8];
#pragma unroll
                for (int i = 0; i < 4; ++i) { x[i] = fsilu(g0[i]) * u0[i]; x[4 + i] = fsilu(g1[i]) * u1[i]; }
                *(v4u*)(HID + (size_t)(row0 + ai * 128 + m * 16) * DEXP + col) = pack8(x);
            }
    }
};
struct EpiDown {
    static constexpr bool PERM = true, AFTER_DRAIN = false; static constexpr int MIDK = 0;
    bf16* YB; const float* wrow;
    DI void operator()(const af4 (&acc)[2][2][4][2], const pg8::Unit& u, int wr, int wc, int fr, int fq) const {
        const int row0 = u.pm * 256 + wr * 64 + fr, colb = u.pn * 256 + wc * 32 + 8 * fq;
#pragma unroll
        for (int ai = 0; ai < 2; ++ai)
#pragma unroll
            for (int m = 0; m < 4; ++m) {
                const int row = row0 + ai * 128 + m * 16; const float w = wrow[row];
#pragma unroll
                for (int bj = 0; bj < 2; ++bj) {
                    const af4 a0 = acc[ai][bj][m][0] * w, a1 = acc[ai][bj][m][1] * w;
                    const float x[8] = {a0[0], a0[1], a0[2], a0[3], a1[0], a1[1], a1[2], a1[3]};
                    *(v4u*)(YB + (size_t)row * DM + colb + bj * 128) = pack8(x);
                }
            }
    }
};
struct EpiPe {
    static constexpr bool PERM = true, AFTER_DRAIN = false; static constexpr int MIDK = 0;
    bf16* PE;
    DI void operator()(const af4 (&acc)[2][2][4][2], const pg8::Unit& u, int wr, int wc, int fr, int fq) const {
        const int row0 = u.pm * 256 + wr * 64 + fr, colb = u.pn * 256 + wc * 32 + 8 * fq;
#pragma unroll
        for (int ai = 0; ai < 2; ++ai)
#pragma unroll
            for (int m = 0; m < 4; ++m)
#pragma unroll
                for (int bj = 0; bj < 2; ++bj) {
                    const af4 a0 = acc[ai][bj][m][0], a1 = acc[ai][bj][m][1];
                    const float x[8] = {a0[0], a0[1], a0[2], a0[3], a1[0], a1[1], a1[2], a1[3]};
                    *(v4u*)(PE + (size_t)(row0 + ai * 128 + m * 16) * DM + colb + bj * 128) = pack8(x);
                }
    }
};
struct EpiPg {
    static constexpr bool PERM = true, AFTER_DRAIN = false; static constexpr int MIDK = 0;
    const bf16* PE; const bf16* x2; float* out;
    DI void operator()(const af4 (&acc)[2][2][4][2], const pg8::Unit& u, int wr, int wc, int fr, int fq) const {
        const int row0 = u.pm * 256 + wr * 64 + fr, colb = u.pn * 256 + wc * 32 + 8 * fq;
#pragma unroll
        for (int ai = 0; ai < 2; ++ai)
#pragma unroll
            for (int m = 0; m < 4; ++m) {
                const size_t ro = (size_t)(row0 + ai * 128 + m * 16) * DM;
#pragma unroll
                for (int bj = 0; bj < 2; ++bj) {
                    const size_t o = ro + colb + bj * 128;
                    float pe[8]; unpack8(*(const v4u*)(PE + o), pe);
                    const af4 a0 = acc[ai][bj][m][0], a1 = acc[ai][bj][m][1];
                    float xr[8]; unpack8(*(const v4u*)(x2 + o), xr);
                    af4 x0 = {xr[0], xr[1], xr[2], xr[3]}, x1 = {xr[4], xr[5], xr[6], xr[7]};
#pragma unroll
                    for (int i = 0; i < 4; ++i) { x0[i] += fsigmoid(a0[i]) * pe[i]; x1[i] += fsigmoid(a1[i]) * pe[4 + i]; }
                    *(af4*)(out + o) = x0; *(af4*)(out + o + 4) = x1;
                }
                asm volatile("" ::: "memory");
            }
    }
};

struct MoeOrder {
    const LAS int* pst; int G, c; size_t estride, tstepB;
    DI bool next(int i, pg8::Unit& u) const {
        const int L = i * G + c, rt = L >> 2; if (rt * 256 >= pst[NEXP]) return false;
        int ex = 0;
#pragma unroll
        for (int e = 1; e < NEXP; ++e) ex += (rt * 256 >= pst[e]) ? 1 : 0;
        u.pm = rt; u.pn = L & 3; u.ex = ex; u.bofs = (size_t)ex * estride + (size_t)u.pn * tstepB; return true;
    }
    DI void a_ready(const pg8::Unit&) const {}
    DI void done(const pg8::Unit&) const {}
};

#ifndef PG8_ALIGN
#define PG8_ALIGN true
#endif
#define GEMM_PHASE(EPI, ORD, g, S, E) pg8::gemm_phase<EPI, ORD, PG8_ALIGN, true>(F.lds + RING_OFF, g, S, E)

DI void fast_proj(Frame& F, const Args& a) {
    unsigned char* ws = F.ws; const bf16* HB = (const bf16*)((unsigned char*)F.out + DO_HB); const bf16* WIN = (const bf16*)(ws + WS_WIN);
    { pg8::Gemm g{HB, WIN, DM, DM}; pg8::StaticOrder S; S.init(NTOK, NMAIN, DM, F.G, (int)blockIdx.x);
      EpiProj E{ws, a.in[4]}; GEMM_PHASE(EpiProj, pg8::StaticOrder, g, S, E); }
    { pg8::Gemm g{WIN + (size_t)(NMAIN + 512) * DM, HB, DM, DM}; pg8::StaticOrder S; S.init(1024, NTOK, DM, F.G, (int)blockIdx.x);
      EpiProjT E{(bf16*)(ws + WS_T)}; GEMM_PHASE(EpiProjT, pg8::StaticOrder, g, S, E); }
}
DI void fast_br(Frame& F, const Args& a) {
    unsigned char* ws = F.ws; bf16* PROJ = (bf16*)(ws + WS_PROJ); const bf16* RS = (const bf16*)((unsigned char*)F.out + DO_RS);
    pg8::StaticOrder S; S.init(NTOK, DM, DM, F.G, (int)blockIdx.x);
    pg8::Gemm g{RS, (const bf16*)(ws + WS_WBR1), DM, DM}; EpiBr E{PROJ}; GEMM_PHASE(EpiBr, pg8::StaticOrder, g, S, E);
}
DI void fast_wout(Frame& F, const Args& a) {
    unsigned char* ws = F.ws;
    pg8::Gemm g{(const bf16*)(ws + WS_PROJ) + C_MG, (const bf16*)(ws + WS_WOUT), NMAIN, DM}; pg8::StaticOrder S; S.init(NTOK, DM, DM, F.G, (int)blockIdx.x);
    EpiWout E{F.x, (bf16*)((unsigned char*)F.out + DO_X1)}; GEMM_PHASE(EpiWout, pg8::StaticOrder, g, S, E);
}
DI void fast_gu(Frame& F, const Args& a) {
    LAS int* pst = (LAS int*)(F.lds + LDSCTL_OFF);
    expert_table(F, pst);
    unsigned char* ws = F.ws;
    pg8::Gemm g{(const bf16*)(ws + WS_XB), (const bf16*)(ws + WS_WGU), DM, DM};
    MoeOrder S{pst, F.G, F.vcu, (size_t)1024 * 1024 * 2, (size_t)256 * DM * 2};
    EpiGu E{(bf16*)(ws + WS_HID)}; GEMM_PHASE(EpiGu, MoeOrder, g, S, E);
}
DI void fast_down(Frame& F, const Args& a) {
    LAS int* pst = (LAS int*)(F.lds + LDSCTL_OFF);
    expert_table(F, pst);
    unsigned char* ws = F.ws;
    pg8::Gemm g{(const bf16*)(ws + WS_HID), (const bf16*)(ws + WS_WD), DEXP, DEXP};
    MoeOrder S{pst, F.G, F.vcu, (size_t)1024 * 512 * 2, (size_t)256 * DEXP * 2};
    EpiDown E{(bf16*)(ws + WS_XB), (const float*)(ws + WS_ROUTE + RT_WROW)}; GEMM_PHASE(EpiDown, MoeOrder, g, S, E);
}
DI void fast_ple(Frame& F, const Args& a) {
    unsigned char* ws = F.ws;
    { int k256 = 256; asm volatile("" : "+s"(k256));
      pg8::Gemm g{(const bf16*)(ws + WS_PB), (const bf16*)(ws + WS_WPLE), 256, k256}; pg8::StaticOrder S; S.init(NTOK, DM, k256, F.G, (int)blockIdx.x);
      EpiPe E{(bf16*)(ws + WS_HID)}; GEMM_PHASE(EpiPe, pg8::StaticOrder, g, S, E); }
    { pg8::Gemm g{(const bf16*)(ws + WS_H2), (const bf16*)(ws + WS_WPG), DM, DM}; pg8::StaticOrder S; S.init(NTOK, DM, DM, F.G, (int)blockIdx.x);
      EpiPg E{(const bf16*)(ws + WS_HID), (const bf16*)(ws + WS_X2), F.out}; GEMM_PHASE(EpiPg, pg8::StaticOrder, g, S, E); }
}

#define MFMA32(a, b, c) __builtin_amdgcn_mfma_f32_32x32x16_bf16((a), (b), (c), 0, 0, 0)
DI int crow(int reg, int h) { return (reg & 3) + 8 * (reg >> 2) + 4 * h; }
DI bf16x8 ld16(const bf16* p) { return *(const bf16x8*)p; }
DI bf16x8 ld8x2(const bf16* p0, const bf16* p1) { const s16x4 lo = *(const s16x4*)p0, hi = *(const s16x4*)p1; return __builtin_shufflevector(lo, hi, 0, 1, 2, 3, 4, 5, 6, 7); }
template <int S> DI bf16x8 pack_step(const f32x16& x) { v4u p; p.x = cvtpk(x[8 * S], x[8 * S + 1]); p.y = cvtpk(x[8 * S + 2], x[8 * S + 3]); p.z = cvtpk(x[8 * S + 4], x[8 * S + 5]); p.w = cvtpk(x[8 * S + 6], x[8 * S + 7]); return __builtin_bit_cast(bf16x8, p); }
DI f32x16 splat16(float v) { f32x16 x;
#pragma unroll
    for (int i = 0; i < 16; ++i) x[i] = v; return x; }

#define SCHED_FENCE() __builtin_amdgcn_sched_barrier(0)
DI void fast_ret_kv(Frame& F, const Args& a) {
    const bf16* __restrict__ T = (const bf16*)(F.ws + WS_T); bf16* __restrict__ ST = (bf16*)((unsigned char*)F.out + DO_ST);
    const int lane = F.lane, r = lane & 31, h2 = lane >> 5, gw = F.vcu * NWAVES + F.wave, NGW = F.G * NWAVES;
    for (int it = gw; it < NBATCH * 4 * 64 * 4; it += NGW) {
        const int eb = it & 3, c = (it >> 2) & 63, hh = (it >> 8) & 3, b = it >> 10;
        const int tok0 = b * SEQ + c * 64;
        const bf16* vrow = T + (size_t)(T_VR + hh * 128 + eb * 32 + r) * NTOK + tok0 + 8 * h2;
        const bf16* krow = T + (size_t)(T_KT + hh * 128 + r) * NTOK + tok0 + 8 * h2;
        bf16x8 vb[4], ka[4][4];
#pragma unroll
        for (int ks = 0; ks < 4; ++ks) vb[ks] = ld16(vrow + 16 * ks);
#pragma unroll
        for (int db = 0; db < 4; ++db)
#pragma unroll
            for (int ks = 0; ks < 4; ++ks) ka[db][ks] = ld16(krow + (size_t)db * 32 * NTOK + 16 * ks);
        SCHED_FENCE();
        bf16* st = ST + ((size_t)((b * 4 + hh) * 64 + c)) * 16384 + (size_t)(eb * 32 + r) * 128 + 4 * h2;
#pragma unroll
        for (int db = 0; db < 4; ++db) {
            f32x16 acc = splat16(0.f);
#pragma unroll
            for (int ks = 0; ks < 4; ++ks) acc = MFMA32(ka[db][ks], vb[ks], acc);
#pragma unroll
            for (int g = 0; g < 4; ++g) { v2u w; w.x = cvtpk(acc[4 * g], acc[4 * g + 1]); w.y = cvtpk(acc[4 * g + 2], acc[4 * g + 3]); *(v2u*)(st + db * 32 + 8 * g) = w; }
        }
    }
}
DI void fast_ret_scan(Frame& F, const Args& a) {
    bf16* ST = (bf16*)((unsigned char*)F.out + DO_ST);
    for (int g = F.vcu * 512 + F.tid; g < NBATCH * 4 * 4096; g += F.G * 512) {
        const int bh = g >> 12, idx = (g & 4095) * 4;
        const float cdec = exp2f(ret_log2g(bh & 3) * 64.0f);
        bf16* p = ST + (size_t)bh * 64 * 16384 + idx;
        float s0 = 0.f, s1 = 0.f, s2 = 0.f, s3 = 0.f;
#pragma unroll 8
        for (int c = 0; c < 64; ++c) {
            const v2u w = *(const v2u*)(p + (size_t)c * 16384);
            v2u o; o.x = cvtpk(s0, s1); o.y = cvtpk(s2, s3); *(v2u*)(p + (size_t)c * 16384) = o;
            s0 = cdec * s0 + bflo(w.x); s1 = cdec * s1 + bfhi(w.x); s2 = cdec * s2 + bflo(w.y); s3 = cdec * s3 + bfhi(w.y);
        }
    }
}
DI void fast_ret_out(Frame& F, const Args& a) {
    const bf16* __restrict__ PROJ = (const bf16*)(F.ws + WS_PROJ); const bf16* __restrict__ T = (const bf16*)(F.ws + WS_T);
    const bf16* __restrict__ ST = (const bf16*)((unsigned char*)F.out + DO_ST); bf16* __restrict__ RS = (bf16*)((unsigned char*)F.out + DO_RS);
    const int lane = F.lane, r = lane & 31, h2 = lane >> 5, gw = F.vcu * NWAVES + F.wave, NGW = F.G * NWAVES;
    for (int it = gw; it < NBATCH * 4 * 64 * 2; it += NGW) {
        const int ib = it & 1, c = (it >> 1) & 63, hh = (it >> 7) & 3, b = it >> 9;
        const int tok0 = b * SEQ + c * 64;
        const float l2g = ret_log2g(hh);
        const bf16* qrow = PROJ + (size_t)(tok0 + ib * 32 + r) * NMAIN + C_RQ + hh * 128 + 8 * h2;
        const bf16* krow = PROJ + (size_t)(tok0 + r) * NMAIN + C_RK + hh * 128 + 8 * h2;
        const bf16* stb = ST + ((size_t)((b * 4 + hh) * 64 + c)) * 16384 + (size_t)r * 128 + 8 * h2;
        const bf16* vrow = T + (size_t)(T_VR + hh * 128 + r) * NTOK + tok0 + 4 * h2;
        const bf16* gp = PROJ + (size_t)(tok0 + ib * 32 + r) * NMAIN + C_RG + hh * 128 + 4 * h2;
        bf16x8 qf[8], kf0[8], kf1[8], sA[8], sB[8], vA[4], vB[4];
#define LD_ST(dst, eb) do { _Pragma("unroll") for (int ks = 0; ks < 8; ++ks) dst[ks] = ld16(stb + (size_t)(eb) * 32 * 128 + 16 * ks); } while (0)
#define LD_VT(dst, eb) do { const bf16* vr_ = vrow + (size_t)(eb) * 32 * NTOK; dst[0] = ld8x2(vr_, vr_ + 8); dst[1] = ld8x2(vr_ + 16, vr_ + 24); dst[2] = ld8x2(vr_ + 32, vr_ + 40); dst[3] = ld8x2(vr_ + 48, vr_ + 56); } while (0)
#define RET_EB(oacc, sfr, vfr) do { f32x16 acc_ = splat16(0.f); \
            _Pragma("unroll") for (int ks = 0; ks < 8; ++ks) acc_ = MFMA32(sfr[ks], qf[ks], acc_);         \
            _Pragma("unroll") for (int reg = 0; reg < 16; ++reg) acc_[reg] *= qd; \
            acc_ = MFMA32(vfr[0], pb[0][0], acc_); acc_ = MFMA32(vfr[1], pb[0][1], acc_); acc_ = MFMA32(vfr[2], pb[1][0], acc_); acc_ = MFMA32(vfr[3], pb[1][1], acc_); oacc = acc_; } while (0)
#pragma unroll
        for (int ks = 0; ks < 8; ++ks) qf[ks] = ld16(qrow + 16 * ks);
#pragma unroll
        for (int ks = 0; ks < 8; ++ks) { kf0[ks] = ld16(krow + 16 * ks); kf1[ks] = ld16(krow + (size_t)32 * NMAIN + 16 * ks); }
        LD_ST(sA, 0); LD_VT(vA, 0);
        SCHED_FENCE();
        f32x16 pt0 = splat16(0.f), pt1 = splat16(0.f);
#pragma unroll
        for (int ks = 0; ks < 8; ++ks) { pt0 = MFMA32(kf0[ks], qf[ks], pt0); pt1 = MFMA32(kf1[ks], qf[ks], pt1); }
        LD_ST(sB, 1); LD_VT(vB, 1);
        SCHED_FENCE();
        bf16x8 pb[2][2];
#pragma unroll
        for (int reg = 0; reg < 16; ++reg) {
            const int d0 = (ib * 32 + r) - crow(reg, h2), d1 = d0 - 32;
            pt0[reg] *= __builtin_amdgcn_exp2f(l2g * (float)(d0 < 0 ? -d0 : d0)); pt1[reg] *= __builtin_amdgcn_exp2f(l2g * (float)(d1 < 0 ? -d1 : d1));
        }
        pb[0][0] = pack_step<0>(pt0); pb[0][1] = pack_step<1>(pt0); pb[1][0] = pack_step<0>(pt1); pb[1][1] = pack_step<1>(pt1);
        const float qd = __builtin_amdgcn_exp2f(l2g * (float)(ib * 32 + r + 1));
        f32x16 o[4];
        RET_EB(o[0], sA, vA);
        LD_ST(sA, 2); LD_VT(vA, 2);
        SCHED_FENCE();
        RET_EB(o[1], sB, vB);
        LD_ST(sB, 3); LD_VT(vB, 3);
        SCHED_FENCE();
        RET_EB(o[2], sA, vA);
        v2u gate[16];
#pragma unroll
        for (int q = 0; q < 16; ++q) gate[q] = *(const v2u*)(gp + (q >> 2) * 32 + 8 * (q & 3));
        SCHED_FENCE();
        RET_EB(o[3], sB, vB);
#undef LD_ST
#undef LD_VT
#undef RET_EB
        float s = 0.f;
#pragma unroll
        for (int eb = 0; eb < 4; ++eb)
#pragma unroll
            for (int reg = 0; reg < 16; ++reg) s += o[eb][reg];
        s += __shfl_xor(s, 32);
        const float mu = s * (1.0f / 128.0f); float v = 0.f;
#pragma unroll
        for (int eb = 0; eb < 4; ++eb)
#pragma unroll
            for (int reg = 0; reg < 16; ++reg) { const float d = o[eb][reg] - mu; v += d * d; }
        v += __shfl_xor(v, 32);
        const float rstd = rsqrtf(v * (1.0f / 128.0f) + EPS);
        bf16* rp = RS + (size_t)(tok0 + ib * 32 + r) * DM + hh * 128 + 4 * h2;
#pragma unroll
        for (int eb = 0; eb < 4; ++eb)
#pragma unroll
            for (int g = 0; g < 4; ++g) {
                const v2u gt = gate[eb * 4 + g];
                v2u w;
                w.x = cvtpk((o[eb][4 * g] - mu) * rstd * bflo(gt.x), (o[eb][4 * g + 1] - mu) * rstd * bfhi(gt.x));
                w.y = cvtpk((o[eb][4 * g + 2] - mu) * rstd * bflo(gt.y), (o[eb][4 * g + 3] - mu) * rstd * bfhi(gt.y));
                *(v2u*)(rp + eb * 32 + 8 * g) = w;
            }
    }
}

DI void fast_att(Frame& F, const Args& a) {
    const bf16* __restrict__ PROJ = (const bf16*)(F.ws + WS_PROJ); const bf16* __restrict__ T = (const bf16*)(F.ws + WS_T); bf16* __restrict__ RS = (bf16*)((unsigned char*)F.out + DO_RS);
    const int lane = F.lane, r = lane & 31, h2 = lane >> 5, gw = F.vcu * NWAVES + F.wave, NGW = F.G * NWAVES;
    bf16x8 tri0, tri1, ones;
#pragma unroll
    for (int j = 0; j < 8; ++j) { const int k0 = 8 * (j >> 2) + 4 * h2 + (j & 3); tri0[j] = (k0 > r) ? (short)0x3F80 : (short)0; tri1[j] = (16 + k0 > r) ? (short)0x3F80 : (short)0; ones[j] = (short)0x3F80; }
    for (int it = gw; it < NBATCH * 8 * 128; it += NGW) {
        const int qb = it & 127, hh = (it >> 7) & 7, b = it >> 10;
        const int q0 = qb * 32, tokq = b * SEQ + q0 + r;
        const bf16* qrow = PROJ + (size_t)tokq * NMAIN + C_SQ + hh * 64 + 8 * h2;
        const bf16* kbase = PROJ + (size_t)(b * SEQ + r) * NMAIN + C_SK + hh * 64 + 8 * h2;
        const bf16* vbase = T + (size_t)(T_VS + hh * 64 + r) * NTOK + b * SEQ + 4 * h2;
        const int ktd = q0 >> 6;
        bf16x8 qf[4], kA[8], vB[8];
#pragma unroll
        for (int ks = 0; ks < 4; ++ks) qf[ks] = ld16(qrow + 16 * ks);
#pragma unroll
        for (int ks = 0; ks < 4; ++ks) { kA[ks] = ld16(kbase + (size_t)(ktd * 64) * NMAIN + 16 * ks); kA[4 + ks] = ld16(kbase + (size_t)(ktd * 64 + 32) * NMAIN + 16 * ks); }
        f32x16 o0 = splat16(0.f), o1 = splat16(0.f);
        float carry = 0.f;
        for (int kt = ktd; kt >= 0; --kt) {
            const int key0 = kt * 64;
            const bool diag = (kt == ktd);
            {
                const bf16* v0row = vbase + key0; const bf16* v1row = v0row + (size_t)32 * NTOK;
#pragma unroll
                for (int q = 0; q < 4; ++q) { vB[q] = ld8x2(v0row + 16 * q, v0row + 16 * q + 8); vB[4 + q] = ld8x2(v1row + 16 * q, v1row + 16 * q + 8); }
            }
            SCHED_FENCE();
            f32x16 p0 = splat16(0.f), p1 = splat16(0.f);
#pragma unroll
            for (int ks = 0; ks < 4; ++ks) { p0 = MFMA32(kA[ks], qf[ks], p0); p1 = MFMA32(kA[4 + ks], qf[ks], p1); }
            {
                const int kn = (kt > 0 ? kt - 1 : 0) * 64;
#pragma unroll
                for (int ks = 0; ks < 4; ++ks) { kA[ks] = ld16(kbase + (size_t)kn * NMAIN + 16 * ks); kA[4 + ks] = ld16(kbase + (size_t)(kn + 32) * NMAIN + 16 * ks); }
            }
            SCHED_FENCE();
            f32x16 l0, l1;
#pragma unroll
            for (int reg = 0; reg < 16; ++reg) {
                const float z0 = fminf(p0[reg], 100.0f), z1 = fminf(p1[reg], 100.0f);
                float a0 = -__builtin_amdgcn_logf(1.0f + __builtin_amdgcn_exp2f(z0)), a1 = -__builtin_amdgcn_logf(1.0f + __builtin_amdgcn_exp2f(z1));
                float b0 = z0 + a0, b1 = z1 + a1;
                if (diag) {
                    const bool v0 = (key0 + crow(reg, h2)) < (q0 + r), v1 = (key0 + 32 + crow(reg, h2)) < (q0 + r);
                    a0 = v0 ? a0 : 0.f; b0 = v0 ? b0 : -1.0e30f; a1 = v1 ? a1 : 0.f; b1 = v1 ? b1 : -1.0e30f;
                }
                l0[reg] = a0; l1[reg] = a1; p0[reg] = b0; p1[reg] = b1;
            }
            f32x16 y0 = splat16(carry), y1 = y0;
            {
                const bf16x8 x00 = pack_step<0>(l0), x01 = pack_step<1>(l0), x10 = pack_step<0>(l1), x11 = pack_step<1>(l1);
                y0 = MFMA32(tri0, x00, y0); y0 = MFMA32(tri1, x01, y0); y0 = MFMA32(ones, x10, y0); y0 = MFMA32(ones, x11, y0);
                y1 = MFMA32(tri0, x10, y1); y1 = MFMA32(tri1, x11, y1);
            }
            const float tot = y0[0] + l0[0];
            carry = __shfl(tot, r);
#pragma unroll
            for (int reg = 0; reg < 16; ++reg) { p0[reg] = __builtin_amdgcn_exp2f(p0[reg] + y0[reg]); p1[reg] = __builtin_amdgcn_exp2f(p1[reg] + y1[reg]); }
            {
                const bf16x8 a00 = pack_step<0>(p0), a01 = pack_step<1>(p0), a10 = pack_step<0>(p1), a11 = pack_step<1>(p1);
                o0 = MFMA32(vB[0], a00, o0); o0 = MFMA32(vB[1], a01, o0); o0 = MFMA32(vB[2], a10, o0); o0 = MFMA32(vB[3], a11, o0);
                o1 = MFMA32(vB[4], a00, o1); o1 = MFMA32(vB[5], a01, o1); o1 = MFMA32(vB[6], a10, o1); o1 = MFMA32(vB[7], a11, o1);
            }
            if (__all(carry < SB_EXIT)) break;
        }
        bf16* op = RS + (size_t)tokq * DM + 512 + hh * 64 + 4 * h2;
#pragma unroll
        for (int g = 0; g < 4; ++g) {
            v2u w; w.x = cvtpk(o0[4 * g], o0[4 * g + 1]); w.y = cvtpk(o0[4 * g + 2], o0[4 * g + 3]); *(v2u*)(op + 8 * g) = w;
            v2u u; u.x = cvtpk(o1[4 * g], o1[4 * g + 1]); u.y = cvtpk(o1[4 * g + 2], o1[4 * g + 3]); *(v2u*)(op + 32 + 8 * g) = u;
        }
    }
}

__global__ void __launch_bounds__(NWAVES * 64, 2) mega(Args args) {
    extern __shared__ __attribute__((aligned(16))) unsigned char lds[];
    Frame F;
    F.lds = (LAS unsigned char*)lds;
    F.MISC = (volatile LAS unsigned*)(F.lds + MISC_OFF);
    F.refresh();
    F.G = gridDim.x; { const int bx = blockIdx.x; F.vcu = (F.G % 8 == 0) ? (bx % 8) * (F.G / 8) + bx / 8 : bx; }
    F.ws = args.ws; F.out = args.out; F.x = args.in[0]; F.p = args.in[1];
    F.ctl = (gu32*)(args.ws + WS_CTL);
    for (int u = F.tid; u < (LDS_BYTES - LDSCTL_OFF) / 4; u += NWAVES * 64) ((LAS unsigned*)(F.lds + LDSCTL_OFF))[u] = 0u;
    __syncthreads();
    const int lo = args.ph_lo, hi = args.ph_hi;
    XcdBarrier bar; bar.bar = (unsigned*)(F.ctl + CW_BAR) + args.li * BAR_STRIDE; bar.x = 0; bar.st = nullptr;
    if (hi - lo > 1) bar = xcd_barrier_post((unsigned*)(F.ctl + CW_BAR) + args.li * BAR_STRIDE, F.MISC + 8);
#define IN(k) (F.refresh(), lo <= (k) && (k) < hi)
#define DUP(k) ((DUP_MASK >> (k)) & 1)
#define SEAM(k) do { if (IN(k) && IN((k) + 1)) xcd_barrier(bar); } while (0)
#define REP(k, body) do { body; if (DUP(k)) { F.refresh(); body; } } while (0)

    if (DUP(16) && hi - lo > 1) { for (int i = 0; i < 10; ++i) xcd_barrier(bar); }
    if (IN(PH_PRO)) { REP(PH_PRO, ph_prologue(F, args)); } SEAM(PH_PRO);
    if (IN(PH_PROJ)) { REP(PH_PROJ, fast_proj(F, args)); } SEAM(PH_PROJ);
    if (IN(PH_MIX1)) { REP(14, fast_ret_kv(F, args)); REP(15, fast_att(F, args)); } SEAM(PH_MIX1);
    if (IN(PH_SCAN)) { fast_ret_scan(F, args); } SEAM(PH_SCAN);
    if (IN(PH_RETO)) { REP(PH_RETO, fast_ret_out(F, args)); } SEAM(PH_RETO);
    if (IN(PH_BR)) { REP(PH_BR, fast_br(F, args)); } SEAM(PH_BR);
    if (IN(PH_WOUT)) { REP(PH_WOUT, fast_wout(F, args)); } SEAM(PH_WOUT);
    if (IN(PH_ROUTE)) { ph_route(F, args); } SEAM(PH_ROUTE);
    if (IN(PH_GATHER)) { REP(PH_GATHER, ph_gather(F, args)); } SEAM(PH_GATHER);
    if (IN(PH_GU)) { REP(PH_GU, fast_gu(F, args)); } SEAM(PH_GU);
    if (IN(PH_DOWN)) { REP(PH_DOWN, fast_down(F, args)); } SEAM(PH_DOWN);
    if (IN(PH_COMB)) { REP(PH_COMB, ph_combine(F, args)); } SEAM(PH_COMB);
    if (IN(PH_PLE)) { REP(PH_PLE, fast_ple(F, args)); } SEAM(PH_PLE);
    if (IN(PH_FINAL)) { ph_final(F, args); }
#undef IN
#undef SEAM
}

extern "C" void kernel_launch(void* const* d_in, const int* in_sizes, int n_in, void* d_out, int out_size, void* d_ws, size_t ws_size, hipStream_t stream) {
    static int grid = 0;
    if (grid == 0) {
        if (n_in != 20 || in_sizes[0] != NTOK * DM || out_size != NTOK * DM || ws_size < WS_END) { fprintf(stderr, "kernel_launch: unexpected shapes (n_in %d, in0 %d, out %d, ws %zu)\n", n_in, n_in > 0 ? in_sizes[0] : -1, out_size, ws_size); grid = -1; return; }
        int dev = 0, cus = 0, per_cu = 0;
        if (hipGetDevice(&dev) != hipSuccess || hipDeviceGetAttribute(&cus, hipDeviceAttributeMultiprocessorCount, dev) != hipSuccess) { grid = -1; return; }
        if (hipFuncSetAttribute((const void*)mega, hipFuncAttributeMaxDynamicSharedMemorySize, LDS_BYTES) != hipSuccess) { fprintf(stderr, "kernel_launch: hipFuncSetAttribute failed\n"); grid = -1; return; }
        if (hipOccupancyMaxActiveBlocksPerMultiprocessor(&per_cu, (const void*)mega, NWAVES * 64, LDS_BYTES) != hipSuccess || per_cu < 1) fprintf(stderr, "kernel_launch: occupancy query reports %d\n", per_cu);
        (void)hipGetLastError();
        grid = cus;
    }
    if (grid < 0) return;
    unsigned char* ws = (unsigned char*)d_ws;
    if (hipMemsetAsync(ws + WS_CTL, 0, CTL_ZERO_BYTES, stream) != hipSuccess) return;
    Args a{};
    for (int i = 0; i < 20; ++i) a.in[i] = (const float*)d_in[i];
    a.out = (float*)d_out; a.ws = ws;
#if SPLIT_PHASES
    for (int p = 0; p < NPH; ++p) { a.ph_lo = p; a.ph_hi = p + 1; a.li = 0; hipLaunchKernelGGL(mega, dim3(grid), dim3(NWAVES * 64), LDS_BYTES, stream, a); }
#else
    a.ph_lo = 0; a.ph_hi = NPH; a.li = 0;
    hipLaunchKernelGGL(mega, dim3(grid), dim3(NWAVES * 64), LDS_BYTES, stream, a);
#endif
}
```

```cpp
#define DUP_MASK 0
#include <hip/hip_runtime.h>
#include <cstdio>
#include <cstdint>

#ifndef SPLIT_PHASES
#define SPLIT_PHASES 0
#endif
#ifndef DUP_MASK
#define DUP_MASK 0
#endif

constexpr int NTOK = 32768, DM = 1024, SEQ = 4096, NBATCH = 8;
constexpr int NMAIN = 4608, NTR = 1536, NWIN = 5632;
constexpr int C_RQ = 0, C_RK = 512, C_RG = 1024, C_SQ = 1536, C_SK = 2048, C_GR = 2560, C_GS = 3584;
constexpr int C_MG = 0;
constexpr int T_KT = 0, T_VR = 512, T_VS = 1024;
constexpr int NEXP = 16, DEXP = 512, MPAD_MAX = 65536 + 16 * 256, NRT_MAX = MPAD_MAX / 256;
constexpr float EPS = 1e-6f;
constexpr float LOG2E = 1.4426950408889634f;
constexpr float SB_QSCALE = 0.125f * LOG2E;
constexpr float SB_EXIT = -152.0f;

constexpr size_t MiB = 1u << 20;
constexpr size_t WS_CTL = 0, CTL_ZERO_BYTES = 1 * MiB;
constexpr size_t WS_WIN = 2 * MiB;
constexpr size_t WS_WBR1 = 14 * MiB;
constexpr size_t WS_WBR2 = 15 * MiB;
constexpr size_t WS_WOUT = 16 * MiB;
constexpr size_t WS_WGU = 18 * MiB;
constexpr size_t WS_WD = 50 * MiB;
constexpr size_t WS_WPLE = 66 * MiB;
constexpr size_t WS_WPG = 67 * MiB;
constexpr size_t WS_TABA = 70 * MiB;
constexpr size_t WS_RW = 72 * MiB;
constexpr size_t WS_ROUTE = 74 * MiB;
constexpr size_t WS_PB = 76 * MiB;
constexpr size_t WS_PROJ = 92 * MiB;
constexpr size_t WS_T = 380 * MiB;
constexpr size_t WS_X2 = 360 * MiB;
constexpr size_t WS_END = 488 * MiB;
constexpr size_t WS_H2 = 92 * MiB;
constexpr size_t WS_LTOK = 92 * MiB, WS_LW = 94 * MiB, WS_LRS = 96 * MiB;
constexpr size_t WS_XB = 156 * MiB;
constexpr size_t WS_HID = 292 * MiB;
constexpr size_t DO_HB = 0, DO_ST = 0, DO_X1 = 0, DO_RS = 64 * MiB;
constexpr size_t RT_EID = 0, RT_WGT = 256 * 1024, RT_RANK = 512 * 1024;
constexpr int CW_TMO = 0, CW_CODE = 1;
constexpr int CW_CNT = 64;
constexpr int CW_BAR = 4096, BAR_STRIDE = 4096;

#define GAS __attribute__((address_space(1)))
#define LAS __attribute__((address_space(3)))
typedef unsigned short bf16;
typedef unsigned v4u __attribute__((ext_vector_type(4)));
typedef unsigned v2u __attribute__((ext_vector_type(2)));
typedef float f32x4 __attribute__((ext_vector_type(4)));
typedef float f32x2 __attribute__((ext_vector_type(2)));
typedef float f32x16 __attribute__((ext_vector_type(16)));
typedef short bf16x8 __attribute__((ext_vector_type(8)));
typedef short s16x4 __attribute__((ext_vector_type(4)));
typedef GAS unsigned gu32;
#define RLX_AGENT __ATOMIC_RELAXED, __HIP_MEMORY_SCOPE_AGENT
#define LDS_WAIT() asm volatile("s_waitcnt lgkmcnt(0)" ::: "memory")
#define VM_WAIT() asm volatile("s_waitcnt vmcnt(0)" ::: "memory")
#define DI __device__ __forceinline__
DI unsigned f2bf(float f) { unsigned u = __builtin_bit_cast(unsigned, f); return (u + 0x7fffu + ((u >> 16) & 1u)) >> 16; }
DI unsigned pk2(float lo, float hi) { return f2bf(lo) | (f2bf(hi) << 16); }
DI float bf2f(unsigned b) { return __builtin_bit_cast(float, b << 16); }
DI float bflo(unsigned w) { return __builtin_bit_cast(float, w << 16); }
DI float bfhi(unsigned w) { return __builtin_bit_cast(float, w & 0xffff0000u); }
DI float fsigmoid(float x) { return 1.0f / (1.0f + __expf(-x)); }
DI float fsilu(float x) { return x / (1.0f + __expf(-x)); }
DI float wave_sum(float v) {
#pragma unroll
    for (int o = 1; o < 64; o <<= 1) v += __shfl_xor(v, o);
    return v;
}
template <int CTRL, int ROWMASK> DI float dpp_add(float v) { return v + __builtin_bit_cast(float, __builtin_amdgcn_update_dpp(0, __builtin_bit_cast(int, v), CTRL, ROWMASK, 0xF, false)); }
DI float wave_sum_dpp(float v) {
    v = dpp_add<0xB1, 0xF>(v);
    v = dpp_add<0x4E, 0xF>(v);
    v = dpp_add<0x141, 0xF>(v);
    v = dpp_add<0x140, 0xF>(v);
    v = dpp_add<0x142, 0xA>(v);
    v = dpp_add<0x143, 0xC>(v);
    return __builtin_bit_cast(float, __builtin_amdgcn_readlane(__builtin_bit_cast(int, v), 63));
}
DI float ret_log2g(int h) { return log2f(1.0f - exp2f(-5.0f - (float)h)); }

__host__ __device__ __forceinline__ int in_src(int r) {
    if (r < 1024) { const int base = (r < 512) ? 0 : 512; const int i = r & 511, h = i >> 7, j = i & 127; return base + h * 128 + (j & 1) * 64 + (j >> 1); }
    if (r < 1536) return 1536 + (r - 1024);
    if (r < 2048) return 2048 + (r - 1536);
    if (r < 2560) return 2560 + (r - 2048);
    if (r < 3584) return 3584 + (r - 2560);
    if (r < 4608) return 4608 + (r - 3584);
    if (r < 5120) { const int i = r - 4608, h = i >> 7, j = i & 127; return 512 + h * 128 + (j & 1) * 64 + (j >> 1); }
    if (r < 5632) return 1024 + (r - 5120);
    return 3072 + (r - 5632);
}


#define MFMA32(a, b, c) __builtin_amdgcn_mfma_f32_32x32x16_bf16((a), (b), (c), 0, 0, 0)
DI int crow(int reg, int h) { return (reg & 3) + 8 * (reg >> 2) + 4 * h; }
DI bf16x8 ld16(const bf16* p) { return *(const bf16x8*)p; }
DI bf16x8 ld8x2(const bf16* p0, const bf16* p1) { const s16x4 lo = *(const s16x4*)p0, hi = *(const s16x4*)p1; return __builtin_shufflevector(lo, hi, 0, 1, 2, 3, 4, 5, 6, 7); }
DI f32x16 splat16(float v) { f32x16 x;
#pragma unroll
    for (int i = 0; i < 16; ++i) x[i] = v; return x; }

namespace pg8 {
#define PG8_LAS __attribute__((address_space(3)))
typedef unsigned short bf16_t;
typedef short bf16x8 __attribute__((ext_vector_type(8)));
typedef float f32x4 __attribute__((ext_vector_type(4)));
typedef unsigned u32x4 __attribute__((ext_vector_type(4)));
constexpr int BM = 256, BK = 64, HALF = 128, HTB = HALF * BK * 2  , STAGE_BYTES = 8 * HTB, NXCD = 8, WGM = 8;

__host__ __device__ __forceinline__ int lds_byte(int r, int c) { const int st = (r >> 4) * 2 + (c >> 5), rr = r & 15, cc = c & 31, ob = rr * 64 + cc * 2; return st * 1024 + (ob ^ (((ob >> 9) & 1) << 5)); }
__host__ __device__ __forceinline__ void stage_rc(int b, int& R, int& C) { const int st = b / 1024, sb = b % 1024, swz = sb ^ (((sb >> 9) & 1) << 5); R = (st >> 1) * 16 + swz / 64; C = (st & 1) * 32 + (swz % 64) / 2; }
__host__ __device__ __forceinline__ int perm32(int rho) { const int n = rho >> 4, i = rho & 15; return 8 * (i >> 2) + 4 * n + (i & 3); }

struct Unit { int pm, pn; size_t bofs; int ex; };
struct Gemm { const bf16_t* A; const bf16_t* Bt; int lda, K; };

struct StaticOrder {
    static constexpr bool GATHER = false;
    int nM, nN, nwg, G, c; size_t tstepB;
    __device__ __forceinline__ unsigned arow_off(const Unit&, int) const { return 0u; }
    __device__ void init(int M, int N, int K, int G_, int c_) { nM = M / BM; nN = N / BM; nwg = nM * nN; G = G_; c = c_; tstepB = (size_t)BM * K * 2; }
    __device__ bool next(int i, Unit& u) const {
        const long L = (long)i * G + c; if (L >= nwg) return false;
        int wgid = (int)L; { const int q = nwg / NXCD, r = nwg % NXCD, xcd = wgid % NXCD, off = wgid / NXCD; wgid = (xcd < r ? xcd * (q + 1) : r * (q + 1) + (xcd - r) * q) + off; }
        const int nig = WGM * nN, gid = wgid / nig, fm = gid * WGM, gsz = (nM - fm) < WGM ? (nM - fm) : WGM;
        u.pm = fm + ((wgid % nig) % gsz); u.pn = (wgid % nig) / gsz; u.bofs = (size_t)u.pn * tstepB; u.ex = 0; return true;
    }
    __device__ __forceinline__ void a_ready(const Unit&) const {}
    __device__ __forceinline__ void done(const Unit&) const {}
};
__device__ __forceinline__ unsigned cvt_pk_bf16(float lo, float hi) { unsigned r; asm volatile("v_cvt_pk_bf16_f32 %0, %1, %2" : "=v"(r) : "v"(lo), "v"(hi)); return r; }
template <class Epi, class Sched, bool ALIGN_EPI = false, bool SP2 = false>
__device__ __forceinline__ void gemm_phase(PG8_LAS unsigned char* lds, const Gemm g, const Sched& S, const Epi& E) {
    int tid_ = threadIdx.x; asm volatile("" : "+v"(tid_));
    const int tid = tid_, wid = __builtin_amdgcn_readfirstlane(tid >> 6), lane = tid & 63, wr = wid >> 2, wc = wid & 3, fr = lane & 15, fq = lane >> 4;
    const int K = g.K, nt = K / BK;
    unsigned voffA[2], voffB[2];
#pragma unroll
    for (int i = 0; i < 2; ++i) { int R, C; stage_rc(tid * 16 + i * 8192, R, C); const int Rb = Epi::PERM ? ((R & ~31) + perm32(R & 31)) : R;
        voffA[i] = (unsigned)(R * g.lda + C) * 2u; voffB[i] = (unsigned)(Rb * K + C) * 2u; }
    constexpr bool GATH = Sched::GATHER;
    static_assert(!GATH || SP2, "gather mode is written for the SP2 loop only");
    int gR[2]; unsigned gC[2];
#pragma unroll
    for (int i = 0; i < 2; ++i) { int R, C; stage_rc(tid * 16 + i * 8192, R, C); gR[i] = R; gC[i] = (unsigned)C * 2u; }
    unsigned voffC0[2] = {0u, 0u}, voffC1[2] = {0u, 0u}, voffN0[2] = {0u, 0u}, voffN1[2] = {0u, 0u};
    const size_t kstep = (size_t)(BK * 2);
    const size_t hstepA = (size_t)HALF * g.lda * 2, hstepB = (size_t)HALF * K * 2;
    const size_t tstepA = 2 * hstepA;
    const unsigned ldsw = (unsigned)wid * 1024u;
    const int aoff = lds_byte(wr * 64 + fr, fq * 8), boff = lds_byte(wc * 32 + fr, fq * 8);
#define PG8_SA(b, h) (((b) * 2 + (h)) * HTB)
#define PG8_SB(b, h) ((4 + (b) * 2 + (h)) * HTB)
#define PG8_STAGE(bufoff, gbase, voff) do { _Pragma("unroll") for (int _i = 0; _i < 2; ++_i) \
        __builtin_amdgcn_global_load_lds((const unsigned*)((const char*)(gbase) + (voff)[_i]), (PG8_LAS unsigned*)(lds + (bufoff) + ldsw + _i * 8192), 16, 0, 0); } while (0)
#define PG8_STAGE_A(bufoff, gbase, half, nextu) do { if constexpr (!GATH) { PG8_STAGE(bufoff, (gbase) + ((half) ? hstepA : (size_t)0), voffA); } else { _Pragma("unroll") for (int _i = 0; _i < 2; ++_i) { \
        const unsigned _o = (nextu) ? ((half) ? voffN1[_i] : voffN0[_i]) : ((half) ? voffC1[_i] : voffC0[_i]); \
        __builtin_amdgcn_global_load_lds((const unsigned*)((const char*)(gbase) + _o), (PG8_LAS unsigned*)(lds + (bufoff) + ldsw + _i * 8192), 16, 0, 0); } } } while (0)
#define PG8_GOFFS(u, d0, d1) do { _Pragma("unroll") for (int _i = 0; _i < 2; ++_i) { d0[_i] = S.arow_off(u, gR[_i]) + gC[_i]; d1[_i] = S.arow_off(u, 128 + gR[_i]) + gC[_i]; } } while (0)
#define PG8_LDA(dst, b, h) do { _Pragma("unroll") for (int m = 0; m < 4; ++m) _Pragma("unroll") for (int k = 0; k < 2; ++k) dst[m][k] = *(const PG8_LAS bf16x8*)(lds + PG8_SA(b, h) + aoff + m * 2048 + k * 1024); } while (0)
#define PG8_LDB(dst, b, h) do { _Pragma("unroll") for (int n = 0; n < 2; ++n) _Pragma("unroll") for (int k = 0; k < 2; ++k) dst[n][k] = *(const PG8_LAS bf16x8*)(lds + PG8_SB(b, h) + boff + n * 2048 + k * 1024); } while (0)
#define PG8_MMA(ai, bj, At, Bt) do { __builtin_amdgcn_s_setprio(1); _Pragma("unroll") for (int m = 0; m < 4; ++m) _Pragma("unroll") for (int n = 0; n < 2; ++n) _Pragma("unroll") for (int k = 0; k < 2; ++k) \
        acc[ai][bj][m][n] = __builtin_amdgcn_mfma_f32_16x16x32_bf16(Bt[n][k], At[m][k], acc[ai][bj][m][n], 0, 0, 0); __builtin_amdgcn_s_setprio(0); } while (0)
#define PG8_WAIT_V(n) asm volatile("s_waitcnt vmcnt(" #n ")" ::: "memory")
#define PG8_WAIT_L(n) asm volatile("s_waitcnt lgkmcnt(" #n ")" ::: "memory")
#define PG8_BAR __builtin_amdgcn_s_barrier()
#define PG8_SCHED __builtin_amdgcn_sched_barrier(0)
    Unit cur, nxt; int ui = 0;
    if (!S.next(0, cur)) return;
    f32x4 acc[2][2][4][2];
#pragma unroll
    for (int a = 0; a < 2; ++a)
#pragma unroll
        for (int b = 0; b < 2; ++b)
#pragma unroll
            for (int m = 0; m < 4; ++m)
#pragma unroll
                for (int n = 0; n < 2; ++n) acc[a][b][m][n] = (f32x4){0.f, 0.f, 0.f, 0.f};
    bf16x8 At[4][2], B0[2][2], B1[2][2];
    const char* cA = (const char*)g.A + (GATH ? (size_t)0 : (size_t)cur.pm * tstepA); const char* cB = (const char*)g.Bt + cur.bofs;
    if constexpr (GATH) PG8_GOFFS(cur, voffC0, voffC1);
    S.a_ready(cur);
    if constexpr (SP2) {
        PG8_STAGE(PG8_SB(0, 0), cB, voffB); PG8_STAGE(PG8_SB(0, 1), cB + hstepB, voffB); PG8_STAGE_A(PG8_SA(0, 0), cA, 0, false); PG8_STAGE_A(PG8_SA(0, 1), cA, 1, false);
        if (wr == 1) PG8_BAR;
        PG8_WAIT_V(2); PG8_BAR;
        PG8_STAGE(PG8_SB(1, 0), cB + kstep, voffB); PG8_STAGE_A(PG8_SA(1, 0), cA + kstep, 0, false); PG8_STAGE(PG8_SB(1, 1), cB + hstepB + kstep, voffB);
        PG8_WAIT_V(6); PG8_BAR;
    } else {
        PG8_STAGE(PG8_SB(0, 0), cB, voffB); PG8_STAGE(PG8_SA(0, 0), cA, voffA); PG8_STAGE(PG8_SB(0, 1), cB + hstepB, voffB); PG8_STAGE(PG8_SA(0, 1), cA + hstepA, voffA);
        if (wr == 1) PG8_BAR;
        PG8_WAIT_V(4); PG8_BAR;
        PG8_STAGE(PG8_SB(1, 0), cB + kstep, voffB); PG8_STAGE(PG8_SA(1, 0), cA + kstep, voffA); PG8_STAGE(PG8_SB(1, 1), cB + hstepB + kstep, voffB);
        PG8_WAIT_V(6); PG8_BAR;
    }
    for (;;) {
        const bool has_next = S.next(ui + 1, nxt);
        const char* nA = has_next ? (const char*)g.A + (GATH ? (size_t)0 : (size_t)nxt.pm * tstepA) : cA; const char* nB = has_next ? (const char*)g.Bt + nxt.bofs : cB;
        if constexpr (GATH) { if (has_next) PG8_GOFFS(nxt, voffN0, voffN1); }
        const bool nu = GATH && has_next;
        for (int th = 0; th < (Epi::MIDK > 0 ? 2 : 1); ++th) {
        if constexpr (Epi::MIDK > 0) { if (th == 1) E.mid(acc, cur, wr, wc, fr, fq); }
        const int t_lo = (Epi::MIDK > 0 && th == 1) ? Epi::MIDK : 0, t_hi = (Epi::MIDK > 0 && th == 0) ? Epi::MIDK : nt;
        for (int t = t_lo; t < t_hi; t += 2) {
            const bool last = (t == nt - 2);
            const char* a1 = cA + (size_t)(t + 1) * kstep;
            const char* a2 = last ? nA : cA + (size_t)(t + 2) * kstep; const char* b2 = last ? nB : cB + (size_t)(t + 2) * kstep;
            const char* a3 = a2 + kstep; const char* b3 = b2 + kstep;
            if (last && has_next) S.a_ready(nxt);
            if constexpr (SP2) {
            PG8_LDB(B0, 0, 0); PG8_LDB(B1, 0, 1); PG8_SCHED; PG8_LDA(At, 0, 0); PG8_STAGE_A(PG8_SA(1, 1), a1, 1, false);
            PG8_WAIT_V(8); PG8_WAIT_L(0); PG8_BAR; PG8_MMA(0, 0, At, B0); PG8_MMA(0, 1, At, B1); PG8_BAR; PG8_SCHED;
            PG8_LDA(At, 0, 1); PG8_STAGE(PG8_SB(0, 0), b2, voffB); PG8_STAGE(PG8_SB(0, 1), b2 + hstepB, voffB); PG8_STAGE_A(PG8_SA(0, 0), a2, 0, last && nu);
            PG8_WAIT_V(8); PG8_WAIT_L(0); PG8_BAR; PG8_MMA(1, 0, At, B0); PG8_MMA(1, 1, At, B1); PG8_BAR; PG8_SCHED;
            PG8_LDB(B0, 1, 0); PG8_LDB(B1, 1, 1); PG8_SCHED; PG8_LDA(At, 1, 0); PG8_STAGE_A(PG8_SA(0, 1), a2, 1, last && nu);
            PG8_WAIT_V(8); PG8_WAIT_L(0); PG8_BAR; PG8_MMA(0, 0, At, B0); PG8_MMA(0, 1, At, B1); PG8_BAR; PG8_SCHED;
            PG8_LDA(At, 1, 1); PG8_STAGE(PG8_SB(1, 0), b3, voffB); PG8_STAGE(PG8_SB(1, 1), b3 + hstepB, voffB); PG8_STAGE_A(PG8_SA(1, 0), a3, 0, last && nu);
            PG8_WAIT_V(8); PG8_WAIT_L(0); PG8_BAR; PG8_MMA(1, 0, At, B0); PG8_MMA(1, 1, At, B1); PG8_BAR; PG8_SCHED;
            } else {
            PG8_LDB(B0, 0, 0); PG8_SCHED; PG8_LDA(At, 0, 0); PG8_STAGE(PG8_SA(1, 1), a1 + hstepA, voffA);
            PG8_WAIT_L(8); PG8_BAR; PG8_WAIT_L(0); PG8_MMA(0, 0, At, B0); PG8_BAR; PG8_SCHED;
            PG8_LDB(B1, 0, 1); PG8_STAGE(PG8_SB(0, 0), b2, voffB);
            PG8_BAR; PG8_WAIT_L(0); PG8_MMA(0, 1, At, B1); PG8_BAR;
            PG8_LDA(At, 0, 1); PG8_STAGE(PG8_SA(0, 0), a2, voffA);
            PG8_BAR; PG8_WAIT_L(0); PG8_MMA(1, 0, At, B0); PG8_BAR; PG8_SCHED;
            PG8_STAGE(PG8_SB(0, 1), b2 + hstepB, voffB);
            PG8_WAIT_V(6); PG8_BAR; PG8_MMA(1, 1, At, B1); PG8_BAR;
            PG8_LDB(B0, 1, 0); PG8_SCHED; PG8_LDA(At, 1, 0); PG8_STAGE(PG8_SA(0, 1), a2 + hstepA, voffA);
            PG8_WAIT_L(8); PG8_BAR; PG8_WAIT_L(0); PG8_MMA(0, 0, At, B0); PG8_BAR; PG8_SCHED;
            PG8_LDB(B1, 1, 1); PG8_STAGE(PG8_SB(1, 0), b3, voffB);
            PG8_BAR; PG8_WAIT_L(0); PG8_MMA(0, 1, At, B1); PG8_BAR;
            PG8_LDA(At, 1, 1); PG8_STAGE(PG8_SA(1, 0), a3, voffA);
            PG8_BAR; PG8_WAIT_L(0); PG8_MMA(1, 0, At, B0); PG8_BAR; PG8_SCHED;
            PG8_STAGE(PG8_SB(1, 1), b3 + hstepB, voffB);
            PG8_WAIT_V(6); PG8_BAR; PG8_MMA(1, 1, At, B1); PG8_BAR;
            }
        }
        }
        if constexpr (ALIGN_EPI) { if (wr == 0) PG8_BAR; }
        if constexpr (!Epi::AFTER_DRAIN) { E(acc, cur, wr, wc, fr, fq); S.done(cur); }
        if (!has_next) break;
#pragma unroll
        for (int a = 0; a < 2; ++a)
#pragma unroll
            for (int b = 0; b < 2; ++b)
#pragma unroll
                for (int m = 0; m < 4; ++m)
#pragma unroll
                    for (int n = 0; n < 2; ++n) acc[a][b][m][n] = (f32x4){0.f, 0.f, 0.f, 0.f};
        cur = nxt; cA = nA; cB = nB; ++ui;
        if constexpr (GATH) { _Pragma("unroll") for (int _i = 0; _i < 2; ++_i) { voffC0[_i] = voffN0[_i]; voffC1[_i] = voffN1[_i]; } }
        if constexpr (ALIGN_EPI) { if (wr == 1) PG8_BAR; }
    }
    PG8_WAIT_V(0);
    if constexpr (!ALIGN_EPI) { if (wr == 0) PG8_BAR; }
    PG8_BAR;
    if constexpr (Epi::AFTER_DRAIN) { E.fused(acc, cur, wr, wc, fr, fq, lds, wid, lane); S.done(cur); }
#undef PG8_SA
#undef PG8_SB
#undef PG8_STAGE
#undef PG8_STAGE_A
#undef PG8_GOFFS
#undef PG8_LDA
#undef PG8_LDB
#undef PG8_MMA
#undef PG8_WAIT_V
#undef PG8_WAIT_L
#undef PG8_BAR
#undef PG8_SCHED
}
}
#define XB_TMO      128
#define XB_XCNT(j)  (256  + 64 * (j))
#define XB_XSUB(j)  (1280 + 64 * (j))
#define XB_XGEN(j)  (2304 + 64 * (j))
#define XB_TOP      3328
#define XB_TOPGEN   3392
#define XCD_BAR_WORDS 3456
#define XB_SPIN_CAP (1u << 18)

__device__ __forceinline__ unsigned xb_ld(unsigned* p)              { return __hip_atomic_load(p, __ATOMIC_RELAXED, __HIP_MEMORY_SCOPE_AGENT); }
__device__ __forceinline__ unsigned xb_add(unsigned* p, unsigned v) { return __hip_atomic_fetch_add(p, v, __ATOMIC_RELAXED, __HIP_MEMORY_SCOPE_AGENT); }
__device__ __forceinline__ unsigned xb_xcc_id() { return (unsigned)__builtin_amdgcn_s_getreg((3 << 11) | 20) & 0xFu; }
#define XB_SPIN(cond, bar) do { unsigned _sp = 0; while (cond) { __builtin_amdgcn_s_sleep(1); \
    if ((++_sp & 255u) == 0u) { if (xb_ld(&(bar)[XB_TMO])) break; if (_sp > XB_SPIN_CAP) { atomicAdd(&(bar)[XB_TMO], 1u); break; } } } } while (0)

struct XcdBarrier {
    unsigned* bar; unsigned x;
    volatile LAS unsigned* st;
};

__device__ __forceinline__ XcdBarrier xcd_barrier_post(unsigned* bar, volatile LAS unsigned* st) {
    XcdBarrier b; b.bar = bar; b.x = xb_xcc_id(); b.st = st;
    if (threadIdx.x == 0) (void)xb_add(&bar[XB_XCNT(b.x)], 1u);
    return b;
}
__device__ __forceinline__ void xcd_barrier_complete(unsigned* bar, unsigned x, unsigned& nloc, unsigned& nx) {
    const unsigned G = gridDim.x * gridDim.y * gridDim.z;
    unsigned sum, cnt, mine, sp = 0u;
    for (;;) {
        sum = 0u; cnt = 0u; mine = 0u;
#pragma unroll
        for (unsigned j = 0; j < 16; ++j) { const unsigned c = xb_ld(&bar[XB_XCNT(j)]); sum += c; cnt += (c > 0u) ? 1u : 0u; mine = (j == x) ? c : mine; }
        if (sum == G) break;
        __builtin_amdgcn_s_sleep(1);
        if ((++sp & 255u) == 0u) { if (xb_ld(&bar[XB_TMO])) break; if (sp > XB_SPIN_CAP) { atomicAdd(&bar[XB_TMO], 1u); break; } }
    }
    nloc = mine > 0u ? mine : 1u; nx = cnt > 0u ? cnt : 1u;
}

__device__ __forceinline__ void xcd_barrier(const XcdBarrier& b) {
    asm volatile("s_waitcnt vmcnt(0)" ::: "memory");
    __syncthreads();
    if (threadIdx.x == 0) {
        unsigned* bar = b.bar;
        __builtin_amdgcn_s_waitcnt(0);
        unsigned nloc = b.st[0], nx = b.st[1];
        if (nloc == 0u) { xcd_barrier_complete(bar, b.x, nloc, nx); b.st[0] = nloc; b.st[1] = nx; }
        const unsigned old = xb_add(&bar[XB_XSUB(b.x)], 1u);
        const unsigned gen = old / nloc;
        if (old + 1u == (gen + 1u) * nloc) {
            __builtin_amdgcn_fence(__ATOMIC_RELEASE, "agent");
            asm volatile("s_waitcnt vmcnt(0)" ::: "memory");
            const unsigned og = xb_add(&bar[XB_TOP], 1u);
            const unsigned tg = og / nx;
            if (og + 1u == (tg + 1u) * nx) xb_add(&bar[XB_TOPGEN], 1u);
            else XB_SPIN(xb_ld(&bar[XB_TOPGEN]) == tg, bar);
            __builtin_amdgcn_fence(__ATOMIC_ACQUIRE, "agent");
            xb_add(&bar[XB_XGEN(b.x)], 1u);
            asm volatile("s_waitcnt vmcnt(0)" ::: "memory");
        } else {
            XB_SPIN(xb_ld(&bar[XB_XGEN(b.x)]) == gen, bar);
            __builtin_amdgcn_fence(__ATOMIC_ACQUIRE, "agent");
            asm volatile("s_waitcnt vmcnt(0)" ::: "memory");
        }
    }
    __syncthreads();
}

constexpr int NWAVES = 8;
constexpr int RING_OFF = 0, RING_BYTES = 131072;
constexpr int LDSCTL_OFF = RING_BYTES, MISC_OFF = LDSCTL_OFF + 320;
constexpr int LDS_BYTES = 147456;

struct Args { const float* in[20]; float* out; unsigned char* ws; int ph_lo, ph_hi, li, pad; };

struct Frame {
    LAS unsigned char* lds;
    volatile LAS unsigned* MISC;
    gu32* ctl;
    int tid, lane, wave, vcu, G;
    __device__ __forceinline__ void refresh() { int t = threadIdx.x; asm volatile("" : "+v"(t)); tid = t; lane = t & 63; wave = __builtin_amdgcn_readfirstlane(t >> 6); }
    unsigned char* ws; float* out;
    const float* x; const float* p;
};

enum Phase { PH_PRO = 0, PH_PROJ, PH_MIX1, PH_SCAN, PH_RETO, PH_BR, PH_WOUT, PH_ROUTE, PH_GU, PH_DOWN, PH_COMB, PH_PLE, PH_FINAL, NPH };

DI void tr_item(const float* __restrict__ W, int ldw, int mycol, bf16* WT, int K, int r0, int k0, LAS float* scr, int lane, const float* __restrict__ kscale = nullptr) {
#pragma unroll 8
    for (int i = 0; i < 32; ++i) { const int kk = 2 * i + (lane >> 5); float w = W[(size_t)(k0 + kk) * ldw + mycol]; if (kscale) w *= kscale[k0 + kk]; scr[kk * 33 + (lane & 31)] = w; }
    LDS_WAIT(); asm volatile("" ::: "memory");
    const int c = lane & 7;
#pragma unroll
    for (int j = 0; j < 4; ++j) { const int n = (lane >> 3) + 8 * j; const LAS float* s = scr + (8 * c) * 33 + n;
        v4u o; o.x = pk2(s[0 * 33], s[1 * 33]); o.y = pk2(s[2 * 33], s[3 * 33]); o.z = pk2(s[4 * 33], s[5 * 33]); o.w = pk2(s[6 * 33], s[7 * 33]);
        *(GAS v4u*)(WT + (size_t)(r0 + n) * K + k0 + 8 * c) = o; }
    LDS_WAIT(); asm volatile("" ::: "memory");
}
DI void rms_row_to_bf16(const float* xrow, const float* gain, bf16* orow, int lane) {
    const GAS f32x4* xr = (const GAS f32x4*)xrow + lane; const GAS f32x4* gr = (const GAS f32x4*)gain + lane;
    f32x4 v[4]; float s = 0.f;
#pragma unroll
    for (int j = 0; j < 4; ++j) { v[j] = xr[64 * j]; s += (v[j].x * v[j].x + v[j].y * v[j].y) + (v[j].z * v[j].z + v[j].w * v[j].w); }
    const float rstd = rsqrtf(wave_sum_dpp(s) * (1.f / DM) + EPS);
    GAS v2u* o8 = (GAS v2u*)orow + lane;
#pragma unroll
    for (int j = 0; j < 4; ++j) { const f32x4 g = gr[64 * j]; v2u o; o.x = pk2(v[j].x * rstd * g.x, v[j].y * rstd * g.y); o.y = pk2(v[j].z * rstd * g.z, v[j].w * rstd * g.w); o8[64 * j] = o; }
}
DI void ph_prologue(Frame& F, const Args& a) {
    LAS float* scr = (LAS float*)(F.lds + RING_OFF + F.wave * 16384);
    const int gw = F.vcu * NWAVES + F.wave, NGW = F.G * NWAVES, lane = F.lane;
    unsigned char* ws = F.ws;
    constexpr int I_IN = (6144 / 32) * 16, I_BR = 32 * 8, I_OUT = 32 * 16, I_GU = 16 * 32 * 16, I_D = 16 * 32 * 8, I_PLE = 32 * 4, I_PG = 32 * 16;
    constexpr int NITEMS = I_IN + 2 * I_BR + I_OUT + I_GU + I_D + I_PLE + I_PG;
    for (int it = gw; it < NITEMS; it += NGW) {
        int r = it;
        if (r < I_IN) { const int rb = r >> 4, kb = r & 15; tr_item(a.in[3], NWIN, in_src(rb * 32 + (lane & 31)), (bf16*)(ws + WS_WIN), 1024, rb * 32, kb * 64, scr, lane); continue; } r -= I_IN;
        if (r < I_BR) { const int rb = r >> 3, kb = r & 7; tr_item(a.in[5], DM, rb * 32 + (lane & 31), (bf16*)(ws + WS_WBR1), 1024, rb * 32, kb * 64, scr, lane); continue; } r -= I_BR;
        if (r < I_BR) { const int rb = r >> 3, kb = r & 7; tr_item(a.in[6], DM, rb * 32 + (lane & 31), (bf16*)(ws + WS_WBR1) + 512, 1024, rb * 32, kb * 64, scr, lane); continue; } r -= I_BR;
        if (r < I_OUT) { const int rb = r >> 4, kb = r & 15; tr_item(a.in[7], DM, rb * 32 + (lane & 31), (bf16*)(ws + WS_WOUT), 1024, rb * 32, kb * 64, scr, lane); continue; } r -= I_OUT;
        if (r < I_GU) { const int e = r >> 9, q = r & 511, rb = q >> 4, kb = q & 15;
            const int row = rb * 32, j = row >> 8, w = row & 255; const bool up = w >= 128; const int col = 128 * j + (w & 127) + (lane & 31);
            tr_item((up ? a.in[14] : a.in[13]) + (size_t)e * DM * DEXP, DEXP, col, (bf16*)(ws + WS_WGU) + (size_t)e * 1024 * 1024, 1024, row, kb * 64, scr, lane, a.in[8]); continue; } r -= I_GU;
        if (r < I_D) { const int e = r >> 8, q = r & 255, rb = q >> 3, kb = q & 7;
            tr_item(a.in[15] + (size_t)e * DEXP * DM, DM, rb * 32 + (lane & 31), (bf16*)(ws + WS_WD) + (size_t)e * 1024 * 512, 512, rb * 32, kb * 64, scr, lane); continue; } r -= I_D;
        if (r < I_PLE) { const int rb = r >> 2, kb = r & 3; tr_item(a.in[17], DM, rb * 32 + (lane & 31), (bf16*)(ws + WS_WPLE), 256, rb * 32, kb * 64, scr, lane); continue; } r -= I_PLE;
        { const int rb = r >> 4, kb = r & 15; tr_item(a.in[18], DM, rb * 32 + (lane & 31), (bf16*)(ws + WS_WPG), 1024, rb * 32, kb * 64, scr, lane); }
    }
    bf16* HB = (bf16*)((unsigned char*)F.out + DO_HB);
    for (int m = gw; m < NTOK; m += NGW) {
        rms_row_to_bf16(F.x + (size_t)m * DM, a.in[2], HB + (size_t)m * DM, lane);
        const f32x4 pv = ((const GAS f32x4*)(F.p + (size_t)m * 256))[lane];
        v2u o; o.x = pk2(pv.x, pv.y); o.y = pk2(pv.z, pv.w); ((GAS v2u*)((bf16*)(ws + WS_PB) + (size_t)m * 256))[lane] = o;
    }
    f32x2* tabA = (f32x2*)(ws + WS_TABA);
    for (int i = F.vcu * 512 + F.tid; i < SEQ * 64; i += F.G * 512) {
        const int pos = i >> 6, p = i & 63;
        const float invf = powf(10000.0f, -(float)(2 * p) * (1.0f / 128.0f)); const float ang = (float)pos * invf;
        tabA[i] = (f32x2){cosf(ang), sinf(ang)};
    }
    for (int i = F.vcu * 512 + F.tid; i < 2 * 32 * 64; i += F.G * 512) {
        const int kh = i >> 11, ks = (i >> 6) & 31, ln = i & 63, o = ln & 31, h2 = ln >> 5;
        unsigned hi[4], lo[4];
#pragma unroll
        for (int jp = 0; jp < 4; ++jp) {
            float wv[2];
#pragma unroll
            for (int q = 0; q < 2; ++q) {
                const int k = 512 * kh + 16 * ks + 8 * h2 + 2 * jp + q;
                float w = 0.f;
                if (o < 8) w = a.in[9][k * 4 + (o & 3)];
                else if (o < 12) w = a.in[11][k * 16 + 0 + (o - 8)];
                else if (o < 16) w = a.in[11][k * 16 + 8 + (o - 12)];
                else if (o < 20) w = a.in[11][k * 16 + 4 + (o - 16)];
                else if (o < 24) w = a.in[11][k * 16 + 12 + (o - 20)];
                wv[q] = w * a.in[8][k];
            }
            const unsigned h0 = f2bf(wv[0]), h1 = f2bf(wv[1]);
            hi[jp] = h0 | (h1 << 16); lo[jp] = pk2(wv[0] - bf2f(h0), wv[1] - bf2f(h1));
        }
        v4u* RW = (v4u*)(ws + WS_RW);
        RW[i] = (v4u){hi[0], hi[1], hi[2], hi[3]}; RW[4096 + i] = (v4u){lo[0], lo[1], lo[2], lo[3]};
    }
}

DI void ph_route(Frame& F, const Args& a, const int dry = 0) {
    unsigned char* ws = F.ws; const int lane = F.lane, r = lane & 31, h2 = lane >> 5, tid = F.tid;
    const bf16* __restrict__ X1 = (const bf16*)((unsigned char*)F.out + DO_X1);
    int* eid = (int*)(ws + WS_ROUTE + RT_EID); float* wgt = (float*)(ws + WS_ROUTE + RT_WGT); int* rank = (int*)(ws + WS_ROUTE + RT_RANK);
    int* ltok = (int*)(ws + WS_LTOK); float* lw = (float*)(ws + WS_LW); float* lrs = (float*)(ws + WS_LRS);
    if (dry) { eid = (int*)(ws + WS_T); wgt = (float*)(ws + WS_T + 1 * MiB); rank = (int*)(ws + WS_T + 2 * MiB); ltok = (int*)(ws + WS_T + 4 * MiB); lw = (float*)(ws + WS_T + 8 * MiB); lrs = (float*)(ws + WS_T + 12 * MiB); }
    const v4u* __restrict__ RW = (const v4u*)(ws + WS_RW);
    LAS v4u* TAB = (LAS v4u*)F.lds;
    LAS float* cmb = (LAS float*)F.lds;
    LAS int* s_e = (LAS int*)(F.lds + 16384); LAS int* s_lr = s_e + 256; LAS float* s_w = (LAS float*)(s_lr + 256); LAS float* s_rs = s_w + 256; LAS int* lcnt = (LAS int*)(s_rs + 128); LAS int* lbase = lcnt + 16;
    const float* bg = a.in[10]; const float* be = a.in[12];
    const int grp = F.wave >> 1, kh = F.wave & 1;
    for (int blk = F.vcu; blk < NTOK / 128; blk += F.G) {
        __syncthreads();
#pragma unroll 4
        for (int i = tid; i < 8192; i += 512) TAB[i] = RW[i];
        __syncthreads();
        const int t0 = blk * 128 + grp * 32;
        const bf16* xrow = X1 + (size_t)(t0 + r) * DM + 512 * kh + 8 * h2;
        f32x16 acc = splat16(0.f); float ss = 0.f;
#pragma unroll 8
        for (int ks = 0; ks < 32; ++ks) {
            const bf16x8 b = ld16(xrow + 16 * ks);
            const bf16x8 ah = __builtin_bit_cast(bf16x8, TAB[(kh * 32 + ks) * 64 + lane]), al = __builtin_bit_cast(bf16x8, TAB[4096 + (kh * 32 + ks) * 64 + lane]);
            acc = MFMA32(ah, b, acc); acc = MFMA32(al, b, acc);
            const v4u bw = __builtin_bit_cast(v4u, b);
            ss += (bflo(bw.x) * bflo(bw.x) + bfhi(bw.x) * bfhi(bw.x)) + (bflo(bw.y) * bflo(bw.y) + bfhi(bw.y) * bfhi(bw.y)) + (bflo(bw.z) * bflo(bw.z) + bfhi(bw.z) * bfhi(bw.z)) + (bflo(bw.w) * bflo(bw.w) + bfhi(bw.w) * bfhi(bw.w));
        }
        ss += __shfl_xor(ss, 32);
        __syncthreads();
        if (tid < 16) lcnt[tid] = 0;
        if (kh == 1) { LAS float* c = cmb + (grp * 64 + lane) * 13;
#pragma unroll
            for (int q = 0; q < 12; ++q) c[q] = acc[q];
            c[12] = ss; }
        __syncthreads();
        if (kh == 0) {
            const LAS float* c = cmb + (grp * 64 + lane) * 13;
#pragma unroll
            for (int q = 0; q < 12; ++q) acc[q] += c[q];
            ss += c[12];
            const float rstd = rsqrtf(ss * (1.f / DM) + EPS);
            float gl[4];
#pragma unroll
            for (int i = 0; i < 4; ++i) gl[i] = acc[i] * rstd + bg[i];
            int g = 0; float gm = gl[0];
#pragma unroll
            for (int i = 1; i < 4; ++i) if (gl[i] > gm) { gm = gl[i]; g = i; }
            float se = 0.f;
#pragma unroll
            for (int i = 0; i < 4; ++i) se += __expf(gl[i] - gm);
            const float pg = 1.0f / se;
            float el[4];
#pragma unroll
            for (int i = 0; i < 4; ++i) el[i] = ((g & 1) ? acc[8 + i] : acc[4 + i]) * rstd + be[4 * g + i];
            int i1 = 0; float m1 = el[0];
#pragma unroll
            for (int i = 1; i < 4; ++i) if (el[i] > m1) { m1 = el[i]; i1 = i; }
            int i2 = -1; float m2 = -3.0e38f;
#pragma unroll
            for (int i = 0; i < 4; ++i) if (i != i1 && el[i] > m2) { m2 = el[i]; i2 = i; }
            const float e2 = __expf(m2 - m1), w1 = pg / (1.0f + e2), w2 = pg * e2 / (1.0f + e2);
            if ((g >> 1) == h2) {
                const int tok = t0 + r, tl = grp * 32 + r;
                eid[2 * tok] = 4 * g + i1; eid[2 * tok + 1] = 4 * g + i2; wgt[2 * tok] = w1; wgt[2 * tok + 1] = w2;
                s_e[2 * tl] = 4 * g + i1; s_e[2 * tl + 1] = 4 * g + i2; s_w[2 * tl] = w1; s_w[2 * tl + 1] = w2; s_rs[tl] = rstd;
            }
        }
        __syncthreads();
        if (tid < 256) s_lr[tid] = atomicAdd((int*)&lcnt[s_e[tid]], 1);
        __syncthreads();
        if (tid < 16) lbase[tid] = (int)__hip_atomic_fetch_add(F.ctl + CW_CNT + (dry ? 32 : 0) + tid, (unsigned)lcnt[tid], RLX_AGENT);
        __syncthreads();
        if (tid < 256) { const int e = s_e[tid], rk = lbase[e] + s_lr[tid], tok = blk * 128 + (tid >> 1);
            rank[2 * tok + (tid & 1)] = rk; ltok[e * NTOK + rk] = tok; lw[e * NTOK + rk] = s_w[tid]; lrs[e * NTOK + rk] = s_rs[tid >> 1]; }
    }
}

DI void expert_table(Frame& F, LAS int* pst) {
    if (F.tid == 0) { int acc = 0; for (int e = 0; e < NEXP; ++e) { pst[e] = acc; const int c = (int)__hip_atomic_load(F.ctl + CW_CNT + e, RLX_AGENT); pst[17 + e] = c; acc += (c + 255) & ~255; } pst[NEXP] = acc; }
    __syncthreads();
}

DI void ph_combine(Frame& F, const Args& a) {
    unsigned char* ws = F.ws; const int lane = F.lane;
    LAS int* pst = (LAS int*)(F.lds); expert_table(F, pst);
    const int* __restrict__ eid = (const int*)(ws + WS_ROUTE + RT_EID); const int* __restrict__ rank = (const int*)(ws + WS_ROUTE + RT_RANK); const bf16* __restrict__ YB = (const bf16*)(ws + WS_XB); bf16* __restrict__ HP = (bf16*)(ws + WS_H2);
    const bf16* __restrict__ X1 = (const bf16*)((unsigned char*)F.out + DO_X1); bf16* __restrict__ X2 = (bf16*)(ws + WS_X2);
    const int gw = F.vcu * NWAVES + F.wave, NGW = F.G * NWAVES;
    v2u cx[4], c0[4], c1[4];
#define COMB_LOAD(tk, dx, d0, d1) do { const int p0_ = pst[eid[2 * (tk)]] + rank[2 * (tk)], p1_ = pst[eid[2 * (tk) + 1]] + rank[2 * (tk) + 1]; \
        const GAS v2u* xr_ = (const GAS v2u*)(X1 + (size_t)(tk) * DM) + lane; const GAS v2u* y0_ = (const GAS v2u*)(YB + (size_t)p0_ * DM) + lane; const GAS v2u* y1_ = (const GAS v2u*)(YB + (size_t)p1_ * DM) + lane; \
        _Pragma("unroll") for (int j = 0; j < 4; ++j) { dx[j] = xr_[64 * j]; d0[j] = y0_[64 * j]; d1[j] = y1_[64 * j]; } } while (0)
    if (gw < NTOK) COMB_LOAD(gw, cx, c0, c1);
    for (int tok = gw; tok < NTOK; tok += NGW) {
        v2u nx[4], n0[4], n1[4];
        { const int tn = (tok + NGW < NTOK) ? tok + NGW : tok; COMB_LOAD(tn, nx, n0, n1); }
        const GAS f32x4* gr = (const GAS f32x4*)a.in[16] + lane; GAS v2u* xw = (GAS v2u*)(X2 + (size_t)tok * DM) + lane;
        f32x4 v[4]; float ss = 0.f;
#pragma unroll
        for (int j = 0; j < 4; ++j) {
            const v2u x0 = cx[j], a0 = c0[j], a1 = c1[j];
            v[j].x = bflo(x0.x) + bflo(a0.x) + bflo(a1.x); v[j].y = bfhi(x0.x) + bfhi(a0.x) + bfhi(a1.x); v[j].z = bflo(x0.y) + bflo(a0.y) + bflo(a1.y); v[j].w = bfhi(x0.y) + bfhi(a0.y) + bfhi(a1.y);
            v2u o; o.x = pk2(v[j].x, v[j].y); o.y = pk2(v[j].z, v[j].w); xw[64 * j] = o;
            ss += (v[j].x * v[j].x + v[j].y * v[j].y) + (v[j].z * v[j].z + v[j].w * v[j].w);
        }
        const float rstd = rsqrtf(wave_sum_dpp(ss) * (1.f / DM) + EPS);
        GAS v2u* o8 = (GAS v2u*)(HP + (size_t)tok * DM) + lane;
#pragma unroll
        for (int j = 0; j < 4; ++j) { const f32x4 g = gr[64 * j]; v2u o; o.x = pk2(v[j].x * rstd * g.x, v[j].y * rstd * g.y); o.y = pk2(v[j].z * rstd * g.z, v[j].w * rstd * g.w); o8[64 * j] = o; }
#pragma unroll
        for (int j = 0; j < 4; ++j) { cx[j] = nx[j]; c0[j] = n0[j]; c1[j] = n1[j]; }
    }
#undef COMB_LOAD
}

DI void ph_final(Frame& F, const Args& a) {
    const int lane = F.lane, gw = F.vcu * NWAVES + F.wave, NGW = F.G * NWAVES;
    f32x4 cur[4];
    if (gw < NTOK) { const GAS f32x4* xr = (const GAS f32x4*)(F.out + (size_t)gw * DM) + lane;
#pragma unroll
        for (int j = 0; j < 4; ++j) cur[j] = xr[64 * j]; }
    for (int tok = gw; tok < NTOK; tok += NGW) {
        f32x4 nxt[4];
        { const int tn = (tok + NGW < NTOK) ? tok + NGW : tok; const GAS f32x4* xn = (const GAS f32x4*)(F.out + (size_t)tn * DM) + lane;
#pragma unroll
          for (int j = 0; j < 4; ++j) nxt[j] = xn[64 * j]; }
        GAS f32x4* xr = (GAS f32x4*)(F.out + (size_t)tok * DM) + lane; const GAS f32x4* gr = (const GAS f32x4*)a.in[19] + lane;
        float ss = 0.f;
#pragma unroll
        for (int j = 0; j < 4; ++j) ss += (cur[j].x * cur[j].x + cur[j].y * cur[j].y) + (cur[j].z * cur[j].z + cur[j].w * cur[j].w);
        const float rstd = rsqrtf(wave_sum_dpp(ss) * (1.f / DM) + EPS);
#pragma unroll
        for (int j = 0; j < 4; ++j) { const f32x4 g = gr[64 * j]; xr[64 * j] = cur[j] * rstd * g; }
#pragma unroll
        for (int j = 0; j < 4; ++j) cur[j] = nxt[j];
    }
}

typedef pg8::f32x4 af4;
DI unsigned cvtpk(float lo, float hi) { typedef float f2 __attribute__((ext_vector_type(2))); typedef __bf16 b2 __attribute__((ext_vector_type(2))); f2 v = {lo, hi}; b2 b = __builtin_convertvector(v, b2); return __builtin_bit_cast(unsigned, b); }
DI v4u pack8(const float (&x)[8]) { v4u w; w.x = cvtpk(x[0], x[1]); w.y = cvtpk(x[2], x[3]); w.z = cvtpk(x[4], x[5]); w.w = cvtpk(x[6], x[7]); return w; }
DI void unpack8(const v4u w, float (&x)[8]) { x[0] = bflo(w.x); x[1] = bfhi(w.x); x[2] = bflo(w.y); x[3] = bfhi(w.y); x[4] = bflo(w.z); x[5] = bfhi(w.z); x[6] = bflo(w.w); x[7] = bfhi(w.w); }

struct EpiProj {
    static constexpr bool PERM = true, AFTER_DRAIN = false; static constexpr int MIDK = 0;
    unsigned char* ws; const float* gn;
    DI void operator()(const af4 (&acc)[2][2][4][2], const pg8::Unit& u, int wr, int wc, int fr, int fq) const {
        bf16* PROJ = (bf16*)(ws + WS_PROJ); const f32x2* tabA = (const f32x2*)(ws + WS_TABA); bf16* T = (bf16*)(ws + WS_T);
        int row0 = u.pm * 256 + wr * 64 + fr, colb = u.pn * 256 + wc * 32 + 8 * fq;
        asm volatile("" : "+v"(row0), "+v"(colb));
        const int kind = u.pn < 2 ? 0 : u.pn < 4 ? 1 : u.pn < 6 ? 2 : u.pn < 8 ? 3 : u.pn < 10 ? 4 : 5;
#pragma unroll
        for (int ai = 0; ai < 2; ++ai)
#pragma unroll
            for (int m = 0; m < 4; ++m) {
                const int row = row0 + ai * 128 + m * 16;
#pragma unroll
                for (int bj = 0; bj < 2; ++bj) {
                    const int col = colb + bj * 128;
                    const af4 a0 = acc[ai][bj][m][0], a1 = acc[ai][bj][m][1];
                    float x[8] = {a0[0], a0[1], a0[2], a0[3], a1[0], a1[1], a1[2], a1[3]};
                    if (kind <= 1) {
                        const int pos = row & (SEQ - 1), p = (col & 127) >> 1;
                        const f32x4* tp = (const f32x4*)(tabA + pos * 64 + p);
                        const f32x4 t0 = tp[0], t1 = tp[1];
                        const float sc = kind == 1 ? 0.08838834764831845f : 1.0f;
                        float y[8];
                        y[0] = (x[0] * t0.x - x[1] * t0.y) * sc; y[1] = (x[0] * t0.y + x[1] * t0.x) * sc;
                        y[2] = (x[2] * t0.z - x[3] * t0.w) * sc; y[3] = (x[2] * t0.w + x[3] * t0.z) * sc;
                        y[4] = (x[4] * t1.x - x[5] * t1.y) * sc; y[5] = (x[4] * t1.y + x[5] * t1.x) * sc;
                        y[6] = (x[6] * t1.z - x[7] * t1.w) * sc; y[7] = (x[6] * t1.w + x[7] * t1.z) * sc;
#pragma unroll
                        for (int i = 0; i < 8; ++i) x[i] = y[i];
                        if (kind == 1) {
                            const int h = (col - C_RK) >> 7;
                            const float kd = exp2f(ret_log2g(h) * (float)(63 - (pos & 63)));
                            float z[8];
#pragma unroll
                            for (int i = 0; i < 8; ++i) z[i] = y[i] * kd;
                            int frl = fr; asm volatile("" : "+v"(frl));
                            const int li = frl & 7;
#pragma unroll
                            for (int s = 4; s >= 1; s >>= 1) {
                                const bool up = (li & s) != 0;
#pragma unroll
                                for (int j = 0; j < 8; ++j) if ((j & s) == 0) {
                                    const float send = up ? z[j] : z[j | s];
                                    float recv;
                                    if (s == 1) recv = __builtin_bit_cast(float, __builtin_amdgcn_update_dpp(0, __builtin_bit_cast(int, send), 0xB1, 0xF, 0xF, true));
                                    else if (s == 2) recv = __builtin_bit_cast(float, __builtin_amdgcn_update_dpp(0, __builtin_bit_cast(int, send), 0x4E, 0xF, 0xF, true));
                                    else { const float dn = __builtin_bit_cast(float, __builtin_amdgcn_update_dpp(0, __builtin_bit_cast(int, send), 0x104, 0xF, 0xF, true));
                                           const float upv = __builtin_bit_cast(float, __builtin_amdgcn_update_dpp(0, __builtin_bit_cast(int, send), 0x114, 0xF, 0xF, true));
                                           recv = up ? upv : dn; }
                                    if (up) z[j] = recv; else z[j | s] = recv;
                                }
                            }
                            *(v4u*)(T + (size_t)(T_KT + (col - C_RK) + li) * NTOK + (row - li)) = pack8(z);
                        }
                    } else if (kind == 2) {
                        const f32x4 g0 = *(const f32x4*)(gn + (col - C_RG)), g1 = *(const f32x4*)(gn + (col - C_RG) + 4);
                        const float gg[8] = {g0.x, g0.y, g0.z, g0.w, g1.x, g1.y, g1.z, g1.w};
#pragma unroll
                        for (int i = 0; i < 8; ++i) x[i] = fsilu(x[i]) * gg[i];
                    } else if (kind == 3) {
#pragma unroll
                        for (int i = 0; i < 8; ++i) x[i] *= SB_QSCALE;
                    } else if (kind == 5) {
#pragma unroll
                        for (int i = 0; i < 8; ++i) x[i] = fsigmoid(x[i]);
                    }
                    *(v4u*)(PROJ + (size_t)row * NMAIN + col) = pack8(x);
                }
                asm volatile("" ::: "memory");
            }
    }
};
struct EpiProjT {
    static constexpr bool PERM = true, AFTER_DRAIN = false; static constexpr int MIDK = 0;
    bf16* T;
    DI void operator()(const af4 (&acc)[2][2][4][2], const pg8::Unit& u, int wr, int wc, int fr, int fq) const {
        const int f0 = T_VR + u.pm * 256 + wr * 64 + fr, tokb = u.pn * 256 + wc * 32 + 8 * fq;
#pragma unroll
        for (int ai = 0; ai < 2; ++ai)
#pragma unroll
            for (int m = 0; m < 4; ++m)
#pragma unroll
                for (int bj = 0; bj < 2; ++bj) {
                    const af4 a0 = acc[ai][bj][m][0], a1 = acc[ai][bj][m][1];
                    const float x[8] = {a0[0], a0[1], a0[2], a0[3], a1[0], a1[1], a1[2], a1[3]};
                    *(v4u*)(T + (size_t)(f0 + ai * 128 + m * 16) * NTOK + tokb + bj * 128) = pack8(x);
                }
    }
};

struct EpiBr {
    static constexpr bool PERM = true, AFTER_DRAIN = false; static constexpr int MIDK = 8;
    bf16* PROJ;
    DI void mid(af4 (&acc)[2][2][4][2], const pg8::Unit& u, int wr, int wc, int fr, int fq) const {
        int row0 = u.pm * 256 + wr * 64 + fr, colb = u.pn * 256 + wc * 32 + 8 * fq;
        asm volatile("" : "+v"(row0), "+v"(colb));
#pragma unroll
        for (int ai = 0; ai < 2; ++ai)
#pragma unroll
            for (int m = 0; m < 4; ++m) {
                const bf16* pr = PROJ + (size_t)(row0 + ai * 128 + m * 16) * NMAIN;
#pragma unroll
                for (int bj = 0; bj < 2; ++bj) {
                    const int col = colb + bj * 128;
                    float gr[8], gs[8]; unpack8(*(const v4u*)(pr + C_GR + col), gr); unpack8(*(const v4u*)(pr + C_GS + col), gs);
#pragma unroll
                    for (int i = 0; i < 4; ++i) { acc[ai][bj][m][0][i] *= gr[i] * __builtin_amdgcn_rcpf(fmaxf(gs[i], 1e-30f)); acc[ai][bj][m][1][i] *= gr[4 + i] * __builtin_amdgcn_rcpf(fmaxf(gs[4 + i], 1e-30f)); }
                }
                asm volatile("" ::: "memory");
            }
    }
    DI void operator()(const af4 (&acc)[2][2][4][2], const pg8::Unit& u, int wr, int wc, int fr, int fq) const {
        int row0 = u.pm * 256 + wr * 64 + fr, colb = u.pn * 256 + wc * 32 + 8 * fq;
        asm volatile("" : "+v"(row0), "+v"(colb));
#pragma unroll
        for (int ai = 0; ai < 2; ++ai)
#pragma unroll
            for (int m = 0; m < 4; ++m) {
                bf16* pr = PROJ + (size_t)(row0 + ai * 128 + m * 16) * NMAIN;
#pragma unroll
                for (int bj = 0; bj < 2; ++bj) {
                    const int col = colb + bj * 128;
                    const af4 a0 = acc[ai][bj][m][0], a1 = acc[ai][bj][m][1];
                    float gs[8], x[8] = {a0[0], a0[1], a0[2], a0[3], a1[0], a1[1], a1[2], a1[3]};
                    unpack8(*(const v4u*)(pr + C_GS + col), gs);
#pragma unroll
                    for (int i = 0; i < 8; ++i) x[i] *= fmaxf(gs[i], 1e-30f);
                    *(v4u*)(pr + C_MG + col) = pack8(x);
                }
            }
    }
};
struct EpiWout {
    static constexpr bool PERM = true, AFTER_DRAIN = false; static constexpr int MIDK = 0;
    const float* x; bf16* x1;
    DI void operator()(const af4 (&acc)[2][2][4][2], const pg8::Unit& u, int wr, int wc, int fr, int fq) const {
        const int row0 = u.pm * 256 + wr * 64 + fr, colb = u.pn * 256 + wc * 32 + 8 * fq;
#pragma unroll
        for (int ai = 0; ai < 2; ++ai)
#pragma unroll
            for (int m = 0; m < 4; ++m) {
                const size_t ro = (size_t)(row0 + ai * 128 + m * 16) * DM;
#pragma unroll
                for (int bj = 0; bj < 2; ++bj) {
                    const size_t o = ro + colb + bj * 128;
                    const af4 x0 = *(const af4*)(x + o) + acc[ai][bj][m][0], x1v = *(const af4*)(x + o + 4) + acc[ai][bj][m][1];
                    const float y[8] = {x0[0], x0[1], x0[2], x0[3], x1v[0], x1v[1], x1v[2], x1v[3]};
                    *(v4u*)(x1 + o) = pack8(y);
                }
            }
    }
};
struct EpiGu {
    static constexpr bool PERM = true, AFTER_DRAIN = false; static constexpr int MIDK = 0;
    bf16* HID; const float* lrs; const LAS int* pst;
    DI void operator()(const af4 (&acc)[2][2][4][2], const pg8::Unit& u, int wr, int wc, int fr, int fq) const {
        const int rl0 = wr * 64 + fr, col = u.pn * 128 + wc * 32 + 8 * fq;
        const int local0 = u.pm * 256 - pst[u.ex], cnt = pst[17 + u.ex];
        const float* rsl = lrs + (size_t)u.ex * NTOK;
#pragma unroll
        for (int ai = 0; ai < 2; ++ai)
#pragma unroll
            for (int m = 0; m < 4; ++m) {
                const int rl = rl0 + ai * 128 + m * 16, loc = local0 + rl;
                const float rs = loc < cnt ? rsl[loc] : 0.f;
                const af4 g0 = acc[ai][0][m][0] * rs, g1 = acc[ai][0][m][1] * rs, u0 = acc[ai][1][m][0] * rs, u1 = acc[ai][1][m][1] * rs;
                float x[8];
#pragma unroll
                for (int i = 0; i < 4; ++i) { x[i] = fsilu(g0[i]) * u0[i]; x[4 + i] = fsilu(g1[i]) * u1[i]; }
                *(v4u*)(HID + (size_t)(u.pm * 256 + rl) * DEXP + col) = pack8(x);
            }
    }
};
struct EpiDown {
    static constexpr bool PERM = true, AFTER_DRAIN = false; static constexpr int MIDK = 0;
    bf16* YB; const float* lw; const LAS int* pst;
    DI void operator()(const af4 (&acc)[2][2][4][2], const pg8::Unit& u, int wr, int wc, int fr, int fq) const {
        const int rl0 = wr * 64 + fr, colb = u.pn * 256 + wc * 32 + 8 * fq;
        const int local0 = u.pm * 256 - pst[u.ex], cnt = pst[17 + u.ex];
        const float* wl = lw + (size_t)u.ex * NTOK;
#pragma unroll
        for (int ai = 0; ai < 2; ++ai)
#pragma unroll
            for (int m = 0; m < 4; ++m) {
                const int rl = rl0 + ai * 128 + m * 16, loc = local0 + rl; const float w = loc < cnt ? wl[loc] : 0.f;
#pragma unroll
                for (int bj = 0; bj < 2; ++bj) {
                    const af4 a0 = acc[ai][bj][m][0] * w, a1 = acc[ai][bj][m][1] * w;
                    const float x[8] = {a0[0], a0[1], a0[2], a0[3], a1[0], a1[1], a1[2], a1[3]};
                    *(v4u*)(YB + (size_t)(u.pm * 256 + rl) * DM + colb + bj * 128) = pack8(x);
                }
            }
    }
};
struct EpiPe {
    static constexpr bool PERM = true, AFTER_DRAIN = false; static constexpr int MIDK = 0;
    bf16* PE;
    DI void operator()(const af4 (&acc)[2][2][4][2], const pg8::Unit& u, int wr, int wc, int fr, int fq) const {
        const int row0 = u.pm * 256 + wr * 64 + fr, colb = u.pn * 256 + wc * 32 + 8 * fq;
#pragma unroll
        for (int ai = 0; ai < 2; ++ai)
#pragma unroll
            for (int m = 0; m < 4; ++m)
#pragma unroll
                for (int bj = 0; bj < 2; ++bj) {
                    const af4 a0 = acc[ai][bj][m][0], a1 = acc[ai][bj][m][1];
                    const float x[8] = {a0[0], a0[1], a0[2], a0[3], a1[0], a1[1], a1[2], a1[3]};
                    *(v4u*)(PE + (size_t)(row0 + ai * 128 + m * 16) * DM + colb + bj * 128) = pack8(x);
                }
    }
};
struct EpiPg {
    static constexpr bool PERM = true, AFTER_DRAIN = false; static constexpr int MIDK = 0;
    const bf16* PE; const bf16* x2; float* out;
    DI void operator()(const af4 (&acc)[2][2][4][2], const pg8::Unit& u, int wr, int wc, int fr, int fq) const {
        const int row0 = u.pm * 256 + wr * 64 + fr, colb = u.pn * 256 + wc * 32 + 8 * fq;
#pragma unroll
        for (int ai = 0; ai < 2; ++ai)
#pragma unroll
            for (int m = 0; m < 4; ++m) {
                const size_t ro = (size_t)(row0 + ai * 128 + m * 16) * DM;
#pragma unroll
                for (int bj = 0; bj < 2; ++bj) {
                    const size_t o = ro + colb + bj * 128;
                    float pe[8]; unpack8(*(const v4u*)(PE + o), pe);
                    const af4 a0 = acc[ai][bj][m][0], a1 = acc[ai][bj][m][1];
                    float xr[8]; unpack8(*(const v4u*)(x2 + o), xr);
                    af4 x0 = {xr[0], xr[1], xr[2], xr[3]}, x1 = {xr[4], xr[5], xr[6], xr[7]};
#pragma unroll
                    for (int i = 0; i < 4; ++i) { x0[i] += fsigmoid(a0[i]) * pe[i]; x1[i] += fsigmoid(a1[i]) * pe[4 + i]; }
                    *(af4*)(out + o) = x0; *(af4*)(out + o + 4) = x1;
                }
                asm volatile("" ::: "memory");
            }
    }
};

template <bool GATH> struct MoeOrder {
    static constexpr bool GATHER = GATH;
    const LAS int* pst; int G, c; size_t estride, tstepB; const int* ltok; unsigned rowbytes;
    DI bool next(int i, pg8::Unit& u) const {
        const int L = i * G + c, rt = L >> 2; if (rt * 256 >= pst[NEXP]) return false;
        int ex = 0;
#pragma unroll
        for (int e = 1; e < NEXP; ++e) ex += (rt * 256 >= pst[e]) ? 1 : 0;
        u.pm = rt; u.pn = L & 3; u.ex = ex; u.bofs = (size_t)ex * estride + (size_t)u.pn * tstepB; return true;
    }
    DI unsigned arow_off(const pg8::Unit& u, int row) const { const int loc = u.pm * 256 - pst[u.ex] + row; const int tok = loc < pst[17 + u.ex] ? ltok[(size_t)u.ex * NTOK + loc] : 0; return (unsigned)tok * rowbytes; }
    DI void a_ready(const pg8::Unit&) const {}
    DI void done(const pg8::Unit&) const {}
};

#ifndef PG8_ALIGN
#define PG8_ALIGN true
#endif
#define GEMM_PHASE(EPI, ORD, g, S, E) pg8::gemm_phase<EPI, ORD, PG8_ALIGN, true>(F.lds + RING_OFF, g, S, E)

DI void fast_proj(Frame& F, const Args& a) {
    unsigned char* ws = F.ws; const bf16* HB = (const bf16*)((unsigned char*)F.out + DO_HB); const bf16* WIN = (const bf16*)(ws + WS_WIN);
    { pg8::Gemm g{HB, WIN, DM, DM}; pg8::StaticOrder S; S.init(NTOK, NMAIN, DM, F.G, (int)blockIdx.x);
      EpiProj E{ws, a.in[4]}; GEMM_PHASE(EpiProj, pg8::StaticOrder, g, S, E); }
    { pg8::Gemm g{WIN + (size_t)(NMAIN + 512) * DM, HB, DM, DM}; pg8::StaticOrder S; S.init(1024, NTOK, DM, F.G, (int)blockIdx.x);
      EpiProjT E{(bf16*)(ws + WS_T)}; GEMM_PHASE(EpiProjT, pg8::StaticOrder, g, S, E); }
}
DI void fast_br(Frame& F, const Args& a) {
    unsigned char* ws = F.ws; bf16* PROJ = (bf16*)(ws + WS_PROJ); const bf16* RS = (const bf16*)((unsigned char*)F.out + DO_RS);
    pg8::StaticOrder S; S.init(NTOK, DM, DM, F.G, (int)blockIdx.x);
    pg8::Gemm g{RS, (const bf16*)(ws + WS_WBR1), DM, DM}; EpiBr E{PROJ}; GEMM_PHASE(EpiBr, pg8::StaticOrder, g, S, E);
}
DI void fast_wout(Frame& F, const Args& a) {
    unsigned char* ws = F.ws;
    pg8::Gemm g{(const bf16*)(ws + WS_PROJ) + C_MG, (const bf16*)(ws + WS_WOUT), NMAIN, DM}; pg8::StaticOrder S; S.init(NTOK, DM, DM, F.G, (int)blockIdx.x);
    EpiWout E{F.x, (bf16*)((unsigned char*)F.out + DO_X1)}; GEMM_PHASE(EpiWout, pg8::StaticOrder, g, S, E);
}
DI void fast_gu(Frame& F, const Args& a) {
    LAS int* pst = (LAS int*)(F.lds + LDSCTL_OFF);
    expert_table(F, pst);
    unsigned char* ws = F.ws;
    pg8::Gemm g{(const bf16*)((unsigned char*)F.out + DO_X1), (const bf16*)(ws + WS_WGU), DM, DM};
    MoeOrder<true> S{pst, F.G, F.vcu, (size_t)1024 * 1024 * 2, (size_t)256 * DM * 2, (const int*)(ws + WS_LTOK), (unsigned)(DM * 2)};
    EpiGu E{(bf16*)(ws + WS_HID), (const float*)(ws + WS_LRS), pst}; GEMM_PHASE(EpiGu, MoeOrder<true>, g, S, E);
}
DI void fast_down(Frame& F, const Args& a) {
    LAS int* pst = (LAS int*)(F.lds + LDSCTL_OFF);
    expert_table(F, pst);
    unsigned char* ws = F.ws;
    pg8::Gemm g{(const bf16*)(ws + WS_HID), (const bf16*)(ws + WS_WD), DEXP, DEXP};
    MoeOrder<false> S{pst, F.G, F.vcu, (size_t)1024 * 512 * 2, (size_t)256 * DEXP * 2, nullptr, 0u};
    EpiDown E{(bf16*)(ws + WS_XB), (const float*)(ws + WS_LW), pst}; GEMM_PHASE(EpiDown, MoeOrder<false>, g, S, E);
}
DI void fast_ple(Frame& F, const Args& a) {
    unsigned char* ws = F.ws;
    { int k256 = 256; asm volatile("" : "+s"(k256));
      pg8::Gemm g{(const bf16*)(ws + WS_PB), (const bf16*)(ws + WS_WPLE), 256, k256}; pg8::StaticOrder S; S.init(NTOK, DM, k256, F.G, (int)blockIdx.x);
      EpiPe E{(bf16*)(ws + WS_HID)}; GEMM_PHASE(EpiPe, pg8::StaticOrder, g, S, E); }
    { pg8::Gemm g{(const bf16*)(ws + WS_H2), (const bf16*)(ws + WS_WPG), DM, DM}; pg8::StaticOrder S; S.init(NTOK, DM, DM, F.G, (int)blockIdx.x);
      EpiPg E{(const bf16*)(ws + WS_HID), (const bf16*)(ws + WS_X2), F.out}; GEMM_PHASE(EpiPg, pg8::StaticOrder, g, S, E); }
}

template <int S> DI bf16x8 pack_step(const f32x16& x) { v4u p; p.x = cvtpk(x[8 * S], x[8 * S + 1]); p.y = cvtpk(x[8 * S + 2], x[8 * S + 3]); p.z = cvtpk(x[8 * S + 4], x[8 * S + 5]); p.w = cvtpk(x[8 * S + 6], x[8 * S + 7]); return __builtin_bit_cast(bf16x8, p); }


#define SCHED_FENCE() __builtin_amdgcn_sched_barrier(0)
DI void fast_ret_kv(Frame& F, const Args& a) {
    const bf16* __restrict__ T = (const bf16*)(F.ws + WS_T); bf16* __restrict__ ST = (bf16*)((unsigned char*)F.out + DO_ST);
    const int lane = F.lane, r = lane & 31, h2 = lane >> 5, gw = F.vcu * NWAVES + F.wave, NGW = F.G * NWAVES;
    for (int it = gw; it < NBATCH * 4 * 64 * 4; it += NGW) {
        const int eb = it & 3, c = (it >> 2) & 63, hh = (it >> 8) & 3, b = it >> 10;
        const int tok0 = b * SEQ + c * 64;
        const bf16* vrow = T + (size_t)(T_VR + hh * 128 + eb * 32 + r) * NTOK + tok0 + 8 * h2;
        const bf16* krow = T + (size_t)(T_KT + hh * 128 + r) * NTOK + tok0 + 8 * h2;
        bf16x8 vb[4], ka[4][4];
#pragma unroll
        for (int ks = 0; ks < 4; ++ks) vb[ks] = ld16(vrow + 16 * ks);
#pragma unroll
        for (int db = 0; db < 4; ++db)
#pragma unroll
            for (int ks = 0; ks < 4; ++ks) ka[db][ks] = ld16(krow + (size_t)db * 32 * NTOK + 16 * ks);
        SCHED_FENCE();
        bf16* st = ST + ((size_t)((b * 4 + hh) * 64 + c)) * 16384 + (size_t)(eb * 32 + r) * 128 + 4 * h2;
#pragma unroll
        for (int db = 0; db < 4; ++db) {
            f32x16 acc = splat16(0.f);
#pragma unroll
            for (int ks = 0; ks < 4; ++ks) acc = MFMA32(ka[db][ks], vb[ks], acc);
#pragma unroll
            for (int g = 0; g < 4; ++g) { v2u w; w.x = cvtpk(acc[4 * g], acc[4 * g + 1]); w.y = cvtpk(acc[4 * g + 2], acc[4 * g + 3]); *(v2u*)(st + db * 32 + 8 * g) = w; }
        }
    }
}
DI void fast_ret_scan(Frame& F, const Args& a) {
    bf16* ST = (bf16*)((unsigned char*)F.out + DO_ST);
    for (int g = F.vcu * 512 + F.tid; g < NBATCH * 4 * 4096; g += F.G * 512) {
        const int bh = g >> 12, idx = (g & 4095) * 4;
        const float cdec = exp2f(ret_log2g(bh & 3) * 64.0f);
        bf16* p = ST + (size_t)bh * 64 * 16384 + idx;
        float s0 = 0.f, s1 = 0.f, s2 = 0.f, s3 = 0.f;
#pragma unroll 8
        for (int c = 0; c < 64; ++c) {
            const v2u w = *(const v2u*)(p + (size_t)c * 16384);
            v2u o; o.x = cvtpk(s0, s1); o.y = cvtpk(s2, s3); *(v2u*)(p + (size_t)c * 16384) = o;
            s0 = cdec * s0 + bflo(w.x); s1 = cdec * s1 + bfhi(w.x); s2 = cdec * s2 + bflo(w.y); s3 = cdec * s3 + bfhi(w.y);
        }
    }
}
DI void fast_ret_out(Frame& F, const Args& a) {
    const bf16* __restrict__ PROJ = (const bf16*)(F.ws + WS_PROJ); const bf16* __restrict__ T = (const bf16*)(F.ws + WS_T);
    const bf16* __restrict__ ST = (const bf16*)((unsigned char*)F.out + DO_ST); bf16* __restrict__ RS = (bf16*)((unsigned char*)F.out + DO_RS);
    const int lane = F.lane, r = lane & 31, h2 = lane >> 5, gw = F.vcu * NWAVES + F.wave, NGW = F.G * NWAVES;
    for (int it = gw; it < NBATCH * 4 * 64 * 2; it += NGW) {
        const int ib = it & 1, c = (it >> 1) & 63, hh = (it >> 7) & 3, b = it >> 9;
        const int tok0 = b * SEQ + c * 64;
        const float l2g = ret_log2g(hh);
        const bf16* qrow = PROJ + (size_t)(tok0 + ib * 32 + r) * NMAIN + C_RQ + hh * 128 + 8 * h2;
        const bf16* krow = PROJ + (size_t)(tok0 + r) * NMAIN + C_RK + hh * 128 + 8 * h2;
        const bf16* stb = ST + ((size_t)((b * 4 + hh) * 64 + c)) * 16384 + (size_t)r * 128 + 8 * h2;
        const bf16* vrow = T + (size_t)(T_VR + hh * 128 + r) * NTOK + tok0 + 4 * h2;
        const bf16* gp = PROJ + (size_t)(tok0 + ib * 32 + r) * NMAIN + C_RG + hh * 128 + 4 * h2;
        bf16x8 qf[8], kf0[8], kf1[8], sA[8], sB[8], vA[4], vB[4];
#define LD_ST(dst, eb) do { _Pragma("unroll") for (int ks = 0; ks < 8; ++ks) dst[ks] = ld16(stb + (size_t)(eb) * 32 * 128 + 16 * ks); } while (0)
#define LD_VT(dst, eb) do { const bf16* vr_ = vrow + (size_t)(eb) * 32 * NTOK; dst[0] = ld8x2(vr_, vr_ + 8); dst[1] = ld8x2(vr_ + 16, vr_ + 24); dst[2] = ld8x2(vr_ + 32, vr_ + 40); dst[3] = ld8x2(vr_ + 48, vr_ + 56); } while (0)
#define RET_EB(oacc, sfr, vfr) do { f32x16 acc_ = splat16(0.f); \
            _Pragma("unroll") for (int ks = 0; ks < 8; ++ks) acc_ = MFMA32(sfr[ks], qf[ks], acc_);         \
            _Pragma("unroll") for (int reg = 0; reg < 16; ++reg) acc_[reg] *= qd; \
            acc_ = MFMA32(vfr[0], pb[0][0], acc_); acc_ = MFMA32(vfr[1], pb[0][1], acc_); acc_ = MFMA32(vfr[2], pb[1][0], acc_); acc_ = MFMA32(vfr[3], pb[1][1], acc_); oacc = acc_; } while (0)
#pragma unroll
        for (int ks = 0; ks < 8; ++ks) qf[ks] = ld16(qrow + 16 * ks);
#pragma unroll
        for (int ks = 0; ks < 8; ++ks) { kf0[ks] = ld16(krow + 16 * ks); kf1[ks] = ld16(krow + (size_t)32 * NMAIN + 16 * ks); }
        LD_ST(sA, 0); LD_VT(vA, 0);
        SCHED_FENCE();
        f32x16 pt0 = splat16(0.f), pt1 = splat16(0.f);
#pragma unroll
        for (int ks = 0; ks < 8; ++ks) { pt0 = MFMA32(kf0[ks], qf[ks], pt0); pt1 = MFMA32(kf1[ks], qf[ks], pt1); }
        LD_ST(sB, 1); LD_VT(vB, 1);
        SCHED_FENCE();
        bf16x8 pb[2][2];
#pragma unroll
        for (int reg = 0; reg < 16; ++reg) {
            const int d0 = (ib * 32 + r) - crow(reg, h2), d1 = d0 - 32;
            pt0[reg] *= __builtin_amdgcn_exp2f(l2g * (float)(d0 < 0 ? -d0 : d0)); pt1[reg] *= __builtin_amdgcn_exp2f(l2g * (float)(d1 < 0 ? -d1 : d1));
        }
        pb[0][0] = pack_step<0>(pt0); pb[0][1] = pack_step<1>(pt0); pb[1][0] = pack_step<0>(pt1); pb[1][1] = pack_step<1>(pt1);
        const float qd = __builtin_amdgcn_exp2f(l2g * (float)(ib * 32 + r + 1));
        f32x16 o[4];
        RET_EB(o[0], sA, vA);
        LD_ST(sA, 2); LD_VT(vA, 2);
        SCHED_FENCE();
        RET_EB(o[1], sB, vB);
        LD_ST(sB, 3); LD_VT(vB, 3);
        SCHED_FENCE();
        RET_EB(o[2], sA, vA);
        v2u gate[16];
#pragma unroll
        for (int q = 0; q < 16; ++q) gate[q] = *(const v2u*)(gp + (q >> 2) * 32 + 8 * (q & 3));
        SCHED_FENCE();
        RET_EB(o[3], sB, vB);
#undef LD_ST
#undef LD_VT
#undef RET_EB
        float s = 0.f;
#pragma unroll
        for (int eb = 0; eb < 4; ++eb)
#pragma unroll
            for (int reg = 0; reg < 16; ++reg) s += o[eb][reg];
        s += __shfl_xor(s, 32);
        const float mu = s * (1.0f / 128.0f); float v = 0.f;
#pragma unroll
        for (int eb = 0; eb < 4; ++eb)
#pragma unroll
            for (int reg = 0; reg < 16; ++reg) { const float d = o[eb][reg] - mu; v += d * d; }
        v += __shfl_xor(v, 32);
        const float rstd = rsqrtf(v * (1.0f / 128.0f) + EPS);
        bf16* rp = RS + (size_t)(tok0 + ib * 32 + r) * DM + hh * 128 + 4 * h2;
#pragma unroll
        for (int eb = 0; eb < 4; ++eb)
#pragma unroll
            for (int g = 0; g < 4; ++g) {
                const v2u gt = gate[eb * 4 + g];
                v2u w;
                w.x = cvtpk((o[eb][4 * g] - mu) * rstd * bflo(gt.x), (o[eb][4 * g + 1] - mu) * rstd * bfhi(gt.x));
                w.y = cvtpk((o[eb][4 * g + 2] - mu) * rstd * bflo(gt.y), (o[eb][4 * g + 3] - mu) * rstd * bfhi(gt.y));
                *(v2u*)(rp + eb * 32 + 8 * g) = w;
            }
    }
}

DI void fast_att(Frame& F, const Args& a) {
    const bf16* __restrict__ PROJ = (const bf16*)(F.ws + WS_PROJ); const bf16* __restrict__ T = (const bf16*)(F.ws + WS_T); bf16* __restrict__ RS = (bf16*)((unsigned char*)F.out + DO_RS);
    const int lane = F.lane, r = lane & 31, h2 = lane >> 5, gw = F.vcu * NWAVES + F.wave, NGW = F.G * NWAVES;
    bf16x8 tri0, tri1, ones;
#pragma unroll
    for (int j = 0; j < 8; ++j) { const int k0 = 8 * (j >> 2) + 4 * h2 + (j & 3); tri0[j] = (k0 > r) ? (short)0x3F80 : (short)0; tri1[j] = (16 + k0 > r) ? (short)0x3F80 : (short)0; ones[j] = (short)0x3F80; }
    for (int it = gw; it < NBATCH * 8 * 128; it += NGW) {
        const int qb = it & 127, hh = (it >> 7) & 7, b = it >> 10;
        const int q0 = qb * 32, tokq = b * SEQ + q0 + r;
        const bf16* qrow = PROJ + (size_t)tokq * NMAIN + C_SQ + hh * 64 + 8 * h2;
        const bf16* kbase = PROJ + (size_t)(b * SEQ + r) * NMAIN + C_SK + hh * 64 + 8 * h2;
        const bf16* vbase = T + (size_t)(T_VS + hh * 64 + r) * NTOK + b * SEQ + 4 * h2;
        const int ktd = q0 >> 6;
        bf16x8 qf[4], kA[8], vB[8];
#pragma unroll
        for (int ks = 0; ks < 4; ++ks) qf[ks] = ld16(qrow + 16 * ks);
#pragma unroll
        for (int ks = 0; ks < 4; ++ks) { kA[ks] = ld16(kbase + (size_t)(ktd * 64) * NMAIN + 16 * ks); kA[4 + ks] = ld16(kbase + (size_t)(ktd * 64 + 32) * NMAIN + 16 * ks); }
        f32x16 o0 = splat16(0.f), o1 = splat16(0.f);
        float carry = 0.f;
        for (int kt = ktd; kt >= 0; --kt) {
            const int key0 = kt * 64;
            const bool diag = (kt == ktd);
            {
                const bf16* v0row = vbase + key0; const bf16* v1row = v0row + (size_t)32 * NTOK;
#pragma unroll
                for (int q = 0; q < 4; ++q) { vB[q] = ld8x2(v0row + 16 * q, v0row + 16 * q + 8); vB[4 + q] = ld8x2(v1row + 16 * q, v1row + 16 * q + 8); }
            }
            SCHED_FENCE();
            f32x16 p0 = splat16(0.f), p1 = splat16(0.f);
#pragma unroll
            for (int ks = 0; ks < 4; ++ks) { p0 = MFMA32(kA[ks], qf[ks], p0); p1 = MFMA32(kA[4 + ks], qf[ks], p1); }
            {
                const int kn = (kt > 0 ? kt - 1 : 0) * 64;
#pragma unroll
                for (int ks = 0; ks < 4; ++ks) { kA[ks] = ld16(kbase + (size_t)kn * NMAIN + 16 * ks); kA[4 + ks] = ld16(kbase + (size_t)(kn + 32) * NMAIN + 16 * ks); }
            }
            SCHED_FENCE();
            f32x16 l0, l1;
#pragma unroll
            for (int reg = 0; reg < 16; ++reg) {
                const float z0 = fminf(p0[reg], 100.0f), z1 = fminf(p1[reg], 100.0f);
                float a0 = -__builtin_amdgcn_logf(1.0f + __builtin_amdgcn_exp2f(z0)), a1 = -__builtin_amdgcn_logf(1.0f + __builtin_amdgcn_exp2f(z1));
                float b0 = z0 + a0, b1 = z1 + a1;
                if (diag) {
                    const bool v0 = (key0 + crow(reg, h2)) < (q0 + r), v1 = (key0 + 32 + crow(reg, h2)) < (q0 + r);
                    a0 = v0 ? a0 : 0.f; b0 = v0 ? b0 : -1.0e30f; a1 = v1 ? a1 : 0.f; b1 = v1 ? b1 : -1.0e30f;
                }
                l0[reg] = a0; l1[reg] = a1; p0[reg] = b0; p1[reg] = b1;
            }
            f32x16 y0 = splat16(carry), y1 = y0;
            {
                const bf16x8 x00 = pack_step<0>(l0), x01 = pack_step<1>(l0), x10 = pack_step<0>(l1), x11 = pack_step<1>(l1);
                y0 = MFMA32(tri0, x00, y0); y0 = MFMA32(tri1, x01, y0); y0 = MFMA32(ones, x10, y0); y0 = MFMA32(ones, x11, y0);
                y1 = MFMA32(tri0, x10, y1); y1 = MFMA32(tri1, x11, y1);
            }
            const float tot = y0[0] + l0[0];
            carry = __shfl(tot, r);
#pragma unroll
            for (int reg = 0; reg < 16; ++reg) { p0[reg] = __builtin_amdgcn_exp2f(p0[reg] + y0[reg]); p1[reg] = __builtin_amdgcn_exp2f(p1[reg] + y1[reg]); }
            {
                const bf16x8 a00 = pack_step<0>(p0), a01 = pack_step<1>(p0), a10 = pack_step<0>(p1), a11 = pack_step<1>(p1);
                o0 = MFMA32(vB[0], a00, o0); o0 = MFMA32(vB[1], a01, o0); o0 = MFMA32(vB[2], a10, o0); o0 = MFMA32(vB[3], a11, o0);
                o1 = MFMA32(vB[4], a00, o1); o1 = MFMA32(vB[5], a01, o1); o1 = MFMA32(vB[6], a10, o1); o1 = MFMA32(vB[7], a11, o1);
            }
            if (__all(carry < SB_EXIT)) break;
        }
        bf16* op = RS + (size_t)tokq * DM + 512 + hh * 64 + 4 * h2;
#pragma unroll
        for (int g = 0; g < 4; ++g) {
            v2u w; w.x = cvtpk(o0[4 * g], o0[4 * g + 1]); w.y = cvtpk(o0[4 * g + 2], o0[4 * g + 3]); *(v2u*)(op + 8 * g) = w;
            v2u u; u.x = cvtpk(o1[4 * g], o1[4 * g + 1]); u.y = cvtpk(o1[4 * g + 2], o1[4 * g + 3]); *(v2u*)(op + 32 + 8 * g) = u;
        }
    }
}

__global__ void __launch_bounds__(NWAVES * 64, 2) mega(Args args) {
    extern __shared__ __attribute__((aligned(16))) unsigned char lds[];
    Frame F;
    F.lds = (LAS unsigned char*)lds;
    F.MISC = (volatile LAS unsigned*)(F.lds + MISC_OFF);
    F.refresh();
    F.G = gridDim.x; { const int bx = blockIdx.x; F.vcu = (F.G % 8 == 0) ? (bx % 8) * (F.G / 8) + bx / 8 : bx; }
    F.ws = args.ws; F.out = args.out; F.x = args.in[0]; F.p = args.in[1];
    F.ctl = (gu32*)(args.ws + WS_CTL);
    for (int u = F.tid; u < (LDS_BYTES - LDSCTL_OFF) / 4; u += NWAVES * 64) ((LAS unsigned*)(F.lds + LDSCTL_OFF))[u] = 0u;
    __syncthreads();
    const int lo = args.ph_lo, hi = args.ph_hi;
    XcdBarrier bar; bar.bar = (unsigned*)(F.ctl + CW_BAR) + args.li * BAR_STRIDE; bar.x = 0; bar.st = nullptr;
    if (hi - lo > 1) bar = xcd_barrier_post((unsigned*)(F.ctl + CW_BAR) + args.li * BAR_STRIDE, F.MISC + 8);
#define IN(k) (F.refresh(), lo <= (k) && (k) < hi)
#define DUP(k) ((DUP_MASK >> (k)) & 1)
#define SEAM(k) do { if (IN(k) && IN((k) + 1)) xcd_barrier(bar); } while (0)
#define REP(k, body) do { body; if (DUP(k)) { F.refresh(); body; } } while (0)

    if (DUP(16) && hi - lo > 1) { for (int i = 0; i < 10; ++i) xcd_barrier(bar); }
    if (IN(PH_PRO)) { REP(PH_PRO, ph_prologue(F, args)); } SEAM(PH_PRO);
    if (IN(PH_PROJ)) { REP(PH_PROJ, fast_proj(F, args)); } SEAM(PH_PROJ);
    if (IN(PH_MIX1)) { REP(14, fast_ret_kv(F, args)); REP(15, fast_att(F, args)); } SEAM(PH_MIX1);
    if (IN(PH_SCAN)) { fast_ret_scan(F, args); } SEAM(PH_SCAN);
    if (IN(PH_RETO)) { REP(PH_RETO, fast_ret_out(F, args)); } SEAM(PH_RETO);
    if (IN(PH_BR)) { REP(PH_BR, fast_br(F, args)); } SEAM(PH_BR);
    if (IN(PH_WOUT)) { REP(PH_WOUT, fast_wout(F, args)); } SEAM(PH_WOUT);
    if (IN(PH_ROUTE)) { ph_route(F, args); if (DUP(PH_ROUTE)) { F.refresh(); ph_route(F, args, 1); } } SEAM(PH_ROUTE);
    if (IN(PH_GU)) { REP(PH_GU, fast_gu(F, args)); } SEAM(PH_GU);
    if (IN(PH_DOWN)) { REP(PH_DOWN, fast_down(F, args)); } SEAM(PH_DOWN);
    if (IN(PH_COMB)) { REP(PH_COMB, ph_combine(F, args)); } SEAM(PH_COMB);
    if (IN(PH_PLE)) { REP(PH_PLE, fast_ple(F, args)); } SEAM(PH_PLE);
    if (IN(PH_FINAL)) { ph_final(F, args); }
#undef IN
#undef SEAM
}

extern "C" void kernel_launch(void* const* d_in, const int* in_sizes, int n_in, void* d_out, int out_size, void* d_ws, size_t ws_size, hipStream_t stream) {
    static int grid = 0;
    if (grid == 0) {
        if (n_in != 20 || in_sizes[0] != NTOK * DM || out_size != NTOK * DM || ws_size < WS_END) { fprintf(stderr, "kernel_launch: unexpected shapes (n_in %d, in0 %d, out %d, ws %zu)\n", n_in, n_in > 0 ? in_sizes[0] : -1, out_size, ws_size); grid = -1; return; }
        int dev = 0, cus = 0, per_cu = 0;
        if (hipGetDevice(&dev) != hipSuccess || hipDeviceGetAttribute(&cus, hipDeviceAttributeMultiprocessorCount, dev) != hipSuccess) { grid = -1; return; }
        if (hipFuncSetAttribute((const void*)mega, hipFuncAttributeMaxDynamicSharedMemorySize, LDS_BYTES) != hipSuccess) { fprintf(stderr, "kernel_launch: hipFuncSetAttribute failed\n"); grid = -1; return; }
        if (hipOccupancyMaxActiveBlocksPerMultiprocessor(&per_cu, (const void*)mega, NWAVES * 64, LDS_BYTES) != hipSuccess || per_cu < 1) fprintf(stderr, "kernel_launch: occupancy query reports %d\n", per_cu);
        (void)hipGetLastError();
        grid = cus;
    }
    if (grid < 0) return;
    unsigned char* ws = (unsigned char*)d_ws;
    if (hipMemsetAsync(ws + WS_CTL, 0, CTL_ZERO_BYTES, stream) != hipSuccess) return;
    Args a{};
    for (int i = 0; i < 20; ++i) a.in[i] = (const float*)d_in[i];
    a.out = (float*)d_out; a.ws = ws;
#if SPLIT_PHASES
    for (int p = 0; p < NPH; ++p) { a.ph_lo = p; a.ph_hi = p + 1; a.li = 0; hipLaunchKernelGGL(mega, dim3(grid), dim3(NWAVES * 64), LDS_BYTES, stream, a); }
#else
    a.ph_lo = 0; a.ph_hi = NPH; a.li = 0;
    hipLaunchKernelGGL(mega, dim3(grid), dim3(NWAVES * 64), LDS_BYTES, stream, a);
#endif
}
```

```cpp
#define DUP_MASK 0
#include <hip/hip_runtime.h>
#include <cstdio>
#include <cstdint>

#ifndef SPLIT_PHASES
#define SPLIT_PHASES 0
#endif
#ifndef DUP_MASK
#define DUP_MASK 0
#endif

constexpr int NTOK = 32768, DM = 1024, SEQ = 4096, NBATCH = 8;
constexpr int NMAIN = 4608, NTR = 1536, NWIN = 5632;
constexpr int C_RQ = 0, C_RK = 512, C_RG = 1024, C_SQ = 1536, C_SK = 2048, C_GR = 2560, C_GS = 3584;
constexpr int C_MG = 0;
constexpr int T_KT = 0, T_VR = 512, T_VS = 1024;
constexpr int NEXP = 16, DEXP = 512, MPAD_MAX = 65536 + 16 * 256, NRT_MAX = MPAD_MAX / 256;
constexpr float EPS = 1e-6f;
constexpr float LOG2E = 1.4426950408889634f;
constexpr float SB_QSCALE = 0.125f * LOG2E;
constexpr float SB_EXIT = -152.0f;

constexpr size_t MiB = 1u << 20;
constexpr size_t WS_CTL = 0, CTL_ZERO_BYTES = 1 * MiB;
constexpr size_t WS_WIN = 2 * MiB;
constexpr size_t WS_WBR1 = 14 * MiB;
constexpr size_t WS_WBR2 = 15 * MiB;
constexpr size_t WS_WOUT = 16 * MiB;
constexpr size_t WS_WGU = 18 * MiB;
constexpr size_t WS_WD = 50 * MiB;
constexpr size_t WS_WPLE = 66 * MiB;
constexpr size_t WS_WPG = 67 * MiB;
constexpr size_t WS_TABA = 70 * MiB;
constexpr size_t WS_RW = 72 * MiB;
constexpr size_t WS_ROUTE = 74 * MiB;
constexpr size_t WS_PB = 76 * MiB;
constexpr size_t WS_PROJ = 92 * MiB;
constexpr size_t WS_T = 380 * MiB;
constexpr size_t WS_X2 = 360 * MiB;
constexpr size_t WS_PE = 424 * MiB;
constexpr size_t WS_END = 488 * MiB;
constexpr size_t WS_H2 = 92 * MiB;
constexpr size_t WS_LTOK = 92 * MiB, WS_LW = 94 * MiB, WS_LRS = 96 * MiB;
constexpr size_t WS_XB = 156 * MiB;
constexpr size_t WS_HID = 292 * MiB;
constexpr size_t DO_HB = 0, DO_ST = 0, DO_X1 = 0, DO_RS = 64 * MiB;
constexpr size_t RT_EID = 0, RT_WGT = 256 * 1024, RT_RANK = 512 * 1024;
constexpr int CW_TMO = 0, CW_CODE = 1;
constexpr int CW_CNT = 64;
constexpr int CW_BAR = 4096, BAR_STRIDE = 4096;

#define GAS __attribute__((address_space(1)))
#define LAS __attribute__((address_space(3)))
typedef unsigned short bf16;
typedef unsigned v4u __attribute__((ext_vector_type(4)));
typedef unsigned v2u __attribute__((ext_vector_type(2)));
typedef float f32x4 __attribute__((ext_vector_type(4)));
typedef float f32x2 __attribute__((ext_vector_type(2)));
typedef float f32x16 __attribute__((ext_vector_type(16)));
typedef short bf16x8 __attribute__((ext_vector_type(8)));
typedef short s16x4 __attribute__((ext_vector_type(4)));
typedef GAS unsigned gu32;
#define RLX_AGENT __ATOMIC_RELAXED, __HIP_MEMORY_SCOPE_AGENT
#define LDS_WAIT() asm volatile("s_waitcnt lgkmcnt(0)" ::: "memory")
#define VM_WAIT() asm volatile("s_waitcnt vmcnt(0)" ::: "memory")
#define DI __device__ __forceinline__
DI unsigned f2bf(float f) { unsigned u = __builtin_bit_cast(unsigned, f); return (u + 0x7fffu + ((u >> 16) & 1u)) >> 16; }
DI unsigned pk2(float lo, float hi) { return f2bf(lo) | (f2bf(hi) << 16); }
DI float bf2f(unsigned b) { return __builtin_bit_cast(float, b << 16); }
DI float bflo(unsigned w) { return __builtin_bit_cast(float, w << 16); }
DI float bfhi(unsigned w) { return __builtin_bit_cast(float, w & 0xffff0000u); }
DI float fsigmoid(float x) { return 1.0f / (1.0f + __expf(-x)); }
DI float fsilu(float x) { return x / (1.0f + __expf(-x)); }
DI float wave_sum(float v) {
#pragma unroll
    for (int o = 1; o < 64; o <<= 1) v += __shfl_xor(v, o);
    return v;
}
template <int CTRL, int ROWMASK> DI float dpp_add(float v) { return v + __builtin_bit_cast(float, __builtin_amdgcn_update_dpp(0, __builtin_bit_cast(int, v), CTRL, ROWMASK, 0xF, false)); }
DI float wave_sum_dpp(float v) {
    v = dpp_add<0xB1, 0xF>(v);
    v = dpp_add<0x4E, 0xF>(v);
    v = dpp_add<0x141, 0xF>(v);
    v = dpp_add<0x140, 0xF>(v);
    v = dpp_add<0x142, 0xA>(v);
    v = dpp_add<0x143, 0xC>(v);
    return __builtin_bit_cast(float, __builtin_amdgcn_readlane(__builtin_bit_cast(int, v), 63));
}
DI float ret_log2g(int h) { return log2f(1.0f - exp2f(-5.0f - (float)h)); }

__host__ __device__ __forceinline__ int in_src(int r) {
    if (r < 1024) { const int base = (r < 512) ? 0 : 512; const int i = r & 511, h = i >> 7, j = i & 127; return base + h * 128 + (j & 1) * 64 + (j >> 1); }
    if (r < 1536) return 1536 + (r - 1024);
    if (r < 2048) return 2048 + (r - 1536);
    if (r < 2560) return 2560 + (r - 2048);
    if (r < 3584) return 3584 + (r - 2560);
    if (r < 4608) return 4608 + (r - 3584);
    if (r < 5120) { const int i = r - 4608, h = i >> 7, j = i & 127; return 512 + h * 128 + (j & 1) * 64 + (j >> 1); }
    if (r < 5632) return 1024 + (r - 5120);
    return 3072 + (r - 5632);
}


#define MFMA32(a, b, c) __builtin_amdgcn_mfma_f32_32x32x16_bf16((a), (b), (c), 0, 0, 0)
DI int crow(int reg, int h) { return (reg & 3) + 8 * (reg >> 2) + 4 * h; }
DI bf16x8 ld16(const bf16* p) { return *(const bf16x8*)p; }
DI bf16x8 ld8x2(const bf16* p0, const bf16* p1) { const s16x4 lo = *(const s16x4*)p0, hi = *(const s16x4*)p1; return __builtin_shufflevector(lo, hi, 0, 1, 2, 3, 4, 5, 6, 7); }
DI f32x16 splat16(float v) { f32x16 x;
#pragma unroll
    for (int i = 0; i < 16; ++i) x[i] = v; return x; }

namespace pg8 {
#define PG8_LAS __attribute__((address_space(3)))
typedef unsigned short bf16_t;
typedef short bf16x8 __attribute__((ext_vector_type(8)));
typedef float f32x4 __attribute__((ext_vector_type(4)));
typedef unsigned u32x4 __attribute__((ext_vector_type(4)));
constexpr int BM = 256, BK = 64, HALF = 128, HTB = HALF * BK * 2  , STAGE_BYTES = 8 * HTB, NXCD = 8, WGM = 8;

__host__ __device__ __forceinline__ int lds_byte(int r, int c) { const int st = (r >> 4) * 2 + (c >> 5), rr = r & 15, cc = c & 31, ob = rr * 64 + cc * 2; return st * 1024 + (ob ^ (((ob >> 9) & 1) << 5)); }
__host__ __device__ __forceinline__ void stage_rc(int b, int& R, int& C) { const int st = b / 1024, sb = b % 1024, swz = sb ^ (((sb >> 9) & 1) << 5); R = (st >> 1) * 16 + swz / 64; C = (st & 1) * 32 + (swz % 64) / 2; }
__host__ __device__ __forceinline__ int perm32(int rho) { const int n = rho >> 4, i = rho & 15; return 8 * (i >> 2) + 4 * n + (i & 3); }

struct Unit { int pm, pn; size_t bofs; int ex; };
struct Gemm { const bf16_t* A; const bf16_t* Bt; int lda, K; };

struct StaticOrder {
    static constexpr bool GATHER = false;
    int nM, nN, nwg, G, c; size_t tstepB;
    __device__ __forceinline__ unsigned arow_off(const Unit&, int) const { return 0u; }
    __device__ void init(int M, int N, int K, int G_, int c_) { nM = M / BM; nN = N / BM; nwg = nM * nN; G = G_; c = c_; tstepB = (size_t)BM * K * 2; }
    __device__ bool next(int i, Unit& u) const {
        const long L = (long)i * G + c; if (L >= nwg) return false;
        int wgid = (int)L; { const int q = nwg / NXCD, r = nwg % NXCD, xcd = wgid % NXCD, off = wgid / NXCD; wgid = (xcd < r ? xcd * (q + 1) : r * (q + 1) + (xcd - r) * q) + off; }
        const int nig = WGM * nN, gid = wgid / nig, fm = gid * WGM, gsz = (nM - fm) < WGM ? (nM - fm) : WGM;
        u.pm = fm + ((wgid % nig) % gsz); u.pn = (wgid % nig) / gsz; u.bofs = (size_t)u.pn * tstepB; u.ex = 0; return true;
    }
    __device__ __forceinline__ void a_ready(const Unit&) const {}
    __device__ __forceinline__ void done(const Unit&) const {}
};
__device__ __forceinline__ unsigned cvt_pk_bf16(float lo, float hi) { unsigned r; asm volatile("v_cvt_pk_bf16_f32 %0, %1, %2" : "=v"(r) : "v"(lo), "v"(hi)); return r; }
template <class Epi, class Sched, bool ALIGN_EPI = false, bool SP2 = false>
__device__ __forceinline__ void gemm_phase(PG8_LAS unsigned char* lds, const Gemm g, const Sched& S, const Epi& E) {
    int tid_ = threadIdx.x; asm volatile("" : "+v"(tid_));
    const int tid = tid_, wid = __builtin_amdgcn_readfirstlane(tid >> 6), lane = tid & 63, wr = wid >> 2, wc = wid & 3, fr = lane & 15, fq = lane >> 4;
    const int K = g.K, nt = K / BK;
    unsigned voffA[2], voffB[2];
#pragma unroll
    for (int i = 0; i < 2; ++i) { int R, C; stage_rc(tid * 16 + i * 8192, R, C); const int Rb = Epi::PERM ? ((R & ~31) + perm32(R & 31)) : R;
        voffA[i] = (unsigned)(R * g.lda + C) * 2u; voffB[i] = (unsigned)(Rb * K + C) * 2u; }
    constexpr bool GATH = Sched::GATHER;
    static_assert(!GATH || SP2, "gather mode is written for the SP2 loop only");
    int gR[2]; unsigned gC[2];
#pragma unroll
    for (int i = 0; i < 2; ++i) { int R, C; stage_rc(tid * 16 + i * 8192, R, C); gR[i] = R; gC[i] = (unsigned)C * 2u; }
    unsigned voffC0[2] = {0u, 0u}, voffC1[2] = {0u, 0u}, voffN0[2] = {0u, 0u}, voffN1[2] = {0u, 0u};
    const size_t kstep = (size_t)(BK * 2);
    const size_t hstepA = (size_t)HALF * g.lda * 2, hstepB = (size_t)HALF * K * 2;
    const size_t tstepA = 2 * hstepA;
    const unsigned ldsw = (unsigned)wid * 1024u;
    const int aoff = lds_byte(wr * 64 + fr, fq * 8), boff = lds_byte(wc * 32 + fr, fq * 8);
#define PG8_SA(b, h) (((b) * 2 + (h)) * HTB)
#define PG8_SB(b, h) ((4 + (b) * 2 + (h)) * HTB)
#define PG8_STAGE(bufoff, gbase, voff) do { _Pragma("unroll") for (int _i = 0; _i < 2; ++_i) \
        __builtin_amdgcn_global_load_lds((const unsigned*)((const char*)(gbase) + (voff)[_i]), (PG8_LAS unsigned*)(lds + (bufoff) + ldsw + _i * 8192), 16, 0, 0); } while (0)
#define PG8_STAGE_A(bufoff, gbase, half, nextu) do { if constexpr (!GATH) { PG8_STAGE(bufoff, (gbase) + ((half) ? hstepA : (size_t)0), voffA); } else { _Pragma("unroll") for (int _i = 0; _i < 2; ++_i) { \
        const unsigned _o = (nextu) ? ((half) ? voffN1[_i] : voffN0[_i]) : ((half) ? voffC1[_i] : voffC0[_i]); \
        __builtin_amdgcn_global_load_lds((const unsigned*)((const char*)(gbase) + _o), (PG8_LAS unsigned*)(lds + (bufoff) + ldsw + _i * 8192), 16, 0, 0); } } } while (0)
#define PG8_GOFFS(u, d0, d1) do { _Pragma("unroll") for (int _i = 0; _i < 2; ++_i) { d0[_i] = S.arow_off(u, gR[_i]) + gC[_i]; d1[_i] = S.arow_off(u, 128 + gR[_i]) + gC[_i]; } } while (0)
#define PG8_LDA(dst, b, h) do { _Pragma("unroll") for (int m = 0; m < 4; ++m) _Pragma("unroll") for (int k = 0; k < 2; ++k) dst[m][k] = *(const PG8_LAS bf16x8*)(lds + PG8_SA(b, h) + aoff + m * 2048 + k * 1024); } while (0)
#define PG8_LDB(dst, b, h) do { _Pragma("unroll") for (int n = 0; n < 2; ++n) _Pragma("unroll") for (int k = 0; k < 2; ++k) dst[n][k] = *(const PG8_LAS bf16x8*)(lds + PG8_SB(b, h) + boff + n * 2048 + k * 1024); } while (0)
#define PG8_MMA(ai, bj, At, Bt) do { __builtin_amdgcn_s_setprio(1); _Pragma("unroll") for (int m = 0; m < 4; ++m) _Pragma("unroll") for (int n = 0; n < 2; ++n) _Pragma("unroll") for (int k = 0; k < 2; ++k) \
        acc[ai][bj][m][n] = __builtin_amdgcn_mfma_f32_16x16x32_bf16(Bt[n][k], At[m][k], acc[ai][bj][m][n], 0, 0, 0); __builtin_amdgcn_s_setprio(0); } while (0)
#define PG8_WAIT_V(n) asm volatile("s_waitcnt vmcnt(" #n ")" ::: "memory")
#define PG8_WAIT_L(n) asm volatile("s_waitcnt lgkmcnt(" #n ")" ::: "memory")
#define PG8_BAR __builtin_amdgcn_s_barrier()
#define PG8_SCHED __builtin_amdgcn_sched_barrier(0)
    Unit cur, nxt; int ui = 0;
    if (!S.next(0, cur)) return;
    f32x4 acc[2][2][4][2];
#pragma unroll
    for (int a = 0; a < 2; ++a)
#pragma unroll
        for (int b = 0; b < 2; ++b)
#pragma unroll
            for (int m = 0; m < 4; ++m)
#pragma unroll
                for (int n = 0; n < 2; ++n) acc[a][b][m][n] = (f32x4){0.f, 0.f, 0.f, 0.f};
    bf16x8 At[4][2], B0[2][2], B1[2][2];
    const char* cA = (const char*)g.A + (GATH ? (size_t)0 : (size_t)cur.pm * tstepA); const char* cB = (const char*)g.Bt + cur.bofs;
    if constexpr (GATH) PG8_GOFFS(cur, voffC0, voffC1);
    S.a_ready(cur);
    if constexpr (SP2) {
        PG8_STAGE(PG8_SB(0, 0), cB, voffB); PG8_STAGE(PG8_SB(0, 1), cB + hstepB, voffB); PG8_STAGE_A(PG8_SA(0, 0), cA, 0, false); PG8_STAGE_A(PG8_SA(0, 1), cA, 1, false);
        if (wr == 1) PG8_BAR;
        PG8_WAIT_V(2); PG8_BAR;
        PG8_STAGE(PG8_SB(1, 0), cB + kstep, voffB); PG8_STAGE_A(PG8_SA(1, 0), cA + kstep, 0, false); PG8_STAGE(PG8_SB(1, 1), cB + hstepB + kstep, voffB);
        PG8_WAIT_V(6); PG8_BAR;
    } else {
        PG8_STAGE(PG8_SB(0, 0), cB, voffB); PG8_STAGE(PG8_SA(0, 0), cA, voffA); PG8_STAGE(PG8_SB(0, 1), cB + hstepB, voffB); PG8_STAGE(PG8_SA(0, 1), cA + hstepA, voffA);
        if (wr == 1) PG8_BAR;
        PG8_WAIT_V(4); PG8_BAR;
        PG8_STAGE(PG8_SB(1, 0), cB + kstep, voffB); PG8_STAGE(PG8_SA(1, 0), cA + kstep, voffA); PG8_STAGE(PG8_SB(1, 1), cB + hstepB + kstep, voffB);
        PG8_WAIT_V(6); PG8_BAR;
    }
    for (;;) {
        const bool has_next = S.next(ui + 1, nxt);
        const char* nA = has_next ? (const char*)g.A + (GATH ? (size_t)0 : (size_t)nxt.pm * tstepA) : cA; const char* nB = has_next ? (const char*)g.Bt + nxt.bofs : cB;
        if constexpr (GATH) { if (has_next) PG8_GOFFS(nxt, voffN0, voffN1); }
        const bool nu = GATH && has_next;
        for (int th = 0; th < (Epi::MIDK > 0 ? 2 : 1); ++th) {
        if constexpr (Epi::MIDK > 0) { if (th == 1) E.mid(acc, cur, wr, wc, fr, fq); }
        const int t_lo = (Epi::MIDK > 0 && th == 1) ? Epi::MIDK : 0, t_hi = (Epi::MIDK > 0 && th == 0) ? Epi::MIDK : nt;
        for (int t = t_lo; t < t_hi; t += 2) {
            const bool last = (t == nt - 2);
            const char* a1 = cA + (size_t)(t + 1) * kstep;
            const char* a2 = last ? nA : cA + (size_t)(t + 2) * kstep; const char* b2 = last ? nB : cB + (size_t)(t + 2) * kstep;
            const char* a3 = a2 + kstep; const char* b3 = b2 + kstep;
            if (last && has_next) S.a_ready(nxt);
            if constexpr (SP2) {
            PG8_LDB(B0, 0, 0); PG8_LDB(B1, 0, 1); PG8_SCHED; PG8_LDA(At, 0, 0); PG8_STAGE_A(PG8_SA(1, 1), a1, 1, false);
            PG8_WAIT_V(8); PG8_WAIT_L(0); PG8_BAR; PG8_MMA(0, 0, At, B0); PG8_MMA(0, 1, At, B1); PG8_BAR; PG8_SCHED;
            PG8_LDA(At, 0, 1); PG8_STAGE(PG8_SB(0, 0), b2, voffB); PG8_STAGE(PG8_SB(0, 1), b2 + hstepB, voffB); PG8_STAGE_A(PG8_SA(0, 0), a2, 0, last && nu);
            PG8_WAIT_V(8); PG8_WAIT_L(0); PG8_BAR; PG8_MMA(1, 0, At, B0); PG8_MMA(1, 1, At, B1); PG8_BAR; PG8_SCHED;
            PG8_LDB(B0, 1, 0); PG8_LDB(B1, 1, 1); PG8_SCHED; PG8_LDA(At, 1, 0); PG8_STAGE_A(PG8_SA(0, 1), a2, 1, last && nu);
            PG8_WAIT_V(8); PG8_WAIT_L(0); PG8_BAR; PG8_MMA(0, 0, At, B0); PG8_MMA(0, 1, At, B1); PG8_BAR; PG8_SCHED;
            PG8_LDA(At, 1, 1); PG8_STAGE(PG8_SB(1, 0), b3, voffB); PG8_STAGE(PG8_SB(1, 1), b3 + hstepB, voffB); PG8_STAGE_A(PG8_SA(1, 0), a3, 0, last && nu);
            PG8_WAIT_V(8); PG8_WAIT_L(0); PG8_BAR; PG8_MMA(1, 0, At, B0); PG8_MMA(1, 1, At, B1); PG8_BAR; PG8_SCHED;
            } else {
            PG8_LDB(B0, 0, 0); PG8_SCHED; PG8_LDA(At, 0, 0); PG8_STAGE(PG8_SA(1, 1), a1 + hstepA, voffA);
            PG8_WAIT_L(8); PG8_BAR; PG8_WAIT_L(0); PG8_MMA(0, 0, At, B0); PG8_BAR; PG8_SCHED;
            PG8_LDB(B1, 0, 1); PG8_STAGE(PG8_SB(0, 0), b2, voffB);
            PG8_BAR; PG8_WAIT_L(0); PG8_MMA(0, 1, At, B1); PG8_BAR;
            PG8_LDA(At, 0, 1); PG8_STAGE(PG8_SA(0, 0), a2, voffA);
            PG8_BAR; PG8_WAIT_L(0); PG8_MMA(1, 0, At, B0); PG8_BAR; PG8_SCHED;
            PG8_STAGE(PG8_SB(0, 1), b2 + hstepB, voffB);
            PG8_WAIT_V(6); PG8_BAR; PG8_MMA(1, 1, At, B1); PG8_BAR;
            PG8_LDB(B0, 1, 0); PG8_SCHED; PG8_LDA(At, 1, 0); PG8_STAGE(PG8_SA(0, 1), a2 + hstepA, voffA);
            PG8_WAIT_L(8); PG8_BAR; PG8_WAIT_L(0); PG8_MMA(0, 0, At, B0); PG8_BAR; PG8_SCHED;
            PG8_LDB(B1, 1, 1); PG8_STAGE(PG8_SB(1, 0), b3, voffB);
            PG8_BAR; PG8_WAIT_L(0); PG8_MMA(0, 1, At, B1); PG8_BAR;
            PG8_LDA(At, 1, 1); PG8_STAGE(PG8_SA(1, 0), a3, voffA);
            PG8_BAR; PG8_WAIT_L(0); PG8_MMA(1, 0, At, B0); PG8_BAR; PG8_SCHED;
            PG8_STAGE(PG8_SB(1, 1), b3 + hstepB, voffB);
            PG8_WAIT_V(6); PG8_BAR; PG8_MMA(1, 1, At, B1); PG8_BAR;
            }
        }
        }
        if constexpr (ALIGN_EPI) { if (wr == 0) PG8_BAR; }
        if constexpr (!Epi::AFTER_DRAIN) { E(acc, cur, wr, wc, fr, fq); S.done(cur); }
        if (!has_next) break;
#pragma unroll
        for (int a = 0; a < 2; ++a)
#pragma unroll
            for (int b = 0; b < 2; ++b)
#pragma unroll
                for (int m = 0; m < 4; ++m)
#pragma unroll
                    for (int n = 0; n < 2; ++n) acc[a][b][m][n] = (f32x4){0.f, 0.f, 0.f, 0.f};
        cur = nxt; cA = nA; cB = nB; ++ui;
        if constexpr (GATH) { _Pragma("unroll") for (int _i = 0; _i < 2; ++_i) { voffC0[_i] = voffN0[_i]; voffC1[_i] = voffN1[_i]; } }
        if constexpr (ALIGN_EPI) { if (wr == 1) PG8_BAR; }
    }
    PG8_WAIT_V(0);
    if constexpr (!ALIGN_EPI) { if (wr == 0) PG8_BAR; }
    PG8_BAR;
    if constexpr (Epi::AFTER_DRAIN) { E.fused(acc, cur, wr, wc, fr, fq, lds, wid, lane); S.done(cur); }
#undef PG8_SA
#undef PG8_SB
#undef PG8_STAGE
#undef PG8_STAGE_A
#undef PG8_GOFFS
#undef PG8_LDA
#undef PG8_LDB
#undef PG8_MMA
#undef PG8_WAIT_V
#undef PG8_WAIT_L
#undef PG8_BAR
#undef PG8_SCHED
}
}
#define XB_TMO      128
#define XB_XCNT(j)  (256  + 64 * (j))
#define XB_XSUB(j)  (1280 + 64 * (j))
#define XB_XGEN(j)  (2304 + 64 * (j))
#define XB_TOP      3328
#define XB_TOPGEN   3392
#define XCD_BAR_WORDS 3456
#define XB_SPIN_CAP (1u << 18)

__device__ __forceinline__ unsigned xb_ld(unsigned* p)              { return __hip_atomic_load(p, __ATOMIC_RELAXED, __HIP_MEMORY_SCOPE_AGENT); }
__device__ __forceinline__ unsigned xb_add(unsigned* p, unsigned v) { return __hip_atomic_fetch_add(p, v, __ATOMIC_RELAXED, __HIP_MEMORY_SCOPE_AGENT); }
__device__ __forceinline__ unsigned xb_xcc_id() { return (unsigned)__builtin_amdgcn_s_getreg((3 << 11) | 20) & 0xFu; }
#define XB_SPIN(cond, bar) do { unsigned _sp = 0; while (cond) { __builtin_amdgcn_s_sleep(1); \
    if ((++_sp & 255u) == 0u) { if (xb_ld(&(bar)[XB_TMO])) break; if (_sp > XB_SPIN_CAP) { atomicAdd(&(bar)[XB_TMO], 1u); break; } } } } while (0)

struct XcdBarrier {
    unsigned* bar; unsigned x;
    volatile LAS unsigned* st;
};

__device__ __forceinline__ XcdBarrier xcd_barrier_post(unsigned* bar, volatile LAS unsigned* st) {
    XcdBarrier b; b.bar = bar; b.x = xb_xcc_id(); b.st = st;
    if (threadIdx.x == 0) (void)xb_add(&bar[XB_XCNT(b.x)], 1u);
    return b;
}
__device__ __forceinline__ void xcd_barrier_complete(unsigned* bar, unsigned x, unsigned& nloc, unsigned& nx) {
    const unsigned G = gridDim.x * gridDim.y * gridDim.z;
    unsigned sum, cnt, mine, sp = 0u;
    for (;;) {
        sum = 0u; cnt = 0u; mine = 0u;
#pragma unroll
        for (unsigned j = 0; j < 16; ++j) { const unsigned c = xb_ld(&bar[XB_XCNT(j)]); sum += c; cnt += (c > 0u) ? 1u : 0u; mine = (j == x) ? c : mine; }
        if (sum == G) break;
        __builtin_amdgcn_s_sleep(1);
        if ((++sp & 255u) == 0u) { if (xb_ld(&bar[XB_TMO])) break; if (sp > XB_SPIN_CAP) { atomicAdd(&bar[XB_TMO], 1u); break; } }
    }
    nloc = mine > 0u ? mine : 1u; nx = cnt > 0u ? cnt : 1u;
}

__device__ __forceinline__ void xcd_barrier(const XcdBarrier& b) {
    asm volatile("s_waitcnt vmcnt(0)" ::: "memory");
    __syncthreads();
    if (threadIdx.x == 0) {
        unsigned* bar = b.bar;
        __builtin_amdgcn_s_waitcnt(0);
        unsigned nloc = b.st[0], nx = b.st[1];
        if (nloc == 0u) { xcd_barrier_complete(bar, b.x, nloc, nx); b.st[0] = nloc; b.st[1] = nx; }
        const unsigned old = xb_add(&bar[XB_XSUB(b.x)], 1u);
        const unsigned gen = old / nloc;
        if (old + 1u == (gen + 1u) * nloc) {
            __builtin_amdgcn_fence(__ATOMIC_RELEASE, "agent");
            asm volatile("s_waitcnt vmcnt(0)" ::: "memory");
            const unsigned og = xb_add(&bar[XB_TOP], 1u);
            const unsigned tg = og / nx;
            if (og + 1u == (tg + 1u) * nx) xb_add(&bar[XB_TOPGEN], 1u);
            else XB_SPIN(xb_ld(&bar[XB_TOPGEN]) == tg, bar);
            __builtin_amdgcn_fence(__ATOMIC_ACQUIRE, "agent");
            xb_add(&bar[XB_XGEN(b.x)], 1u);
            asm volatile("s_waitcnt vmcnt(0)" ::: "memory");
        } else {
            XB_SPIN(xb_ld(&bar[XB_XGEN(b.x)]) == gen, bar);
            __builtin_amdgcn_fence(__ATOMIC_ACQUIRE, "agent");
            asm volatile("s_waitcnt vmcnt(0)" ::: "memory");
        }
    }
    __syncthreads();
}

constexpr int NWAVES = 8;
constexpr int RING_OFF = 0, RING_BYTES = 131072;
constexpr int LDSCTL_OFF = RING_BYTES, MISC_OFF = LDSCTL_OFF + 320;
constexpr int LDS_BYTES = 147456;

struct Args { const float* in[20]; float* out; unsigned char* ws; int ph_lo, ph_hi, li, pad; };

struct Frame {
    LAS unsigned char* lds;
    volatile LAS unsigned* MISC;
    gu32* ctl;
    int tid, lane, wave, vcu, G;
    __device__ __forceinline__ void refresh() { int t = threadIdx.x; asm volatile("" : "+v"(t)); tid = t; lane = t & 63; wave = __builtin_amdgcn_readfirstlane(t >> 6); }
    unsigned char* ws; float* out;
    const float* x; const float* p;
};

enum Phase { PH_PRO = 0, PH_PROJ, PH_MIX1, PH_SCAN, PH_RETO, PH_BR, PH_WOUT, PH_ROUTE, PH_GU, PH_DOWN, PH_COMB, PH_PLE, PH_FINAL, NPH };

DI void tr_item(const float* __restrict__ W, int ldw, int mycol, bf16* WT, int K, int r0, int k0, LAS float* scr, int lane, const float* __restrict__ kscale = nullptr) {
#pragma unroll 8
    for (int i = 0; i < 32; ++i) { const int kk = 2 * i + (lane >> 5); float w = W[(size_t)(k0 + kk) * ldw + mycol]; if (kscale) w *= kscale[k0 + kk]; scr[kk * 33 + (lane & 31)] = w; }
    LDS_WAIT(); asm volatile("" ::: "memory");
    const int c = lane & 7;
#pragma unroll
    for (int j = 0; j < 4; ++j) { const int n = (lane >> 3) + 8 * j; const LAS float* s = scr + (8 * c) * 33 + n;
        v4u o; o.x = pk2(s[0 * 33], s[1 * 33]); o.y = pk2(s[2 * 33], s[3 * 33]); o.z = pk2(s[4 * 33], s[5 * 33]); o.w = pk2(s[6 * 33], s[7 * 33]);
        *(GAS v4u*)(WT + (size_t)(r0 + n) * K + k0 + 8 * c) = o; }
    LDS_WAIT(); asm volatile("" ::: "memory");
}
DI void rms_row_to_bf16(const float* xrow, const float* gain, bf16* orow, int lane) {
    const GAS f32x4* xr = (const GAS f32x4*)xrow + lane; const GAS f32x4* gr = (const GAS f32x4*)gain + lane;
    f32x4 v[4]; float s = 0.f;
#pragma unroll
    for (int j = 0; j < 4; ++j) { v[j] = xr[64 * j]; s += (v[j].x * v[j].x + v[j].y * v[j].y) + (v[j].z * v[j].z + v[j].w * v[j].w); }
    const float rstd = rsqrtf(wave_sum_dpp(s) * (1.f / DM) + EPS);
    GAS v2u* o8 = (GAS v2u*)orow + lane;
#pragma unroll
    for (int j = 0; j < 4; ++j) { const f32x4 g = gr[64 * j]; v2u o; o.x = pk2(v[j].x * rstd * g.x, v[j].y * rstd * g.y); o.y = pk2(v[j].z * rstd * g.z, v[j].w * rstd * g.w); o8[64 * j] = o; }
}
DI void ph_prologue(Frame& F, const Args& a) {
    LAS float* scr = (LAS float*)(F.lds + RING_OFF + F.wave * 16384);
    const int gw = F.vcu * NWAVES + F.wave, NGW = F.G * NWAVES, lane = F.lane;
    unsigned char* ws = F.ws;
    constexpr int I_IN = (6144 / 32) * 16, I_BR = 32 * 8, I_OUT = 32 * 16, I_GU = 16 * 32 * 16, I_D = 16 * 32 * 8, I_PLE = 32 * 4, I_PG = 32 * 16;
    constexpr int NITEMS = I_IN + 2 * I_BR + I_OUT + I_GU + I_D + I_PLE + I_PG;
    for (int it = gw; it < NITEMS; it += NGW) {
        int r = it;
        if (r < I_IN) { const int rb = r >> 4, kb = r & 15; tr_item(a.in[3], NWIN, in_src(rb * 32 + (lane & 31)), (bf16*)(ws + WS_WIN), 1024, rb * 32, kb * 64, scr, lane); continue; } r -= I_IN;
        if (r < I_BR) { const int rb = r >> 3, kb = r & 7; tr_item(a.in[5], DM, rb * 32 + (lane & 31), (bf16*)(ws + WS_WBR1), 1024, rb * 32, kb * 64, scr, lane); continue; } r -= I_BR;
        if (r < I_BR) { const int rb = r >> 3, kb = r & 7; tr_item(a.in[6], DM, rb * 32 + (lane & 31), (bf16*)(ws + WS_WBR1) + 512, 1024, rb * 32, kb * 64, scr, lane); continue; } r -= I_BR;
        if (r < I_OUT) { const int rb = r >> 4, kb = r & 15; tr_item(a.in[7], DM, rb * 32 + (lane & 31), (bf16*)(ws + WS_WOUT), 1024, rb * 32, kb * 64, scr, lane); continue; } r -= I_OUT;
        if (r < I_GU) { const int e = r >> 9, q = r & 511, rb = q >> 4, kb = q & 15;
            const int row = rb * 32, j = row >> 8, w = row & 255; const bool up = w >= 128; const int col = 128 * j + (w & 127) + (lane & 31);
            tr_item((up ? a.in[14] : a.in[13]) + (size_t)e * DM * DEXP, DEXP, col, (bf16*)(ws + WS_WGU) + (size_t)e * 1024 * 1024, 1024, row, kb * 64, scr, lane, a.in[8]); continue; } r -= I_GU;
        if (r < I_D) { const int e = r >> 8, q = r & 255, rb = q >> 3, kb = q & 7;
            tr_item(a.in[15] + (size_t)e * DEXP * DM, DM, rb * 32 + (lane & 31), (bf16*)(ws + WS_WD) + (size_t)e * 1024 * 512, 512, rb * 32, kb * 64, scr, lane); continue; } r -= I_D;
        if (r < I_PLE) { const int rb = r >> 2, kb = r & 3; tr_item(a.in[17], DM, rb * 32 + (lane & 31), (bf16*)(ws + WS_WPLE), 256, rb * 32, kb * 64, scr, lane); continue; } r -= I_PLE;
        { const int rb = r >> 4, kb = r & 15; tr_item(a.in[18], DM, rb * 32 + (lane & 31), (bf16*)(ws + WS_WPG), 1024, rb * 32, kb * 64, scr, lane); }
    }
    bf16* HB = (bf16*)((unsigned char*)F.out + DO_HB);
    for (int m = gw; m < NTOK; m += NGW) {
        rms_row_to_bf16(F.x + (size_t)m * DM, a.in[2], HB + (size_t)m * DM, lane);
        const f32x4 pv = ((const GAS f32x4*)(F.p + (size_t)m * 256))[lane];
        v2u o; o.x = pk2(pv.x, pv.y); o.y = pk2(pv.z, pv.w); ((GAS v2u*)((bf16*)(ws + WS_PB) + (size_t)m * 256))[lane] = o;
    }
    f32x2* tabA = (f32x2*)(ws + WS_TABA);
    for (int i = F.vcu * 512 + F.tid; i < SEQ * 64; i += F.G * 512) {
        const int pos = i >> 6, p = i & 63;
        const float invf = powf(10000.0f, -(float)(2 * p) * (1.0f / 128.0f)); const float ang = (float)pos * invf;
        tabA[i] = (f32x2){cosf(ang), sinf(ang)};
    }
    for (int i = F.vcu * 512 + F.tid; i < 2 * 32 * 64; i += F.G * 512) {
        const int kh = i >> 11, ks = (i >> 6) & 31, ln = i & 63, o = ln & 31, h2 = ln >> 5;
        unsigned hi[4], lo[4];
#pragma unroll
        for (int jp = 0; jp < 4; ++jp) {
            float wv[2];
#pragma unroll
            for (int q = 0; q < 2; ++q) {
                const int k = 512 * kh + 16 * ks + 8 * h2 + 2 * jp + q;
                float w = 0.f;
                if (o < 8) w = a.in[9][k * 4 + (o & 3)];
                else if (o < 12) w = a.in[11][k * 16 + 0 + (o - 8)];
                else if (o < 16) w = a.in[11][k * 16 + 8 + (o - 12)];
                else if (o < 20) w = a.in[11][k * 16 + 4 + (o - 16)];
                else if (o < 24) w = a.in[11][k * 16 + 12 + (o - 20)];
                wv[q] = w * a.in[8][k];
            }
            const unsigned h0 = f2bf(wv[0]), h1 = f2bf(wv[1]);
            hi[jp] = h0 | (h1 << 16); lo[jp] = pk2(wv[0] - bf2f(h0), wv[1] - bf2f(h1));
        }
        v4u* RW = (v4u*)(ws + WS_RW);
        RW[i] = (v4u){hi[0], hi[1], hi[2], hi[3]}; RW[4096 + i] = (v4u){lo[0], lo[1], lo[2], lo[3]};
    }
}

DI void ph_route(Frame& F, const Args& a, const int dry = 0) {
    unsigned char* ws = F.ws; const int lane = F.lane, r = lane & 31, h2 = lane >> 5, tid = F.tid;
    const bf16* __restrict__ X1 = (const bf16*)((unsigned char*)F.out + DO_X1);
    int* eid = (int*)(ws + WS_ROUTE + RT_EID); float* wgt = (float*)(ws + WS_ROUTE + RT_WGT); int* rank = (int*)(ws + WS_ROUTE + RT_RANK);
    int* ltok = (int*)(ws + WS_LTOK); float* lw = (float*)(ws + WS_LW); float* lrs = (float*)(ws + WS_LRS);
    if (dry) { eid = (int*)(ws + WS_T); wgt = (float*)(ws + WS_T + 1 * MiB); rank = (int*)(ws + WS_T + 2 * MiB); ltok = (int*)(ws + WS_T + 4 * MiB); lw = (float*)(ws + WS_T + 8 * MiB); lrs = (float*)(ws + WS_T + 12 * MiB); }
    const v4u* __restrict__ RW = (const v4u*)(ws + WS_RW);
    LAS v4u* TAB = (LAS v4u*)F.lds;
    LAS float* cmb = (LAS float*)F.lds;
    LAS int* s_e = (LAS int*)(F.lds + 16384); LAS int* s_lr = s_e + 256; LAS float* s_w = (LAS float*)(s_lr + 256); LAS float* s_rs = s_w + 256; LAS int* lcnt = (LAS int*)(s_rs + 128); LAS int* lbase = lcnt + 16;
    const float* bg = a.in[10]; const float* be = a.in[12];
    const int grp = F.wave >> 1, kh = F.wave & 1;
    for (int blk = F.vcu; blk < NTOK / 128; blk += F.G) {
        __syncthreads();
#pragma unroll 4
        for (int i = tid; i < 8192; i += 512) TAB[i] = RW[i];
        __syncthreads();
        const int t0 = blk * 128 + grp * 32;
        const bf16* xrow = X1 + (size_t)(t0 + r) * DM + 512 * kh + 8 * h2;
        f32x16 acc = splat16(0.f); float ss = 0.f;
#pragma unroll 8
        for (int ks = 0; ks < 32; ++ks) {
            const bf16x8 b = ld16(xrow + 16 * ks);
            const bf16x8 ah = __builtin_bit_cast(bf16x8, TAB[(kh * 32 + ks) * 64 + lane]), al = __builtin_bit_cast(bf16x8, TAB[4096 + (kh * 32 + ks) * 64 + lane]);
            acc = MFMA32(ah, b, acc); acc = MFMA32(al, b, acc);
            const v4u bw = __builtin_bit_cast(v4u, b);
            ss += (bflo(bw.x) * bflo(bw.x) + bfhi(bw.x) * bfhi(bw.x)) + (bflo(bw.y) * bflo(bw.y) + bfhi(bw.y) * bfhi(bw.y)) + (bflo(bw.z) * bflo(bw.z) + bfhi(bw.z) * bfhi(bw.z)) + (bflo(bw.w) * bflo(bw.w) + bfhi(bw.w) * bfhi(bw.w));
        }
        ss += __shfl_xor(ss, 32);
        __syncthreads();
        if (tid < 16) lcnt[tid] = 0;
        if (kh == 1) { LAS float* c = cmb + (grp * 64 + lane) * 13;
#pragma unroll
            for (int q = 0; q < 12; ++q) c[q] = acc[q];
            c[12] = ss; }
        __syncthreads();
        if (kh == 0) {
            const LAS float* c = cmb + (grp * 64 + lane) * 13;
#pragma unroll
            for (int q = 0; q < 12; ++q) acc[q] += c[q];
            ss += c[12];
            const float rstd = rsqrtf(ss * (1.f / DM) + EPS);
            float gl[4];
#pragma unroll
            for (int i = 0; i < 4; ++i) gl[i] = acc[i] * rstd + bg[i];
            int g = 0; float gm = gl[0];
#pragma unroll
            for (int i = 1; i < 4; ++i) if (gl[i] > gm) { gm = gl[i]; g = i; }
            float se = 0.f;
#pragma unroll
            for (int i = 0; i < 4; ++i) se += __expf(gl[i] - gm);
            const float pg = 1.0f / se;
            float el[4];
#pragma unroll
            for (int i = 0; i < 4; ++i) el[i] = ((g & 1) ? acc[8 + i] : acc[4 + i]) * rstd + be[4 * g + i];
            int i1 = 0; float m1 = el[0];
#pragma unroll
            for (int i = 1; i < 4; ++i) if (el[i] > m1) { m1 = el[i]; i1 = i; }
            int i2 = -1; float m2 = -3.0e38f;
#pragma unroll
            for (int i = 0; i < 4; ++i) if (i != i1 && el[i] > m2) { m2 = el[i]; i2 = i; }
            const float e2 = __expf(m2 - m1), w1 = pg / (1.0f + e2), w2 = pg * e2 / (1.0f + e2);
            if ((g >> 1) == h2) {
                const int tok = t0 + r, tl = grp * 32 + r;
                eid[2 * tok] = 4 * g + i1; eid[2 * tok + 1] = 4 * g + i2; wgt[2 * tok] = w1; wgt[2 * tok + 1] = w2;
                s_e[2 * tl] = 4 * g + i1; s_e[2 * tl + 1] = 4 * g + i2; s_w[2 * tl] = w1; s_w[2 * tl + 1] = w2; s_rs[tl] = rstd;
            }
        }
        __syncthreads();
        if (tid < 256) s_lr[tid] = atomicAdd((int*)&lcnt[s_e[tid]], 1);
        __syncthreads();
        if (tid < 16) lbase[tid] = (int)__hip_atomic_fetch_add(F.ctl + CW_CNT + (dry ? 32 : 0) + tid, (unsigned)lcnt[tid], RLX_AGENT);
        __syncthreads();
        if (tid < 256) { const int e = s_e[tid], rk = lbase[e] + s_lr[tid], tok = blk * 128 + (tid >> 1);
            rank[2 * tok + (tid & 1)] = rk; ltok[e * NTOK + rk] = tok; lw[e * NTOK + rk] = s_w[tid]; lrs[e * NTOK + rk] = s_rs[tid >> 1]; }
    }
}

DI void expert_table(Frame& F, LAS int* pst) {
    if (F.tid == 0) { int acc = 0; for (int e = 0; e < NEXP; ++e) { pst[e] = acc; const int c = (int)__hip_atomic_load(F.ctl + CW_CNT + e, RLX_AGENT); pst[17 + e] = c; acc += (c + 255) & ~255; } pst[NEXP] = acc; }
    __syncthreads();
}

DI void ph_combine(Frame& F, const Args& a) {
    unsigned char* ws = F.ws; const int lane = F.lane;
    LAS int* pst = (LAS int*)(F.lds); expert_table(F, pst);
    const int* __restrict__ eid = (const int*)(ws + WS_ROUTE + RT_EID); const int* __restrict__ rank = (const int*)(ws + WS_ROUTE + RT_RANK); const bf16* __restrict__ YB = (const bf16*)(ws + WS_XB); bf16* __restrict__ HP = (bf16*)(ws + WS_H2);
    const bf16* __restrict__ X1 = (const bf16*)((unsigned char*)F.out + DO_X1); bf16* __restrict__ X2 = (bf16*)(ws + WS_X2);
    const int gw = F.vcu * NWAVES + F.wave, NGW = F.G * NWAVES;
    v2u cx[4], c0[4], c1[4];
#define COMB_LOAD(tk, dx, d0, d1) do { const int p0_ = pst[eid[2 * (tk)]] + rank[2 * (tk)], p1_ = pst[eid[2 * (tk) + 1]] + rank[2 * (tk) + 1]; \
        const GAS v2u* xr_ = (const GAS v2u*)(X1 + (size_t)(tk) * DM) + lane; const GAS v2u* y0_ = (const GAS v2u*)(YB + (size_t)p0_ * DM) + lane; const GAS v2u* y1_ = (const GAS v2u*)(YB + (size_t)p1_ * DM) + lane; \
        _Pragma("unroll") for (int j = 0; j < 4; ++j) { dx[j] = xr_[64 * j]; d0[j] = y0_[64 * j]; d1[j] = y1_[64 * j]; } } while (0)
    if (gw < NTOK) COMB_LOAD(gw, cx, c0, c1);
    for (int tok = gw; tok < NTOK; tok += NGW) {
        v2u nx[4], n0[4], n1[4];
        { const int tn = (tok + NGW < NTOK) ? tok + NGW : tok; COMB_LOAD(tn, nx, n0, n1); }
        const GAS f32x4* gr = (const GAS f32x4*)a.in[16] + lane; GAS v2u* xw = (GAS v2u*)(X2 + (size_t)tok * DM) + lane;
        f32x4 v[4]; float ss = 0.f;
#pragma unroll
        for (int j = 0; j < 4; ++j) {
            const v2u x0 = cx[j], a0 = c0[j], a1 = c1[j];
            v[j].x = bflo(x0.x) + bflo(a0.x) + bflo(a1.x); v[j].y = bfhi(x0.x) + bfhi(a0.x) + bfhi(a1.x); v[j].z = bflo(x0.y) + bflo(a0.y) + bflo(a1.y); v[j].w = bfhi(x0.y) + bfhi(a0.y) + bfhi(a1.y);
            v2u o; o.x = pk2(v[j].x, v[j].y); o.y = pk2(v[j].z, v[j].w); xw[64 * j] = o;
            ss += (v[j].x * v[j].x + v[j].y * v[j].y) + (v[j].z * v[j].z + v[j].w * v[j].w);
        }
        const float rstd = rsqrtf(wave_sum_dpp(ss) * (1.f / DM) + EPS);
        GAS v2u* o8 = (GAS v2u*)(HP + (size_t)tok * DM) + lane;
#pragma unroll
        for (int j = 0; j < 4; ++j) { const f32x4 g = gr[64 * j]; v2u o; o.x = pk2(v[j].x * rstd * g.x, v[j].y * rstd * g.y); o.y = pk2(v[j].z * rstd * g.z, v[j].w * rstd * g.w); o8[64 * j] = o; }
#pragma unroll
        for (int j = 0; j < 4; ++j) { cx[j] = nx[j]; c0[j] = n0[j]; c1[j] = n1[j]; }
    }
#undef COMB_LOAD
}

DI void ph_final(Frame& F, const Args& a) {
    const int lane = F.lane, gw = F.vcu * NWAVES + F.wave, NGW = F.G * NWAVES;
    f32x4 cur[4];
    if (gw < NTOK) { const GAS f32x4* xr = (const GAS f32x4*)(F.out + (size_t)gw * DM) + lane;
#pragma unroll
        for (int j = 0; j < 4; ++j) cur[j] = xr[64 * j]; }
    for (int tok = gw; tok < NTOK; tok += NGW) {
        f32x4 nxt[4];
        { const int tn = (tok + NGW < NTOK) ? tok + NGW : tok; const GAS f32x4* xn = (const GAS f32x4*)(F.out + (size_t)tn * DM) + lane;
#pragma unroll
          for (int j = 0; j < 4; ++j) nxt[j] = xn[64 * j]; }
        GAS f32x4* xr = (GAS f32x4*)(F.out + (size_t)tok * DM) + lane; const GAS f32x4* gr = (const GAS f32x4*)a.in[19] + lane;
        float ss = 0.f;
#pragma unroll
        for (int j = 0; j < 4; ++j) ss += (cur[j].x * cur[j].x + cur[j].y * cur[j].y) + (cur[j].z * cur[j].z + cur[j].w * cur[j].w);
        const float rstd = rsqrtf(wave_sum_dpp(ss) * (1.f / DM) + EPS);
#pragma unroll
        for (int j = 0; j < 4; ++j) { const f32x4 g = gr[64 * j]; xr[64 * j] = cur[j] * rstd * g; }
#pragma unroll
        for (int j = 0; j < 4; ++j) cur[j] = nxt[j];
    }
}

typedef pg8::f32x4 af4;
DI unsigned cvtpk(float lo, float hi) { typedef float f2 __attribute__((ext_vector_type(2))); typedef __bf16 b2 __attribute__((ext_vector_type(2))); f2 v = {lo, hi}; b2 b = __builtin_convertvector(v, b2); return __builtin_bit_cast(unsigned, b); }
DI v4u pack8(const float (&x)[8]) { v4u w; w.x = cvtpk(x[0], x[1]); w.y = cvtpk(x[2], x[3]); w.z = cvtpk(x[4], x[5]); w.w = cvtpk(x[6], x[7]); return w; }
DI void unpack8(const v4u w, float (&x)[8]) { x[0] = bflo(w.x); x[1] = bfhi(w.x); x[2] = bflo(w.y); x[3] = bfhi(w.y); x[4] = bflo(w.z); x[5] = bfhi(w.z); x[6] = bflo(w.w); x[7] = bfhi(w.w); }

struct EpiProj {
    static constexpr bool PERM = true, AFTER_DRAIN = false; static constexpr int MIDK = 0;
    unsigned char* ws; const float* gn;
    DI void operator()(const af4 (&acc)[2][2][4][2], const pg8::Unit& u, int wr, int wc, int fr, int fq) const {
        bf16* PROJ = (bf16*)(ws + WS_PROJ); const f32x2* tabA = (const f32x2*)(ws + WS_TABA); bf16* T = (bf16*)(ws + WS_T);
        int row0 = u.pm * 256 + wr * 64 + fr, colb = u.pn * 256 + wc * 32 + 8 * fq;
        asm volatile("" : "+v"(row0), "+v"(colb));
        const int kind = u.pn < 2 ? 0 : u.pn < 4 ? 1 : u.pn < 6 ? 2 : u.pn < 8 ? 3 : u.pn < 10 ? 4 : 5;
#pragma unroll
        for (int ai = 0; ai < 2; ++ai)
#pragma unroll
            for (int m = 0; m < 4; ++m) {
                const int row = row0 + ai * 128 + m * 16;
#pragma unroll
                for (int bj = 0; bj < 2; ++bj) {
                    const int col = colb + bj * 128;
                    const af4 a0 = acc[ai][bj][m][0], a1 = acc[ai][bj][m][1];
                    float x[8] = {a0[0], a0[1], a0[2], a0[3], a1[0], a1[1], a1[2], a1[3]};
                    if (kind <= 1) {
                        const int pos = row & (SEQ - 1), p = (col & 127) >> 1;
                        const f32x4* tp = (const f32x4*)(tabA + pos * 64 + p);
                        const f32x4 t0 = tp[0], t1 = tp[1];
                        const float sc = kind == 1 ? 0.08838834764831845f : 1.0f;
                        float y[8];
                        y[0] = (x[0] * t0.x - x[1] * t0.y) * sc; y[1] = (x[0] * t0.y + x[1] * t0.x) * sc;
                        y[2] = (x[2] * t0.z - x[3] * t0.w) * sc; y[3] = (x[2] * t0.w + x[3] * t0.z) * sc;
                        y[4] = (x[4] * t1.x - x[5] * t1.y) * sc; y[5] = (x[4] * t1.y + x[5] * t1.x) * sc;
                        y[6] = (x[6] * t1.z - x[7] * t1.w) * sc; y[7] = (x[6] * t1.w + x[7] * t1.z) * sc;
#pragma unroll
                        for (int i = 0; i < 8; ++i) x[i] = y[i];
                        if (kind == 1) {
                            const int h = (col - C_RK) >> 7;
                            const float kd = exp2f(ret_log2g(h) * (float)(63 - (pos & 63)));
                            float z[8];
#pragma unroll
                            for (int i = 0; i < 8; ++i) z[i] = y[i] * kd;
                            int frl = fr; asm volatile("" : "+v"(frl));
                            const int li = frl & 7;
#pragma unroll
                            for (int s = 4; s >= 1; s >>= 1) {
                                const bool up = (li & s) != 0;
#pragma unroll
                                for (int j = 0; j < 8; ++j) if ((j & s) == 0) {
                                    const float send = up ? z[j] : z[j | s];
                                    float recv;
                                    if (s == 1) recv = __builtin_bit_cast(float, __builtin_amdgcn_update_dpp(0, __builtin_bit_cast(int, send), 0xB1, 0xF, 0xF, true));
                                    else if (s == 2) recv = __builtin_bit_cast(float, __builtin_amdgcn_update_dpp(0, __builtin_bit_cast(int, send), 0x4E, 0xF, 0xF, true));
                                    else { const float dn = __builtin_bit_cast(float, __builtin_amdgcn_update_dpp(0, __builtin_bit_cast(int, send), 0x104, 0xF, 0xF, true));
                                           const float upv = __builtin_bit_cast(float, __builtin_amdgcn_update_dpp(0, __builtin_bit_cast(int, send), 0x114, 0xF, 0xF, true));
                                           recv = up ? upv : dn; }
                                    if (up) z[j] = recv; else z[j | s] = recv;
                                }
                            }
                            *(v4u*)(T + (size_t)(T_KT + (col - C_RK) + li) * NTOK + (row - li)) = pack8(z);
                        }
                    } else if (kind == 2) {
                        const f32x4 g0 = *(const f32x4*)(gn + (col - C_RG)), g1 = *(const f32x4*)(gn + (col - C_RG) + 4);
                        const float gg[8] = {g0.x, g0.y, g0.z, g0.w, g1.x, g1.y, g1.z, g1.w};
#pragma unroll
                        for (int i = 0; i < 8; ++i) x[i] = fsilu(x[i]) * gg[i];
                    } else if (kind == 3) {
#pragma unroll
                        for (int i = 0; i < 8; ++i) x[i] *= SB_QSCALE;
                    } else if (kind == 5) {
#pragma unroll
                        for (int i = 0; i < 8; ++i) x[i] = fsigmoid(x[i]);
                    }
                    *(v4u*)(PROJ + (size_t)row * NMAIN + col) = pack8(x);
                }
                asm volatile("" ::: "memory");
            }
    }
};
struct EpiProjT {
    static constexpr bool PERM = true, AFTER_DRAIN = false; static constexpr int MIDK = 0;
    bf16* T;
    DI void operator()(const af4 (&acc)[2][2][4][2], const pg8::Unit& u, int wr, int wc, int fr, int fq) const {
        const int f0 = T_VR + u.pm * 256 + wr * 64 + fr, tokb = u.pn * 256 + wc * 32 + 8 * fq;
#pragma unroll
        for (int ai = 0; ai < 2; ++ai)
#pragma unroll
            for (int m = 0; m < 4; ++m)
#pragma unroll
                for (int bj = 0; bj < 2; ++bj) {
                    const af4 a0 = acc[ai][bj][m][0], a1 = acc[ai][bj][m][1];
                    const float x[8] = {a0[0], a0[1], a0[2], a0[3], a1[0], a1[1], a1[2], a1[3]};
                    *(v4u*)(T + (size_t)(f0 + ai * 128 + m * 16) * NTOK + tokb + bj * 128) = pack8(x);
                }
    }
};

struct EpiBr {
    static constexpr bool PERM = true, AFTER_DRAIN = false; static constexpr int MIDK = 8;
    bf16* PROJ;
    DI void mid(af4 (&acc)[2][2][4][2], const pg8::Unit& u, int wr, int wc, int fr, int fq) const {
        int row0 = u.pm * 256 + wr * 64 + fr, colb = u.pn * 256 + wc * 32 + 8 * fq;
        asm volatile("" : "+v"(row0), "+v"(colb));
#pragma unroll
        for (int ai = 0; ai < 2; ++ai)
#pragma unroll
            for (int m = 0; m < 4; ++m) {
                const bf16* pr = PROJ + (size_t)(row0 + ai * 128 + m * 16) * NMAIN;
#pragma unroll
                for (int bj = 0; bj < 2; ++bj) {
                    const int col = colb + bj * 128;
                    float gr[8], gs[8]; unpack8(*(const v4u*)(pr + C_GR + col), gr); unpack8(*(const v4u*)(pr + C_GS + col), gs);
#pragma unroll
                    for (int i = 0; i < 4; ++i) { acc[ai][bj][m][0][i] *= gr[i] * __builtin_amdgcn_rcpf(fmaxf(gs[i], 1e-30f)); acc[ai][bj][m][1][i] *= gr[4 + i] * __builtin_amdgcn_rcpf(fmaxf(gs[4 + i], 1e-30f)); }
                }
                asm volatile("" ::: "memory");
            }
    }
    DI void operator()(const af4 (&acc)[2][2][4][2], const pg8::Unit& u, int wr, int wc, int fr, int fq) const {
        int row0 = u.pm * 256 + wr * 64 + fr, colb = u.pn * 256 + wc * 32 + 8 * fq;
        asm volatile("" : "+v"(row0), "+v"(colb));
#pragma unroll
        for (int ai = 0; ai < 2; ++ai)
#pragma unroll
            for (int m = 0; m < 4; ++m) {
                bf16* pr = PROJ + (size_t)(row0 + ai * 128 + m * 16) * NMAIN;
#pragma unroll
                for (int bj = 0; bj < 2; ++bj) {
                    const int col = colb + bj * 128;
                    const af4 a0 = acc[ai][bj][m][0], a1 = acc[ai][bj][m][1];
                    float gs[8], x[8] = {a0[0], a0[1], a0[2], a0[3], a1[0], a1[1], a1[2], a1[3]};
                    unpack8(*(const v4u*)(pr + C_GS + col), gs);
#pragma unroll
                    for (int i = 0; i < 8; ++i) x[i] *= fmaxf(gs[i], 1e-30f);
                    *(v4u*)(pr + C_MG + col) = pack8(x);
                }
            }
    }
};
struct EpiWout {
    static constexpr bool PERM = true, AFTER_DRAIN = false; static constexpr int MIDK = 0;
    const float* x; bf16* x1;
    DI void operator()(const af4 (&acc)[2][2][4][2], const pg8::Unit& u, int wr, int wc, int fr, int fq) const {
        const int row0 = u.pm * 256 + wr * 64 + fr, colb = u.pn * 256 + wc * 32 + 8 * fq;
#pragma unroll
        for (int ai = 0; ai < 2; ++ai)
#pragma unroll
            for (int m = 0; m < 4; ++m) {
                const size_t ro = (size_t)(row0 + ai * 128 + m * 16) * DM;
#pragma unroll
                for (int bj = 0; bj < 2; ++bj) {
                    const size_t o = ro + colb + bj * 128;
                    const af4 x0 = *(const af4*)(x + o) + acc[ai][bj][m][0], x1v = *(const af4*)(x + o + 4) + acc[ai][bj][m][1];
                    const float y[8] = {x0[0], x0[1], x0[2], x0[3], x1v[0], x1v[1], x1v[2], x1v[3]};
                    *(v4u*)(x1 + o) = pack8(y);
                }
            }
    }
};
struct EpiGu {
    static constexpr bool PERM = true, AFTER_DRAIN = false; static constexpr int MIDK = 0;
    bf16* HID; const float* lrs; const LAS int* pst;
    DI void operator()(const af4 (&acc)[2][2][4][2], const pg8::Unit& u, int wr, int wc, int fr, int fq) const {
        const int rl0 = wr * 64 + fr, col = u.pn * 128 + wc * 32 + 8 * fq;
        const int local0 = u.pm * 256 - pst[u.ex], cnt = pst[17 + u.ex];
        const float* rsl = lrs + (size_t)u.ex * NTOK;
#pragma unroll
        for (int ai = 0; ai < 2; ++ai)
#pragma unroll
            for (int m = 0; m < 4; ++m) {
                const int rl = rl0 + ai * 128 + m * 16, loc = local0 + rl;
                const float rs = loc < cnt ? rsl[loc] : 0.f;
                const af4 g0 = acc[ai][0][m][0] * rs, g1 = acc[ai][0][m][1] * rs, u0 = acc[ai][1][m][0] * rs, u1 = acc[ai][1][m][1] * rs;
                float x[8];
#pragma unroll
                for (int i = 0; i < 4; ++i) { x[i] = fsilu(g0[i]) * u0[i]; x[4 + i] = fsilu(g1[i]) * u1[i]; }
                *(v4u*)(HID + (size_t)(u.pm * 256 + rl) * DEXP + col) = pack8(x);
            }
    }
};
struct EpiDown {
    static constexpr bool PERM = true, AFTER_DRAIN = false; static constexpr int MIDK = 0;
    bf16* YB; const float* lw; const LAS int* pst;
    DI void operator()(const af4 (&acc)[2][2][4][2], const pg8::Unit& u, int wr, int wc, int fr, int fq) const {
        const int rl0 = wr * 64 + fr, colb = u.pn * 256 + wc * 32 + 8 * fq;
        const int local0 = u.pm * 256 - pst[u.ex], cnt = pst[17 + u.ex];
        const float* wl = lw + (size_t)u.ex * NTOK;
#pragma unroll
        for (int ai = 0; ai < 2; ++ai)
#pragma unroll
            for (int m = 0; m < 4; ++m) {
                const int rl = rl0 + ai * 128 + m * 16, loc = local0 + rl; const float w = loc < cnt ? wl[loc] : 0.f;
#pragma unroll
                for (int bj = 0; bj < 2; ++bj) {
                    const af4 a0 = acc[ai][bj][m][0] * w, a1 = acc[ai][bj][m][1] * w;
                    const float x[8] = {a0[0], a0[1], a0[2], a0[3], a1[0], a1[1], a1[2], a1[3]};
                    *(v4u*)(YB + (size_t)(u.pm * 256 + rl) * DM + colb + bj * 128) = pack8(x);
                }
            }
    }
};
struct EpiPe {
    static constexpr bool PERM = true, AFTER_DRAIN = false; static constexpr int MIDK = 0;
    bf16* PE;
    DI void operator()(const af4 (&acc)[2][2][4][2], const pg8::Unit& u, int wr, int wc, int fr, int fq) const {
        const int row0 = u.pm * 256 + wr * 64 + fr, colb = u.pn * 256 + wc * 32 + 8 * fq;
#pragma unroll
        for (int ai = 0; ai < 2; ++ai)
#pragma unroll
            for (int m = 0; m < 4; ++m)
#pragma unroll
                for (int bj = 0; bj < 2; ++bj) {
                    const af4 a0 = acc[ai][bj][m][0], a1 = acc[ai][bj][m][1];
                    const float x[8] = {a0[0], a0[1], a0[2], a0[3], a1[0], a1[1], a1[2], a1[3]};
                    *(v4u*)(PE + (size_t)(row0 + ai * 128 + m * 16) * DM + colb + bj * 128) = pack8(x);
                }
    }
};
struct EpiPg {
    static constexpr bool PERM = true, AFTER_DRAIN = false; static constexpr int MIDK = 0;
    const bf16* PE; const bf16* x2; float* out;
    DI void operator()(const af4 (&acc)[2][2][4][2], const pg8::Unit& u, int wr, int wc, int fr, int fq) const {
        const int row0 = u.pm * 256 + wr * 64 + fr, colb = u.pn * 256 + wc * 32 + 8 * fq;
#pragma unroll
        for (int ai = 0; ai < 2; ++ai)
#pragma unroll
            for (int m = 0; m < 4; ++m) {
                const size_t ro = (size_t)(row0 + ai * 128 + m * 16) * DM;
#pragma unroll
                for (int bj = 0; bj < 2; ++bj) {
                    const size_t o = ro + colb + bj * 128;
                    float pe[8]; unpack8(*(const v4u*)(PE + o), pe);
                    const af4 a0 = acc[ai][bj][m][0], a1 = acc[ai][bj][m][1];
                    float xr[8]; unpack8(*(const v4u*)(x2 + o), xr);
                    af4 x0 = {xr[0], xr[1], xr[2], xr[3]}, x1 = {xr[4], xr[5], xr[6], xr[7]};
#pragma unroll
                    for (int i = 0; i < 4; ++i) { x0[i] += fsigmoid(a0[i]) * pe[i]; x1[i] += fsigmoid(a1[i]) * pe[4 + i]; }
                    *(af4*)(out + o) = x0; *(af4*)(out + o + 4) = x1;
                }
                asm volatile("" ::: "memory");
            }
    }
};

template <bool GATH> struct MoeOrder {
    static constexpr bool GATHER = GATH;
    const LAS int* pst; int G, c; size_t estride, tstepB; const int* ltok; unsigned rowbytes;
    DI bool next(int i, pg8::Unit& u) const {
        const int L = i * G + c, rt = L >> 2; if (rt * 256 >= pst[NEXP]) return false;
        int ex = 0;
#pragma unroll
        for (int e = 1; e < NEXP; ++e) ex += (rt * 256 >= pst[e]) ? 1 : 0;
        u.pm = rt; u.pn = L & 3; u.ex = ex; u.bofs = (size_t)ex * estride + (size_t)u.pn * tstepB; return true;
    }
    DI unsigned arow_off(const pg8::Unit& u, int row) const { const int loc = u.pm * 256 - pst[u.ex] + row; const int tok = loc < pst[17 + u.ex] ? ltok[(size_t)u.ex * NTOK + loc] : 0; return (unsigned)tok * rowbytes; }
    DI void a_ready(const pg8::Unit&) const {}
    DI void done(const pg8::Unit&) const {}
};

struct TailOrder {
    static constexpr bool GATHER = false;
    int G, c, c0, nunits; size_t tstepB;
    DI bool next(int i, pg8::Unit& u) const { if (c < c0) return false; const int L = i * (G - c0) + (c - c0); if (L >= nunits) return false; u.pm = L >> 2; u.pn = L & 3; u.bofs = (size_t)u.pn * tstepB; u.ex = 0; return true; }
    DI unsigned arow_off(const pg8::Unit&, int) const { return 0u; }
    DI void a_ready(const pg8::Unit&) const {}
    DI void done(const pg8::Unit&) const {}
};
#ifndef PG8_ALIGN
#define PG8_ALIGN true
#endif
#define GEMM_PHASE(EPI, ORD, g, S, E) pg8::gemm_phase<EPI, ORD, PG8_ALIGN, true>(F.lds + RING_OFF, g, S, E)

DI void fast_proj(Frame& F, const Args& a) {
    unsigned char* ws = F.ws; const bf16* HB = (const bf16*)((unsigned char*)F.out + DO_HB); const bf16* WIN = (const bf16*)(ws + WS_WIN);
    { pg8::Gemm g{HB, WIN, DM, DM}; pg8::StaticOrder S; S.init(NTOK, NMAIN, DM, F.G, (int)blockIdx.x);
      EpiProj E{ws, a.in[4]}; GEMM_PHASE(EpiProj, pg8::StaticOrder, g, S, E); }
    { pg8::Gemm g{WIN + (size_t)(NMAIN + 512) * DM, HB, DM, DM}; pg8::StaticOrder S; S.init(1024, NTOK, DM, F.G, (int)blockIdx.x);
      EpiProjT E{(bf16*)(ws + WS_T)}; GEMM_PHASE(EpiProjT, pg8::StaticOrder, g, S, E); }
}
DI void fast_br(Frame& F, const Args& a) {
    unsigned char* ws = F.ws; bf16* PROJ = (bf16*)(ws + WS_PROJ); const bf16* RS = (const bf16*)((unsigned char*)F.out + DO_RS);
    pg8::StaticOrder S; S.init(NTOK, DM, DM, F.G, (int)blockIdx.x);
    pg8::Gemm g{RS, (const bf16*)(ws + WS_WBR1), DM, DM}; EpiBr E{PROJ}; GEMM_PHASE(EpiBr, pg8::StaticOrder, g, S, E);
}
DI void fast_wout(Frame& F, const Args& a) {
    unsigned char* ws = F.ws;
    pg8::Gemm g{(const bf16*)(ws + WS_PROJ) + C_MG, (const bf16*)(ws + WS_WOUT), NMAIN, DM}; pg8::StaticOrder S; S.init(NTOK, DM, DM, F.G, (int)blockIdx.x);
    EpiWout E{F.x, (bf16*)((unsigned char*)F.out + DO_X1)}; GEMM_PHASE(EpiWout, pg8::StaticOrder, g, S, E);
}
DI void fast_gu(Frame& F, const Args& a) {
    LAS int* pst = (LAS int*)(F.lds + LDSCTL_OFF);
    expert_table(F, pst);
    unsigned char* ws = F.ws;
    pg8::Gemm g{(const bf16*)((unsigned char*)F.out + DO_X1), (const bf16*)(ws + WS_WGU), DM, DM};
    MoeOrder<true> S{pst, F.G, F.vcu, (size_t)1024 * 1024 * 2, (size_t)256 * DM * 2, (const int*)(ws + WS_LTOK), (unsigned)(DM * 2)};
    EpiGu E{(bf16*)(ws + WS_HID), (const float*)(ws + WS_LRS), pst}; GEMM_PHASE(EpiGu, MoeOrder<true>, g, S, E);
    { int k256 = 256; asm volatile("" : "+s"(k256));
      const int nun = pst[NEXP] >> 6;
      pg8::Gemm g2{(const bf16*)(ws + WS_PB), (const bf16*)(ws + WS_WPLE), 256, k256};
      const int nbusy = nun % F.G;
      TailOrder S2{F.G, F.vcu, (F.G - nbusy >= 128) ? nbusy : 0, (NTOK / 256) * 4, (size_t)256 * k256 * 2};
      EpiPe E2{(bf16*)(ws + WS_PE)}; GEMM_PHASE(EpiPe, TailOrder, g2, S2, E2); }
}
DI void fast_down(Frame& F, const Args& a) {
    LAS int* pst = (LAS int*)(F.lds + LDSCTL_OFF);
    expert_table(F, pst);
    unsigned char* ws = F.ws;
    pg8::Gemm g{(const bf16*)(ws + WS_HID), (const bf16*)(ws + WS_WD), DEXP, DEXP};
    MoeOrder<false> S{pst, F.G, F.vcu, (size_t)1024 * 512 * 2, (size_t)256 * DEXP * 2, nullptr, 0u};
    EpiDown E{(bf16*)(ws + WS_XB), (const float*)(ws + WS_LW), pst}; GEMM_PHASE(EpiDown, MoeOrder<false>, g, S, E);
}
DI void fast_ple(Frame& F, const Args& a) {
    unsigned char* ws = F.ws;
    pg8::Gemm g{(const bf16*)(ws + WS_H2), (const bf16*)(ws + WS_WPG), DM, DM}; pg8::StaticOrder S; S.init(NTOK, DM, DM, F.G, (int)blockIdx.x);
    EpiPg E{(const bf16*)(ws + WS_PE), (const bf16*)(ws + WS_X2), F.out}; GEMM_PHASE(EpiPg, pg8::StaticOrder, g, S, E);
}

template <int S> DI bf16x8 pack_step(const f32x16& x) { v4u p; p.x = cvtpk(x[8 * S], x[8 * S + 1]); p.y = cvtpk(x[8 * S + 2], x[8 * S + 3]); p.z = cvtpk(x[8 * S + 4], x[8 * S + 5]); p.w = cvtpk(x[8 * S + 6], x[8 * S + 7]); return __builtin_bit_cast(bf16x8, p); }


#define SCHED_FENCE() __builtin_amdgcn_sched_barrier(0)
DI void fast_ret_kv(Frame& F, const Args& a) {
    const bf16* __restrict__ T = (const bf16*)(F.ws + WS_T); bf16* __restrict__ ST = (bf16*)((unsigned char*)F.out + DO_ST);
    const int lane = F.lane, r = lane & 31, h2 = lane >> 5, gw = F.vcu * NWAVES + F.wave, NGW = F.G * NWAVES;
    for (int it = gw; it < NBATCH * 4 * 64 * 4; it += NGW) {
        const int eb = it & 3, c = (it >> 2) & 63, hh = (it >> 8) & 3, b = it >> 10;
        const int tok0 = b * SEQ + c * 64;
        const bf16* vrow = T + (size_t)(T_VR + hh * 128 + eb * 32 + r) * NTOK + tok0 + 8 * h2;
        const bf16* krow = T + (size_t)(T_KT + hh * 128 + r) * NTOK + tok0 + 8 * h2;
        bf16x8 vb[4], ka[4][4];
#pragma unroll
        for (int ks = 0; ks < 4; ++ks) vb[ks] = ld16(vrow + 16 * ks);
#pragma unroll
        for (int db = 0; db < 4; ++db)
#pragma unroll
            for (int ks = 0; ks < 4; ++ks) ka[db][ks] = ld16(krow + (size_t)db * 32 * NTOK + 16 * ks);
        SCHED_FENCE();
        bf16* st = ST + ((size_t)((b * 4 + hh) * 64 + c)) * 16384 + (size_t)(eb * 32 + r) * 128 + 4 * h2;
#pragma unroll
        for (int db = 0; db < 4; ++db) {
            f32x16 acc = splat16(0.f);
#pragma unroll
            for (int ks = 0; ks < 4; ++ks) acc = MFMA32(ka[db][ks], vb[ks], acc);
#pragma unroll
            for (int g = 0; g < 4; ++g) { v2u w; w.x = cvtpk(acc[4 * g], acc[4 * g + 1]); w.y = cvtpk(acc[4 * g + 2], acc[4 * g + 3]); *(v2u*)(st + db * 32 + 8 * g) = w; }
        }
    }
}
DI void fast_ret_scan(Frame& F, const Args& a) {
    bf16* ST = (bf16*)((unsigned char*)F.out + DO_ST);
    for (int g = F.vcu * 512 + F.tid; g < NBATCH * 4 * 4096; g += F.G * 512) {
        const int bh = g >> 12, idx = (g & 4095) * 4;
        const float cdec = exp2f(ret_log2g(bh & 3) * 64.0f);
        bf16* p = ST + (size_t)bh * 64 * 16384 + idx;
        float s0 = 0.f, s1 = 0.f, s2 = 0.f, s3 = 0.f;
#pragma unroll 8
        for (int c = 0; c < 64; ++c) {
            const v2u w = *(const v2u*)(p + (size_t)c * 16384);
            v2u o; o.x = cvtpk(s0, s1); o.y = cvtpk(s2, s3); *(v2u*)(p + (size_t)c * 16384) = o;
            s0 = cdec * s0 + bflo(w.x); s1 = cdec * s1 + bfhi(w.x); s2 = cdec * s2 + bflo(w.y); s3 = cdec * s3 + bfhi(w.y);
        }
    }
}
DI void fast_ret_out(Frame& F, const Args& a) {
    const bf16* __restrict__ PROJ = (const bf16*)(F.ws + WS_PROJ); const bf16* __restrict__ T = (const bf16*)(F.ws + WS_T);
    const bf16* __restrict__ ST = (const bf16*)((unsigned char*)F.out + DO_ST); bf16* __restrict__ RS = (bf16*)((unsigned char*)F.out + DO_RS);
    const int lane = F.lane, r = lane & 31, h2 = lane >> 5, gw = F.vcu * NWAVES + F.wave, NGW = F.G * NWAVES;
    for (int it = gw; it < NBATCH * 4 * 64 * 2; it += NGW) {
        const int ib = it & 1, c = (it >> 1) & 63, hh = (it >> 7) & 3, b = it >> 9;
        const int tok0 = b * SEQ + c * 64;
        const float l2g = ret_log2g(hh);
        const bf16* qrow = PROJ + (size_t)(tok0 + ib * 32 + r) * NMAIN + C_RQ + hh * 128 + 8 * h2;
        const bf16* krow = PROJ + (size_t)(tok0 + r) * NMAIN + C_RK + hh * 128 + 8 * h2;
        const bf16* stb = ST + ((size_t)((b * 4 + hh) * 64 + c)) * 16384 + (size_t)r * 128 + 8 * h2;
        const bf16* vrow = T + (size_t)(T_VR + hh * 128 + r) * NTOK + tok0 + 4 * h2;
        const bf16* gp = PROJ + (size_t)(tok0 + ib * 32 + r) * NMAIN + C_RG + hh * 128 + 4 * h2;
        bf16x8 qf[8], kf0[8], kf1[8], sA[8], sB[8], vA[4], vB[4];
#define LD_ST(dst, eb) do { _Pragma("unroll") for (int ks = 0; ks < 8; ++ks) dst[ks] = ld16(stb + (size_t)(eb) * 32 * 128 + 16 * ks); } while (0)
#define LD_VT(dst, eb) do { const bf16* vr_ = vrow + (size_t)(eb) * 32 * NTOK; dst[0] = ld8x2(vr_, vr_ + 8); dst[1] = ld8x2(vr_ + 16, vr_ + 24); dst[2] = ld8x2(vr_ + 32, vr_ + 40); dst[3] = ld8x2(vr_ + 48, vr_ + 56); } while (0)
#define RET_EB(oacc, sfr, vfr) do { f32x16 acc_ = splat16(0.f); \
            _Pragma("unroll") for (int ks = 0; ks < 8; ++ks) acc_ = MFMA32(sfr[ks], qf[ks], acc_);         \
            _Pragma("unroll") for (int reg = 0; reg < 16; ++reg) acc_[reg] *= qd; \
            acc_ = MFMA32(vfr[0], pb[0][0], acc_); acc_ = MFMA32(vfr[1], pb[0][1], acc_); acc_ = MFMA32(vfr[2], pb[1][0], acc_); acc_ = MFMA32(vfr[3], pb[1][1], acc_); oacc = acc_; } while (0)
#pragma unroll
        for (int ks = 0; ks < 8; ++ks) qf[ks] = ld16(qrow + 16 * ks);
#pragma unroll
        for (int ks = 0; ks < 8; ++ks) { kf0[ks] = ld16(krow + 16 * ks); kf1[ks] = ld16(krow + (size_t)32 * NMAIN + 16 * ks); }
        LD_ST(sA, 0); LD_VT(vA, 0);
        SCHED_FENCE();
        f32x16 pt0 = splat16(0.f), pt1 = splat16(0.f);
#pragma unroll
        for (int ks = 0; ks < 8; ++ks) { pt0 = MFMA32(kf0[ks], qf[ks], pt0); pt1 = MFMA32(kf1[ks], qf[ks], pt1); }
        LD_ST(sB, 1); LD_VT(vB, 1);
        SCHED_FENCE();
        bf16x8 pb[2][2];
#pragma unroll
        for (int reg = 0; reg < 16; ++reg) {
            const int d0 = (ib * 32 + r) - crow(reg, h2), d1 = d0 - 32;
            pt0[reg] *= __builtin_amdgcn_exp2f(l2g * (float)(d0 < 0 ? -d0 : d0)); pt1[reg] *= __builtin_amdgcn_exp2f(l2g * (float)(d1 < 0 ? -d1 : d1));
        }
        pb[0][0] = pack_step<0>(pt0); pb[0][1] = pack_step<1>(pt0); pb[1][0] = pack_step<0>(pt1); pb[1][1] = pack_step<1>(pt1);
        const float qd = __builtin_amdgcn_exp2f(l2g * (float)(ib * 32 + r + 1));
        f32x16 o[4];
        RET_EB(o[0], sA, vA);
        LD_ST(sA, 2); LD_VT(vA, 2);
        SCHED_FENCE();
        RET_EB(o[1], sB, vB);
        LD_ST(sB, 3); LD_VT(vB, 3);
        SCHED_FENCE();
        RET_EB(o[2], sA, vA);
        v2u gate[16];
#pragma unroll
        for (int q = 0; q < 16; ++q) gate[q] = *(const v2u*)(gp + (q >> 2) * 32 + 8 * (q & 3));
        SCHED_FENCE();
        RET_EB(o[3], sB, vB);
#undef LD_ST
#undef LD_VT
#undef RET_EB
        float s = 0.f;
#pragma unroll
        for (int eb = 0; eb < 4; ++eb)
#pragma unroll
            for (int reg = 0; reg < 16; ++reg) s += o[eb][reg];
        s += __shfl_xor(s, 32);
        const float mu = s * (1.0f / 128.0f); float v = 0.f;
#pragma unroll
        for (int eb = 0; eb < 4; ++eb)
#pragma unroll
            for (int reg = 0; reg < 16; ++reg) { const float d = o[eb][reg] - mu; v += d * d; }
        v += __shfl_xor(v, 32);
        const float rstd = rsqrtf(v * (1.0f / 128.0f) + EPS);
        bf16* rp = RS + (size_t)(tok0 + ib * 32 + r) * DM + hh * 128 + 4 * h2;
#pragma unroll
        for (int eb = 0; eb < 4; ++eb)
#pragma unroll
            for (int g = 0; g < 4; ++g) {
                const v2u gt = gate[eb * 4 + g];
                v2u w;
                w.x = cvtpk((o[eb][4 * g] - mu) * rstd * bflo(gt.x), (o[eb][4 * g + 1] - mu) * rstd * bfhi(gt.x));
                w.y = cvtpk((o[eb][4 * g + 2] - mu) * rstd * bflo(gt.y), (o[eb][4 * g + 3] - mu) * rstd * bfhi(gt.y));
                *(v2u*)(rp + eb * 32 + 8 * g) = w;
            }
    }
}

DI void fast_att(Frame& F, const Args& a) {
    const bf16* __restrict__ PROJ = (const bf16*)(F.ws + WS_PROJ); const bf16* __restrict__ T = (const bf16*)(F.ws + WS_T); bf16* __restrict__ RS = (bf16*)((unsigned char*)F.out + DO_RS);
    const int lane = F.lane, r = lane & 31, h2 = lane >> 5, gw = F.vcu * NWAVES + F.wave, NGW = F.G * NWAVES;
    bf16x8 tri0, tri1, ones;
#pragma unroll
    for (int j = 0; j < 8; ++j) { const int k0 = 8 * (j >> 2) + 4 * h2 + (j & 3); tri0[j] = (k0 > r) ? (short)0x3F80 : (short)0; tri1[j] = (16 + k0 > r) ? (short)0x3F80 : (short)0; ones[j] = (short)0x3F80; }
    for (int it = gw; it < NBATCH * 8 * 128; it += NGW) {
        const int qb = it & 127, hh = (it >> 7) & 7, b = it >> 10;
        const int q0 = qb * 32, tokq = b * SEQ + q0 + r;
        const bf16* qrow = PROJ + (size_t)tokq * NMAIN + C_SQ + hh * 64 + 8 * h2;
        const bf16* kbase = PROJ + (size_t)(b * SEQ + r) * NMAIN + C_SK + hh * 64 + 8 * h2;
        const bf16* vbase = T + (size_t)(T_VS + hh * 64 + r) * NTOK + b * SEQ + 4 * h2;
        const int ktd = q0 >> 6;
        bf16x8 qf[4], kA[8], vB[8];
#pragma unroll
        for (int ks = 0; ks < 4; ++ks) qf[ks] = ld16(qrow + 16 * ks);
#pragma unroll
        for (int ks = 0; ks < 4; ++ks) { kA[ks] = ld16(kbase + (size_t)(ktd * 64) * NMAIN + 16 * ks); kA[4 + ks] = ld16(kbase + (size_t)(ktd * 64 + 32) * NMAIN + 16 * ks); }
        f32x16 o0 = splat16(0.f), o1 = splat16(0.f);
        float carry = 0.f;
        for (int kt = ktd; kt >= 0; --kt) {
            const int key0 = kt * 64;
            const bool diag = (kt == ktd);
            {
                const bf16* v0row = vbase + key0; const bf16* v1row = v0row + (size_t)32 * NTOK;
#pragma unroll
                for (int q = 0; q < 4; ++q) { vB[q] = ld8x2(v0row + 16 * q, v0row + 16 * q + 8); vB[4 + q] = ld8x2(v1row + 16 * q, v1row + 16 * q + 8); }
            }
            SCHED_FENCE();
            f32x16 p0 = splat16(0.f), p1 = splat16(0.f);
#pragma unroll
            for (int ks = 0; ks < 4; ++ks) { p0 = MFMA32(kA[ks], qf[ks], p0); p1 = MFMA32(kA[4 + ks], qf[ks], p1); }
            {
                const int kn = (kt > 0 ? kt - 1 : 0) * 64;
#pragma unroll
                for (int ks = 0; ks < 4; ++ks) { kA[ks] = ld16(kbase + (size_t)kn * NMAIN + 16 * ks); kA[4 + ks] = ld16(kbase + (size_t)(kn + 32) * NMAIN + 16 * ks); }
            }
            SCHED_FENCE();
            f32x16 l0, l1;
#pragma unroll
            for (int reg = 0; reg < 16; ++reg) {
                const float z0 = fminf(p0[reg], 100.0f), z1 = fminf(p1[reg], 100.0f);
                float a0 = -__builtin_amdgcn_logf(1.0f + __builtin_amdgcn_exp2f(z0)), a1 = -__builtin_amdgcn_logf(1.0f + __builtin_amdgcn_exp2f(z1));
                float b0 = z0 + a0, b1 = z1 + a1;
                if (diag) {
                    const bool v0 = (key0 + crow(reg, h2)) < (q0 + r), v1 = (key0 + 32 + crow(reg, h2)) < (q0 + r);
                    a0 = v0 ? a0 : 0.f; b0 = v0 ? b0 : -1.0e30f; a1 = v1 ? a1 : 0.f; b1 = v1 ? b1 : -1.0e30f;
                }
                l0[reg] = a0; l1[reg] = a1; p0[reg] = b0; p1[reg] = b1;
            }
            f32x16 y0 = splat16(carry), y1 = y0;
            {
                const bf16x8 x00 = pack_step<0>(l0), x01 = pack_step<1>(l0), x10 = pack_step<0>(l1), x11 = pack_step<1>(l1);
                y0 = MFMA32(tri0, x00, y0); y0 = MFMA32(tri1, x01, y0); y0 = MFMA32(ones, x10, y0); y0 = MFMA32(ones, x11, y0);
                y1 = MFMA32(tri0, x10, y1); y1 = MFMA32(tri1, x11, y1);
            }
            const float tot = y0[0] + l0[0];
            carry = __shfl(tot, r);
#pragma unroll
            for (int reg = 0; reg < 16; ++reg) { p0[reg] = __builtin_amdgcn_exp2f(p0[reg] + y0[reg]); p1[reg] = __builtin_amdgcn_exp2f(p1[reg] + y1[reg]); }
            {
                const bf16x8 a00 = pack_step<0>(p0), a01 = pack_step<1>(p0), a10 = pack_step<0>(p1), a11 = pack_step<1>(p1);
                o0 = MFMA32(vB[0], a00, o0); o0 = MFMA32(vB[1], a01, o0); o0 = MFMA32(vB[2], a10, o0); o0 = MFMA32(vB[3], a11, o0);
                o1 = MFMA32(vB[4], a00, o1); o1 = MFMA32(vB[5], a01, o1); o1 = MFMA32(vB[6], a10, o1); o1 = MFMA32(vB[7], a11, o1);
            }
            if (__all(carry < SB_EXIT)) break;
        }
        bf16* op = RS + (size_t)tokq * DM + 512 + hh * 64 + 4 * h2;
#pragma unroll
        for (int g = 0; g < 4; ++g) {
            v2u w; w.x = cvtpk(o0[4 * g], o0[4 * g + 1]); w.y = cvtpk(o0[4 * g + 2], o0[4 * g + 3]); *(v2u*)(op + 8 * g) = w;
            v2u u; u.x = cvtpk(o1[4 * g], o1[4 * g + 1]); u.y = cvtpk(o1[4 * g + 2], o1[4 * g + 3]); *(v2u*)(op + 32 + 8 * g) = u;
        }
    }
}

__global__ void __launch_bounds__(NWAVES * 64, 2) mega(Args args) {
    extern __shared__ __attribute__((aligned(16))) unsigned char lds[];
    Frame F;
    F.lds = (LAS unsigned char*)lds;
    F.MISC = (volatile LAS unsigned*)(F.lds + MISC_OFF);
    F.refresh();
    F.G = gridDim.x; { const int bx = blockIdx.x; F.vcu = (F.G % 8 == 0) ? (bx % 8) * (F.G / 8) + bx / 8 : bx; }
    F.ws = args.ws; F.out = args.out; F.x = args.in[0]; F.p = args.in[1];
    F.ctl = (gu32*)(args.ws + WS_CTL);
    for (int u = F.tid; u < (LDS_BYTES - LDSCTL_OFF) / 4; u += NWAVES * 64) ((LAS unsigned*)(F.lds + LDSCTL_OFF))[u] = 0u;
    __syncthreads();
    const int lo = args.ph_lo, hi = args.ph_hi;
    XcdBarrier bar; bar.bar = (unsigned*)(F.ctl + CW_BAR) + args.li * BAR_STRIDE; bar.x = 0; bar.st = nullptr;
    if (hi - lo > 1) bar = xcd_barrier_post((unsigned*)(F.ctl + CW_BAR) + args.li * BAR_STRIDE, F.MISC + 8);
#define IN(k) (F.refresh(), lo <= (k) && (k) < hi)
#define DUP(k) ((DUP_MASK >> (k)) & 1)
#define SEAM(k) do { if (IN(k) && IN((k) + 1)) xcd_barrier(bar); } while (0)
#define REP(k, body) do { body; if (DUP(k)) { F.refresh(); body; } } while (0)

    if (DUP(16) && hi - lo > 1) { for (int i = 0; i < 10; ++i) xcd_barrier(bar); }
    if (IN(PH_PRO)) { REP(PH_PRO, ph_prologue(F, args)); } SEAM(PH_PRO);
    if (IN(PH_PROJ)) { REP(PH_PROJ, fast_proj(F, args)); } SEAM(PH_PROJ);
    if (IN(PH_MIX1)) { REP(14, fast_ret_kv(F, args)); REP(15, fast_att(F, args)); } SEAM(PH_MIX1);
    if (IN(PH_SCAN)) { fast_ret_scan(F, args); } SEAM(PH_SCAN);
    if (IN(PH_RETO)) { REP(PH_RETO, fast_ret_out(F, args)); } SEAM(PH_RETO);
    if (IN(PH_BR)) { REP(PH_BR, fast_br(F, args)); } SEAM(PH_BR);
    if (IN(PH_WOUT)) { REP(PH_WOUT, fast_wout(F, args)); } SEAM(PH_WOUT);
    if (IN(PH_ROUTE)) { ph_route(F, args); if (DUP(PH_ROUTE)) { F.refresh(); ph_route(F, args, 1); } } SEAM(PH_ROUTE);
    if (IN(PH_GU)) { REP(PH_GU, fast_gu(F, args)); } SEAM(PH_GU);
    if (IN(PH_DOWN)) { REP(PH_DOWN, fast_down(F, args)); } SEAM(PH_DOWN);
    if (IN(PH_COMB)) { REP(PH_COMB, ph_combine(F, args)); } SEAM(PH_COMB);
    if (IN(PH_PLE)) { REP(PH_PLE, fast_ple(F, args)); } SEAM(PH_PLE);
    if (IN(PH_FINAL)) { ph_final(F, args); }
#undef IN
#undef SEAM
}

extern "C" void kernel_launch(void* const* d_in, const int* in_sizes, int n_in, void* d_out, int out_size, void* d_ws, size_t ws_size, hipStream_t stream) {
    static int grid = 0;
    if (grid == 0) {
        if (n_in != 20 || in_sizes[0] != NTOK * DM || out_size != NTOK * DM || ws_size < WS_END) { fprintf(stderr, "kernel_launch: unexpected shapes (n_in %d, in0 %d, out %d, ws %zu)\n", n_in, n_in > 0 ? in_sizes[0] : -1, out_size, ws_size); grid = -1; return; }
        int dev = 0, cus = 0, per_cu = 0;
        if (hipGetDevice(&dev) != hipSuccess || hipDeviceGetAttribute(&cus, hipDeviceAttributeMultiprocessorCount, dev) != hipSuccess) { grid = -1; return; }
        if (hipFuncSetAttribute((const void*)mega, hipFuncAttributeMaxDynamicSharedMemorySize, LDS_BYTES) != hipSuccess) { fprintf(stderr, "kernel_launch: hipFuncSetAttribute failed\n"); grid = -1; return; }
        if (hipOccupancyMaxActiveBlocksPerMultiprocessor(&per_cu, (const void*)mega, NWAVES * 64, LDS_BYTES) != hipSuccess || per_cu < 1) fprintf(stderr, "kernel_launch: occupancy query reports %d\n", per_cu);
        (void)hipGetLastError();
        grid = cus;
    }
    if (grid < 0) return;
    unsigned char* ws = (unsigned char*)d_ws;
    if (hipMemsetAsync(ws + WS_CTL, 0, CTL_ZERO_BYTES, stream) != hipSuccess) return;
    Args a{};
    for (int i = 0; i < 20; ++i) a.in[i] = (const float*)d_in[i];
    a.out = (float*)d_out; a.ws = ws;
#if SPLIT_PHASES
    for (int p = 0; p < NPH; ++p) { a.ph_lo = p; a.ph_hi = p + 1; a.li = 0; hipLaunchKernelGGL(mega, dim3(grid), dim3(NWAVES * 64), LDS_BYTES, stream, a); }
#else
    a.ph_lo = 0; a.ph_hi = NPH; a.li = 0;
    hipLaunchKernelGGL(mega, dim3(grid), dim3(NWAVES * 64), LDS_BYTES, stream, a);
#endif
}
```
